# Optimizing an MI355X kernel written in HIP

```python
import jax, jax.numpy as jnp
from jax import lax
import numpy as np

D_MODEL = 1024
BATCH = 8
SEQ = 2048
DEPTH = 4

HEAD_DIM = 64
SB_HEADS = 8
SB_WIDTH = SB_HEADS * HEAD_DIM
POOL_WINDOWS = (2, 4, 8, 16)
POOL_WIDTH = D_MODEL // 2
POOL_GROUP = POOL_WIDTH // len(POOL_WINDOWS)
EVEN_IN = 3 * SB_WIDTH + POOL_WIDTH
EVEN_MIX = SB_WIDTH + POOL_WIDTH
MOBA_HEADS = D_MODEL // HEAD_DIM
MOBA_WIDTH = MOBA_HEADS * HEAD_DIM
MOBA_BLOCK = 256
MOBA_TOPK = 3
MOBA_QCHUNK = 16
Q_BLOCK = 128
D_FF = 2816
N_EVEN = (DEPTH + 1) // 2
N_ODD = DEPTH // 2
RMS_EPS = 1e-6

kernel_name = "hybrid_stickbreak_pool_moba_macaron"


def rmsnorm(x, g):
    xf = x.astype(jnp.float32)
    y = xf * lax.rsqrt(jnp.mean(xf * xf, axis=-1, keepdims=True) + RMS_EPS)
    return (y * g.astype(jnp.float32)).astype(x.dtype)


def swiglu(h, w_gate, w_up, w_down):
    return (jax.nn.silu(h @ w_gate) * (h @ w_up)) @ w_down


def split_heads(t, n):
    b, s, _ = t.shape
    return t.reshape(b, s, n, HEAD_DIM).transpose(0, 2, 1, 3)


def merge_heads(t):
    b, h, s, dh = t.shape
    return t.transpose(0, 2, 1, 3).reshape(b, s, h * dh)


def alibi_slopes(n):
    return jnp.asarray(2.0 ** (-8.0 * np.arange(1, n + 1) / n), dtype=jnp.float32)


def stick_breaking_attention(q, k, v):
    s_len = q.shape[2]
    scale = HEAD_DIM ** -0.5
    outs = []
    for i in range(s_len // Q_BLOCK):
        q0 = i * Q_BLOCK
        kv_len = q0 + Q_BLOCK
        qb = q[:, :, q0:kv_len]
        kb = k[:, :, :kv_len]
        vb = v[:, :, :kv_len]
        z = jnp.einsum('bhtd,bhsd->bhts', qb, kb).astype(jnp.float32) * scale
        tpos = q0 + jnp.arange(Q_BLOCK)[:, None]
        spos = jnp.arange(kv_len)[None, :]
        past = spos < tpos
        log_1m = jnp.where(past, jax.nn.log_sigmoid(-z), 0.0)
        later = lax.cumsum(log_1m, axis=3, reverse=True) - log_1m
        a = jnp.where(past, jnp.exp(jax.nn.log_sigmoid(z) + later), 0.0)
        outs.append(jnp.einsum('bhts,bhsd->bhtd', a.astype(v.dtype), vb))
    return jnp.concatenate(outs, axis=2)


def multiscale_pool(u, w_pool, pool_scale):
    b, s, _ = u.shape
    uf = u.astype(jnp.float32)
    cs = jnp.concatenate([jnp.zeros((b, 1, POOL_WIDTH), jnp.float32), jnp.cumsum(uf, axis=1)], axis=1)
    t = jnp.arange(s)
    groups = []
    for g, w in enumerate(POOL_WINDOWS):
        sl = slice(g * POOL_GROUP, (g + 1) * POOL_GROUP)
        start = jnp.maximum(t + 1 - w, 0)
        win_sum = cs[:, 1:, sl] - cs[:, start, sl]
        count = jnp.minimum(t + 1, w).astype(jnp.float32)[None, :, None]
        groups.append(win_sum / count - uf[:, :, sl])
    pooled = jnp.stack(groups, axis=2).astype(u.dtype)
    mixed = jnp.einsum('bsgc,gcd->bsgd', pooled, w_pool).reshape(b, s, POOL_WIDTH)
    return mixed * pool_scale


def moba_attention(q, k, v):
    b, h, s, dh = q.shape
    nb = -(-s // MOBA_BLOCK)
    pad = nb * MOBA_BLOCK - s
    kp = jnp.pad(k, ((0, 0), (0, 0), (0, pad), (0, 0)))
    vp = jnp.pad(v, ((0, 0), (0, 0), (0, pad), (0, 0)))
    k_blocks = kp.reshape(b, h, nb, MOBA_BLOCK, dh)
    v_blocks = vp.reshape(b, h, nb, MOBA_BLOCK, dh)
    k_mean = jnp.mean(k_blocks.astype(jnp.float32), axis=3).astype(k.dtype)
    gate = jnp.einsum('bhtd,bhnd->bhtn', q, k_mean).astype(jnp.float32)
    qblk_all = jnp.arange(s) // MOBA_BLOCK
    past_blk = jnp.arange(nb)[None, :] < qblk_all[:, None]
    gate = jnp.where(past_blk, gate, -jnp.inf)
    topk = min(MOBA_TOPK, nb)
    _, sel = lax.top_k(gate, topk)
    scale = dh ** -0.5
    slopes = alibi_slopes(h)
    bi = jnp.arange(b)[:, None, None, None]
    hi = jnp.arange(h)[None, :, None, None]

    def chunk(c):
        t0 = c * MOBA_QCHUNK
        qc = lax.dynamic_slice_in_dim(q, t0, MOBA_QCHUNK, axis=2)
        sel_c = lax.dynamic_slice_in_dim(sel, t0, MOBA_QCHUNK, axis=2)
        tq = t0 + jnp.arange(MOBA_QCHUNK)
        blk0 = (t0 // MOBA_BLOCK) * MOBA_BLOCK
        k_own = lax.dynamic_slice_in_dim(kp, blk0, MOBA_BLOCK, axis=2)
        v_own = lax.dynamic_slice_in_dim(vp, blk0, MOBA_BLOCK, axis=2)
        own_pos = blk0 + jnp.arange(MOBA_BLOCK)
        k_sel = k_blocks[bi, hi, sel_c]
        v_sel = v_blocks[bi, hi, sel_c]
        sel_pos = sel_c[..., None] * MOBA_BLOCK + jnp.arange(MOBA_BLOCK)
        sel_ok = (sel_c < (tq // MOBA_BLOCK)[:, None])[..., None]
        d_own = (tq[:, None] - own_pos[None, :]).astype(jnp.float32)
        s_own = (jnp.einsum('bhtd,bhsd->bhts', qc, k_own).astype(jnp.float32) * scale
                 - slopes[None, :, None, None] * d_own)
        s_own = jnp.where(own_pos[None, :] <= tq[:, None], s_own, -jnp.inf)
        d_sel = (tq[:, None, None] - sel_pos).astype(jnp.float32)
        s_sel = (jnp.einsum('bhtd,bhtksd->bhtks', qc, k_sel).astype(jnp.float32) * scale
                 - slopes[None, :, None, None, None] * d_sel)
        s_sel = jnp.where(sel_ok, s_sel, -jnp.inf).reshape(b, h, MOBA_QCHUNK, topk * MOBA_BLOCK)
        p = jax.nn.softmax(jnp.concatenate([s_own, s_sel], axis=-1), axis=-1)
        p_own = p[..., :MOBA_BLOCK].astype(v.dtype)
        p_sel = p[..., MOBA_BLOCK:].reshape(b, h, MOBA_QCHUNK, topk, MOBA_BLOCK).astype(v.dtype)
        return (jnp.einsum('bhts,bhsd->bhtd', p_own, v_own)
                + jnp.einsum('bhtks,bhtksd->bhtd', p_sel, v_sel))

    outs = lax.map(chunk, jnp.arange(s // MOBA_QCHUNK))
    return outs.transpose(1, 2, 0, 3, 4).reshape(b, h, s, dh)


def even_mixer(h, w_in, w_pool, pool_scale, w_out):
    proj = h @ w_in
    q, k, v, u = jnp.split(proj, [SB_WIDTH, 2 * SB_WIDTH, 3 * SB_WIDTH], axis=-1)
    a = stick_breaking_attention(split_heads(q, SB_HEADS), split_heads(k, SB_HEADS), split_heads(v, SB_HEADS))
    p = multiscale_pool(u, w_pool, pool_scale)
    return jnp.concatenate([merge_heads(a), p], axis=-1) @ w_out


def odd_mixer(h, w_qkv, w_o):
    q, k, v = jnp.split(h @ w_qkv, 3, axis=-1)
    o = moba_attention(split_heads(q, MOBA_HEADS), split_heads(k, MOBA_HEADS), split_heads(v, MOBA_HEADS))
    return merge_heads(o) @ w_o


def setup_inputs(seed: int = 0) -> dict:
    key = jax.random.key(seed)
    ks = jax.random.split(key, 20)
    f32 = jnp.float32

    def w(k, shape, fan_in):
        return jax.random.normal(k, shape, f32) * (fan_in ** -0.5)

    def gain(k, shape):
        return 1.0 + 0.05 * jax.random.normal(k, shape, f32)

    return {
        "x": jax.random.normal(ks[0], (BATCH, SEQ, D_MODEL), f32),
        "norm_ffn1": gain(ks[1], (DEPTH, D_MODEL)),
        "ffn1_gate": w(ks[2], (DEPTH, D_MODEL, D_FF), D_MODEL),
        "ffn1_up": w(ks[3], (DEPTH, D_MODEL, D_FF), D_MODEL),
        "ffn1_down": w(ks[4], (DEPTH, D_FF, D_MODEL), D_FF),
        "norm_mix": gain(ks[5], (DEPTH, D_MODEL)),
        "norm_ffn2": gain(ks[6], (DEPTH, D_MODEL)),
        "ffn2_gate": w(ks[7], (DEPTH, D_MODEL, D_FF), D_MODEL),
        "ffn2_up": w(ks[8], (DEPTH, D_MODEL, D_FF), D_MODEL),
        "ffn2_down": w(ks[9], (DEPTH, D_FF, D_MODEL), D_FF),
        "even_w_in": w(ks[10], (N_EVEN, D_MODEL, EVEN_IN), D_MODEL),
        "even_w_pool": w(ks[11], (N_EVEN, len(POOL_WINDOWS), POOL_GROUP, POOL_GROUP), POOL_GROUP),
        "even_pool_scale": gain(ks[12], (N_EVEN, POOL_WIDTH)),
        "even_w_out": w(ks[13], (N_EVEN, EVEN_MIX, D_MODEL), EVEN_MIX),
        "odd_w_qkv": w(ks[14], (N_ODD, D_MODEL, 3 * MOBA_WIDTH), D_MODEL),
        "odd_w_o": w(ks[15], (N_ODD, MOBA_WIDTH, D_MODEL), MOBA_WIDTH),
        "norm_final": gain(ks[16], (D_MODEL,)),
    }


def reference(x, norm_ffn1, ffn1_gate, ffn1_up, ffn1_down, norm_mix, norm_ffn2,
              ffn2_gate, ffn2_up, ffn2_down, even_w_in, even_w_pool, even_pool_scale,
              even_w_out, odd_w_qkv, odd_w_o, norm_final):
    for layer in range(DEPTH):
        x = x + 0.5 * swiglu(rmsnorm(x, norm_ffn1[layer]), ffn1_gate[layer], ffn1_up[layer], ffn1_down[layer])
        h = rmsnorm(x, norm_mix[layer])
        i = layer // 2
        if layer % 2 == 0:
            x = x + even_mixer(h, even_w_in[i], even_w_pool[i], even_pool_scale[i], even_w_out[i])
        else:
            x = x + odd_mixer(h, odd_w_qkv[i], odd_w_o[i])
        x = x + 0.5 * swiglu(rmsnorm(x, norm_ffn2[layer]), ffn2_gate[layer], ffn2_up[layer], ffn2_down[layer])
    return rmsnorm(x, norm_final)
```

```cpp
#include <hip/hip_runtime.h>
#include <cstdio>
#include <cstdint>
#define LAS __attribute__((address_space(3)))
#define GAS __attribute__((address_space(1)))
#ifndef MK_N_LAUNCHES
#define MK_N_LAUNCHES 1
#endif
namespace pg8 {
#define PG8_LAS __attribute__((address_space(3)))
typedef unsigned short bf16_t;
typedef short bf16x8 __attribute__((ext_vector_type(8)));
typedef float f32x4 __attribute__((ext_vector_type(4)));
typedef unsigned u32x4 __attribute__((ext_vector_type(4)));
constexpr int BM = 256, BK = 64, HALF = 128, HTB = HALF * BK * 2  , STAGE_BYTES = 8 * HTB, NXCD = 8, WGM = 8;

__host__ __device__ __forceinline__ int lds_byte(int r, int c) { const int st = (r >> 4) * 2 + (c >> 5), rr = r & 15, cc = c & 31, ob = rr * 64 + cc * 2; return st * 1024 + (ob ^ (((ob >> 9) & 1) << 5)); }
__host__ __device__ __forceinline__ void stage_rc(int b, int& R, int& C) { const int st = b / 1024, sb = b % 1024, swz = sb ^ (((sb >> 9) & 1) << 5); R = (st >> 1) * 16 + swz / 64; C = (st & 1) * 32 + (swz % 64) / 2; }
__host__ __device__ __forceinline__ int perm32(int rho) { const int n = rho >> 4, i = rho & 15; return 8 * (i >> 2) + 4 * n + (i & 3); }

struct Unit { int pm, pn; };
struct Gemm { const bf16_t* A; const bf16_t* Bt; int M, N, K; };

struct StaticOrder {
    int nM, nN, nwg, G, c;
    __host__ __device__ void init(int M, int N, int G_, int c_) { nM = M / BM; nN = N / BM; nwg = nM * nN; G = G_; c = c_; }
    __host__ __device__ bool next(int i, Unit& u) const {
        const long L = (long)i * G + c; if (L >= nwg) return false;
        int wgid = (int)L; { const int q = nwg / NXCD, r = nwg % NXCD, xcd = wgid % NXCD, off = wgid / NXCD; wgid = (xcd < r ? xcd * (q + 1) : r * (q + 1) + (xcd - r) * q) + off; }
        const int nig = WGM * nN, gid = wgid / nig, fm = gid * WGM, gsz = (nM - fm) < WGM ? (nM - fm) : WGM;
        u.pm = fm + ((wgid % nig) % gsz); u.pn = (wgid % nig) / gsz; return true;
    }
    __device__ __forceinline__ void a_ready(const Unit&) const {}
    __device__ __forceinline__ void done(const Unit&) const {}
};

__device__ __forceinline__ unsigned cvt_pk_bf16(float lo, float hi) { unsigned r; asm volatile("v_cvt_pk_bf16_f32 %0, %1, %2" : "=v"(r) : "v"(lo), "v"(hi)); return r; }
typedef float f32x2 __attribute__((ext_vector_type(2)));
__device__ __forceinline__ float row_rstd(const float* SS, int row, int fq) {
    const f32x4 v = *(const f32x4*)(SS + (size_t)row * 16 + 4 * fq);
    float s = (v[0] + v[1]) + (v[2] + v[3]);
    s += __shfl_xor(s, 16); s += __shfl_xor(s, 32);
    return __builtin_amdgcn_rsqf(s * (1.0f / 1024.0f) + 1e-6f);
}
__device__ __forceinline__ void row_rstd8(const float* SS, int row0, int fq, float (&r8)[8]) {
    f32x4 sv[8];
#pragma unroll
    for (int k = 0; k < 8; ++k) sv[k] = *(const f32x4*)(SS + (size_t)(row0 + (k >> 2) * HALF + (k & 3) * 16) * 16 + 4 * fq);
#pragma unroll
    for (int k = 0; k < 8; ++k) { float s = (sv[k][0] + sv[k][1]) + (sv[k][2] + sv[k][3]); s += __shfl_xor(s, 16); s += __shfl_xor(s, 32); r8[k] = __builtin_amdgcn_rsqf(s * (1.0f / 1024.0f) + 1e-6f); }
}
template <int VARIANT = 0> struct EpiGU_ {
    static constexpr bool PERM = true, AFTER_DRAIN = false;
    bf16_t* H; const float* SS;
    __device__ __forceinline__ void operator()(const f32x4 (&acc)[2][2][4][2], const Unit& u, int wr, int wc, int fr, int fq) const {
        if (VARIANT == 1) {
#pragma unroll
            for (int ai = 0; ai < 2; ++ai)
#pragma unroll
                for (int bj = 0; bj < 2; ++bj)
                    asm volatile("" :: "v"(acc[ai][bj][0][0]), "v"(acc[ai][bj][0][1]), "v"(acc[ai][bj][1][0]), "v"(acc[ai][bj][1][1]), "v"(acc[ai][bj][2][0]), "v"(acc[ai][bj][2][1]), "v"(acc[ai][bj][3][0]), "v"(acc[ai][bj][3][1]));
            return; }
        const int row0 = u.pm * BM + wr * 64 + fr, col0 = u.pn * 128 + wc * 32 + 8 * fq;
        float r8[8]; row_rstd8(SS, row0, fq, r8);
#pragma unroll
        for (int ai = 0; ai < 2; ++ai)
#pragma unroll
            for (int m = 0; m < 4; ++m) {
                const int row = row0 + ai * HALF + m * 16;
                const float r = r8[ai * 4 + m], rn = r * -1.4426950408889634f, r2 = r * r;
                float hv[8], ev[8], pv8[8];
#pragma unroll
                for (int k = 0; k < 8; ++k) ev[k] = __builtin_amdgcn_exp2f(acc[ai][0][m][k >> 2][k & 3] * rn);
#pragma unroll
                for (int k = 0; k < 8; ++k) pv8[k] = acc[ai][0][m][k >> 2][k & 3] * acc[ai][1][m][k >> 2][k & 3];
#pragma unroll
                for (int k = 0; k < 8; ++k) ev[k] = __builtin_amdgcn_rcpf(1.0f + ev[k]);
#pragma unroll
                for (int k = 0; k < 8; ++k) hv[k] = pv8[k] * (ev[k] * r2);
                u32x4 w; w.x = cvt_pk_bf16(hv[0], hv[1]); w.y = cvt_pk_bf16(hv[2], hv[3]); w.z = cvt_pk_bf16(hv[4], hv[5]); w.w = cvt_pk_bf16(hv[6], hv[7]);
                if (VARIANT == 2) { asm volatile("" :: "v"(w)); } else *(u32x4*)(H + (size_t)row * 2816 + col0) = w;
            }
    }
};
typedef EpiGU_<0> EpiGU;
struct EpiRes {
    static constexpr bool PERM = true, AFTER_DRAIN = false;
    const float* base; float* out; bf16_t* XB; float* SS; float alpha;
    __device__ __forceinline__ void operator()(const f32x4 (&acc)[2][2][4][2], const Unit& u, int wr, int wc, int fr, int fq) const {
        const int row0 = u.pm * BM + wr * 64 + fr, col0 = u.pn * BM + wc * 32 + 8 * fq;
#pragma unroll
        for (int ai = 0; ai < 2; ++ai) {
            f32x4 bv[4][2][2];
#pragma unroll
            for (int m = 0; m < 4; ++m)
#pragma unroll
                for (int bj = 0; bj < 2; ++bj) { const size_t off = (size_t)(row0 + ai * HALF + m * 16) * 1024 + col0 + bj * HALF; bv[m][bj][0] = *(const f32x4*)(base + off); bv[m][bj][1] = *(const f32x4*)(base + off + 4); }
#pragma unroll
            for (int m = 0; m < 4; ++m) {
                const int row = row0 + ai * HALF + m * 16; const size_t off = (size_t)row * 1024 + col0;
                float s = 0.f;
#pragma unroll
                for (int bj = 0; bj < 2; ++bj) {
                    const f32x4 v0 = bv[m][bj][0] + acc[ai][bj][m][0] * alpha, v1 = bv[m][bj][1] + acc[ai][bj][m][1] * alpha;
                    *(f32x4*)(out + off + bj * HALF) = v0; *(f32x4*)(out + off + bj * HALF + 4) = v1;
                    u32x4 w; w.x = cvt_pk_bf16(v0[0], v0[1]); w.y = cvt_pk_bf16(v0[2], v0[3]); w.z = cvt_pk_bf16(v1[0], v1[1]); w.w = cvt_pk_bf16(v1[2], v1[3]);
                    *(u32x4*)(XB + off + bj * HALF) = w;
                    s += (v0[0] * v0[0] + v0[1] * v0[1]) + (v0[2] * v0[2] + v0[3] * v0[3]) + (v1[0] * v1[0] + v1[1] * v1[1]) + (v1[2] * v1[2] + v1[3] * v1[3]);
                }
                s += __shfl_xor(s, 16); s += __shfl_xor(s, 32);
                if (fq == 0) SS[(size_t)row * 16 + u.pn * 4 + wc] = s;
            }
        }
    }
};
struct EpiQKV {
    static constexpr bool PERM = true, AFTER_DRAIN = false;
    bf16_t* O; int ldc; const float* SS; int nq_tiles; float qscale; float* KMP; int k_lo, k_hi;
    __device__ __forceinline__ void operator()(const f32x4 (&acc)[2][2][4][2], const Unit& u, int wr, int wc, int fr, int fq) const {
        const int row0 = u.pm * BM + wr * 64 + fr, col0 = u.pn * BM + wc * 32 + 8 * fq;
        const float sc = (u.pn < nq_tiles) ? qscale : 1.0f;
        float r8[8]; row_rstd8(SS, row0, fq, r8);
#pragma unroll
        for (int ai = 0; ai < 2; ++ai)
#pragma unroll
            for (int m = 0; m < 4; ++m) {
                const int row = row0 + ai * HALF + m * 16;
                const float r = r8[ai * 4 + m] * sc;
                bf16_t* rowp = O + (size_t)row * ldc + col0;
#pragma unroll
                for (int bj = 0; bj < 2; ++bj) {
                    const f32x4 v0 = acc[ai][bj][m][0] * r, v1 = acc[ai][bj][m][1] * r;
                    u32x4 w; w.x = cvt_pk_bf16(v0[0], v0[1]); w.y = cvt_pk_bf16(v0[2], v0[3]); w.z = cvt_pk_bf16(v1[0], v1[1]); w.w = cvt_pk_bf16(v1[2], v1[3]);
                    *(u32x4*)(rowp + bj * HALF) = w;
                }
            }
        if (KMP != nullptr && u.pn >= k_lo && u.pn < k_hi) {
            float* dst = KMP + ((size_t)u.pm * 2 + wr) * 1024 + (u.pn - k_lo) * BM + wc * 32 + 8 * fq;
#pragma unroll
            for (int bj = 0; bj < 2; ++bj)
#pragma unroll
                for (int n = 0; n < 2; ++n) {
                    f32x4 cs = {0.f, 0.f, 0.f, 0.f};
#pragma unroll
                    for (int ai = 0; ai < 2; ++ai)
#pragma unroll
                        for (int m = 0; m < 4; ++m) cs += acc[ai][bj][m][n] * r8[ai * 4 + m];
#pragma unroll
                    for (int i = 0; i < 4; ++i) { float c = cs[i]; c += __shfl_xor(c, 1); c += __shfl_xor(c, 2); c += __shfl_xor(c, 4); c += __shfl_xor(c, 8); cs[i] = c; }
                    if (fr == 0) *(f32x4*)(dst + bj * HALF + 4 * n) = cs;
                }
        }
    }
};
template <class Epi, class Sched, bool ALIGN_EPI = false, bool SP2 = false>
__device__ __forceinline__ void gemm_phase(PG8_LAS unsigned char* lds, const Gemm g, const Sched& S, const Epi& E) {
    int tid = threadIdx.x; asm volatile("" : "+v"(tid));
    const int wid = __builtin_amdgcn_readfirstlane(tid >> 6), lane = tid & 63, wr = wid >> 2, wc = wid & 3, fr = lane & 15, fq = lane >> 4;
    const int K = g.K, nt = K / BK;
    unsigned voffA[2], voffB[2];
#pragma unroll
    for (int i = 0; i < 2; ++i) { int R, C; stage_rc(tid * 16 + i * 8192, R, C); const int Rb = Epi::PERM ? ((R & ~31) + perm32(R & 31)) : R;
        voffA[i] = (unsigned)(R * K + C) * 2u; voffB[i] = (unsigned)(Rb * K + C) * 2u; }
    const size_t kstep = (size_t)(BK * 2);
    const size_t hstep = (size_t)HALF * K * 2;
    const size_t tstep = 2 * hstep;
    const unsigned ldsw = (unsigned)wid * 1024u;
    const int aoff = lds_byte(wr * 64 + fr, fq * 8), boff = lds_byte(wc * 32 + fr, fq * 8);
#define PG8_SA(b, h) (((b) * 2 + (h)) * HTB)
#define PG8_SB(b, h) ((4 + (b) * 2 + (h)) * HTB)
#define PG8_STAGE(bufoff, gbase, voff) do { _Pragma("unroll") for (int _i = 0; _i < 2; ++_i) \
        __builtin_amdgcn_global_load_lds((const unsigned*)((const char*)(gbase) + (voff)[_i]), (PG8_LAS unsigned*)(lds + (bufoff) + ldsw + _i * 8192), 16, 0, 0); } while (0)
#define PG8_LDA(dst, b, h) do { _Pragma("unroll") for (int m = 0; m < 4; ++m) _Pragma("unroll") for (int k = 0; k < 2; ++k) dst[m][k] = *(const PG8_LAS bf16x8*)(lds + PG8_SA(b, h) + aoff + m * 2048 + k * 1024); } while (0)
#define PG8_LDB(dst, b, h) do { _Pragma("unroll") for (int n = 0; n < 2; ++n) _Pragma("unroll") for (int k = 0; k < 2; ++k) dst[n][k] = *(const PG8_LAS bf16x8*)(lds + PG8_SB(b, h) + boff + n * 2048 + k * 1024); } while (0)
#define PG8_MMA(ai, bj, At, Bt) do { __builtin_amdgcn_s_setprio(1); _Pragma("unroll") for (int m = 0; m < 4; ++m) _Pragma("unroll") for (int n = 0; n < 2; ++n) _Pragma("unroll") for (int k = 0; k < 2; ++k) \
        acc[ai][bj][m][n] = __builtin_amdgcn_mfma_f32_16x16x32_bf16(Bt[n][k], At[m][k], acc[ai][bj][m][n], 0, 0, 0); __builtin_amdgcn_s_setprio(0); } while (0)
#define PG8_WAIT_V(n) asm volatile("s_waitcnt vmcnt(" #n ")" ::: "memory")
#define PG8_WAIT_L(n) asm volatile("s_waitcnt lgkmcnt(" #n ")" ::: "memory")
#define PG8_BAR __builtin_amdgcn_s_barrier()
#define PG8_SCHED __builtin_amdgcn_sched_barrier(0)
    Unit cur, nxt; int ui = 0;
    if (!S.next(0, cur)) return;
    f32x4 acc[2][2][4][2];
#pragma unroll
    for (int a = 0; a < 2; ++a)
#pragma unroll
        for (int b = 0; b < 2; ++b)
#pragma unroll
            for (int m = 0; m < 4; ++m)
#pragma unroll
                for (int n = 0; n < 2; ++n) acc[a][b][m][n] = (f32x4){0.f, 0.f, 0.f, 0.f};
    bf16x8 At[4][2], B0[2][2], B1[2][2];
    const char* cA = (const char*)g.A + (size_t)cur.pm * tstep; const char* cB = (const char*)g.Bt + (size_t)cur.pn * tstep;
    S.a_ready(cur);
    if constexpr (SP2) {
        PG8_STAGE(PG8_SB(0, 0), cB, voffB); PG8_STAGE(PG8_SB(0, 1), cB + hstep, voffB); PG8_STAGE(PG8_SA(0, 0), cA, voffA); PG8_STAGE(PG8_SA(0, 1), cA + hstep, voffA);
        if (wr == 1) PG8_BAR;
        PG8_WAIT_V(2); PG8_BAR;
        PG8_STAGE(PG8_SB(1, 0), cB + kstep, voffB); PG8_STAGE(PG8_SA(1, 0), cA + kstep, voffA); PG8_STAGE(PG8_SB(1, 1), cB + hstep + kstep, voffB);
        PG8_WAIT_V(6); PG8_BAR;
    } else {
        PG8_STAGE(PG8_SB(0, 0), cB, voffB); PG8_STAGE(PG8_SA(0, 0), cA, voffA); PG8_STAGE(PG8_SB(0, 1), cB + hstep, voffB); PG8_STAGE(PG8_SA(0, 1), cA + hstep, voffA);
        if (wr == 1) PG8_BAR;
        PG8_WAIT_V(4); PG8_BAR;
        PG8_STAGE(PG8_SB(1, 0), cB + kstep, voffB); PG8_STAGE(PG8_SA(1, 0), cA + kstep, voffA); PG8_STAGE(PG8_SB(1, 1), cB + hstep + kstep, voffB);
        PG8_WAIT_V(6); PG8_BAR;
    }
    for (;;) {
        const bool has_next = S.next(ui + 1, nxt);
        const char* nA = has_next ? (const char*)g.A + (size_t)nxt.pm * tstep : cA; const char* nB = has_next ? (const char*)g.Bt + (size_t)nxt.pn * tstep : cB;
        for (int t = 0; t < nt; t += 2) {
            const bool last = (t == nt - 2);
            const char* a1 = cA + (size_t)(t + 1) * kstep;
            const char* a2 = last ? nA : cA + (size_t)(t + 2) * kstep; const char* b2 = last ? nB : cB + (size_t)(t + 2) * kstep;
            const char* a3 = a2 + kstep; const char* b3 = b2 + kstep;
            if (last && has_next) S.a_ready(nxt);
            if constexpr (SP2) {
            PG8_LDB(B0, 0, 0); PG8_LDB(B1, 0, 1); PG8_SCHED; PG8_LDA(At, 0, 0); PG8_STAGE(PG8_SA(1, 1), a1 + hstep, voffA);
            PG8_WAIT_V(8); PG8_WAIT_L(0); PG8_BAR; PG8_MMA(0, 0, At, B0); PG8_MMA(0, 1, At, B1); PG8_BAR; PG8_SCHED;
            PG8_LDA(At, 0, 1); PG8_STAGE(PG8_SB(0, 0), b2, voffB); PG8_STAGE(PG8_SB(0, 1), b2 + hstep, voffB); PG8_STAGE(PG8_SA(0, 0), a2, voffA);
            PG8_WAIT_V(8); PG8_WAIT_L(0); PG8_BAR; PG8_MMA(1, 0, At, B0); PG8_MMA(1, 1, At, B1); PG8_BAR; PG8_SCHED;
            PG8_LDB(B0, 1, 0); PG8_LDB(B1, 1, 1); PG8_SCHED; PG8_LDA(At, 1, 0); PG8_STAGE(PG8_SA(0, 1), a2 + hstep, voffA);
            PG8_WAIT_V(8); PG8_WAIT_L(0); PG8_BAR; PG8_MMA(0, 0, At, B0); PG8_MMA(0, 1, At, B1); PG8_BAR; PG8_SCHED;
            PG8_LDA(At, 1, 1); PG8_STAGE(PG8_SB(1, 0), b3, voffB); PG8_STAGE(PG8_SB(1, 1), b3 + hstep, voffB); PG8_STAGE(PG8_SA(1, 0), a3, voffA);
            PG8_WAIT_V(8); PG8_WAIT_L(0); PG8_BAR; PG8_MMA(1, 0, At, B0); PG8_MMA(1, 1, At, B1); PG8_BAR; PG8_SCHED;
            } else {
            PG8_LDB(B0, 0, 0); PG8_SCHED; PG8_LDA(At, 0, 0); PG8_STAGE(PG8_SA(1, 1), a1 + hstep, voffA);
            PG8_WAIT_L(8); PG8_BAR; PG8_WAIT_L(0); PG8_MMA(0, 0, At, B0); PG8_BAR; PG8_SCHED;
            PG8_LDB(B1, 0, 1); PG8_STAGE(PG8_SB(0, 0), b2, voffB);
            PG8_BAR; PG8_WAIT_L(0); PG8_MMA(0, 1, At, B1); PG8_BAR;
            PG8_LDA(At, 0, 1); PG8_STAGE(PG8_SA(0, 0), a2, voffA);
            PG8_BAR; PG8_WAIT_L(0); PG8_MMA(1, 0, At, B0); PG8_BAR; PG8_SCHED;
            PG8_STAGE(PG8_SB(0, 1), b2 + hstep, voffB);
            PG8_WAIT_V(6); PG8_BAR; PG8_MMA(1, 1, At, B1); PG8_BAR;
            PG8_LDB(B0, 1, 0); PG8_SCHED; PG8_LDA(At, 1, 0); PG8_STAGE(PG8_SA(0, 1), a2 + hstep, voffA);
            PG8_WAIT_L(8); PG8_BAR; PG8_WAIT_L(0); PG8_MMA(0, 0, At, B0); PG8_BAR; PG8_SCHED;
            PG8_LDB(B1, 1, 1); PG8_STAGE(PG8_SB(1, 0), b3, voffB);
            PG8_BAR; PG8_WAIT_L(0); PG8_MMA(0, 1, At, B1); PG8_BAR;
            PG8_LDA(At, 1, 1); PG8_STAGE(PG8_SA(1, 0), a3, voffA);
            PG8_BAR; PG8_WAIT_L(0); PG8_MMA(1, 0, At, B0); PG8_BAR; PG8_SCHED;
            PG8_STAGE(PG8_SB(1, 1), b3 + hstep, voffB);
            PG8_WAIT_V(6); PG8_BAR; PG8_MMA(1, 1, At, B1); PG8_BAR;
            }
        }
        if constexpr (ALIGN_EPI) { if (wr == 0) PG8_BAR; }
        if constexpr (!Epi::AFTER_DRAIN) { E(acc, cur, wr, wc, fr, fq); S.done(cur); }
        if (!has_next) break;
#pragma unroll
        for (int a = 0; a < 2; ++a)
#pragma unroll
            for (int b = 0; b < 2; ++b)
#pragma unroll
                for (int m = 0; m < 4; ++m)
#pragma unroll
                    for (int n = 0; n < 2; ++n) acc[a][b][m][n] = (f32x4){0.f, 0.f, 0.f, 0.f};
        cur = nxt; cA = nA; cB = nB; ++ui;
        if constexpr (ALIGN_EPI) { if (wr == 1) PG8_BAR; }
    }
    PG8_WAIT_V(0);
    if constexpr (!ALIGN_EPI) { if (wr == 0) PG8_BAR; }
    PG8_BAR;
    if constexpr (Epi::AFTER_DRAIN) { E.fused(acc, cur, wr, wc, fr, fq, lds, wid, lane); S.done(cur); }
#undef PG8_SA
#undef PG8_SB
#undef PG8_STAGE
#undef PG8_LDA
#undef PG8_LDB
#undef PG8_MMA
#undef PG8_WAIT_V
#undef PG8_WAIT_L
#undef PG8_BAR
#undef PG8_SCHED
}
}
namespace att {
typedef short bf16x8 __attribute__((ext_vector_type(8)));
typedef short s16x4 __attribute__((ext_vector_type(4)));
typedef float f32x16 __attribute__((ext_vector_type(16)));
typedef float f32x4 __attribute__((ext_vector_type(4)));
typedef unsigned u32x4 __attribute__((ext_vector_type(4)));
typedef int int4v __attribute__((ext_vector_type(4)));
typedef unsigned short bf16_t;
constexpr int SEQ = 2048, OPITCH = 1024;
constexpr int SLOTB = 8192, NSLOT = 4;
constexpr int LDS_K = 0, LDS_V = NSLOT * SLOTB, LDS_WS = 2 * NSLOT * SLOTB, LDS_OST = LDS_WS + 8 * 256, LDS_KMT = LDS_OST + 8 * 4096, LDS_END = LDS_KMT + 8 * 64 * 4;
typedef LAS const char* lds_cptr;
#define ATT_SBAR() __builtin_amdgcn_sched_barrier(0)
#define ATT_WAIT_BAR(N) asm volatile("s_waitcnt vmcnt(" #N ") lgkmcnt(0)\n\ts_barrier" ::: "memory")
__device__ __forceinline__ int crow(int r, int hi) { return (r & 3) + 8 * (r >> 2) + 4 * hi; }
__device__ __forceinline__ void glds16(const void* gsrc, unsigned lds_dst) { unsigned keep;
    asm volatile("s_mov_b32 %0, m0\n\ts_mov_b32 m0, %2\n\ts_nop 0\n\tglobal_load_lds_dwordx4 %1, off\n\ts_mov_b32 m0, %0" : "=&s"(keep) : "v"(gsrc), "s"(lds_dst) : "memory"); }
typedef float f32x2_t __attribute__((ext_vector_type(2))); typedef __bf16 bf16x2_t __attribute__((ext_vector_type(2)));
__device__ __forceinline__ unsigned cvtpk(float lo, float hi) { f32x2_t v = {lo, hi}; bf16x2_t b = __builtin_convertvector(v, bf16x2_t); return __builtin_bit_cast(unsigned, b); }
__device__ __forceinline__ float bf2f(short s) { return __builtin_bit_cast(float, (unsigned)(unsigned short)s << 16); }
__device__ __forceinline__ float partner(float x, int hi) {
    auto rr = __builtin_amdgcn_permlane32_swap(__builtin_bit_cast(unsigned, x), __builtin_bit_cast(unsigned, x), false, false);
    return __builtin_bit_cast(float, hi ? rr[0] : rr[1]);
}
typedef short v4i16_t __attribute__((ext_vector_type(4)));
__device__ __forceinline__ s16x4 vtr(lds_cptr p) { return __builtin_bit_cast(s16x4, __builtin_amdgcn_ds_read_tr16_b64_v4i16((LAS v4i16_t*)p)); }
__device__ __forceinline__ void vload16(s16x4* vlo, s16x4* vhi, lds_cptr vp) {
#pragma unroll
    for (int i = 0; i < 8; ++i) { vlo[i] = vtr(vp + ((i >> 2) * 4096 + (i & 3) * 1024)); vhi[i] = vtr(vp + ((i >> 2) * 4096 + (i & 3) * 1024 + 512)); }
}
__device__ __forceinline__ void pv_r(f32x16* o, const s16x4* vlo, const s16x4* vhi, bf16x8 pa0, bf16x8 pa1, bf16x8 pa2, bf16x8 pa3) {
#define ATT_VF(i) (bf16x8){vlo[i][0], vlo[i][1], vlo[i][2], vlo[i][3], vhi[i][0], vhi[i][1], vhi[i][2], vhi[i][3]}
    o[0] = __builtin_amdgcn_mfma_f32_32x32x16_bf16(pa0, ATT_VF(0), o[0], 0, 0, 0); o[1] = __builtin_amdgcn_mfma_f32_32x32x16_bf16(pa0, ATT_VF(4), o[1], 0, 0, 0);
    o[0] = __builtin_amdgcn_mfma_f32_32x32x16_bf16(pa1, ATT_VF(1), o[0], 0, 0, 0); o[1] = __builtin_amdgcn_mfma_f32_32x32x16_bf16(pa1, ATT_VF(5), o[1], 0, 0, 0);
    o[0] = __builtin_amdgcn_mfma_f32_32x32x16_bf16(pa2, ATT_VF(2), o[0], 0, 0, 0); o[1] = __builtin_amdgcn_mfma_f32_32x32x16_bf16(pa2, ATT_VF(6), o[1], 0, 0, 0);
    o[0] = __builtin_amdgcn_mfma_f32_32x32x16_bf16(pa3, ATT_VF(3), o[0], 0, 0, 0); o[1] = __builtin_amdgcn_mfma_f32_32x32x16_bf16(pa3, ATT_VF(7), o[1], 0, 0, 0);
#undef ATT_VF
}
__device__ __forceinline__ void qkt(f32x16& p0, f32x16& p1, lds_cptr kb, const bf16x8* qr) {
    const f32x16 z = {};
#pragma unroll
    for (int d0 = 0; d0 < 4; ++d0) {
        const bf16x8 b0 = *(const LAS bf16x8*)(kb + d0 * 2048);
        const bf16x8 b1 = *(const LAS bf16x8*)(kb + d0 * 2048 + 512);
        if (d0 == 0) { p0 = __builtin_amdgcn_mfma_f32_32x32x16_bf16(b0, qr[0], z, 0, 0, 0); p1 = __builtin_amdgcn_mfma_f32_32x32x16_bf16(b1, qr[0], z, 0, 0, 0); }
        else { p0 = __builtin_amdgcn_mfma_f32_32x32x16_bf16(b0, qr[d0], p0, 0, 0, 0); p1 = __builtin_amdgcn_mfma_f32_32x32x16_bf16(b1, qr[d0], p1, 0, 0, 0); }
    }
}
__device__ __forceinline__ void qkt_aug(f32x16& p0, f32x16& p1, lds_cptr kb, const bf16x8* qr, const f32x16& c, bf16x8 kaug0, bf16x8 kaug1, bf16x8 qaug) {
    p0 = __builtin_amdgcn_mfma_f32_32x32x16_bf16(kaug0, qaug, c, 0, 0, 0); p1 = __builtin_amdgcn_mfma_f32_32x32x16_bf16(kaug1, qaug, c, 0, 0, 0);
#pragma unroll
    for (int d0 = 0; d0 < 4; ++d0) {
        const bf16x8 b0 = *(const LAS bf16x8*)(kb + d0 * 2048);
        const bf16x8 b1 = *(const LAS bf16x8*)(kb + d0 * 2048 + 512);
        p0 = __builtin_amdgcn_mfma_f32_32x32x16_bf16(b0, qr[d0], p0, 0, 0, 0); p1 = __builtin_amdgcn_mfma_f32_32x32x16_bf16(b1, qr[d0], p1, 0, 0, 0);
    }
}
__device__ __forceinline__ void pv(f32x16* o, int vb, bf16x8 pa0, bf16x8 pa1, bf16x8 pa2, bf16x8 pa3) {
#pragma unroll
    for (int d0 = 0; d0 < 2; ++d0) { s16x4 lo[4], hi[4];
#pragma unroll
        for (int ks = 0; ks < 4; ++ks) {
            asm volatile("ds_read_b64_tr_b16 %0,%1 offset:%c2" : "=&v"(lo[ks]) : "v"(vb), "i"(d0 * 4096 + ks * 1024) : "memory");
            asm volatile("ds_read_b64_tr_b16 %0,%1 offset:%c2" : "=&v"(hi[ks]) : "v"(vb), "i"(d0 * 4096 + ks * 1024 + 512) : "memory"); }
        asm volatile("s_waitcnt lgkmcnt(0)" ::: "memory"); ATT_SBAR();
#define ATT_PK(k) (bf16x8){lo[k][0], lo[k][1], lo[k][2], lo[k][3], hi[k][0], hi[k][1], hi[k][2], hi[k][3]}
        o[d0] = __builtin_amdgcn_mfma_f32_32x32x16_bf16(pa0, ATT_PK(0), o[d0], 0, 0, 0);
        o[d0] = __builtin_amdgcn_mfma_f32_32x32x16_bf16(pa1, ATT_PK(1), o[d0], 0, 0, 0);
        o[d0] = __builtin_amdgcn_mfma_f32_32x32x16_bf16(pa2, ATT_PK(2), o[d0], 0, 0, 0);
        o[d0] = __builtin_amdgcn_mfma_f32_32x32x16_bf16(pa3, ATT_PK(3), o[d0], 0, 0, 0);
#undef ATT_PK
    }
}
template <bool MOBA>
__device__ __forceinline__ void attn_unit(const int b, const int h, const int qb, const bf16_t* __restrict__ QKV, const int pitch, const int koff, const int voff,
                                          bf16_t* __restrict__ O, LAS unsigned char* lds, const float* __restrict__ KMP, const float sl2) {
    int tid = threadIdx.x; asm volatile("" : "+v"(tid));
    const int lane = tid & 63, r32 = lane & 31, hi = lane >> 5;
    const int wid = __builtin_amdgcn_readfirstlane(tid >> 6);
    const long rowbase = (long)b * SEQ; const int q0 = qb * 256;
    const bf16_t* Qw = QKV + (rowbase + q0 + wid * 32) * pitch + h * 64;
    const bf16_t* Kh = QKV + rowbase * pitch + koff + h * 64;
    const bf16_t* Vh = QKV + rowbase * pitch + voff + h * 64;
    const unsigned lds0 = (unsigned)(uintptr_t)lds;
    const bf16_t* ksrc = Kh + (long)lane * pitch + wid * 8;
    const bf16_t* vsrc = Vh + (long)(16 * (wid & 3) + (lane >> 2)) * pitch + (wid >> 2) * 32 + (lane & 3) * 8;
    const unsigned kdst = lds0 + LDS_K + wid * 1024, vdst = lds0 + LDS_V + wid * 1024;
#define ATT_DMA_KV(t, slot) do { glds16(ksrc + (long)(t) * 64 * pitch, (unsigned)__builtin_amdgcn_readfirstlane(kdst + (slot))); \
                                 glds16(vsrc + (long)(t) * 64 * pitch, (unsigned)__builtin_amdgcn_readfirstlane(vdst + (slot))); } while (0)
    const int NT = 4 * qb + 4;
    const int tdiag = 4 * qb + (wid >> 1);
    LAS float* wsf = (LAS float*)(lds + LDS_WS) + wid * 64;
    const lds_cptr kp0 = (lds_cptr)lds + LDS_K + hi * 1024 + r32 * 16;
    const int vb0 = (int)(lds0 + LDS_V) + ((lane >> 4) & 1) * 32 + (lane & 3) * 8 + (4 * hi + ((lane & 15) >> 2)) * 64;
    ATT_DMA_KV(NT - 1, 0); ATT_DMA_KV(NT - 2, SLOTB);
    bf16x8 qr[4];
#pragma unroll
    for (int d0 = 0; d0 < 4; ++d0) qr[d0] = *(const bf16x8*)(Qw + (long)r32 * pitch + d0 * 16 + hi * 8);
    f32x16 o[2]; o[0] = f32x16{}; o[1] = f32x16{};
    const int qrel = wid * 32 + r32;
    float carry = 1.0f;
    float mhat = 0.f, lrow = 0.f; unsigned selmask = 0u;
    bf16x8 kaug0 = {0, 0, 0, 0, 0, 0, 0, 0}, kaug1 = {0, 0, 0, 0, 0, 0, 0, 0}, qaug = {0, 0, 0, 0, 0, 0, 0, 0};
    if constexpr (MOBA) {
        LAS float* kmt = (LAS float*)(lds + LDS_KMT);
        { const int n = tid >> 6, d = tid & 63;
          if (n < qb) { const float* kp = KMP + ((size_t)(b * 8 + n) * 2) * 1024 + h * 64 + d; kmt[n * 64 + d] = (kp[0] + kp[1024]) * (1.0f / 256.0f); } }
        asm volatile("s_waitcnt lgkmcnt(0)\n\ts_barrier" ::: "memory");
        float gate[7];
#pragma unroll
        for (int n = 0; n < 7; ++n) {
            float g = -INFINITY;
            if (n < qb) {
                float s = 0.f;
#pragma unroll
                for (int d0 = 0; d0 < 4; ++d0) {
                    const f32x4 k0 = *(const LAS f32x4*)(kmt + n * 64 + d0 * 16 + hi * 8), k1 = *(const LAS f32x4*)(kmt + n * 64 + d0 * 16 + hi * 8 + 4);
                    s += bf2f(qr[d0][0]) * k0[0] + bf2f(qr[d0][1]) * k0[1] + bf2f(qr[d0][2]) * k0[2] + bf2f(qr[d0][3]) * k0[3]
                       + bf2f(qr[d0][4]) * k1[0] + bf2f(qr[d0][5]) * k1[1] + bf2f(qr[d0][6]) * k1[2] + bf2f(qr[d0][7]) * k1[3];
                }
                g = s + partner(s, hi);
            }
            gate[n] = g;
        }
#pragma unroll
        for (int r = 0; r < 3; ++r) {
            int best = -1; float bv = -INFINITY;
#pragma unroll
            for (int n = 0; n < 7; ++n) { const bool taken = (selmask >> n) & 1u; if (!taken && gate[n] > bv) { best = n; bv = gate[n]; } }
            if (best >= 0) selmask |= 1u << best;
        }
        selmask |= 1u << qb;
        mhat = sl2 * (float)qrel;
        if (hi == 0) {
            const unsigned sh = __builtin_bit_cast(unsigned, sl2) + 0x7fffu + ((__builtin_bit_cast(unsigned, sl2) >> 16) & 1u), shb = sh >> 16;
            const float rem = sl2 - __builtin_bit_cast(float, shb << 16); const unsigned sl = (__builtin_bit_cast(unsigned, rem) + 0x7fffu + ((__builtin_bit_cast(unsigned, rem) >> 16) & 1u)) >> 16;
            qaug[0] = (short)shb; qaug[1] = (short)sl;
            const short k0s = (short)(__builtin_bit_cast(unsigned, (float)r32) >> 16), k1s = (short)(__builtin_bit_cast(unsigned, (float)(32 + r32)) >> 16);
            kaug0[0] = k0s; kaug0[1] = k0s; kaug1[0] = k1s; kaug1[1] = k1s;
        }
    }
    LAS int* done = (LAS int*)(lds + LDS_KMT);
    bool wdone = false;
    if constexpr (!MOBA) { if (lane == 0) done[wid] = 0x7fffffff; }
    const lds_cptr vp0 = (lds_cptr)lds + LDS_V + ((lane >> 4) & 1) * 32 + (lane & 3) * 8 + (4 * hi + ((lane & 15) >> 2)) * 64;
    int slot = 0;
    for (int i = 0; i < NT; ++i) {
        const int t = NT - 1 - i;
        const int nslot = (slot == (NSLOT - 1) * SLOTB) ? 0 : slot + SLOTB;
        const int n2slot = (nslot == (NSLOT - 1) * SLOTB) ? 0 : nslot + SLOTB;
        if (i + 2 < NT) { ATT_DMA_KV(t - 2, n2slot); ATT_WAIT_BAR(4); } else if (i + 1 < NT) { ATT_WAIT_BAR(2); } else { ATT_WAIT_BAR(0); }
        if constexpr (!MOBA) {
            const int4v d0v = *(const LAS int4v*)(done), d1v = *(const LAS int4v*)(done + 4);
            int dm = max(max(max(d0v[0], d0v[1]), max(d0v[2], d0v[3])), max(max(d1v[0], d1v[1]), max(d1v[2], d1v[3])));
            dm = __builtin_amdgcn_readfirstlane(dm);
            if (dm < i) break;
        }
        if (t <= tdiag && !wdone) {
            f32x16 p0, p1;
            u32x4 pw0 = {0u, 0u, 0u, 0u}, pw1 = pw0, pw2 = pw0, pw3 = pw0; bool dead = false;
            if constexpr (!MOBA) {
                qkt(p0, p1, kp0 + slot, qr);
                s16x4 vlo[8], vhi[8]; vload16(vlo, vhi, vp0 + slot);
                float om[32], be[32];
#pragma unroll
                for (int r = 0; r < 16; ++r) {
                    const float e0 = __builtin_amdgcn_exp2f(__builtin_fminf(p0[r], 80.0f)), e1 = __builtin_amdgcn_exp2f(__builtin_fminf(p1[r], 80.0f));
                    om[r] = __builtin_amdgcn_rcpf(1.0f + e0); om[16 + r] = __builtin_amdgcn_rcpf(1.0f + e1);
                    be[r] = e0 * om[r]; be[16 + r] = e1 * om[16 + r];
                }
                if (t == tdiag) {
                    const int kb = 64 * (t - 4 * qb) + 4 * hi;
#pragma unroll
                    for (int r = 0; r < 16; ++r) { const int kv = kb + (r & 3) + 8 * (r >> 2);
                        if (kv >= qrel) { om[r] = 1.0f; be[r] = 0.f; } if (kv + 32 >= qrel) { om[16 + r] = 1.0f; be[16 + r] = 0.f; } }
                }
                float xin0[8], xin1[8], xin2[8], OS[9];
#pragma unroll
                for (int j = 0; j < 8; ++j) { xin2[j] = om[4 * j + 3]; xin1[j] = xin2[j] * om[4 * j + 2]; xin0[j] = xin1[j] * om[4 * j + 1]; }
                OS[8] = 1.0f;
#pragma unroll
                for (int j = 7; j >= 0; --j) OS[j] = (xin0[j] * om[4 * j]) * OS[j + 1];
                float oth[8];
#pragma unroll
                for (int j = 0; j < 8; ++j) {
                    auto rr = __builtin_amdgcn_permlane32_swap(__builtin_bit_cast(unsigned, OS[j]), __builtin_bit_cast(unsigned, OS[j + 1]), false, false);
                    oth[j] = __builtin_bit_cast(float, hi ? rr[0] : rr[1]);
                }
                float tot = OS[0] * oth[0];
                { auto rr = __builtin_amdgcn_permlane32_swap(__builtin_bit_cast(unsigned, tot), __builtin_bit_cast(unsigned, tot), false, false); tot = hi ? __builtin_bit_cast(float, rr[0]) : tot; }
                float av[32];
#pragma unroll
                for (int j = 0; j < 8; ++j) { const float xc = carry * (OS[j + 1] * oth[j]);
                    av[4 * j + 3] = be[4 * j + 3] * xc; av[4 * j + 2] = be[4 * j + 2] * (xc * xin2[j]); av[4 * j + 1] = be[4 * j + 1] * (xc * xin1[j]); av[4 * j] = be[4 * j] * (xc * xin0[j]); }
                carry *= tot;
                if (__all(carry == 0.0f)) { wdone = true; if (lane == 0) done[wid] = i; }
                pw0 = (u32x4){cvtpk(av[0], av[1]), cvtpk(av[2], av[3]), cvtpk(av[4], av[5]), cvtpk(av[6], av[7])};
                pw1 = (u32x4){cvtpk(av[8], av[9]), cvtpk(av[10], av[11]), cvtpk(av[12], av[13]), cvtpk(av[14], av[15])};
                pw2 = (u32x4){cvtpk(av[16], av[17]), cvtpk(av[18], av[19]), cvtpk(av[20], av[21]), cvtpk(av[22], av[23])};
                pw3 = (u32x4){cvtpk(av[24], av[25]), cvtpk(av[26], av[27]), cvtpk(av[28], av[29]), cvtpk(av[30], av[31])};
                pv_r(o, vlo, vhi, __builtin_bit_cast(bf16x8, pw0), __builtin_bit_cast(bf16x8, pw1), __builtin_bit_cast(bf16x8, pw2), __builtin_bit_cast(bf16x8, pw3));
            } else {
                const int blk = t >> 2;
                const bool sel = (selmask >> blk) & 1u;
                const float nv = sel ? (sl2 * (float)(64 * t - q0) - mhat) : -INFINITY;
                f32x16 c;
#pragma unroll
                for (int r = 0; r < 16; ++r) c[r] = nv;
                qkt_aug(p0, p1, kp0 + slot, qr, c, kaug0, kaug1, qaug);
                s16x4 vlo[8], vhi[8]; vload16(vlo, vhi, vp0 + slot);
                if (t == tdiag) {
                    const int kb = 64 * (t - 4 * qb) + 4 * hi;
#pragma unroll
                    for (int r = 0; r < 16; ++r) { const int kv = kb + (r & 3) + 8 * (r >> 2);
                        if (kv > qrel) p0[r] = -INFINITY; if (kv + 32 > qrel) p1[r] = -INFINITY; }
                }
                float a0 = __builtin_fmaxf(__builtin_fmaxf(p0[0], p0[1]), p0[2]), a1 = __builtin_fmaxf(__builtin_fmaxf(p1[0], p1[1]), p1[2]);
#pragma unroll
                for (int r = 3; r < 15; r += 2) { a0 = __builtin_fmaxf(__builtin_fmaxf(a0, p0[r]), p0[r + 1]); a1 = __builtin_fmaxf(__builtin_fmaxf(a1, p1[r]), p1[r + 1]); }
                float rm = __builtin_fmaxf(__builtin_fmaxf(a0, p0[15]), __builtin_fmaxf(a1, p1[15]));
                rm = __builtin_fmaxf(rm, partner(rm, hi));
                dead = __all(rm < -160.0f);
                if (!dead && __any(rm > 8.0f)) {
                    const float dl = __builtin_fmaxf(rm, 0.f);
                    mhat += dl;
#pragma unroll
                    for (int r = 0; r < 16; ++r) { p0[r] -= dl; p1[r] -= dl; }
                    const float f = __builtin_amdgcn_exp2f(-dl);
                    lrow *= f;
                    if (hi == 0) wsf[r32] = f;
                    asm volatile("s_waitcnt lgkmcnt(0)" ::: "memory");
#pragma unroll
                    for (int g4 = 0; g4 < 4; ++g4) { const f32x4 fv = *(const LAS f32x4*)(wsf + 8 * g4 + 4 * hi);
#pragma unroll
                        for (int i2 = 0; i2 < 4; ++i2) { o[0][4 * g4 + i2] *= fv[i2]; o[1][4 * g4 + i2] *= fv[i2]; } }
                    asm volatile("s_waitcnt lgkmcnt(0)" ::: "memory");
                }
                if (!dead) {
                float rs = 0.f;
#pragma unroll
                for (int r = 0; r < 16; ++r) { p0[r] = __builtin_amdgcn_exp2f(p0[r]); p1[r] = __builtin_amdgcn_exp2f(p1[r]); rs += p0[r] + p1[r]; }
                lrow += rs;
                pw0 = (u32x4){cvtpk(p0[0], p0[1]), cvtpk(p0[2], p0[3]), cvtpk(p0[4], p0[5]), cvtpk(p0[6], p0[7])};
                pw1 = (u32x4){cvtpk(p0[8], p0[9]), cvtpk(p0[10], p0[11]), cvtpk(p0[12], p0[13]), cvtpk(p0[14], p0[15])};
                pw2 = (u32x4){cvtpk(p1[0], p1[1]), cvtpk(p1[2], p1[3]), cvtpk(p1[4], p1[5]), cvtpk(p1[6], p1[7])};
                pw3 = (u32x4){cvtpk(p1[8], p1[9]), cvtpk(p1[10], p1[11]), cvtpk(p1[12], p1[13]), cvtpk(p1[14], p1[15])};
                pv_r(o, vlo, vhi, __builtin_bit_cast(bf16x8, pw0), __builtin_bit_cast(bf16x8, pw1), __builtin_bit_cast(bf16x8, pw2), __builtin_bit_cast(bf16x8, pw3));
                }
            }
        }
        slot = nslot;
    }
    if constexpr (!MOBA) asm volatile("s_waitcnt vmcnt(0)" ::: "memory");
    float rli[16];
    if constexpr (MOBA) {
        const float lt = lrow + partner(lrow, hi);
        if (hi == 0) wsf[32 + r32] = lt;
        asm volatile("s_waitcnt lgkmcnt(0)" ::: "memory");
#pragma unroll
        for (int g4 = 0; g4 < 4; ++g4) { const f32x4 lv = *(const LAS f32x4*)(wsf + 32 + 8 * g4 + 4 * hi);
#pragma unroll
            for (int i2 = 0; i2 < 4; ++i2) rli[4 * g4 + i2] = __builtin_amdgcn_rcpf(lv[i2]); }
    } else {
#pragma unroll
        for (int r = 0; r < 16; ++r) rli[r] = 1.0f;
    }
    {
        LAS bf16_t* stg = (LAS bf16_t*)(lds + LDS_OST) + wid * 2048;
#pragma unroll
        for (int r = 0; r < 16; ++r) { const int orow = crow(r, hi);
#pragma unroll
            for (int d0 = 0; d0 < 2; ++d0) stg[orow * 64 + d0 * 32 + r32] = (bf16_t)(cvtpk(o[d0][r] * rli[r], 0.f) & 0xffffu); }
        asm volatile("s_waitcnt lgkmcnt(0)" ::: "memory");
        bf16_t* Ow = O + (rowbase + q0 + wid * 32) * OPITCH + h * 64;
#pragma unroll
        for (int i = 0; i < 4; ++i) { const int row = i * 8 + (lane >> 3), ch = lane & 7; const u32x4 v = *(const LAS u32x4*)(stg + row * 64 + ch * 8); *(u32x4*)(Ow + (long)row * OPITCH + ch * 8) = v; }
    }
    asm volatile("s_waitcnt lgkmcnt(0)\n\ts_barrier" ::: "memory");
#undef ATT_DMA_KV
}
#undef ATT_SBAR
#undef ATT_WAIT_BAR
}
#define XB_TMO      128
#define XB_XCNT(j)  (256  + 64 * (j))
#define XB_XSUB(j)  (1280 + 64 * (j))
#define XB_XGEN(j)  (2304 + 64 * (j))
#define XB_TOP      3328
#define XB_TOPGEN   3392
#define XCD_BAR_WORDS 3456
#define XB_SPIN_CAP (1u << 18)

__device__ __forceinline__ unsigned xb_ld(unsigned* p)              { return __hip_atomic_load(p, __ATOMIC_RELAXED, __HIP_MEMORY_SCOPE_AGENT); }
__device__ __forceinline__ unsigned xb_add(unsigned* p, unsigned v) { return __hip_atomic_fetch_add(p, v, __ATOMIC_RELAXED, __HIP_MEMORY_SCOPE_AGENT); }
__device__ __forceinline__ unsigned xb_xcc_id() { return (unsigned)__builtin_amdgcn_s_getreg((3 << 11) | 20) & 0xFu; }
#define XB_SPIN(cond, bar) do { unsigned _sp = 0; while (cond) { __builtin_amdgcn_s_sleep(1); \
    if ((++_sp & 255u) == 0u) { if (xb_ld(&(bar)[XB_TMO])) break; if (_sp > XB_SPIN_CAP) { atomicAdd(&(bar)[XB_TMO], 1u); break; } } } } while (0)

struct XcdBarrier {
    unsigned* bar; unsigned x;
    volatile LAS unsigned* st;
};

__device__ __forceinline__ XcdBarrier xcd_barrier_post(unsigned* bar, volatile LAS unsigned* st) {
    XcdBarrier b; b.bar = bar; b.x = xb_xcc_id(); b.st = st;
    if (threadIdx.x == 0) (void)xb_add(&bar[XB_XCNT(b.x)], 1u);
    return b;
}
__device__ __forceinline__ void xcd_barrier_complete(unsigned* bar, unsigned x, unsigned& nloc, unsigned& nx) {
    const unsigned G = gridDim.x * gridDim.y * gridDim.z;
    unsigned sum, cnt, mine, sp = 0u;
    for (;;) {
        sum = 0u; cnt = 0u; mine = 0u;
#pragma unroll
        for (unsigned j = 0; j < 16; ++j) { const unsigned c = xb_ld(&bar[XB_XCNT(j)]); sum += c; cnt += (c > 0u) ? 1u : 0u; mine = (j == x) ? c : mine; }
        if (sum == G) break;
        __builtin_amdgcn_s_sleep(1);
        if ((++sp & 255u) == 0u) { if (xb_ld(&bar[XB_TMO])) break; if (sp > XB_SPIN_CAP) { atomicAdd(&bar[XB_TMO], 1u); break; } }
    }
    nloc = mine > 0u ? mine : 1u; nx = cnt > 0u ? cnt : 1u;
}

__device__ __forceinline__ void xcd_barrier(const XcdBarrier& b) {
    asm volatile("s_waitcnt vmcnt(0)" ::: "memory");
    __syncthreads();
    if (threadIdx.x == 0) {
        unsigned* bar = b.bar;
        __builtin_amdgcn_s_waitcnt(0);
        unsigned nloc = b.st[0], nx = b.st[1];
        if (nloc == 0u) { xcd_barrier_complete(bar, b.x, nloc, nx); b.st[0] = nloc; b.st[1] = nx; }
        const unsigned old = xb_add(&bar[XB_XSUB(b.x)], 1u);
        const unsigned gen = old / nloc;
        if (old + 1u == (gen + 1u) * nloc) {
            __builtin_amdgcn_fence(__ATOMIC_RELEASE, "agent");
            asm volatile("s_waitcnt vmcnt(0)" ::: "memory");
            const unsigned og = xb_add(&bar[XB_TOP], 1u);
            const unsigned tg = og / nx;
            if (og + 1u == (tg + 1u) * nx) xb_add(&bar[XB_TOPGEN], 1u);
            else XB_SPIN(xb_ld(&bar[XB_TOPGEN]) == tg, bar);
            __builtin_amdgcn_fence(__ATOMIC_ACQUIRE, "agent");
            xb_add(&bar[XB_XGEN(b.x)], 1u);
            asm volatile("s_waitcnt vmcnt(0)" ::: "memory");
        } else {
            XB_SPIN(xb_ld(&bar[XB_XGEN(b.x)]) == gen, bar);
            __builtin_amdgcn_fence(__ATOMIC_ACQUIRE, "agent");
            asm volatile("s_waitcnt vmcnt(0)" ::: "memory");
        }
    }
    __syncthreads();
}
#ifndef DBG_MASK
#define DBG_MASK 255
#endif
#ifndef DUP_MASK
#define DUP_MASK 0
#endif
#define NREP(bit) ((DUP_MASK & (bit)) ? 2 : 1)
constexpr int NWAVES = 8;
constexpr int NBATCH = 8, SEQ = 2048, D = 1024, FF = 2816, M = NBATCH * SEQ, DEPTH = 4;
constexpr int N_PHASES = 2 + 7 * DEPTH;
constexpr float QSCALE = 0.125f * 1.4426950408889634f;
typedef unsigned short bf16;
typedef float f32x4 __attribute__((ext_vector_type(4)));
typedef unsigned v4u __attribute__((ext_vector_type(4)));
typedef GAS unsigned gu32;
#define RLX_AGENT __ATOMIC_RELAXED, __HIP_MEMORY_SCOPE_AGENT
constexpr size_t MiB = 1u << 20;
constexpr size_t WS_CTL = 0, CTL_ZERO_BYTES = 1 * MiB;
constexpr size_t WS_WGU = 1 * MiB;
constexpr size_t WS_WD = 89 * MiB;
constexpr size_t WS_WIN_E = 133 * MiB;
constexpr size_t WS_WOUT_E = 141 * MiB;
constexpr size_t WS_WQKV_O = 145 * MiB;
constexpr size_t WS_WO_O = 157 * MiB;
constexpr size_t WS_XB = 161 * MiB;
constexpr size_t WS_SS = 193 * MiB;
constexpr size_t WS_KMP = 194 * MiB;
constexpr size_t WS_QKV = 195 * MiB;
constexpr size_t WS_O = 291 * MiB;
constexpr size_t WS_END = 323 * MiB;
constexpr size_t WGU_BYTES = (size_t)2 * FF * D * 2, WD_BYTES = (size_t)D * FF * 2;
static_assert(WS_WGU + 8 * WGU_BYTES <= WS_WD && WS_WD + 8 * WD_BYTES <= WS_WIN_E && WS_QKV + (size_t)M * 3072 * 2 <= WS_O && WS_O + (size_t)M * D * 2 <= WS_END, "d_ws map");
constexpr int CW_BAR = 4096;
constexpr int RING_OFF = 0, RING_BYTES = 131072;
constexpr int P0_TS = 65, P0_SCR_BYTES = 64 * P0_TS * 4;
constexpr int LDSCTL_OFF = RING_BYTES + 4096, MISC_OFF = LDSCTL_OFF + 320;
constexpr int LDS_BYTES = 147456;
static_assert(att::LDS_END <= RING_BYTES && MISC_OFF + 128 <= LDS_BYTES && 8 * P0_SCR_BYTES <= LDSCTL_OFF, "LDS map");

__device__ __forceinline__ unsigned f2bf(float f) { unsigned u = __builtin_bit_cast(unsigned, f); return (u + 0x7fffu + ((u >> 16) & 1u)) >> 16; }
__device__ __forceinline__ unsigned pk2(float lo, float hi) { return f2bf(lo) | (f2bf(hi) << 16); }
__device__ __forceinline__ float wave_sum(float v) {
#pragma unroll
    for (int o = 1; o < 64; o <<= 1) v += __shfl_xor(v, o);
    return v;
}
#define LDS_WAIT() asm volatile("s_waitcnt lgkmcnt(0)" ::: "memory")
#define VM_WAIT() asm volatile("s_waitcnt vmcnt(0)" ::: "memory")

__device__ __forceinline__ void p0_write_tile(bf16* WT, int K, int dst_row0, int k0, LAS float* scr, int lane) {
    LDS_WAIT(); asm volatile("" ::: "memory");
    const int c = lane & 7, nn = lane >> 3;
#pragma unroll
    for (int j = 0; j < 8; ++j) { const int n = nn + 8 * j; const LAS float* s = scr + (8 * c) * P0_TS + n;
        v4u o; o.x = pk2(s[0 * P0_TS], s[1 * P0_TS]); o.y = pk2(s[2 * P0_TS], s[3 * P0_TS]); o.z = pk2(s[4 * P0_TS], s[5 * P0_TS]); o.w = pk2(s[6 * P0_TS], s[7 * P0_TS]);
        *(GAS v4u*)(WT + (size_t)(dst_row0 + n) * K + k0 + 8 * c) = o; }
    LDS_WAIT(); asm volatile("" ::: "memory");
}
struct P0Item { const float* W; const float* gain; bf16* WT; int ldw, K, dst_row0, k0, n0; };
__device__ __forceinline__ void p0_item_load(const P0Item& d, f32x4 (&v)[16], float (&g)[16], int lane) {
    const int q = lane >> 4, p = lane & 15;
#pragma unroll
    for (int i = 0; i < 16; ++i) { v[i] = *(const GAS f32x4*)(d.W + (size_t)(d.k0 + 4 * i + q) * d.ldw + d.n0 + 4 * p); g[i] = d.gain ? d.gain[d.k0 + 4 * i + q] : 1.0f; }
}
__device__ __forceinline__ void p0_item_finish(const P0Item& d, const f32x4 (&v)[16], const float (&g)[16], LAS float* scr, int lane) {
    const int q = lane >> 4, p = lane & 15;
#pragma unroll
    for (int i = 0; i < 16; ++i) { LAS float* dd = scr + (4 * i + q) * P0_TS + 4 * p; dd[0] = v[i][0] * g[i]; dd[1] = v[i][1] * g[i]; dd[2] = v[i][2] * g[i]; dd[3] = v[i][3] * g[i]; }
    p0_write_tile(d.WT, d.K, d.dst_row0, d.k0, scr, lane);
}
__device__ __forceinline__ void p0_fold_item(const float* Win  , const float* Wp  , const float* pscale  , const float* gain, bf16* WT, int k0, int n0, LAS float* scr, int lane) {
    const int g = n0 >> 7, d = (n0 & 127) + lane;
    const float* wpb = Wp + (size_t)g * 128 * 128 + d;
    const int q = lane >> 4, p = lane & 15;
    float acc[64];
#pragma unroll
    for (int i = 0; i < 64; ++i) acc[i] = 0.f;
#pragma unroll 1
    for (int hc = 0; hc < 2; ++hc) {
        f32x4 v[16];
#pragma unroll
        for (int i = 0; i < 16; ++i) v[i] = *(const GAS f32x4*)(Win + (size_t)(k0 + 4 * i + q) * 2048 + 1536 + g * 128 + hc * 64 + 4 * p);
        LDS_WAIT(); asm volatile("" ::: "memory");
#pragma unroll
        for (int i = 0; i < 16; ++i) { LAS float* dd = scr + (4 * i + q) * P0_TS + 4 * p; dd[0] = v[i][0]; dd[1] = v[i][1]; dd[2] = v[i][2]; dd[3] = v[i][3]; }
        LDS_WAIT(); asm volatile("" ::: "memory");
#pragma unroll 1
        for (int c = 0; c < 64; c += 4) {
            const float w0 = wpb[(size_t)(hc * 64 + c + 0) * 128], w1 = wpb[(size_t)(hc * 64 + c + 1) * 128], w2 = wpb[(size_t)(hc * 64 + c + 2) * 128], w3 = wpb[(size_t)(hc * 64 + c + 3) * 128];
            const LAS float* sc = scr + c;
#pragma unroll
            for (int k = 0; k < 64; ++k) acc[k] += (sc[k * P0_TS] * w0 + sc[k * P0_TS + 1] * w1) + (sc[k * P0_TS + 2] * w2 + sc[k * P0_TS + 3] * w3);
        }
    }
    const float ps = pscale[g * 128 + d];
    LDS_WAIT(); asm volatile("" ::: "memory");
#pragma unroll
    for (int i = 0; i < 64; ++i) scr[i * P0_TS + lane] = acc[i] * ps * gain[k0 + i];
    p0_write_tile(WT, 1024, 1536 + n0, k0, scr, lane);
}

struct Args { const float* in[17]; float* out; unsigned char* ws; int ph_lo, ph_hi; };

__device__ __forceinline__ void p0_prologue(const Args& a, unsigned char* ws, LAS unsigned char* lds, int vcu, int G, int wave, int lane) {
    LAS float* scr = (LAS float*)(lds + wave * P0_SCR_BYTES);
    const int gw = vcu * NWAVES + wave, NGW = G * NWAVES;
    constexpr int I_GU = 16 * 44, I_DN = 44 * 16, I_EIN = 16 * 24, I_EFO = 16 * 8, I_SQ = 16 * 16, I_OQKV = 16 * 48;
    constexpr int S_G = 0, S_U = S_G + 8 * I_GU, S_D = S_U + 8 * I_GU, S_EIN = S_D + 8 * I_DN, S_EOUT = S_EIN + 2 * I_EIN, S_OQKV = S_EOUT + 2 * I_SQ, S_OO = S_OQKV + 2 * I_OQKV, NITEMS = S_OO + 2 * I_SQ;
    auto decode = [&](int it) -> P0Item {
        P0Item d;
        if (it < S_D) {
            const bool up = it >= S_U; const int r0 = it - (up ? S_U : S_G), f = r0 / I_GU, r = r0 % I_GU, layer = f >> 1, half = f & 1, kb = r / 44, nb = r % 44, n0 = 64 * nb;
            d.W = a.in[half ? (up ? 8 : 7) : (up ? 3 : 2)] + (size_t)layer * D * FF; d.gain = a.in[half ? 6 : 1] + layer * D; d.WT = (bf16*)(ws + WS_WGU + (size_t)f * WGU_BYTES);
            d.ldw = FF; d.K = D; d.dst_row0 = (n0 >> 7) * 256 + (up ? 128 : 0) + (n0 & 127); d.k0 = 64 * kb; d.n0 = n0;
        } else if (it < S_EIN) {
            const int r0 = it - S_D, f = r0 / I_DN, r = r0 % I_DN, layer = f >> 1, half = f & 1, kb = r / 16, nb = r % 16;
            d.W = a.in[half ? 9 : 4] + (size_t)layer * FF * D; d.gain = nullptr; d.WT = (bf16*)(ws + WS_WD + (size_t)f * WD_BYTES); d.ldw = D; d.K = FF; d.dst_row0 = 64 * nb; d.k0 = 64 * kb; d.n0 = 64 * nb;
        } else if (it < S_EOUT) {
            const int r0 = it - S_EIN, i = r0 / I_EIN, r = r0 % I_EIN, kb = r / 24, nb = r % 24;
            d.W = a.in[10] + (size_t)i * D * 2048; d.gain = a.in[5] + (2 * i) * D; d.WT = (bf16*)(ws + WS_WIN_E + (size_t)i * 2048 * D * 2); d.ldw = 2048; d.K = D; d.dst_row0 = 64 * nb; d.k0 = 64 * kb; d.n0 = 64 * nb;
        } else if (it < S_OQKV) {
            const int r0 = it - S_EOUT, i = r0 / I_SQ, r = r0 % I_SQ, kb = r / 16, nb = r % 16;
            d.W = a.in[13] + (size_t)i * D * D; d.gain = nullptr; d.WT = (bf16*)(ws + WS_WOUT_E + (size_t)i * D * D * 2); d.ldw = D; d.K = D; d.dst_row0 = 64 * nb; d.k0 = 64 * kb; d.n0 = 64 * nb;
        } else if (it < S_OO) {
            const int r0 = it - S_OQKV, i = r0 / I_OQKV, r = r0 % I_OQKV, kb = r / 48, nb = r % 48;
            d.W = a.in[14] + (size_t)i * D * 3072; d.gain = a.in[5] + (2 * i + 1) * D; d.WT = (bf16*)(ws + WS_WQKV_O + (size_t)i * 3072 * D * 2); d.ldw = 3072; d.K = D; d.dst_row0 = 64 * nb; d.k0 = 64 * kb; d.n0 = 64 * nb;
        } else {
            const int r0 = it - S_OO, i = r0 / I_SQ, r = r0 % I_SQ, kb = r / 16, nb = r % 16;
            d.W = a.in[15] + (size_t)i * D * D; d.gain = nullptr; d.WT = (bf16*)(ws + WS_WO_O + (size_t)i * D * D * 2); d.ldw = D; d.K = D; d.dst_row0 = 64 * nb; d.k0 = 64 * kb; d.n0 = 64 * nb;
        }
        return d;
    };
    if (gw < NITEMS) {
        P0Item cur = decode(gw); f32x4 v[16]; float g[16];
        p0_item_load(cur, v, g, lane);
        for (int it = gw; it < NITEMS; it += NGW) {
            const bool more = it + NGW < NITEMS;
            P0Item nxt = cur; f32x4 v2[16]; float g2[16];
            if (more) { nxt = decode(it + NGW); p0_item_load(nxt, v2, g2, lane); }
            p0_item_finish(cur, v, g, scr, lane);
            if (more) { cur = nxt;
#pragma unroll
                for (int i = 0; i < 16; ++i) { v[i] = v2[i]; g[i] = g2[i]; } }
        }
    }
    if (wave == 0) for (int r0 = vcu; r0 < 2 * I_EFO; r0 += G) {
        const int i = r0 / I_EFO, r = r0 % I_EFO, kb = r / 8, nb = r % 8;
        p0_fold_item(a.in[10] + (size_t)i * D * 2048, a.in[11] + (size_t)i * 4 * 128 * 128, a.in[12] + i * 512, a.in[5] + (2 * i) * D, (bf16*)(ws + WS_WIN_E + (size_t)i * 2048 * D * 2), 64 * kb, 64 * nb, scr, lane);
    }
    const float* x = a.in[0]; bf16* XB = (bf16*)(ws + WS_XB); float* SS = (float*)(ws + WS_SS);
    for (int m = gw; m < M; m += NGW) {
        const GAS f32x4* xr = (const GAS f32x4*)(x + (size_t)m * D) + lane;
        f32x4 v[4]; float s = 0.f;
#pragma unroll
        for (int j = 0; j < 4; ++j) { v[j] = xr[64 * j]; s += (v[j].x * v[j].x + v[j].y * v[j].y) + (v[j].z * v[j].z + v[j].w * v[j].w); }
        s = wave_sum(s);
        GAS unsigned long long* o8 = (GAS unsigned long long*)(XB + (size_t)m * D) + lane;
#pragma unroll
        for (int j = 0; j < 4; ++j) o8[64 * j] = (unsigned long long)pk2(v[j].x, v[j].y) | ((unsigned long long)pk2(v[j].z, v[j].w) << 32);
        if (lane < 16) SS[(size_t)m * 16 + lane] = (lane == 0) ? s : 0.f;
    }
}
__device__ __forceinline__ void pool_rows(const bf16* QKV, bf16* O, int vcu, int G, int tid) {
    asm volatile("" : "+v"(tid));
    const int cc = tid & 63, rg = tid >> 6, g = cc >> 4, w = 2 << g;
    for (int R0 = vcu * 64; R0 < M; R0 += G * 64) {
#pragma unroll 1
        for (int rr = 0; rr < 8; ++rr) {
            const int row = R0 + rg * 8 + rr, t = row & (SEQ - 1);
            const int cnt = (t + 1) < w ? (t + 1) : w;
            float s[8];
#pragma unroll
            for (int e = 0; e < 8; ++e) s[e] = 0.f;
            v4u cur = {0u, 0u, 0u, 0u};
            for (int i = 0; i < cnt; ++i) {
                const v4u v = *(const v4u*)(QKV + (size_t)(row - i) * 2048 + 1536 + cc * 8);
                if (i == 0) cur = v;
                s[0] += __builtin_bit_cast(float, v.x << 16); s[1] += __builtin_bit_cast(float, v.x & 0xffff0000u);
                s[2] += __builtin_bit_cast(float, v.y << 16); s[3] += __builtin_bit_cast(float, v.y & 0xffff0000u);
                s[4] += __builtin_bit_cast(float, v.z << 16); s[5] += __builtin_bit_cast(float, v.z & 0xffff0000u);
                s[6] += __builtin_bit_cast(float, v.w << 16); s[7] += __builtin_bit_cast(float, v.w & 0xffff0000u);
            }
            const float rc = 1.0f / (float)cnt;
            v4u o;
            o.x = pk2(s[0] * rc - __builtin_bit_cast(float, cur.x << 16), s[1] * rc - __builtin_bit_cast(float, cur.x & 0xffff0000u));
            o.y = pk2(s[2] * rc - __builtin_bit_cast(float, cur.y << 16), s[3] * rc - __builtin_bit_cast(float, cur.y & 0xffff0000u));
            o.z = pk2(s[4] * rc - __builtin_bit_cast(float, cur.z << 16), s[5] * rc - __builtin_bit_cast(float, cur.z & 0xffff0000u));
            o.w = pk2(s[6] * rc - __builtin_bit_cast(float, cur.w << 16), s[7] * rc - __builtin_bit_cast(float, cur.w & 0xffff0000u));
            *(v4u*)(O + (size_t)row * 1024 + 512 + cc * 8) = o;
        }
    }
}
__device__ __forceinline__ void final_norm(float* X, const float* SS, const float* gfin, int vcu, int G, int wave, int lane) {
    const int gw = vcu * NWAVES + wave, NGW = G * NWAVES;
    f32x4 gv[4];
#pragma unroll
    for (int j = 0; j < 4; ++j) gv[j] = ((const f32x4*)gfin)[lane + 64 * j];
    for (int m = gw; m < M; m += NGW) {
        float s = (lane < 16) ? SS[(size_t)m * 16 + lane] : 0.f;
        s = wave_sum(s);
        const float r = 1.0f / sqrtf(s * (1.0f / D) + 1e-6f);
        GAS f32x4* xr = (GAS f32x4*)(X + (size_t)m * D) + lane;
#pragma unroll
        for (int j = 0; j < 4; ++j) { const f32x4 v = xr[64 * j]; xr[64 * j] = v * r * gv[j]; }
    }
}

__global__ void __launch_bounds__(NWAVES * 64, 2) mk_fwd(Args args) {
    extern __shared__ __attribute__((aligned(16))) unsigned char lds_raw[];
    LAS unsigned char* lds = (LAS unsigned char*)lds_raw;
    volatile LAS unsigned* MISC = (volatile LAS unsigned*)(lds + MISC_OFF);
    const int tid = threadIdx.x, lane = tid & 63, wave = __builtin_amdgcn_readfirstlane(tid >> 6);
    const int G = gridDim.x; const int bx = blockIdx.x; const int vcu = (G % 8 == 0) ? (bx % 8) * (G / 8) + bx / 8 : bx;
    unsigned char* ws = args.ws;
    gu32* ctl = (gu32*)(ws + WS_CTL);
    for (int u = tid; u < (LDS_BYTES - LDSCTL_OFF) / 4; u += NWAVES * 64) ((LAS unsigned*)(lds + LDSCTL_OFF))[u] = 0u;
    __syncthreads();
    XcdBarrier bar; bar.bar = (unsigned*)(ctl + CW_BAR); bar.x = 0; bar.st = nullptr;
    if (MK_N_LAUNCHES == 1) bar = xcd_barrier_post((unsigned*)(ctl + CW_BAR), MISC + 8);
    const int lo = args.ph_lo, hi = args.ph_hi;
#define IN(k) (lo <= (k) && (k) < hi)
#define SEAM(k) do { if (IN(k) && IN((k) + 1)) xcd_barrier(bar); } while (0)

    bf16* XB = (bf16*)(ws + WS_XB); float* SS = (float*)(ws + WS_SS); float* KMP = (float*)(ws + WS_KMP);
    bf16* QKV = (bf16*)(ws + WS_QKV); bf16* HB = (bf16*)(ws + WS_QKV); bf16* OB = (bf16*)(ws + WS_O);
    float* X = args.out;

    if ((DBG_MASK & 1) && IN(0)) { for (int rep = 0; rep < NREP(1); ++rep) { p0_prologue(args, ws, lds, vcu, G, wave, lane); __syncthreads(); } }
    SEAM(0);

    for (int layer = 0; layer < DEPTH; ++layer) {
        const int pb = 1 + 7 * layer;
        for (int half = 0; half < 2; ++half) {
            const int f = layer * 2 + half, pg = pb + (half ? 5 : 0);
            if ((DBG_MASK & 2) && IN(pg)) for (int rep = 0; rep < NREP(2); ++rep) {
                pg8::Gemm g{XB, (const bf16*)(ws + WS_WGU + (size_t)f * WGU_BYTES), M, 2 * FF, D}; pg8::StaticOrder S; S.init(M, 2 * FF, G, bx);
#if defined(GU_PROBE_VARIANT)
                if (rep == 1) { pg8::EpiGU_<GU_PROBE_VARIANT> E{HB, SS}; pg8::gemm_phase<pg8::EpiGU_<GU_PROBE_VARIANT>, pg8::StaticOrder, true, true>(lds + RING_OFF, g, S, E); } else
#endif
                { pg8::EpiGU E{HB, SS};
                pg8::gemm_phase<pg8::EpiGU, pg8::StaticOrder, true, true>(lds + RING_OFF, g, S, E); }
            }
            SEAM(pg);
            if ((DBG_MASK & 4) && IN(pg + 1)) for (int rep = 0; rep < NREP(4); ++rep) {
                pg8::Gemm g{HB, (const bf16*)(ws + WS_WD + (size_t)f * WD_BYTES), M, D, FF}; pg8::StaticOrder S; S.init(M, D, G, bx);
                pg8::EpiRes E{(f == 0 && rep == 0) ? args.in[0] : (const float*)X, X, XB, SS, rep ? 0.0f : 0.5f};
                pg8::gemm_phase<pg8::EpiRes, pg8::StaticOrder, true, true>(lds + RING_OFF, g, S, E);
            }
            SEAM(pg + 1);
            if (half == 0) {
                const int i2 = layer >> 1; const bool odd = layer & 1;
                if ((DBG_MASK & 8) && IN(pb + 2)) for (int rep = 0; rep < NREP(8); ++rep) {
                    const int N = odd ? 3072 : 2048;
                    pg8::Gemm g{XB, (const bf16*)(ws + (odd ? WS_WQKV_O + (size_t)i2 * 3072 * D * 2 : WS_WIN_E + (size_t)i2 * 2048 * D * 2)), M, N, D}; pg8::StaticOrder S; S.init(M, N, G, bx);
                    pg8::EpiQKV E{QKV, N, SS, odd ? 4 : 2, QSCALE, odd ? KMP : nullptr, 4, 8};
                    pg8::gemm_phase<pg8::EpiQKV, pg8::StaticOrder, true, true>(lds + RING_OFF, g, S, E);
                }
                SEAM(pb + 2);
                if (IN(pb + 3)) {
                    if ((DBG_MASK & 16) && !odd) for (int rep = 0; rep < NREP(16); ++rep) {
                        for (int ui = vcu; ui < 512; ui += G) {
                            const int bh = (ui & 255) >> 2, s = ui & 3, qb = (ui >> 8) ? 7 - s : s;
                            att::attn_unit<false>(bh >> 3, bh & 7, qb, QKV, 2048, 512, 1024, OB, lds + RING_OFF, nullptr, 0.f);
                        }
                        pool_rows(QKV, OB, vcu, G, tid);
                    } else if (DBG_MASK & 32) for (int rep = 0; rep < NREP(32); ++rep) {
                        for (int ui = vcu; ui < 1024; ui += G) {
                            const int bh = (ui & 255) >> 1, j = ui & 1, k = ui >> 8;
                            const int qb = (k == 0) ? (j ? 6 : 7) : (k == 1) ? (j ? 5 : 4) : (k == 2) ? (j ? 2 : 3) : (j ? 1 : 0);
                            const int h = bh & 15;
                            const float sl2 = exp2f(-0.5f * (float)(h + 1)) * 1.4426950408889634f;
                            att::attn_unit<true>(bh >> 4, h, qb, QKV, 3072, 1024, 2048, OB, lds + RING_OFF, KMP, sl2);
                        }
                    }
                }
                SEAM(pb + 3);
                if ((DBG_MASK & 64) && IN(pb + 4)) for (int rep = 0; rep < NREP(64); ++rep) {
                    pg8::Gemm g{OB, (const bf16*)(ws + (odd ? WS_WO_O : WS_WOUT_E) + (size_t)i2 * D * D * 2), M, D, D}; pg8::StaticOrder S; S.init(M, D, G, bx);
                    pg8::EpiRes E{X, X, XB, SS, rep ? 0.0f : 1.0f};
                    pg8::gemm_phase<pg8::EpiRes, pg8::StaticOrder, true, true>(lds + RING_OFF, g, S, E);
                }
                SEAM(pb + 4);
            }
        }
    }
    if ((DBG_MASK & 128) && IN(N_PHASES - 1)) final_norm(X, SS, args.in[16], vcu, G, wave, lane);
#undef IN
#undef SEAM
}

extern "C" void kernel_launch(void* const* d_in, const int* in_sizes, int n_in, void* d_out, int out_size, void* d_ws, size_t ws_size, hipStream_t stream) {
    static int grid = 0;
    if (grid == 0) {
        if (n_in != 17 || in_sizes[0] != M * D || out_size != M * D || ws_size < WS_END) { fprintf(stderr, "kernel_launch: unexpected shapes (n_in %d, in0 %d, out %d, ws %zu); nothing launched\n", n_in, n_in > 0 ? in_sizes[0] : -1, out_size, ws_size); grid = -1; return; }
        int dev = 0, cus = 0, per_cu = 0;
        if (hipGetDevice(&dev) != hipSuccess || hipDeviceGetAttribute(&cus, hipDeviceAttributeMultiprocessorCount, dev) != hipSuccess) { grid = -1; return; }
        if (hipFuncSetAttribute((const void*)mk_fwd, hipFuncAttributeMaxDynamicSharedMemorySize, LDS_BYTES) != hipSuccess) { fprintf(stderr, "kernel_launch: hipFuncSetAttribute failed\n"); grid = -1; return; }
        if (hipOccupancyMaxActiveBlocksPerMultiprocessor(&per_cu, (const void*)mk_fwd, NWAVES * 64, LDS_BYTES) != hipSuccess || per_cu < 1)
            fprintf(stderr, "kernel_launch: note: occupancy query reports %d workgroups per CU\n", per_cu);
        (void)hipGetLastError();
        grid = cus;
    }
    if (grid < 0) return;
    if (hipMemsetAsync((char*)d_ws + WS_CTL, 0, CTL_ZERO_BYTES, stream) != hipSuccess) return;
    Args a{};
    for (int i = 0; i < 17; ++i) a.in[i] = (const float*)d_in[i];
    a.out = (float*)d_out; a.ws = (unsigned char*)d_ws;
#if MK_N_LAUNCHES == 1
    a.ph_lo = 0; a.ph_hi = N_PHASES;
    hipLaunchKernelGGL(mk_fwd, dim3(grid), dim3(NWAVES * 64), LDS_BYTES, stream, a);
#else
    for (int p = 0; p < N_PHASES; ++p) { a.ph_lo = p; a.ph_hi = p + 1; hipLaunchKernelGGL(mk_fwd, dim3(grid), dim3(NWAVES * 64), LDS_BYTES, stream, a); }
#endif
}
```

```cpp
#include <hip/hip_runtime.h>
#include <cstdio>
#include <cstdint>
#define LAS __attribute__((address_space(3)))
#define GAS __attribute__((address_space(1)))
#ifndef MK_N_LAUNCHES
#define MK_N_LAUNCHES 1
#endif
#define P0_NT 1
#define EXA_G1 1
#define EXA_G2 1
#define EXA_G3 1
namespace pg8 {
#define PG8_LAS __attribute__((address_space(3)))
typedef unsigned short bf16_t;
typedef short bf16x8 __attribute__((ext_vector_type(8)));
typedef float f32x4 __attribute__((ext_vector_type(4)));
typedef unsigned u32x4 __attribute__((ext_vector_type(4)));
constexpr int BM = 256, BK = 64, HALF = 128, HTB = HALF * BK * 2  , STAGE_BYTES = 8 * HTB, NXCD = 8, WGM = 8;

__host__ __device__ __forceinline__ int lds_byte(int r, int c) { const int st = (r >> 4) * 2 + (c >> 5), rr = r & 15, cc = c & 31, ob = rr * 64 + cc * 2; return st * 1024 + (ob ^ (((ob >> 9) & 1) << 5)); }
__host__ __device__ __forceinline__ void stage_rc(int b, int& R, int& C) { const int st = b / 1024, sb = b % 1024, swz = sb ^ (((sb >> 9) & 1) << 5); R = (st >> 1) * 16 + swz / 64; C = (st & 1) * 32 + (swz % 64) / 2; }
__host__ __device__ __forceinline__ int perm32(int rho) { const int n = rho >> 4, i = rho & 15; return 8 * (i >> 2) + 4 * n + (i & 3); }

struct Unit { int pm, pn; };
struct HUnit { int pm2, pn; };
struct Gemm { const bf16_t* A; const bf16_t* Bt; int M, N, K; };

struct StaticOrder {
    int nM, nN, nwg, G, c, maxr;
    __host__ __device__ void init(int M, int N, int G_, int c_) { nM = M / BM; nN = N / BM; nwg = nM * nN; G = G_; c = c_; maxr = 1 << 30; }
    __host__ __device__ bool next(int i, Unit& u) const {
        const long L = (long)i * G + c; if (L >= nwg || i >= maxr) return false;
        unit_of(L, u); return true;
    }
    __host__ __device__ void unit_of(long L, Unit& u) const {
        int wgid = (int)L; { const int q = nwg / NXCD, r = nwg % NXCD, xcd = wgid % NXCD, off = wgid / NXCD; wgid = (xcd < r ? xcd * (q + 1) : r * (q + 1) + (xcd - r) * q) + off; }
        const int nig = WGM * nN, gid = wgid / nig, fm = gid * WGM, gsz = (nM - fm) < WGM ? (nM - fm) : WGM;
        u.pm = fm + ((wgid % nig) % gsz); u.pn = (wgid % nig) / gsz;
    }
    __device__ __forceinline__ void a_ready(const Unit&) const {}
    __device__ __forceinline__ void done(const Unit&) const {}
};

__device__ __forceinline__ unsigned cvt_pk_bf16(float lo, float hi) { unsigned r; asm volatile("v_cvt_pk_bf16_f32 %0, %1, %2" : "=v"(r) : "v"(lo), "v"(hi)); return r; }
typedef float f32x2 __attribute__((ext_vector_type(2)));
__device__ __forceinline__ float row_rstd(const float* SS, int row, int fq) {
    const f32x4 v = *(const f32x4*)(SS + (size_t)row * 16 + 4 * fq);
    float s = (v[0] + v[1]) + (v[2] + v[3]);
    s += __shfl_xor(s, 16); s += __shfl_xor(s, 32);
    return __builtin_amdgcn_rsqf(s * (1.0f / 1024.0f) + 1e-6f);
}
__device__ __forceinline__ void row_rstd8(const float* SS, int row0, int fq, float (&r8)[8]) {
    f32x4 sv[8];
#pragma unroll
    for (int k = 0; k < 8; ++k) sv[k] = *(const f32x4*)(SS + (size_t)(row0 + (k >> 2) * HALF + (k & 3) * 16) * 16 + 4 * fq);
#pragma unroll
    for (int k = 0; k < 8; ++k) { float s = (sv[k][0] + sv[k][1]) + (sv[k][2] + sv[k][3]); s += __shfl_xor(s, 16); s += __shfl_xor(s, 32); r8[k] = __builtin_amdgcn_rsqf(s * (1.0f / 1024.0f) + 1e-6f); }
}
__device__ __forceinline__ void row_rstd8v(const float* SS, int row0, int fq, float (&r8)[8], float (&v8)[8]) {
    f32x4 sv[8];
#pragma unroll
    for (int k = 0; k < 8; ++k) sv[k] = *(const f32x4*)(SS + (size_t)(row0 + (k >> 2) * HALF + (k & 3) * 16) * 16 + 4 * fq);
#pragma unroll
    for (int k = 0; k < 8; ++k) { float s = (sv[k][0] + sv[k][1]) + (sv[k][2] + sv[k][3]); s += __shfl_xor(s, 16); s += __shfl_xor(s, 32); v8[k] = s * (1.0f / 1024.0f) + 1e-6f; r8[k] = __builtin_amdgcn_rsqf(v8[k]); }
}
template <int VARIANT = 0> struct EpiGU_ {
    static constexpr bool PERM = true, AFTER_DRAIN = false;
    bf16_t* H; const float* SS;
    __device__ __forceinline__ void gu_row(const f32x4 (&ga)[2], const f32x4 (&ua)[2], float r, float v, bf16_t* dst) const {
        const float rn = r * -1.4426950408889634f;
        const f32x2 rn2 = {rn, rn}, v2 = {v, v};
        f32x2 t[4], p[4];
#pragma unroll
        for (int k = 0; k < 4; ++k) { const f32x2 g = {ga[k >> 1][2 * (k & 1)], ga[k >> 1][2 * (k & 1) + 1]}, uu = {ua[k >> 1][2 * (k & 1)], ua[k >> 1][2 * (k & 1) + 1]};
            t[k] = g * rn2; p[k] = g * uu; }
#pragma unroll
        for (int k = 0; k < 4; ++k) { t[k].x = __builtin_amdgcn_exp2f(t[k].x); t[k].y = __builtin_amdgcn_exp2f(t[k].y); }
#pragma unroll
        for (int k = 0; k < 4; ++k) t[k] = __builtin_elementwise_fma(t[k], v2, v2);
#pragma unroll
        for (int k = 0; k < 4; ++k) { t[k].x = __builtin_amdgcn_rcpf(t[k].x); t[k].y = __builtin_amdgcn_rcpf(t[k].y); }
#pragma unroll
        for (int k = 0; k < 4; ++k) p[k] = p[k] * t[k];
        u32x4 w; w.x = cvt_pk_bf16(p[0].x, p[0].y); w.y = cvt_pk_bf16(p[1].x, p[1].y); w.z = cvt_pk_bf16(p[2].x, p[2].y); w.w = cvt_pk_bf16(p[3].x, p[3].y);
        if (VARIANT == 2) { asm volatile("" :: "v"(w)); } else *(u32x4*)dst = w;
    }
    __device__ __forceinline__ void half(const f32x4 (&acc)[2][4][2], const HUnit& u, int wr, int wc, int fr, int fq) const {
        const int row0 = u.pm2 * HALF + wr * 64 + fr, col0 = u.pn * 128 + wc * 32 + 8 * fq;
        f32x4 sv[4];
#pragma unroll
        for (int k = 0; k < 4; ++k) sv[k] = *(const f32x4*)(SS + (size_t)(row0 + k * 16) * 16 + 4 * fq);
#pragma unroll
        for (int m = 0; m < 4; ++m) { float s = (sv[m][0] + sv[m][1]) + (sv[m][2] + sv[m][3]); s += __shfl_xor(s, 16); s += __shfl_xor(s, 32); const float v = s * (1.0f / 1024.0f) + 1e-6f;
            gu_row(acc[0][m], acc[1][m], __builtin_amdgcn_rsqf(v), v, H + (size_t)(row0 + m * 16) * 2816 + col0); }
    }
    __device__ __forceinline__ void operator()(const f32x4 (&acc)[2][2][4][2], const Unit& u, int wr, int wc, int fr, int fq) const {
        if (VARIANT == 1) {
#pragma unroll
            for (int ai = 0; ai < 2; ++ai)
#pragma unroll
                for (int bj = 0; bj < 2; ++bj)
                    asm volatile("" :: "v"(acc[ai][bj][0][0]), "v"(acc[ai][bj][0][1]), "v"(acc[ai][bj][1][0]), "v"(acc[ai][bj][1][1]), "v"(acc[ai][bj][2][0]), "v"(acc[ai][bj][2][1]), "v"(acc[ai][bj][3][0]), "v"(acc[ai][bj][3][1]));
            return; }
        const int row0 = u.pm * BM + wr * 64 + fr, col0 = u.pn * 128 + wc * 32 + 8 * fq;
        float r8[8], v8[8]; row_rstd8v(SS, row0, fq, r8, v8);
#pragma unroll
        for (int ai = 0; ai < 2; ++ai)
#pragma unroll
            for (int m = 0; m < 4; ++m) {
                gu_row(acc[ai][0][m], acc[ai][1][m], r8[ai * 4 + m], v8[ai * 4 + m], H + (size_t)(row0 + ai * HALF + m * 16) * 2816 + col0);
            }
    }
};
typedef EpiGU_<0> EpiGU;
template <int KP> struct EpiGUProbe : EpiGU_<1> { static constexpr int KPROBE = KP; };
struct EpiRes {
    static constexpr bool PERM = true, AFTER_DRAIN = false;
    bf16_t* XB; float* SS; float alpha;
    __device__ __forceinline__ void operator()(const f32x4 (&acc)[2][2][4][2], const Unit& u, int wr, int wc, int fr, int fq) const {
        const int row0 = u.pm * BM + wr * 64 + fr, col0 = u.pn * BM + wc * 32 + 8 * fq;
#pragma unroll
        for (int ai = 0; ai < 2; ++ai) {
            u32x4 bv[4][2];
#pragma unroll
            for (int m = 0; m < 4; ++m)
#pragma unroll
                for (int bj = 0; bj < 2; ++bj) bv[m][bj] = *(const u32x4*)(XB + (size_t)(row0 + ai * HALF + m * 16) * 1024 + col0 + bj * HALF);
#pragma unroll
            for (int m = 0; m < 4; ++m) {
                const int row = row0 + ai * HALF + m * 16; const size_t off = (size_t)row * 1024 + col0;
                float s = 0.f;
#pragma unroll
                for (int bj = 0; bj < 2; ++bj) {
                    const u32x4 b = bv[m][bj];
                    const f32x4 b0 = {__builtin_bit_cast(float, b.x << 16), __builtin_bit_cast(float, b.x & 0xffff0000u), __builtin_bit_cast(float, b.y << 16), __builtin_bit_cast(float, b.y & 0xffff0000u)};
                    const f32x4 b1 = {__builtin_bit_cast(float, b.z << 16), __builtin_bit_cast(float, b.z & 0xffff0000u), __builtin_bit_cast(float, b.w << 16), __builtin_bit_cast(float, b.w & 0xffff0000u)};
                    const f32x4 v0 = b0 + acc[ai][bj][m][0] * alpha, v1 = b1 + acc[ai][bj][m][1] * alpha;
                    u32x4 w; w.x = cvt_pk_bf16(v0[0], v0[1]); w.y = cvt_pk_bf16(v0[2], v0[3]); w.z = cvt_pk_bf16(v1[0], v1[1]); w.w = cvt_pk_bf16(v1[2], v1[3]);
                    *(u32x4*)(XB + off + bj * HALF) = w;
                    const float r0 = __builtin_bit_cast(float, w.x << 16), r1 = __builtin_bit_cast(float, w.x & 0xffff0000u), r2 = __builtin_bit_cast(float, w.y << 16), r3 = __builtin_bit_cast(float, w.y & 0xffff0000u);
                    const float r4 = __builtin_bit_cast(float, w.z << 16), r5 = __builtin_bit_cast(float, w.z & 0xffff0000u), r6 = __builtin_bit_cast(float, w.w << 16), r7 = __builtin_bit_cast(float, w.w & 0xffff0000u);
                    s += (r0 * r0 + r1 * r1) + (r2 * r2 + r3 * r3) + (r4 * r4 + r5 * r5) + (r6 * r6 + r7 * r7);
                }
                s += __shfl_xor(s, 16); s += __shfl_xor(s, 32);
                if (fq == 0) SS[(size_t)row * 16 + u.pn * 4 + wc] = s;
            }
        }
    }
};
struct EpiResNoop {
    static constexpr bool PERM = true, AFTER_DRAIN = false;
    __device__ __forceinline__ void operator()(const f32x4 (&acc)[2][2][4][2], const Unit&, int, int, int, int) const {
#pragma unroll
        for (int ai = 0; ai < 2; ++ai)
#pragma unroll
            for (int bj = 0; bj < 2; ++bj)
                asm volatile("" :: "v"(acc[ai][bj][0][0]), "v"(acc[ai][bj][0][1]), "v"(acc[ai][bj][1][0]), "v"(acc[ai][bj][1][1]), "v"(acc[ai][bj][2][0]), "v"(acc[ai][bj][2][1]), "v"(acc[ai][bj][3][0]), "v"(acc[ai][bj][3][1]));
    }
};
struct EpiQKV {
    static constexpr bool PERM = true, AFTER_DRAIN = false;
    bf16_t* O; int ldc; const float* SS; int nq_tiles; float qscale; float* KMP; int k_lo, k_hi;
    __device__ __forceinline__ void operator()(const f32x4 (&acc)[2][2][4][2], const Unit& u, int wr, int wc, int fr, int fq) const {
        const int row0 = u.pm * BM + wr * 64 + fr, col0 = u.pn * BM + wc * 32 + 8 * fq;
        const float sc = (u.pn < nq_tiles) ? qscale : 1.0f;
        float r8[8]; row_rstd8(SS, row0, fq, r8);
#pragma unroll
        for (int ai = 0; ai < 2; ++ai)
#pragma unroll
            for (int m = 0; m < 4; ++m) {
                const int row = row0 + ai * HALF + m * 16;
                const float r = r8[ai * 4 + m] * sc;
                bf16_t* rowp = O + (size_t)row * ldc + col0;
#pragma unroll
                for (int bj = 0; bj < 2; ++bj) {
                    const f32x4 v0 = acc[ai][bj][m][0] * r, v1 = acc[ai][bj][m][1] * r;
                    u32x4 w; w.x = cvt_pk_bf16(v0[0], v0[1]); w.y = cvt_pk_bf16(v0[2], v0[3]); w.z = cvt_pk_bf16(v1[0], v1[1]); w.w = cvt_pk_bf16(v1[2], v1[3]);
                    *(u32x4*)(rowp + bj * HALF) = w;
                }
            }
        if (KMP != nullptr && u.pn >= k_lo && u.pn < k_hi) {
            float* dst = KMP + ((size_t)u.pm * 2 + wr) * 1024 + (u.pn - k_lo) * BM + wc * 32 + 8 * fq;
#pragma unroll
            for (int bj = 0; bj < 2; ++bj)
#pragma unroll
                for (int n = 0; n < 2; ++n) {
                    f32x4 cs = {0.f, 0.f, 0.f, 0.f};
#pragma unroll
                    for (int ai = 0; ai < 2; ++ai)
#pragma unroll
                        for (int m = 0; m < 4; ++m) cs += acc[ai][bj][m][n] * r8[ai * 4 + m];
#pragma unroll
                    for (int i = 0; i < 4; ++i) { float c = cs[i]; c += __shfl_xor(c, 1); c += __shfl_xor(c, 2); c += __shfl_xor(c, 4); c += __shfl_xor(c, 8); cs[i] = c; }
                    if (fr == 0) *(f32x4*)(dst + bj * HALF + 4 * n) = cs;
                }
        }
    }
};
#ifndef PG8_PRIO_MMA
#define PG8_PRIO_MMA 1
#define PG8_PRIO_LOAD 0
#endif
template <class E, class = void> struct kprobe_of { static constexpr int value = 0; };
template <class E> struct kprobe_of<E, decltype((void)E::KPROBE)> { static constexpr int value = E::KPROBE; };
template <class Epi, class Sched, bool ALIGN_EPI = false, bool SP2 = false, bool XDMA = false>
__device__ __forceinline__ void gemm_phase(PG8_LAS unsigned char* lds, const Gemm g, const Sched& S, const Epi& E) {
    int tid = threadIdx.x; asm volatile("" : "+v"(tid));
    const int wid = __builtin_amdgcn_readfirstlane(tid >> 6), lane = tid & 63, wr = wid >> 2, wc = wid & 3, fr = lane & 15, fq = lane >> 4;
    const int K = g.K, nt = K / BK;
    unsigned voffA[2], voffB[2];
#pragma unroll
    for (int i = 0; i < 2; ++i) { int R, C; stage_rc(tid * 16 + i * 8192, R, C); const int Rb = Epi::PERM ? ((R & ~31) + perm32(R & 31)) : R;
        voffA[i] = (unsigned)(R * K + C) * 2u; voffB[i] = (unsigned)(Rb * K + C) * 2u; }
    const size_t kstep = (size_t)(BK * 2);
    const size_t hstep = (size_t)HALF * K * 2;
    const size_t tstep = 2 * hstep;
    const unsigned ldsw = (unsigned)wid * 1024u;
    const int aoff = lds_byte(wr * 64 + fr, fq * 8), boff = lds_byte(wc * 32 + fr, fq * 8);
#define PG8_SA(b, h) (((b) * 2 + (h)) * HTB)
#define PG8_SB(b, h) ((4 + (b) * 2 + (h)) * HTB)
#define PG8_STAGE(bufoff, gbase, voff) do { if constexpr (kprobe_of<Epi>::value != 1) _Pragma("unroll") for (int _i = 0; _i < 2; ++_i) \
        __builtin_amdgcn_global_load_lds((const unsigned*)((const char*)(gbase) + (voff)[_i]), (PG8_LAS unsigned*)(lds + (bufoff) + ldsw + _i * 8192), 16, 0, 0); } while (0)
#define PG8_LDA(dst, b, h) do { if constexpr (kprobe_of<Epi>::value != 2) _Pragma("unroll") for (int m = 0; m < 4; ++m) _Pragma("unroll") for (int k = 0; k < 2; ++k) dst[m][k] = *(const PG8_LAS bf16x8*)(lds + PG8_SA(b, h) + aoff + m * 2048 + k * 1024); } while (0)
#define PG8_LDB(dst, b, h) do { if constexpr (kprobe_of<Epi>::value != 2) _Pragma("unroll") for (int n = 0; n < 2; ++n) _Pragma("unroll") for (int k = 0; k < 2; ++k) dst[n][k] = *(const PG8_LAS bf16x8*)(lds + PG8_SB(b, h) + boff + n * 2048 + k * 1024); } while (0)
#define PG8_MMA(ai, bj, At, Bt) do { __builtin_amdgcn_s_setprio(PG8_PRIO_MMA); _Pragma("unroll") for (int m = 0; m < 4; ++m) _Pragma("unroll") for (int n = 0; n < 2; ++n) _Pragma("unroll") for (int k = 0; k < 2; ++k) \
        acc[ai][bj][m][n] = __builtin_amdgcn_mfma_f32_16x16x32_bf16(Bt[n][k], At[m][k], acc[ai][bj][m][n], 0, 0, 0); __builtin_amdgcn_s_setprio(PG8_PRIO_LOAD); } while (0)
#define PG8_WAIT_V(n) asm volatile("s_waitcnt vmcnt(" #n ")" ::: "memory")
#define PG8_WAIT_L(n) asm volatile("s_waitcnt lgkmcnt(" #n ")" ::: "memory")
#define PG8_BAR __builtin_amdgcn_s_barrier()
#define PG8_SCHED __builtin_amdgcn_sched_barrier(0)
    Unit cur, nxt; int ui = 0;
    if (!S.next(0, cur)) return;
    f32x4 acc[2][2][4][2];
#pragma unroll
    for (int a = 0; a < 2; ++a)
#pragma unroll
        for (int b = 0; b < 2; ++b)
#pragma unroll
            for (int m = 0; m < 4; ++m)
#pragma unroll
                for (int n = 0; n < 2; ++n) acc[a][b][m][n] = (f32x4){0.f, 0.f, 0.f, 0.f};
    bf16x8 At[4][2], B0[2][2], B1[2][2];
    const char* cA = (const char*)g.A + (size_t)cur.pm * tstep; const char* cB = (const char*)g.Bt + (size_t)cur.pn * tstep;
    S.a_ready(cur);
    if constexpr (SP2) {
        PG8_STAGE(PG8_SB(0, 0), cB, voffB); PG8_STAGE(PG8_SB(0, 1), cB + hstep, voffB); PG8_STAGE(PG8_SA(0, 0), cA, voffA); PG8_STAGE(PG8_SA(0, 1), cA + hstep, voffA);
        if (wr == 1) PG8_BAR;
        PG8_WAIT_V(2); PG8_BAR;
        PG8_STAGE(PG8_SB(1, 0), cB + kstep, voffB); PG8_STAGE(PG8_SA(1, 0), cA + kstep, voffA); PG8_STAGE(PG8_SB(1, 1), cB + hstep + kstep, voffB);
        PG8_WAIT_V(6); PG8_BAR;
    } else {
        PG8_STAGE(PG8_SB(0, 0), cB, voffB); PG8_STAGE(PG8_SA(0, 0), cA, voffA); PG8_STAGE(PG8_SB(0, 1), cB + hstep, voffB); PG8_STAGE(PG8_SA(0, 1), cA + hstep, voffA);
        if (wr == 1) PG8_BAR;
        PG8_WAIT_V(4); PG8_BAR;
        PG8_STAGE(PG8_SB(1, 0), cB + kstep, voffB); PG8_STAGE(PG8_SA(1, 0), cA + kstep, voffA); PG8_STAGE(PG8_SB(1, 1), cB + hstep + kstep, voffB);
        PG8_WAIT_V(6); PG8_BAR;
    }
    for (;;) {
        const bool has_next = S.next(ui + 1, nxt);
        const char* nA = has_next ? (const char*)g.A + (size_t)nxt.pm * tstep : cA; const char* nB = has_next ? (const char*)g.Bt + (size_t)nxt.pn * tstep : cB;
        for (int t = 0; t < nt; t += 2) {
            const bool last = (t == nt - 2);
            const char* a1 = cA + (size_t)(t + 1) * kstep;
            const char* a2 = last ? nA : cA + (size_t)(t + 2) * kstep; const char* b2 = last ? nB : cB + (size_t)(t + 2) * kstep;
            const char* a3 = a2 + kstep; const char* b3 = b2 + kstep;
            if (last && has_next) S.a_ready(nxt);
            if constexpr (SP2) {
            if constexpr (XDMA) {
            PG8_LDB(B0, 0, 0); PG8_LDB(B1, 0, 1); PG8_SCHED; PG8_LDA(At, 0, 0);
            PG8_WAIT_V(6); PG8_WAIT_L(0); PG8_BAR; PG8_MMA(0, 0, At, B0); PG8_STAGE(PG8_SA(1, 1), a1 + hstep, voffA); PG8_MMA(0, 1, At, B1); PG8_BAR; PG8_SCHED;
            PG8_LDA(At, 0, 1);
            PG8_WAIT_V(2); PG8_WAIT_L(0); PG8_BAR; PG8_MMA(1, 0, At, B0); PG8_STAGE(PG8_SB(0, 0), b2, voffB); PG8_STAGE(PG8_SB(0, 1), b2 + hstep, voffB); PG8_STAGE(PG8_SA(0, 0), a2, voffA); PG8_MMA(1, 1, At, B1); PG8_BAR; PG8_SCHED;
            PG8_LDB(B0, 1, 0); PG8_LDB(B1, 1, 1); PG8_SCHED; PG8_LDA(At, 1, 0);
            PG8_WAIT_V(6); PG8_WAIT_L(0); PG8_BAR; PG8_MMA(0, 0, At, B0); PG8_STAGE(PG8_SA(0, 1), a2 + hstep, voffA); PG8_MMA(0, 1, At, B1); PG8_BAR; PG8_SCHED;
            PG8_LDA(At, 1, 1);
            PG8_WAIT_V(2); PG8_WAIT_L(0); PG8_BAR; PG8_MMA(1, 0, At, B0); PG8_STAGE(PG8_SB(1, 0), b3, voffB); PG8_STAGE(PG8_SB(1, 1), b3 + hstep, voffB); PG8_STAGE(PG8_SA(1, 0), a3, voffA); PG8_MMA(1, 1, At, B1); PG8_BAR; PG8_SCHED;
            } else {
            PG8_LDB(B0, 0, 0); PG8_LDB(B1, 0, 1); PG8_SCHED; PG8_LDA(At, 0, 0); PG8_STAGE(PG8_SA(1, 1), a1 + hstep, voffA);
            PG8_WAIT_V(8); PG8_WAIT_L(0); PG8_BAR; PG8_MMA(0, 0, At, B0); PG8_MMA(0, 1, At, B1); PG8_BAR; PG8_SCHED;
            PG8_LDA(At, 0, 1); PG8_STAGE(PG8_SB(0, 0), b2, voffB); PG8_STAGE(PG8_SB(0, 1), b2 + hstep, voffB); PG8_STAGE(PG8_SA(0, 0), a2, voffA);
            PG8_WAIT_V(8); PG8_WAIT_L(0); PG8_BAR; PG8_MMA(1, 0, At, B0); PG8_MMA(1, 1, At, B1); PG8_BAR; PG8_SCHED;
            PG8_LDB(B0, 1, 0); PG8_LDB(B1, 1, 1); PG8_SCHED; PG8_LDA(At, 1, 0); PG8_STAGE(PG8_SA(0, 1), a2 + hstep, voffA);
            PG8_WAIT_V(8); PG8_WAIT_L(0); PG8_BAR; PG8_MMA(0, 0, At, B0); PG8_MMA(0, 1, At, B1); PG8_BAR; PG8_SCHED;
            PG8_LDA(At, 1, 1); PG8_STAGE(PG8_SB(1, 0), b3, voffB); PG8_STAGE(PG8_SB(1, 1), b3 + hstep, voffB); PG8_STAGE(PG8_SA(1, 0), a3, voffA);
            PG8_WAIT_V(8); PG8_WAIT_L(0); PG8_BAR; PG8_MMA(1, 0, At, B0); PG8_MMA(1, 1, At, B1); PG8_BAR; PG8_SCHED;
            }
            } else {
            PG8_LDB(B0, 0, 0); PG8_SCHED; PG8_LDA(At, 0, 0); PG8_STAGE(PG8_SA(1, 1), a1 + hstep, voffA);
            PG8_WAIT_L(8); PG8_BAR; PG8_WAIT_L(0); PG8_MMA(0, 0, At, B0); PG8_BAR; PG8_SCHED;
            PG8_LDB(B1, 0, 1); PG8_STAGE(PG8_SB(0, 0), b2, voffB);
            PG8_BAR; PG8_WAIT_L(0); PG8_MMA(0, 1, At, B1); PG8_BAR;
            PG8_LDA(At, 0, 1); PG8_STAGE(PG8_SA(0, 0), a2, voffA);
            PG8_BAR; PG8_WAIT_L(0); PG8_MMA(1, 0, At, B0); PG8_BAR; PG8_SCHED;
            PG8_STAGE(PG8_SB(0, 1), b2 + hstep, voffB);
            PG8_WAIT_V(6); PG8_BAR; PG8_MMA(1, 1, At, B1); PG8_BAR;
            PG8_LDB(B0, 1, 0); PG8_SCHED; PG8_LDA(At, 1, 0); PG8_STAGE(PG8_SA(0, 1), a2 + hstep, voffA);
            PG8_WAIT_L(8); PG8_BAR; PG8_WAIT_L(0); PG8_MMA(0, 0, At, B0); PG8_BAR; PG8_SCHED;
            PG8_LDB(B1, 1, 1); PG8_STAGE(PG8_SB(1, 0), b3, voffB);
            PG8_BAR; PG8_WAIT_L(0); PG8_MMA(0, 1, At, B1); PG8_BAR;
            PG8_LDA(At, 1, 1); PG8_STAGE(PG8_SA(1, 0), a3, voffA);
            PG8_BAR; PG8_WAIT_L(0); PG8_MMA(1, 0, At, B0); PG8_BAR; PG8_SCHED;
            PG8_STAGE(PG8_SB(1, 1), b3 + hstep, voffB);
            PG8_WAIT_V(6); PG8_BAR; PG8_MMA(1, 1, At, B1); PG8_BAR;
            }
        }
        if constexpr (ALIGN_EPI) { if (wr == 0) PG8_BAR; }
        if constexpr (!Epi::AFTER_DRAIN) { E(acc, cur, wr, wc, fr, fq); S.done(cur); }
        if (!has_next) break;
#pragma unroll
        for (int a = 0; a < 2; ++a)
#pragma unroll
            for (int b = 0; b < 2; ++b)
#pragma unroll
                for (int m = 0; m < 4; ++m)
#pragma unroll
                    for (int n = 0; n < 2; ++n) acc[a][b][m][n] = (f32x4){0.f, 0.f, 0.f, 0.f};
        cur = nxt; cA = nA; cB = nB; ++ui;
        if constexpr (ALIGN_EPI) { if (wr == 1) PG8_BAR; }
    }
    PG8_WAIT_V(0);
    if constexpr (!ALIGN_EPI) { if (wr == 0) PG8_BAR; }
    PG8_BAR;
    if constexpr (Epi::AFTER_DRAIN) { E.fused(acc, cur, wr, wc, fr, fq, lds, wid, lane); S.done(cur); }
#undef PG8_SA
#undef PG8_SB
#undef PG8_STAGE
#undef PG8_LDA
#undef PG8_LDB
#undef PG8_MMA
#undef PG8_WAIT_V
#undef PG8_WAIT_L
#undef PG8_BAR
#undef PG8_SCHED
}
}
namespace pg8 {
constexpr int HM_STAGE_BYTES = 9 * HTB;
template <class Epi>
__device__ __forceinline__ void gemm_half_unit(PG8_LAS unsigned char* lds, const Gemm g, const HUnit hu, const Epi& E) {
    int tid = threadIdx.x; asm volatile("" : "+v"(tid));
    const int wid = __builtin_amdgcn_readfirstlane(tid >> 6), lane = tid & 63, wr = wid >> 2, wc = wid & 3, fr = lane & 15, fq = lane >> 4;
    const int K = g.K, nt = K / BK;
    unsigned voffA[2], voffB[2];
#pragma unroll
    for (int i = 0; i < 2; ++i) { int R, C; stage_rc(tid * 16 + i * 8192, R, C); const int Rb = Epi::PERM ? ((R & ~31) + perm32(R & 31)) : R;
        voffA[i] = (unsigned)(R * K + C) * 2u; voffB[i] = (unsigned)(Rb * K + C) * 2u; }
    const size_t kstep = (size_t)(BK * 2);
    const size_t hstep = (size_t)HALF * K * 2;
    const unsigned ldsw = (unsigned)wid * 1024u;
    const int aoff = lds_byte(wr * 64 + fr, fq * 8), boff = lds_byte(wc * 32 + fr, fq * 8);
#define HM_SA(b) ((b) * 3 * HTB)
#define HM_SB(b, h) (((b) * 3 + 1 + (h)) * HTB)
#define HM_STAGE(bufoff, gbase, voff) do { _Pragma("unroll") for (int _i = 0; _i < 2; ++_i) \
        __builtin_amdgcn_global_load_lds((const unsigned*)((const char*)(gbase) + (voff)[_i]), (PG8_LAS unsigned*)(lds + (bufoff) + ldsw + _i * 8192), 16, 0, 0); } while (0)
#define HM_LDA(dst, b) do { _Pragma("unroll") for (int m = 0; m < 4; ++m) _Pragma("unroll") for (int k = 0; k < 2; ++k) dst[m][k] = *(const PG8_LAS bf16x8*)(lds + HM_SA(b) + aoff + m * 2048 + k * 1024); } while (0)
#define HM_LDB(dst, b, h) do { _Pragma("unroll") for (int n = 0; n < 2; ++n) _Pragma("unroll") for (int k = 0; k < 2; ++k) dst[n][k] = *(const PG8_LAS bf16x8*)(lds + HM_SB(b, h) + boff + n * 2048 + k * 1024); } while (0)
#define HM_MMA(bj, At, Bt) do { __builtin_amdgcn_s_setprio(PG8_PRIO_MMA); _Pragma("unroll") for (int m = 0; m < 4; ++m) _Pragma("unroll") for (int n = 0; n < 2; ++n) _Pragma("unroll") for (int k = 0; k < 2; ++k) \
        acc[bj][m][n] = __builtin_amdgcn_mfma_f32_16x16x32_bf16(Bt[n][k], At[m][k], acc[bj][m][n], 0, 0, 0); __builtin_amdgcn_s_setprio(PG8_PRIO_LOAD); } while (0)
#define HM_WAIT_V(n) asm volatile("s_waitcnt vmcnt(" #n ")" ::: "memory")
#define HM_WAIT_L(n) asm volatile("s_waitcnt lgkmcnt(" #n ")" ::: "memory")
#define HM_BAR __builtin_amdgcn_s_barrier()
#define HM_SCHED __builtin_amdgcn_sched_barrier(0)
    f32x4 acc[2][4][2];
#pragma unroll
    for (int b = 0; b < 2; ++b)
#pragma unroll
        for (int m = 0; m < 4; ++m)
#pragma unroll
            for (int n = 0; n < 2; ++n) acc[b][m][n] = (f32x4){0.f, 0.f, 0.f, 0.f};
    bf16x8 At[4][2], B0[2][2], B1[2][2];
    const char* cA = (const char*)g.A + (size_t)hu.pm2 * hstep; const char* cB = (const char*)g.Bt + (size_t)hu.pn * 2 * hstep;
    HM_STAGE(HM_SB(0, 0), cB, voffB); HM_STAGE(HM_SB(0, 1), cB + hstep, voffB); HM_STAGE(HM_SA(0), cA, voffA);
    HM_STAGE(HM_SB(1, 0), cB + kstep, voffB); HM_STAGE(HM_SB(1, 1), cB + hstep + kstep, voffB); HM_STAGE(HM_SA(1), cA + kstep, voffA);
    if (wr == 1) HM_BAR;
    HM_WAIT_V(6); HM_BAR; HM_BAR;
#define HM_SP(b, bn2, s) do { \
        HM_LDB(B0, b, 0); HM_LDB(B1, b, 1); HM_SCHED; HM_LDA(At, b); \
        if ((s) + 2 < nt) { const char* a2 = cA + (size_t)((s) + 2) * kstep; const char* b2 = cB + (size_t)((s) + 2) * kstep; \
            HM_STAGE(HM_SB(bn2, 0), b2, voffB); HM_STAGE(HM_SB(bn2, 1), b2 + hstep, voffB); HM_STAGE(HM_SA(bn2), a2, voffA); HM_WAIT_V(6); } \
        else { HM_WAIT_V(0); } \
        HM_WAIT_L(0); HM_BAR; HM_MMA(0, At, B0); HM_MMA(1, At, B1); HM_BAR; HM_SCHED; } while (0)
    for (int s = 0; s < nt; s += 3) {
        HM_SP(0, 2, s);
        if (s + 1 < nt) HM_SP(1, 0, s + 1);
        if (s + 2 < nt) HM_SP(2, 1, s + 2);
    }
    if (wr == 0) HM_BAR;
    E.half(acc, hu, wr, wc, fr, fq);
#undef HM_SA
#undef HM_SB
#undef HM_STAGE
#undef HM_LDA
#undef HM_LDB
#undef HM_MMA
#undef HM_WAIT_V
#undef HM_WAIT_L
#undef HM_BAR
#undef HM_SCHED
#undef HM_SP
}
}
namespace att {
typedef short bf16x8 __attribute__((ext_vector_type(8)));
typedef short s16x4 __attribute__((ext_vector_type(4)));
typedef float f32x16 __attribute__((ext_vector_type(16)));
typedef float f32x4 __attribute__((ext_vector_type(4)));
typedef unsigned u32x4 __attribute__((ext_vector_type(4)));
typedef int int4v __attribute__((ext_vector_type(4)));
typedef unsigned short bf16_t;
constexpr int SEQ = 2048, OPITCH = 1024;
constexpr int SLOTB = 8192, NSLOT = 4;
constexpr int LDS_K = 0, LDS_V = NSLOT * SLOTB, LDS_WS = 2 * NSLOT * SLOTB, LDS_OST = LDS_WS + 8 * 256, LDS_KMT = LDS_OST + 8 * 4096, LDS_END = LDS_KMT + 8 * 64 * 4;
typedef LAS const char* lds_cptr;
#define ATT_SBAR() __builtin_amdgcn_sched_barrier(0)
#define ATT_WAIT_BAR(N) asm volatile("s_waitcnt vmcnt(" #N ") lgkmcnt(0)\n\ts_barrier" ::: "memory")
__device__ __forceinline__ int crow(int r, int hi) { return (r & 3) + 8 * (r >> 2) + 4 * hi; }
__device__ __forceinline__ void glds16(const void* gsrc, unsigned lds_dst) { unsigned keep;
    asm volatile("s_mov_b32 %0, m0\n\ts_mov_b32 m0, %2\n\ts_nop 0\n\tglobal_load_lds_dwordx4 %1, off\n\ts_mov_b32 m0, %0" : "=&s"(keep) : "v"(gsrc), "s"(lds_dst) : "memory"); }
typedef float f32x2_t __attribute__((ext_vector_type(2))); typedef __bf16 bf16x2_t __attribute__((ext_vector_type(2)));
__device__ __forceinline__ unsigned cvtpk(float lo, float hi) { f32x2_t v = {lo, hi}; bf16x2_t b = __builtin_convertvector(v, bf16x2_t); return __builtin_bit_cast(unsigned, b); }
__device__ __forceinline__ float bf2f(short s) { return __builtin_bit_cast(float, (unsigned)(unsigned short)s << 16); }
__device__ __forceinline__ float partner(float x, int hi) {
    auto rr = __builtin_amdgcn_permlane32_swap(__builtin_bit_cast(unsigned, x), __builtin_bit_cast(unsigned, x), false, false);
    return __builtin_bit_cast(float, hi ? rr[0] : rr[1]);
}
typedef short v4i16_t __attribute__((ext_vector_type(4)));
__device__ __forceinline__ s16x4 vtr(lds_cptr p) { return __builtin_bit_cast(s16x4, __builtin_amdgcn_ds_read_tr16_b64_v4i16((LAS v4i16_t*)p)); }
__device__ __forceinline__ void vload16(s16x4* vlo, s16x4* vhi, lds_cptr vp) {
#pragma unroll
    for (int i = 0; i < 8; ++i) { vlo[i] = vtr(vp + ((i >> 2) * 4096 + (i & 3) * 1024)); vhi[i] = vtr(vp + ((i >> 2) * 4096 + (i & 3) * 1024 + 512)); }
}
__device__ __forceinline__ void pv_r(f32x16* o, const s16x4* vlo, const s16x4* vhi, bf16x8 pa0, bf16x8 pa1, bf16x8 pa2, bf16x8 pa3) {
#define ATT_VF(i) (bf16x8){vlo[i][0], vlo[i][1], vlo[i][2], vlo[i][3], vhi[i][0], vhi[i][1], vhi[i][2], vhi[i][3]}
    o[0] = __builtin_amdgcn_mfma_f32_32x32x16_bf16(pa0, ATT_VF(0), o[0], 0, 0, 0); o[1] = __builtin_amdgcn_mfma_f32_32x32x16_bf16(pa0, ATT_VF(4), o[1], 0, 0, 0);
    o[0] = __builtin_amdgcn_mfma_f32_32x32x16_bf16(pa1, ATT_VF(1), o[0], 0, 0, 0); o[1] = __builtin_amdgcn_mfma_f32_32x32x16_bf16(pa1, ATT_VF(5), o[1], 0, 0, 0);
    o[0] = __builtin_amdgcn_mfma_f32_32x32x16_bf16(pa2, ATT_VF(2), o[0], 0, 0, 0); o[1] = __builtin_amdgcn_mfma_f32_32x32x16_bf16(pa2, ATT_VF(6), o[1], 0, 0, 0);
    o[0] = __builtin_amdgcn_mfma_f32_32x32x16_bf16(pa3, ATT_VF(3), o[0], 0, 0, 0); o[1] = __builtin_amdgcn_mfma_f32_32x32x16_bf16(pa3, ATT_VF(7), o[1], 0, 0, 0);
#undef ATT_VF
}
__device__ __forceinline__ void qkt(f32x16& p0, f32x16& p1, lds_cptr kb, const bf16x8* qr) {
    const f32x16 z = {};
#pragma unroll
    for (int d0 = 0; d0 < 4; ++d0) {
        const bf16x8 b0 = *(const LAS bf16x8*)(kb + d0 * 2048);
        const bf16x8 b1 = *(const LAS bf16x8*)(kb + d0 * 2048 + 512);
        if (d0 == 0) { p0 = __builtin_amdgcn_mfma_f32_32x32x16_bf16(b0, qr[0], z, 0, 0, 0); p1 = __builtin_amdgcn_mfma_f32_32x32x16_bf16(b1, qr[0], z, 0, 0, 0); }
        else { p0 = __builtin_amdgcn_mfma_f32_32x32x16_bf16(b0, qr[d0], p0, 0, 0, 0); p1 = __builtin_amdgcn_mfma_f32_32x32x16_bf16(b1, qr[d0], p1, 0, 0, 0); }
    }
}
__device__ __forceinline__ void qkt_aug(f32x16& p0, f32x16& p1, lds_cptr kb, const bf16x8* qr, const f32x16& c, bf16x8 kaug0, bf16x8 kaug1, bf16x8 qaug) {
    p0 = __builtin_amdgcn_mfma_f32_32x32x16_bf16(kaug0, qaug, c, 0, 0, 0); p1 = __builtin_amdgcn_mfma_f32_32x32x16_bf16(kaug1, qaug, c, 0, 0, 0);
#pragma unroll
    for (int d0 = 0; d0 < 4; ++d0) {
        const bf16x8 b0 = *(const LAS bf16x8*)(kb + d0 * 2048);
        const bf16x8 b1 = *(const LAS bf16x8*)(kb + d0 * 2048 + 512);
        p0 = __builtin_amdgcn_mfma_f32_32x32x16_bf16(b0, qr[d0], p0, 0, 0, 0); p1 = __builtin_amdgcn_mfma_f32_32x32x16_bf16(b1, qr[d0], p1, 0, 0, 0);
    }
}
__device__ __forceinline__ void pv(f32x16* o, int vb, bf16x8 pa0, bf16x8 pa1, bf16x8 pa2, bf16x8 pa3) {
#pragma unroll
    for (int d0 = 0; d0 < 2; ++d0) { s16x4 lo[4], hi[4];
#pragma unroll
        for (int ks = 0; ks < 4; ++ks) {
            asm volatile("ds_read_b64_tr_b16 %0,%1 offset:%c2" : "=&v"(lo[ks]) : "v"(vb), "i"(d0 * 4096 + ks * 1024) : "memory");
            asm volatile("ds_read_b64_tr_b16 %0,%1 offset:%c2" : "=&v"(hi[ks]) : "v"(vb), "i"(d0 * 4096 + ks * 1024 + 512) : "memory"); }
        asm volatile("s_waitcnt lgkmcnt(0)" ::: "memory"); ATT_SBAR();
#define ATT_PK(k) (bf16x8){lo[k][0], lo[k][1], lo[k][2], lo[k][3], hi[k][0], hi[k][1], hi[k][2], hi[k][3]}
        o[d0] = __builtin_amdgcn_mfma_f32_32x32x16_bf16(pa0, ATT_PK(0), o[d0], 0, 0, 0);
        o[d0] = __builtin_amdgcn_mfma_f32_32x32x16_bf16(pa1, ATT_PK(1), o[d0], 0, 0, 0);
        o[d0] = __builtin_amdgcn_mfma_f32_32x32x16_bf16(pa2, ATT_PK(2), o[d0], 0, 0, 0);
        o[d0] = __builtin_amdgcn_mfma_f32_32x32x16_bf16(pa3, ATT_PK(3), o[d0], 0, 0, 0);
#undef ATT_PK
    }
}
template <bool MOBA>
__device__ __forceinline__ void attn_unit(const int b, const int h, const int qb, const bf16_t* __restrict__ QKV, const int pitch, const int koff, const int voff,
                                          bf16_t* __restrict__ O, LAS unsigned char* lds, const float* __restrict__ KMP, const float sl2, const unsigned force_sel = 0u) {
    int tid = threadIdx.x; asm volatile("" : "+v"(tid));
    const int lane = tid & 63, r32 = lane & 31, hi = lane >> 5;
    const int wid = __builtin_amdgcn_readfirstlane(tid >> 6);
    const long rowbase = (long)b * SEQ; const int q0 = qb * 256;
    const bf16_t* Qw = QKV + (rowbase + q0 + wid * 32) * pitch + h * 64;
    const bf16_t* Kh = QKV + rowbase * pitch + koff + h * 64;
    const bf16_t* Vh = QKV + rowbase * pitch + voff + h * 64;
    const unsigned lds0 = (unsigned)(uintptr_t)lds;
    const bf16_t* ksrc = Kh + (long)lane * pitch + wid * 8;
    const bf16_t* vsrc = Vh + (long)(16 * (wid & 3) + (lane >> 2)) * pitch + (wid >> 2) * 32 + (lane & 3) * 8;
    const unsigned kdst = lds0 + LDS_K + wid * 1024, vdst = lds0 + LDS_V + wid * 1024;
#define ATT_DMA_KV(t, slot) do { glds16(ksrc + (long)(t) * 64 * pitch, (unsigned)__builtin_amdgcn_readfirstlane(kdst + (slot))); \
                                 glds16(vsrc + (long)(t) * 64 * pitch, (unsigned)__builtin_amdgcn_readfirstlane(vdst + (slot))); } while (0)
    const int NT = 4 * qb + 4;
    const int tdiag = 4 * qb + (wid >> 1);
    LAS float* wsf = (LAS float*)(lds + LDS_WS) + wid * 64;
    const lds_cptr kp0 = (lds_cptr)lds + LDS_K + hi * 1024 + r32 * 16;
    const int vb0 = (int)(lds0 + LDS_V) + ((lane >> 4) & 1) * 32 + (lane & 3) * 8 + (4 * hi + ((lane & 15) >> 2)) * 64;
    ATT_DMA_KV(NT - 1, 0); ATT_DMA_KV(NT - 2, SLOTB);
    bf16x8 qr[4];
#pragma unroll
    for (int d0 = 0; d0 < 4; ++d0) qr[d0] = *(const bf16x8*)(Qw + (long)r32 * pitch + d0 * 16 + hi * 8);
    f32x16 o[2]; o[0] = f32x16{}; o[1] = f32x16{};
    const int qrel = wid * 32 + r32;
    float carry = 1.0f;
    float mhat = 0.f, lrow = 0.f; unsigned selmask = 0u;
    bf16x8 kaug0 = {0, 0, 0, 0, 0, 0, 0, 0}, kaug1 = {0, 0, 0, 0, 0, 0, 0, 0}, qaug = {0, 0, 0, 0, 0, 0, 0, 0};
    if constexpr (MOBA) {
        LAS float* kmt = (LAS float*)(lds + LDS_KMT);
        { const int n = tid >> 6, d = tid & 63;
          if (n < qb) { const float* kp = KMP + ((size_t)(b * 8 + n) * 2) * 1024 + h * 64 + d; kmt[n * 64 + d] = (kp[0] + kp[1024]) * (1.0f / 256.0f); } }
        asm volatile("s_waitcnt lgkmcnt(0)\n\ts_barrier" ::: "memory");
        float gate[7];
#pragma unroll
        for (int n = 0; n < 7; ++n) {
            float g = -INFINITY;
            if (n < qb) {
                float s = 0.f;
#pragma unroll
                for (int d0 = 0; d0 < 4; ++d0) {
                    const f32x4 k0 = *(const LAS f32x4*)(kmt + n * 64 + d0 * 16 + hi * 8), k1 = *(const LAS f32x4*)(kmt + n * 64 + d0 * 16 + hi * 8 + 4);
                    s += bf2f(qr[d0][0]) * k0[0] + bf2f(qr[d0][1]) * k0[1] + bf2f(qr[d0][2]) * k0[2] + bf2f(qr[d0][3]) * k0[3]
                       + bf2f(qr[d0][4]) * k1[0] + bf2f(qr[d0][5]) * k1[1] + bf2f(qr[d0][6]) * k1[2] + bf2f(qr[d0][7]) * k1[3];
                }
                g = s + partner(s, hi);
            }
            gate[n] = g;
        }
#pragma unroll
        for (int r = 0; r < 3; ++r) {
            int best = -1; float bv = -INFINITY;
#pragma unroll
            for (int n = 0; n < 7; ++n) { const bool taken = (selmask >> n) & 1u; if (!taken && gate[n] > bv) { best = n; bv = gate[n]; } }
            if (best >= 0) selmask |= 1u << best;
        }
        selmask |= (1u << qb) | force_sel;
        mhat = sl2 * (float)qrel;
        if (hi == 0) {
            const unsigned sh = __builtin_bit_cast(unsigned, sl2) + 0x7fffu + ((__builtin_bit_cast(unsigned, sl2) >> 16) & 1u), shb = sh >> 16;
            const float rem = sl2 - __builtin_bit_cast(float, shb << 16); const unsigned sl = (__builtin_bit_cast(unsigned, rem) + 0x7fffu + ((__builtin_bit_cast(unsigned, rem) >> 16) & 1u)) >> 16;
            qaug[0] = (short)shb; qaug[1] = (short)sl;
            const short k0s = (short)(__builtin_bit_cast(unsigned, (float)r32) >> 16), k1s = (short)(__builtin_bit_cast(unsigned, (float)(32 + r32)) >> 16);
            kaug0[0] = k0s; kaug0[1] = k0s; kaug1[0] = k1s; kaug1[1] = k1s;
        }
    }
    LAS int* done = (LAS int*)(lds + LDS_KMT);
    bool wdone = false;
    if constexpr (!MOBA) { if (lane == 0) done[wid] = 0x7fffffff; }
    const lds_cptr vp0 = (lds_cptr)lds + LDS_V + ((lane >> 4) & 1) * 32 + (lane & 3) * 8 + (4 * hi + ((lane & 15) >> 2)) * 64;
    int slot = 0;
    for (int i = 0; i < NT; ++i) {
        const int t = NT - 1 - i;
        const int nslot = (slot == (NSLOT - 1) * SLOTB) ? 0 : slot + SLOTB;
        const int n2slot = (nslot == (NSLOT - 1) * SLOTB) ? 0 : nslot + SLOTB;
        if (i + 2 < NT) { ATT_DMA_KV(t - 2, n2slot); ATT_WAIT_BAR(4); } else if (i + 1 < NT) { ATT_WAIT_BAR(2); } else { ATT_WAIT_BAR(0); }
        if constexpr (!MOBA) {
            const int4v d0v = *(const LAS int4v*)(done), d1v = *(const LAS int4v*)(done + 4);
            int dm = max(max(max(d0v[0], d0v[1]), max(d0v[2], d0v[3])), max(max(d1v[0], d1v[1]), max(d1v[2], d1v[3])));
            dm = __builtin_amdgcn_readfirstlane(dm);
            if (dm < i) break;
        }
        if (t <= tdiag && !wdone) {
            f32x16 p0, p1;
            u32x4 pw0 = {0u, 0u, 0u, 0u}, pw1 = pw0, pw2 = pw0, pw3 = pw0; bool dead = false;
            if constexpr (!MOBA) {
                qkt(p0, p1, kp0 + slot, qr);
                s16x4 vlo[8], vhi[8]; vload16(vlo, vhi, vp0 + slot);
                float om[32];
#pragma unroll
                for (int r = 0; r < 16; r += 2) {
                    f32x2_t e0 = {__builtin_amdgcn_exp2f(p0[r]), __builtin_amdgcn_exp2f(p0[r + 1])}, e1 = {__builtin_amdgcn_exp2f(p1[r]), __builtin_amdgcn_exp2f(p1[r + 1])};
                    const f32x2_t one2 = {1.0f, 1.0f}; e0 = e0 + one2; e1 = e1 + one2;
                    om[r] = __builtin_amdgcn_rcpf(e0.x); om[r + 1] = __builtin_amdgcn_rcpf(e0.y); om[16 + r] = __builtin_amdgcn_rcpf(e1.x); om[16 + r + 1] = __builtin_amdgcn_rcpf(e1.y);
                }
                if (t == tdiag) {
                    const int kb = 64 * (t - 4 * qb) + 4 * hi;
#pragma unroll
                    for (int r = 0; r < 16; ++r) { const int kv = kb + (r & 3) + 8 * (r >> 2);
                        if (kv >= qrel) om[r] = 1.0f; if (kv + 32 >= qrel) om[16 + r] = 1.0f; }
                }
                float xin0[8], xin1[8], xin2[8], gp[8], OS[9];
#pragma unroll
                for (int j = 0; j < 8; ++j) { xin2[j] = om[4 * j + 3]; xin1[j] = xin2[j] * om[4 * j + 2]; xin0[j] = xin1[j] * om[4 * j + 1]; gp[j] = xin0[j] * om[4 * j]; }
                OS[8] = 1.0f;
#pragma unroll
                for (int j = 7; j >= 0; --j) OS[j] = gp[j] * OS[j + 1];
                float oth[8];
#pragma unroll
                for (int j = 0; j < 8; ++j) {
                    auto rr = __builtin_amdgcn_permlane32_swap(__builtin_bit_cast(unsigned, OS[j]), __builtin_bit_cast(unsigned, OS[j + 1]), false, false);
                    oth[j] = __builtin_bit_cast(float, hi ? rr[0] : rr[1]);
                }
                float tot = OS[0] * oth[0];
                { auto rr = __builtin_amdgcn_permlane32_swap(__builtin_bit_cast(unsigned, tot), __builtin_bit_cast(unsigned, tot), false, false); tot = hi ? __builtin_bit_cast(float, rr[0]) : tot; }
                float av[32];
#pragma unroll
                for (int j = 0; j < 8; ++j) { const float xc = carry * (OS[j + 1] * oth[j]); const f32x2_t xc2 = {xc, xc};
                    const f32x2_t dlo = {xin0[j] - gp[j], xin1[j] - xin0[j]}, dhi = {xin2[j] - xin1[j], 1.0f - xin2[j]};
                    const f32x2_t alo = dlo * xc2, ahi = dhi * xc2;
                    av[4 * j] = alo.x; av[4 * j + 1] = alo.y; av[4 * j + 2] = ahi.x; av[4 * j + 3] = ahi.y; }
                carry *= tot;
                if (__all(carry == 0.0f)) { wdone = true; if (lane == 0) done[wid] = i; }
                pw0 = (u32x4){cvtpk(av[0], av[1]), cvtpk(av[2], av[3]), cvtpk(av[4], av[5]), cvtpk(av[6], av[7])};
                pw1 = (u32x4){cvtpk(av[8], av[9]), cvtpk(av[10], av[11]), cvtpk(av[12], av[13]), cvtpk(av[14], av[15])};
                pw2 = (u32x4){cvtpk(av[16], av[17]), cvtpk(av[18], av[19]), cvtpk(av[20], av[21]), cvtpk(av[22], av[23])};
                pw3 = (u32x4){cvtpk(av[24], av[25]), cvtpk(av[26], av[27]), cvtpk(av[28], av[29]), cvtpk(av[30], av[31])};
                pv_r(o, vlo, vhi, __builtin_bit_cast(bf16x8, pw0), __builtin_bit_cast(bf16x8, pw1), __builtin_bit_cast(bf16x8, pw2), __builtin_bit_cast(bf16x8, pw3));
            } else {
                const int blk = t >> 2;
                const bool sel = (selmask >> blk) & 1u;
                const float nv = sel ? (sl2 * (float)(64 * t - q0) - mhat) : -INFINITY;
                f32x16 c;
#pragma unroll
                for (int r = 0; r < 16; ++r) c[r] = nv;
                qkt_aug(p0, p1, kp0 + slot, qr, c, kaug0, kaug1, qaug);
                s16x4 vlo[8], vhi[8]; vload16(vlo, vhi, vp0 + slot);
                if (t == tdiag) {
                    const int kb = 64 * (t - 4 * qb) + 4 * hi;
#pragma unroll
                    for (int r = 0; r < 16; ++r) { const int kv = kb + (r & 3) + 8 * (r >> 2);
                        if (kv > qrel) p0[r] = -INFINITY; if (kv + 32 > qrel) p1[r] = -INFINITY; }
                }
                float a0 = __builtin_fmaxf(__builtin_fmaxf(p0[0], p0[1]), p0[2]), a1 = __builtin_fmaxf(__builtin_fmaxf(p1[0], p1[1]), p1[2]);
#pragma unroll
                for (int r = 3; r < 15; r += 2) { a0 = __builtin_fmaxf(__builtin_fmaxf(a0, p0[r]), p0[r + 1]); a1 = __builtin_fmaxf(__builtin_fmaxf(a1, p1[r]), p1[r + 1]); }
                float rm = __builtin_fmaxf(__builtin_fmaxf(a0, p0[15]), __builtin_fmaxf(a1, p1[15]));
                rm = __builtin_fmaxf(rm, partner(rm, hi));
                dead = __all(rm < -160.0f);
                if (!dead && __any(rm > 8.0f)) {
                    const float dl = __builtin_fmaxf(rm, 0.f);
                    mhat += dl;
#pragma unroll
                    for (int r = 0; r < 16; ++r) { p0[r] -= dl; p1[r] -= dl; }
                    const float f = __builtin_amdgcn_exp2f(-dl);
                    lrow *= f;
                    if (hi == 0) wsf[r32] = f;
                    asm volatile("s_waitcnt lgkmcnt(0)" ::: "memory");
#pragma unroll
                    for (int g4 = 0; g4 < 4; ++g4) { const f32x4 fv = *(const LAS f32x4*)(wsf + 8 * g4 + 4 * hi);
#pragma unroll
                        for (int i2 = 0; i2 < 4; ++i2) { o[0][4 * g4 + i2] *= fv[i2]; o[1][4 * g4 + i2] *= fv[i2]; } }
                    asm volatile("s_waitcnt lgkmcnt(0)" ::: "memory");
                }
                if (!dead) {
                float rs = 0.f;
#pragma unroll
                for (int r = 0; r < 16; ++r) { p0[r] = __builtin_amdgcn_exp2f(p0[r]); p1[r] = __builtin_amdgcn_exp2f(p1[r]); rs += p0[r] + p1[r]; }
                lrow += rs;
                pw0 = (u32x4){cvtpk(p0[0], p0[1]), cvtpk(p0[2], p0[3]), cvtpk(p0[4], p0[5]), cvtpk(p0[6], p0[7])};
                pw1 = (u32x4){cvtpk(p0[8], p0[9]), cvtpk(p0[10], p0[11]), cvtpk(p0[12], p0[13]), cvtpk(p0[14], p0[15])};
                pw2 = (u32x4){cvtpk(p1[0], p1[1]), cvtpk(p1[2], p1[3]), cvtpk(p1[4], p1[5]), cvtpk(p1[6], p1[7])};
                pw3 = (u32x4){cvtpk(p1[8], p1[9]), cvtpk(p1[10], p1[11]), cvtpk(p1[12], p1[13]), cvtpk(p1[14], p1[15])};
                pv_r(o, vlo, vhi, __builtin_bit_cast(bf16x8, pw0), __builtin_bit_cast(bf16x8, pw1), __builtin_bit_cast(bf16x8, pw2), __builtin_bit_cast(bf16x8, pw3));
                }
            }
        }
        slot = nslot;
    }
    if constexpr (!MOBA) asm volatile("s_waitcnt vmcnt(0)" ::: "memory");
    float rli[16];
    if constexpr (MOBA) {
        const float lt = lrow + partner(lrow, hi);
        if (hi == 0) wsf[32 + r32] = lt;
        asm volatile("s_waitcnt lgkmcnt(0)" ::: "memory");
#pragma unroll
        for (int g4 = 0; g4 < 4; ++g4) { const f32x4 lv = *(const LAS f32x4*)(wsf + 32 + 8 * g4 + 4 * hi);
#pragma unroll
            for (int i2 = 0; i2 < 4; ++i2) rli[4 * g4 + i2] = __builtin_amdgcn_rcpf(lv[i2]); }
    } else {
#pragma unroll
        for (int r = 0; r < 16; ++r) rli[r] = 1.0f;
    }
    {
        LAS bf16_t* stg = (LAS bf16_t*)(lds + LDS_OST) + wid * 2048;
#pragma unroll
        for (int r = 0; r < 16; ++r) { const int orow = crow(r, hi);
#pragma unroll
            for (int d0 = 0; d0 < 2; ++d0) stg[orow * 64 + d0 * 32 + r32] = (bf16_t)(cvtpk(o[d0][r] * rli[r], 0.f) & 0xffffu); }
        asm volatile("s_waitcnt lgkmcnt(0)" ::: "memory");
        bf16_t* Ow = O + (rowbase + q0 + wid * 32) * OPITCH + h * 64;
#pragma unroll
        for (int i = 0; i < 4; ++i) { const int row = i * 8 + (lane >> 3), ch = lane & 7; const u32x4 v = *(const LAS u32x4*)(stg + row * 64 + ch * 8); *(u32x4*)(Ow + (long)row * OPITCH + ch * 8) = v; }
    }
    asm volatile("s_waitcnt lgkmcnt(0)\n\ts_barrier" ::: "memory");
#undef ATT_DMA_KV
}
#undef ATT_SBAR
#undef ATT_WAIT_BAR
}
namespace exa {
using bf16=unsigned short;
using bf16x8=__attribute__((ext_vector_type(8)))short;
using s16x4=__attribute__((ext_vector_type(4)))short;
using f32x16=__attribute__((ext_vector_type(16)))float;
using u32x4=__attribute__((ext_vector_type(4)))unsigned;
constexpr int SEQ=2048,D=64,DM=3072;
constexpr int NW=8,QBLK=32,QB=QBLK*NW,KVBLK=64;
__device__ __forceinline__ int crow(int r,int hi){return (r&3)+8*(r>>2)+4*hi;}
#define SBAR() __builtin_amdgcn_sched_barrier(0)
__device__ __forceinline__ void cmask(f32x16&p0,f32x16&p1,int jb,int qrel,int hi){
  const float NEG=-INFINITY; int kb=64*jb+4*hi;
  #pragma unroll
  for(int r=0;r<16;++r){int kv=kb+(r&3)+8*(r>>2); if(kv>qrel)p0[r]=NEG; if(kv+32>qrel)p1[r]=NEG;}
}
constexpr int NSLOT=3, SLOTB=8192;
constexpr int LDS_K=0, LDS_V=NSLOT*SLOTB, LDS_WS=2*NSLOT*SLOTB, LDS_OST=LDS_WS+NW*64*4, LDS_BYTES=LDS_OST+NW*4096;
__device__ __forceinline__ void glds16(const void*gsrc,unsigned lds_dst){unsigned keep;
  asm volatile("s_mov_b32 %0, m0\n\ts_mov_b32 m0, %2\n\ts_nop 0\n\tglobal_load_lds_dwordx4 %1, off\n\ts_mov_b32 m0, %0":"=&s"(keep):"v"(gsrc),"s"(lds_dst):"memory");}
__device__ __forceinline__ float max3f(float a,float b,float c){float r;asm("v_max3_f32 %0, %1, %2, %3":"=v"(r):"v"(a),"v"(b),"v"(c));return r;}
__device__ __forceinline__ float max2f(float a,float b){float r;asm("v_max_f32_e32 %0, %1, %2":"=v"(r):"v"(a),"v"(b));return r;}
__device__ __forceinline__ float fadd_s(float a,float b){float r;asm("v_add_f32_e32 %0, %1, %2":"=v"(r):"v"(a),"v"(b));return r;}
__device__ __forceinline__ float fsub_s(float a,float b){float r;asm("v_sub_f32_e32 %0, %1, %2":"=v"(r):"v"(a),"v"(b));return r;}
typedef float f32x2_t __attribute__((ext_vector_type(2))); typedef __bf16 bf16x2_t __attribute__((ext_vector_type(2)));
__device__ __forceinline__ unsigned cvtpk_s(float lo,float hi){f32x2_t v={lo,hi};bf16x2_t b=__builtin_convertvector(v,bf16x2_t);return __builtin_bit_cast(unsigned,b);}
#define WAIT_BAR(N) asm volatile("s_waitcnt vmcnt(" #N ") lgkmcnt(0)\n\ts_barrier":::"memory")
typedef LAS const char* lds_cptr;
__device__ __forceinline__ void qkt(f32x16&p0,f32x16&p1,lds_cptr Kslot,const bf16x8*qr,const f32x16&negm,int r32,int hi){
  const lds_cptr kb=Kslot+hi*1024+r32*16;
  #pragma unroll
  for(int d0=0;d0<4;++d0){
    const bf16x8 b0=*(const LAS bf16x8*)(kb+d0*2048);
    const bf16x8 b1=*(const LAS bf16x8*)(kb+d0*2048+512);
    if(d0==0){p0=__builtin_amdgcn_mfma_f32_32x32x16_bf16(b0,qr[0],negm,0,0,0);p1=__builtin_amdgcn_mfma_f32_32x32x16_bf16(b1,qr[0],negm,0,0,0);}
    else{p0=__builtin_amdgcn_mfma_f32_32x32x16_bf16(b0,qr[d0],p0,0,0,0);p1=__builtin_amdgcn_mfma_f32_32x32x16_bf16(b1,qr[d0],p1,0,0,0);}}
}
typedef short v4i16_t __attribute__((ext_vector_type(4)));
__device__ __forceinline__ void kload8(bf16x8*kf,lds_cptr kp){
  kf[0]=*(const LAS bf16x8*)(kp);      kf[1]=*(const LAS bf16x8*)(kp+512);
  kf[2]=*(const LAS bf16x8*)(kp+2048); kf[3]=*(const LAS bf16x8*)(kp+2560);
  kf[4]=*(const LAS bf16x8*)(kp+4096); kf[5]=*(const LAS bf16x8*)(kp+4608);
  kf[6]=*(const LAS bf16x8*)(kp+6144); kf[7]=*(const LAS bf16x8*)(kp+6656);
}
__device__ __forceinline__ void kload2(bf16x8*kf,lds_cptr kp,int j){ kf[2*j]=*(const LAS bf16x8*)(kp+j*2048); kf[2*j+1]=*(const LAS bf16x8*)(kp+j*2048+512); }
__device__ __forceinline__ s16x4 vtr(lds_cptr p){ return __builtin_bit_cast(s16x4,__builtin_amdgcn_ds_read_tr16_b64_v4i16((LAS v4i16_t*)p)); }
__device__ __forceinline__ float rowmax(const f32x16&p0,const f32x16&p1){
  float a=max3f(p0[0],p0[1],p1[0]),b=max3f(p0[2],p0[3],p1[1]);a=max3f(a,p1[2],p1[3]);
  #pragma unroll
  for(int r=4;r<16;r+=4){a=max3f(a,p0[r],p0[r+1]);b=max3f(b,p0[r+2],p0[r+3]);a=max3f(a,p1[r],p1[r+1]);b=max3f(b,p1[r+2],p1[r+3]);}
  const float m=max2f(a,b);
  auto rr=__builtin_amdgcn_permlane32_swap(__float_as_uint(m),__float_as_uint(m),false,false);
  return max2f(__uint_as_float(rr[0]),__uint_as_float(rr[1]));
}
__device__ __forceinline__ void pv(f32x16*o,int vb,bf16x8 pa0,bf16x8 pa1,bf16x8 pa2,bf16x8 pa3){
  #pragma unroll
  for(int d0=0;d0<2;++d0){s16x4 lo[4],hi[4];
    #pragma unroll
    for(int ks=0;ks<4;++ks){
      asm volatile("ds_read_b64_tr_b16 %0,%1 offset:%c2":"=&v"(lo[ks]):"v"(vb),"i"(d0*4096+ks*1024):"memory");
      asm volatile("ds_read_b64_tr_b16 %0,%1 offset:%c2":"=&v"(hi[ks]):"v"(vb),"i"(d0*4096+ks*1024+512):"memory");}
    asm volatile("s_waitcnt lgkmcnt(0)":::"memory");SBAR();
    #define PK(k) (bf16x8){lo[k][0],lo[k][1],lo[k][2],lo[k][3],hi[k][0],hi[k][1],hi[k][2],hi[k][3]}
    o[d0]=__builtin_amdgcn_mfma_f32_32x32x16_bf16(pa0,PK(0),o[d0],0,0,0);
    o[d0]=__builtin_amdgcn_mfma_f32_32x32x16_bf16(pa1,PK(1),o[d0],0,0,0);
    o[d0]=__builtin_amdgcn_mfma_f32_32x32x16_bf16(pa2,PK(2),o[d0],0,0,0);
    o[d0]=__builtin_amdgcn_mfma_f32_32x32x16_bf16(pa3,PK(3),o[d0],0,0,0);
    #undef PK
  }
}
template<int THRL> __device__ __forceinline__ void attn_unit(int b,int h,int qb,const bf16*QKV,bf16*O,LAS unsigned char*shm,const float*KMP=nullptr,const float sl2=0.f,const unsigned force_sel=0u){
  int tid=threadIdx.x; asm volatile("":"+v"(tid)); const int lane=tid&63,r32=lane&31,hi=lane>>5; const int wid=__builtin_amdgcn_readfirstlane(tid>>6);
  const long rowbase=(long)b*SEQ; const int q0=qb*QB;
  const bf16*Qw=QKV+(rowbase+q0+wid*QBLK)*DM+h*D;
  const bf16*Kh=QKV+rowbase*DM+1024+h*D,*Vh=QKV+rowbase*DM+2048+h*D;
  const unsigned lds0=(unsigned)(uintptr_t)shm;
  LAS float*wsf=(LAS float*)(shm+LDS_WS)+wid*64;
  const bf16*ksrc=Kh+(long)lane*DM+wid*8;
  const bf16*vsrc=Vh+(long)(16*(wid&3)+(lane>>2))*DM+(wid>>2)*32+(lane&3)*8;
  const unsigned kdst=lds0+LDS_K+wid*1024, vdst=lds0+LDS_V+wid*1024;
  #define DMA_K(t,slot) glds16(ksrc+(long)(t)*KVBLK*DM,(unsigned)__builtin_amdgcn_readfirstlane(kdst+(slot)))
  #define DMA_V(t,slot) glds16(vsrc+(long)(t)*KVBLK*DM,(unsigned)__builtin_amdgcn_readfirstlane(vdst+(slot)))
  const int vb0=(int)(lds0+LDS_V)+((lane>>4)&1)*32+(lane&3)*8+(4*hi+((lane&15)>>2))*64;
  bf16x8 kf[8];
  const lds_cptr shm3=(lds_cptr)shm; const lds_cptr kp0=shm3+LDS_K+hi*1024+r32*16; const lds_cptr vp0=shm3+LDS_V+((lane>>4)&1)*32+(lane&3)*8+(4*hi+((lane&15)>>2))*64;
  const int NT=(q0+QB)/KVBLK;
  DMA_K(0,0);DMA_V(0,0);DMA_K(1,SLOTB);DMA_K(2,2*SLOTB);
  bf16x8 qr[4];
  #pragma unroll
  for(int d0=0;d0<4;++d0)qr[d0]=*reinterpret_cast<const bf16x8*>(&Qw[(long)r32*DM+d0*16+hi*8]);
#if defined(EXA_G1)
  unsigned selmask=0u; bf16x8 kaug0={0,0,0,0,0,0,0,0},kaug1={0,0,0,0,0,0,0,0},qaug={0,0,0,0,0,0,0,0};
  { LAS float*kmt=(LAS float*)(shm+LDS_BYTES);
    { const int n=tid>>6,d=tid&63; if(n<qb){ const float*kp=KMP+((size_t)(b*8+n)*2)*1024+h*64+d; kmt[n*64+d]=(kp[0]+kp[1024])*(1.0f/256.0f);} }
    asm volatile("s_waitcnt lgkmcnt(0)\n\ts_barrier":::"memory");
    float gate[7];
    #pragma unroll
    for(int n=0;n<7;++n){ float g=-INFINITY; if(n<qb){ float s=0.f;
        #pragma unroll
        for(int d0=0;d0<4;++d0){ const att::f32x4 k0=*(const LAS att::f32x4*)(kmt+n*64+d0*16+hi*8),k1=*(const LAS att::f32x4*)(kmt+n*64+d0*16+hi*8+4);
          s+=att::bf2f(qr[d0][0])*k0[0]+att::bf2f(qr[d0][1])*k0[1]+att::bf2f(qr[d0][2])*k0[2]+att::bf2f(qr[d0][3])*k0[3]+att::bf2f(qr[d0][4])*k1[0]+att::bf2f(qr[d0][5])*k1[1]+att::bf2f(qr[d0][6])*k1[2]+att::bf2f(qr[d0][7])*k1[3]; }
        g=s+att::partner(s,hi);} gate[n]=g; }
    #pragma unroll
    for(int r=0;r<3;++r){ int best=-1; float bv=-INFINITY;
      #pragma unroll
      for(int n=0;n<7;++n){ const bool taken=(selmask>>n)&1u; if(!taken&&gate[n]>bv){best=n;bv=gate[n];} }
      if(best>=0)selmask|=1u<<best; }
    selmask|=(1u<<qb)|force_sel;
    if(hi==0){ const unsigned sh=__float_as_uint(sl2)+0x7fffu+((__float_as_uint(sl2)>>16)&1u),shb=sh>>16; const float rem=sl2-__uint_as_float(shb<<16); const unsigned sl=(__float_as_uint(rem)+0x7fffu+((__float_as_uint(rem)>>16)&1u))>>16;
      qaug[0]=(short)shb; qaug[1]=(short)sl; const short k0s=(short)(__float_as_uint((float)r32)>>16),k1s=(short)(__float_as_uint((float)(32+r32))>>16); kaug0[0]=k0s;kaug0[1]=k0s;kaug1[0]=k1s;kaug1[1]=k1s; } }
  asm volatile(""::"v"(selmask),"v"(kaug0),"v"(kaug1),"v"(qaug));
#endif
  float mhat=0.f,l_reg=0.f;f32x16 o[2];o[0]=f32x16{};o[1]=f32x16{};f32x16 negm=f32x16{};asm volatile("":"+v"(negm));
  const int qrel=wid*QBLK+r32;
  #define CMASK(P0,P1,t) do{int jb_=(t)-(NT-4); if(jb_>=0)cmask(P0,P1,jb_,qrel,hi);}while(0)
  bool resc=false;
  #define START(P0,P1) do{ const float rm=rowmax(P0,P1); resc=false; \
    { const float dl=rm; mhat=fadd_s(mhat,dl); \
      _Pragma("unroll") for(int r=0;r<16;++r){P0[r]=fsub_s(P0[r],dl);P1[r]=fsub_s(P1[r],dl);} \
      _Pragma("unroll") for(int r=0;r<16;++r)negm[r]=-mhat; asm volatile("":"+v"(negm)); } \
    _Pragma("unroll") for(int r=0;r<16;++r)P0[r]=__builtin_amdgcn_exp2f(P0[r]); }while(0)
  #define RESC() do{ if(resc){ asm volatile("s_waitcnt lgkmcnt(0)":::"memory"); \
      _Pragma("unroll") for(int d_=0;d_<2;++d_) _Pragma("unroll") for(int r=0;r<16;++r)o[d_][r]*=wsf[crow(r,hi)]; } }while(0)
#if defined(EXA_G3)
  const float boff=-sl2*(float)(q0+qrel);
  #define SETNEGM(t) do{ const float nv_=((selmask>>((t)>>2))&1u)?(sl2*(float)(64*(t))+boff-mhat):-INFINITY; _Pragma("unroll") for(int r=0;r<16;++r)negm[r]=nv_; asm volatile("":"+v"(negm)); }while(0)
  #define NEGMUPD() do{}while(0)
#else
  #define SETNEGM(t) do{}while(0)
  #define NEGMUPD() do{ _Pragma("unroll") for(int r=0;r<16;++r)negm[r]=-mhat; asm volatile("":"+v"(negm)); }while(0)
#endif
  f32x16 pA0,pA1,pB0,pB1;
  int sl_prev=0,sl_cur=0,sl_next=SLOTB;
  #define ROT() do{sl_prev=sl_cur;sl_cur=sl_next;sl_next=(sl_next==(NSLOT-1)*SLOTB)?0:sl_next+SLOTB;}while(0)
  WAIT_BAR(3);
  SETNEGM(0);
#if defined(EXA_G2)
  { f32x16 a0_=__builtin_amdgcn_mfma_f32_32x32x16_bf16(kaug0,qaug,negm,0,0,0), a1_=__builtin_amdgcn_mfma_f32_32x32x16_bf16(kaug1,qaug,negm,0,0,0); qkt(pA0,pA1,(lds_cptr)shm+LDS_K,qr,negm,r32,hi);
    (void)a0_; (void)a1_; }
  {
    const lds_cptr kb=(lds_cptr)shm+LDS_K+hi*1024+r32*16;
    pA0=__builtin_amdgcn_mfma_f32_32x32x16_bf16(kaug0,qaug,negm,0,0,0); pA1=__builtin_amdgcn_mfma_f32_32x32x16_bf16(kaug1,qaug,negm,0,0,0);
    #pragma unroll
    for(int d0=0;d0<4;++d0){ const bf16x8 b0=*(const LAS bf16x8*)(kb+d0*2048); const bf16x8 b1=*(const LAS bf16x8*)(kb+d0*2048+512);
      pA0=__builtin_amdgcn_mfma_f32_32x32x16_bf16(b0,qr[d0],pA0,0,0,0); pA1=__builtin_amdgcn_mfma_f32_32x32x16_bf16(b1,qr[d0],pA1,0,0,0); }
  }
#else
  qkt(pA0,pA1,(lds_cptr)shm+LDS_K,qr,negm,r32,hi);
#endif
  asm volatile("s_nop 15\n\ts_nop 7":"+v"(pA0),"+v"(pA1));CMASK(pA0,pA1,0);
#if defined(EXA_G3)
  { const float rm=rowmax(pA0,pA1); if(__builtin_expect(__any(rm>(float)THRL),0)){ const float dl=__builtin_fmaxf(rm,0.f); mhat+=dl;
      #pragma unroll
      for(int r=0;r<16;++r){pA0[r]-=dl;pA1[r]-=dl;} } }
  #pragma unroll
  for(int r=0;r<16;++r)pA0[r]=__builtin_amdgcn_exp2f(pA0[r]);
#else
  START(pA0,pA1);
#endif
  _Pragma("unroll") for(int r=0;r<16;++r)pA1[r]=__builtin_amdgcn_exp2f(pA1[r]);
  WAIT_BAR(0);
  DMA_K(3,0);DMA_V(1,SLOTB);
  ROT();
  kload8(kf,kp0+sl_cur);
  WAIT_BAR(2);
  s16x4 vlo[8],vhi[8]; u32x4 pw0,pw1,pw2,pw3;
  #define PKW(P,B) cvtpk_s(P[B],P[B+1])
  #define PAF(k) __builtin_bit_cast(bf16x8,pw##k)
  #define VFR(i) (bf16x8){vlo[i][0],vlo[i][1],vlo[i][2],vlo[i][3],vhi[i][0],vhi[i][1],vhi[i][2],vhi[i][3]}
  #define PIN(x) asm volatile("":"+v"(x))
  #define MX3(a,b,c) __builtin_fmaxf(__builtin_fmaxf((a),(b)),(c))
  #define PADD(X,B) asm volatile("v_pk_add_f32 %0, %0, %1" : "+v"(sacc) : "v"(__builtin_shufflevector(X,X,B,B+1)))
  #define GAPA(MF,X0,B0,X1,B1,W0,W1,PW) do{ MF; PADD(X0,B0); PADD(X1,B1); W0; W1; PIN(PW); SBAR(); }while(0)
  #define GAPA1(MF,X0,B0,W0,W1,PW) do{ MF; PADD(X0,B0); W0; W1; PIN(PW); SBAR(); }while(0)
  #define EX(v) __builtin_amdgcn_exp2f(v)
  #define GAPB(MF,X,B) do{ MF; X[B]=EX(X[B]); X[B+1]=EX(X[B+1]); X[B+2]=EX(X[B+2]); X[B+3]=EX(X[B+3]); PIN(X); SBAR(); }while(0)
  #define VRD(i) do{ vlo[i]=vtr(vp_+(((i)>>2)*4096+((i)&3)*1024)); vhi[i]=vtr(vp_+(((i)>>2)*4096+((i)&3)*1024+512)); }while(0)
  #define KRD(G,j) do{ if(G){ kload2(kf,kp0+sl_next,j); SBAR(); } }while(0)
#if defined(EXA_G2)
  #define EXA_AUG(C0,C1) do{ C0=__builtin_amdgcn_mfma_f32_32x32x16_bf16(kaug0,qaug,negm,0,0,0); C1=__builtin_amdgcn_mfma_f32_32x32x16_bf16(kaug1,qaug,negm,0,0,0); SBAR(); }while(0)
  #define EXA_C0IN(C) C
#else
  #define EXA_AUG(C0,C1) do{}while(0)
  #define EXA_C0IN(C) negm
#endif
  #define STEP(C0,C1,P0,P1,t,GK,GV,GL) do{ SBAR(); \
    const lds_cptr vp_=vp0+sl_prev; \
    EXA_AUG(C0,C1); \
    VRD(0); SBAR(); f32x2_t sacc={P0[0],P0[1]}; \
    GAPA(C0=__builtin_amdgcn_mfma_f32_32x32x16_bf16(kf[0],qr[0],EXA_C0IN(C0),0,0,0), P0,2,P0,4,     pw0[0]=PKW(P0,0), pw0[1]=PKW(P0,2), pw0); \
    VRD(4); SBAR(); GAPA(C1=__builtin_amdgcn_mfma_f32_32x32x16_bf16(kf[1],qr[0],EXA_C0IN(C1),0,0,0), P0,6,P0,8,     pw0[2]=PKW(P0,4), pw0[3]=PKW(P0,6), pw0); \
    VRD(1); SBAR(); GAPA(C0=__builtin_amdgcn_mfma_f32_32x32x16_bf16(kf[2],qr[1],C0,0,0,0),   P0,10,P0,12, pw1[0]=PKW(P0,8), pw1[1]=PKW(P0,10), pw1); \
    VRD(5); SBAR(); GAPA(C1=__builtin_amdgcn_mfma_f32_32x32x16_bf16(kf[3],qr[1],C1,0,0,0),   P0,14,P1,0,   pw1[2]=PKW(P0,12),pw1[3]=PKW(P0,14), pw1); \
    VRD(2); SBAR(); GAPA(C0=__builtin_amdgcn_mfma_f32_32x32x16_bf16(kf[4],qr[2],C0,0,0,0),   P1,2,P1,4,     pw2[0]=PKW(P1,0), pw2[1]=PKW(P1,2), pw2); \
    VRD(6); SBAR(); GAPA(C1=__builtin_amdgcn_mfma_f32_32x32x16_bf16(kf[5],qr[2],C1,0,0,0),   P1,6,P1,8,     pw2[2]=PKW(P1,4), pw2[3]=PKW(P1,6), pw2); \
    VRD(3); SBAR(); GAPA(C0=__builtin_amdgcn_mfma_f32_32x32x16_bf16(kf[6],qr[3],C0,0,0,0),   P1,10,P1,12, pw3[0]=PKW(P1,8), pw3[1]=PKW(P1,10), pw3); \
    VRD(7); SBAR(); GAPA1(C1=__builtin_amdgcn_mfma_f32_32x32x16_bf16(kf[7],qr[3],C1,0,0,0),   P1,14,       pw3[2]=PKW(P1,12),pw3[3]=PKW(P1,14), pw3); \
    l_reg+=sacc.x+sacc.y; \
    if(GK){DMA_K((t)+3,sl_cur);} if(GV){DMA_V((t)+1,sl_next);} \
    CMASK(C0,C1,t); \
    { float a=MX3(C0[0],C0[1],C1[0]),b=MX3(C0[2],C0[3],C1[1]); a=MX3(a,C1[2],C1[3]); \
      _Pragma("unroll") for(int r=4;r<16;r+=4){a=MX3(a,C0[r],C0[r+1]);b=MX3(b,C0[r+2],C0[r+3]);a=MX3(a,C1[r],C1[r+1]);b=MX3(b,C1[r+2],C1[r+3]);} \
      float rm=__builtin_fmaxf(a,b); { auto rr=__builtin_amdgcn_permlane32_swap(__float_as_uint(rm),__float_as_uint(rm),false,false); rm=__builtin_fmaxf(__uint_as_float(rr[0]),__uint_as_float(rr[1])); } \
      resc=false; \
      if(__builtin_expect(__any(rm>(float)THRL),0)){ const float dl=__builtin_fmaxf(rm,0.f); mhat+=dl; \
        _Pragma("unroll") for(int r=0;r<16;++r){C0[r]-=dl;C1[r]-=dl;} \
        NEGMUPD(); \
        const float f=__builtin_amdgcn_exp2f(-dl); l_reg*=f; if(hi==0)wsf[r32]=f; resc=true; } } \
    SBAR(); \
    GAPB(o[0]=__builtin_amdgcn_mfma_f32_32x32x16_bf16(PAF(0),VFR(0),o[0],0,0,0), C0,0); \
    GAPB(o[1]=__builtin_amdgcn_mfma_f32_32x32x16_bf16(PAF(0),VFR(4),o[1],0,0,0), C0,4); \
    KRD(GL,0); GAPB(o[0]=__builtin_amdgcn_mfma_f32_32x32x16_bf16(PAF(1),VFR(1),o[0],0,0,0), C0,8); \
    KRD(GL,1); GAPB(o[1]=__builtin_amdgcn_mfma_f32_32x32x16_bf16(PAF(1),VFR(5),o[1],0,0,0), C0,12); \
    KRD(GL,2); GAPB(o[0]=__builtin_amdgcn_mfma_f32_32x32x16_bf16(PAF(2),VFR(2),o[0],0,0,0), C1,0); \
    KRD(GL,3); GAPB(o[1]=__builtin_amdgcn_mfma_f32_32x32x16_bf16(PAF(2),VFR(6),o[1],0,0,0), C1,4); \
    GAPB(o[0]=__builtin_amdgcn_mfma_f32_32x32x16_bf16(PAF(3),VFR(3),o[0],0,0,0), C1,8); \
    GAPB(o[1]=__builtin_amdgcn_mfma_f32_32x32x16_bf16(PAF(3),VFR(7),o[1],0,0,0), C1,12); \
    }while(0)
  int t=1;
  #undef CMASK
  #define CMASK(P0,P1,t) do{}while(0)
  for(;t+5<NT;t+=2){
    SETNEGM(t); STEP(pB0,pB1,pA0,pA1,t,true,true,true);     WAIT_BAR(2); RESC(); ROT();
    SETNEGM(t+1); STEP(pA0,pA1,pB0,pB1,t+1,true,true,true);   WAIT_BAR(2); RESC(); ROT();
  }
  #undef CMASK
  #define CMASK(P0,P1,t) do{int jb_=(t)-(NT-4); if(jb_>=0)cmask(P0,P1,jb_,qrel,hi);}while(0)
  #define ENDW(tt) do{ if((tt)+3<NT){WAIT_BAR(2);} else if((tt)+2<NT){WAIT_BAR(1);} else {WAIT_BAR(0);} }while(0)
  for(;t+1<NT;t+=2){
    SETNEGM(t); STEP(pB0,pB1,pA0,pA1,t,(t+3<NT),(t+1<NT),(t+1<NT));       ENDW(t);   RESC(); ROT();
    SETNEGM(t+1); STEP(pA0,pA1,pB0,pB1,t+1,(t+4<NT),(t+2<NT),(t+2<NT));     ENDW(t+1); RESC(); ROT();
  }
  SETNEGM(NT-1); STEP(pB0,pB1,pA0,pA1,NT-1,false,false,false); RESC();
  { float sacc=pB0[0]+pB0[1]; _Pragma("unroll") for(int r=2;r<16;++r)sacc+=pB0[r]; _Pragma("unroll") for(int r=0;r<16;++r)sacc+=pB1[r]; l_reg+=sacc;
    pw0=(u32x4){PKW(pB0,0),PKW(pB0,2),PKW(pB0,4),PKW(pB0,6)};pw1=(u32x4){PKW(pB0,8),PKW(pB0,10),PKW(pB0,12),PKW(pB0,14)};pw2=(u32x4){PKW(pB1,0),PKW(pB1,2),PKW(pB1,4),PKW(pB1,6)};pw3=(u32x4){PKW(pB1,8),PKW(pB1,10),PKW(pB1,12),PKW(pB1,14)};
    SBAR(); pv(o,vb0+sl_cur,PAF(0),PAF(1),PAF(2),PAF(3)); }
  #undef PKW
  #undef PAF
  #undef VFR
  #undef PIN
  #undef MX3
  #undef GAPA
  #undef GAPB
  #undef EX
  #undef VRD
  #undef KRD
  #undef STEP
  #undef ENDW
  {auto rr=__builtin_amdgcn_permlane32_swap(__float_as_uint(l_reg),__float_as_uint(l_reg),false,false);l_reg=__uint_as_float(rr[0])+__uint_as_float(rr[1]);}
  if(hi==0)wsf[32+r32]=l_reg;asm volatile("s_waitcnt lgkmcnt(0)":::"memory");
  float rli[16];
  #pragma unroll
  for(int r=0;r<16;++r)rli[r]=__builtin_amdgcn_rcpf(wsf[32+crow(r,hi)]);
  bf16*Ow=O+(rowbase+q0+wid*QBLK)*1024+h*D;
  { LAS bf16*stg=(LAS bf16*)(shm+LDS_OST)+wid*2048;
    #pragma unroll
    for(int r=0;r<16;++r){const int orow=crow(r,hi);
      #pragma unroll
      for(int d0=0;d0<2;++d0)stg[orow*64+d0*32+r32]=(bf16)(cvtpk_s(o[d0][r]*rli[r],0.f)&0xffffu);}
    asm volatile("s_waitcnt lgkmcnt(0)":::"memory");
    #pragma unroll
    for(int i=0;i<4;++i){const int row=i*8+(lane>>3),ch=lane&7; const u32x4 v=*(const LAS u32x4*)(stg+row*64+ch*8); *(u32x4*)(Ow+(long)row*1024+ch*8)=v;} }
  asm volatile("s_waitcnt lgkmcnt(0)\n\ts_barrier":::"memory");
  #undef DMA_K
  #undef DMA_V
  #undef CMASK
  #undef START
  #undef RESC
  #undef ROT
}

#undef SBAR
#undef WAIT_BAR
}
#define XB_TMO      128
#define XB_XCNT(j)  (256  + 64 * (j))
#define XB_XSUB(j)  (1280 + 64 * (j))
#define XB_XGEN(j)  (2304 + 64 * (j))
#define XB_TOP      3328
#define XB_TOPGEN   3392
#define XCD_BAR_WORDS 3456
#define XB_SPIN_CAP (1u << 18)

__device__ __forceinline__ unsigned xb_ld(unsigned* p)              { return __hip_atomic_load(p, __ATOMIC_RELAXED, __HIP_MEMORY_SCOPE_AGENT); }
__device__ __forceinline__ unsigned xb_add(unsigned* p, unsigned v) { return __hip_atomic_fetch_add(p, v, __ATOMIC_RELAXED, __HIP_MEMORY_SCOPE_AGENT); }
__device__ __forceinline__ unsigned xb_xcc_id() { return (unsigned)__builtin_amdgcn_s_getreg((3 << 11) | 20) & 0xFu; }
#define XB_SPIN(cond, bar) do { unsigned _sp = 0; while (cond) { __builtin_amdgcn_s_sleep(1); \
    if ((++_sp & 255u) == 0u) { if (xb_ld(&(bar)[XB_TMO])) break; if (_sp > XB_SPIN_CAP) { atomicAdd(&(bar)[XB_TMO], 1u); break; } } } } while (0)

struct XcdBarrier {
    unsigned* bar; unsigned x;
    volatile LAS unsigned* st;
};

__device__ __forceinline__ XcdBarrier xcd_barrier_post(unsigned* bar, volatile LAS unsigned* st) {
    XcdBarrier b; b.bar = bar; b.x = xb_xcc_id(); b.st = st;
    if (threadIdx.x == 0) (void)xb_add(&bar[XB_XCNT(b.x)], 1u);
    return b;
}
__device__ __forceinline__ void xcd_barrier_complete(unsigned* bar, unsigned x, unsigned& nloc, unsigned& nx) {
    const unsigned G = gridDim.x * gridDim.y * gridDim.z;
    unsigned sum, cnt, mine, sp = 0u;
    for (;;) {
        sum = 0u; cnt = 0u; mine = 0u;
#pragma unroll
        for (unsigned j = 0; j < 16; ++j) { const unsigned c = xb_ld(&bar[XB_XCNT(j)]); sum += c; cnt += (c > 0u) ? 1u : 0u; mine = (j == x) ? c : mine; }
        if (sum == G) break;
        __builtin_amdgcn_s_sleep(1);
        if ((++sp & 255u) == 0u) { if (xb_ld(&bar[XB_TMO])) break; if (sp > XB_SPIN_CAP) { atomicAdd(&bar[XB_TMO], 1u); break; } }
    }
    nloc = mine > 0u ? mine : 1u; nx = cnt > 0u ? cnt : 1u;
}

__device__ __forceinline__ void xcd_barrier(const XcdBarrier& b) {
    asm volatile("s_waitcnt vmcnt(0)" ::: "memory");
    __syncthreads();
    if (threadIdx.x == 0) {
        unsigned* bar = b.bar;
        __builtin_amdgcn_s_waitcnt(0);
        unsigned nloc = b.st[0], nx = b.st[1];
        if (nloc == 0u) { xcd_barrier_complete(bar, b.x, nloc, nx); b.st[0] = nloc; b.st[1] = nx; }
        const unsigned old = xb_add(&bar[XB_XSUB(b.x)], 1u);
        const unsigned gen = old / nloc;
        if (old + 1u == (gen + 1u) * nloc) {
            __builtin_amdgcn_fence(__ATOMIC_RELEASE, "agent");
            asm volatile("s_waitcnt vmcnt(0)" ::: "memory");
            const unsigned og = xb_add(&bar[XB_TOP], 1u);
            const unsigned tg = og / nx;
            if (og + 1u == (tg + 1u) * nx) xb_add(&bar[XB_TOPGEN], 1u);
            else XB_SPIN(xb_ld(&bar[XB_TOPGEN]) == tg, bar);
            __builtin_amdgcn_fence(__ATOMIC_ACQUIRE, "agent");
            xb_add(&bar[XB_XGEN(b.x)], 1u);
            asm volatile("s_waitcnt vmcnt(0)" ::: "memory");
        } else {
            XB_SPIN(xb_ld(&bar[XB_XGEN(b.x)]) == gen, bar);
            __builtin_amdgcn_fence(__ATOMIC_ACQUIRE, "agent");
            asm volatile("s_waitcnt vmcnt(0)" ::: "memory");
        }
    }
    __syncthreads();
}
#ifndef DBG_MASK
#define DBG_MASK 255
#endif
#ifndef GEMM_XDMA
#define GEMM_XDMA false
#endif
#ifndef GU_ALIGN
#define GU_ALIGN true
#endif
#ifndef DUP_MASK
#define DUP_MASK 0
#endif
#define NREP(bit) ((DUP_MASK & (bit)) ? 2 : 1)
constexpr int NWAVES = 8;
constexpr int NBATCH = 8, SEQ = 2048, D = 1024, FF = 2816, M = NBATCH * SEQ, DEPTH = 4;
constexpr int N_PHASES = 2 + 7 * DEPTH;
constexpr float QSCALE = 0.125f * 1.4426950408889634f;
typedef unsigned short bf16;
typedef float f32x4 __attribute__((ext_vector_type(4)));
typedef unsigned v4u __attribute__((ext_vector_type(4)));
typedef GAS unsigned gu32;
#define RLX_AGENT __ATOMIC_RELAXED, __HIP_MEMORY_SCOPE_AGENT
constexpr size_t MiB = 1u << 20;
constexpr size_t WS_CTL = 0, CTL_ZERO_BYTES = 1 * MiB;
constexpr size_t WS_WGU = 1 * MiB;
constexpr size_t WS_WD = 89 * MiB;
constexpr size_t WS_WIN_E = 133 * MiB;
constexpr size_t WS_WOUT_E = 141 * MiB;
constexpr size_t WS_WQKV_O = 145 * MiB;
constexpr size_t WS_WO_O = 157 * MiB;
constexpr size_t WS_XB = 161 * MiB;
constexpr size_t WS_SS = 193 * MiB;
constexpr size_t WS_KMP = 194 * MiB;
constexpr size_t WS_QKV = 195 * MiB;
constexpr size_t WS_O = 291 * MiB;
constexpr size_t WS_END = 323 * MiB;
constexpr size_t WGU_BYTES = (size_t)2 * FF * D * 2, WD_BYTES = (size_t)D * FF * 2;
static_assert(WS_WGU + 8 * WGU_BYTES <= WS_WD && WS_WD + 8 * WD_BYTES <= WS_WIN_E && WS_QKV + (size_t)M * 3072 * 2 <= WS_O && WS_O + (size_t)M * D * 2 <= WS_END, "d_ws map");
constexpr int CW_BAR = 4096;
constexpr int RING_OFF = 0, RING_BYTES = 131072;
constexpr int P0_TS = 65, P0_SCR_BYTES = 64 * P0_TS * 4;
constexpr int LDSCTL_OFF = pg8::HM_STAGE_BYTES, MISC_OFF = LDSCTL_OFF + 320;
constexpr int LDS_BYTES = LDSCTL_OFF + 1024;
static_assert(att::LDS_END <= RING_BYTES && exa::LDS_BYTES + 2048 <= RING_BYTES && MISC_OFF + 128 <= LDS_BYTES && 8 * P0_SCR_BYTES <= LDSCTL_OFF && LDS_BYTES <= 160 * 1024, "LDS map");

__device__ __forceinline__ unsigned f2bf(float f) { unsigned u = __builtin_bit_cast(unsigned, f); return (u + 0x7fffu + ((u >> 16) & 1u)) >> 16; }
__device__ __forceinline__ unsigned pk2(float lo, float hi) { return f2bf(lo) | (f2bf(hi) << 16); }
__device__ __forceinline__ float wave_sum(float v) {
#pragma unroll
    for (int o = 1; o < 64; o <<= 1) v += __shfl_xor(v, o);
    return v;
}
#define LDS_WAIT() asm volatile("s_waitcnt lgkmcnt(0)" ::: "memory")
#define VM_WAIT() asm volatile("s_waitcnt vmcnt(0)" ::: "memory")

__device__ __forceinline__ void p0_write_tile(bf16* WT, int K, int dst_row0, int k0, LAS float* scr, int lane) {
    LDS_WAIT(); asm volatile("" ::: "memory");
    const int c = lane & 7, nn = lane >> 3;
#pragma unroll
    for (int j = 0; j < 8; ++j) { const int n = nn + 8 * j; const LAS float* s = scr + (8 * c) * P0_TS + n;
        v4u o; o.x = pk2(s[0 * P0_TS], s[1 * P0_TS]); o.y = pk2(s[2 * P0_TS], s[3 * P0_TS]); o.z = pk2(s[4 * P0_TS], s[5 * P0_TS]); o.w = pk2(s[6 * P0_TS], s[7 * P0_TS]);
        *(GAS v4u*)(WT + (size_t)(dst_row0 + n) * K + k0 + 8 * c) = o; }
    LDS_WAIT(); asm volatile("" ::: "memory");
}
#if defined(P0_NT)
#define P0_LOADW(p) __builtin_nontemporal_load(p)
#else
#define P0_LOADW(p) (*(p))
#endif
struct P0Item { const float* W; const float* gain; bf16* WT; int ldw, K, dst_row0, k0, n0; };
__device__ __forceinline__ void p0_item_load(const P0Item& d, f32x4 (&v)[16], float (&g)[16], int lane) {
    const int q = lane >> 4, p = lane & 15;
#pragma unroll
    for (int i = 0; i < 16; ++i) { v[i] = P0_LOADW((const GAS f32x4*)(d.W + (size_t)(d.k0 + 4 * i + q) * d.ldw + d.n0 + 4 * p)); g[i] = d.gain ? d.gain[d.k0 + 4 * i + q] : 1.0f; }
}
__device__ __forceinline__ void p0_item_finish(const P0Item& d, const f32x4 (&v)[16], const float (&g)[16], LAS float* scr, int lane) {
    const int q = lane >> 4, p = lane & 15;
#pragma unroll
    for (int i = 0; i < 16; ++i) { LAS float* dd = scr + (4 * i + q) * P0_TS + 4 * p; dd[0] = v[i][0] * g[i]; dd[1] = v[i][1] * g[i]; dd[2] = v[i][2] * g[i]; dd[3] = v[i][3] * g[i]; }
    p0_write_tile(d.WT, d.K, d.dst_row0, d.k0, scr, lane);
}
__device__ __forceinline__ void p0_fold_item(const float* Win  , const float* Wp  , const float* pscale  , const float* gain, bf16* WT, int k0, int n0, LAS float* scr, int lane) {
    const int g = n0 >> 7, d = (n0 & 127) + lane;
    const float* wpb = Wp + (size_t)g * 128 * 128 + d;
    const int q = lane >> 4, p = lane & 15;
    float acc[64];
#pragma unroll
    for (int i = 0; i < 64; ++i) acc[i] = 0.f;
#pragma unroll 1
    for (int hc = 0; hc < 2; ++hc) {
        f32x4 v[16];
#pragma unroll
        for (int i = 0; i < 16; ++i) v[i] = *(const GAS f32x4*)(Win + (size_t)(k0 + 4 * i + q) * 2048 + 1536 + g * 128 + hc * 64 + 4 * p);
        LDS_WAIT(); asm volatile("" ::: "memory");
#pragma unroll
        for (int i = 0; i < 16; ++i) { LAS float* dd = scr + (4 * i + q) * P0_TS + 4 * p; dd[0] = v[i][0]; dd[1] = v[i][1]; dd[2] = v[i][2]; dd[3] = v[i][3]; }
        LDS_WAIT(); asm volatile("" ::: "memory");
#pragma unroll 1
        for (int c = 0; c < 64; c += 4) {
            const float w0 = wpb[(size_t)(hc * 64 + c + 0) * 128], w1 = wpb[(size_t)(hc * 64 + c + 1) * 128], w2 = wpb[(size_t)(hc * 64 + c + 2) * 128], w3 = wpb[(size_t)(hc * 64 + c + 3) * 128];
            const LAS float* sc = scr + c;
#pragma unroll
            for (int k = 0; k < 64; ++k) acc[k] += (sc[k * P0_TS] * w0 + sc[k * P0_TS + 1] * w1) + (sc[k * P0_TS + 2] * w2 + sc[k * P0_TS + 3] * w3);
        }
    }
    const float ps = pscale[g * 128 + d];
    LDS_WAIT(); asm volatile("" ::: "memory");
#pragma unroll
    for (int i = 0; i < 64; ++i) scr[i * P0_TS + lane] = acc[i] * ps * gain[k0 + i];
    p0_write_tile(WT, 1024, 1536 + n0, k0, scr, lane);
}

struct Args { const float* in[17]; float* out; unsigned char* ws; int ph_lo, ph_hi; };

__device__ __forceinline__ void p0_prologue(const Args& a, unsigned char* ws, LAS unsigned char* lds, int vcu, int G, int wave, int lane) {
    LAS float* scr = (LAS float*)(lds + wave * P0_SCR_BYTES);
    const int gw = vcu * NWAVES + wave, NGW = G * NWAVES;
    constexpr int I_GU = 16 * 44, I_DN = 44 * 16, I_EIN = 16 * 24, I_EFO = 16 * 8, I_SQ = 16 * 16, I_OQKV = 16 * 48;
    constexpr int S_G = 0, S_U = S_G + 8 * I_GU, S_D = S_U + 8 * I_GU, S_EIN = S_D + 8 * I_DN, S_EOUT = S_EIN + 2 * I_EIN, S_OQKV = S_EOUT + 2 * I_SQ, S_OO = S_OQKV + 2 * I_OQKV, NITEMS = S_OO + 2 * I_SQ;
    auto decode = [&](int it) -> P0Item {
        P0Item d;
        if (it < S_D) {
            const bool up = it >= S_U; const int r0 = it - (up ? S_U : S_G), f = r0 / I_GU, r = r0 % I_GU, layer = f >> 1, half = f & 1, kb = r / 44, nb = r % 44, n0 = 64 * nb;
            d.W = a.in[half ? (up ? 8 : 7) : (up ? 3 : 2)] + (size_t)layer * D * FF; d.gain = a.in[half ? 6 : 1] + layer * D; d.WT = (bf16*)(ws + WS_WGU + (size_t)f * WGU_BYTES);
            d.ldw = FF; d.K = D; d.dst_row0 = (n0 >> 7) * 256 + (up ? 128 : 0) + (n0 & 127); d.k0 = 64 * kb; d.n0 = n0;
        } else if (it < S_EIN) {
            const int r0 = it - S_D, f = r0 / I_DN, r = r0 % I_DN, layer = f >> 1, half = f & 1, kb = r / 16, nb = r % 16;
            d.W = a.in[half ? 9 : 4] + (size_t)layer * FF * D; d.gain = nullptr; d.WT = (bf16*)(ws + WS_WD + (size_t)f * WD_BYTES); d.ldw = D; d.K = FF; d.dst_row0 = 64 * nb; d.k0 = 64 * kb; d.n0 = 64 * nb;
        } else if (it < S_EOUT) {
            const int r0 = it - S_EIN, i = r0 / I_EIN, r = r0 % I_EIN, kb = r / 24, nb = r % 24;
            d.W = a.in[10] + (size_t)i * D * 2048; d.gain = a.in[5] + (2 * i) * D; d.WT = (bf16*)(ws + WS_WIN_E + (size_t)i * 2048 * D * 2); d.ldw = 2048; d.K = D; d.dst_row0 = 64 * nb; d.k0 = 64 * kb; d.n0 = 64 * nb;
        } else if (it < S_OQKV) {
            const int r0 = it - S_EOUT, i = r0 / I_SQ, r = r0 % I_SQ, kb = r / 16, nb = r % 16;
            d.W = a.in[13] + (size_t)i * D * D; d.gain = nullptr; d.WT = (bf16*)(ws + WS_WOUT_E + (size_t)i * D * D * 2); d.ldw = D; d.K = D; d.dst_row0 = 64 * nb; d.k0 = 64 * kb; d.n0 = 64 * nb;
        } else if (it < S_OO) {
            const int r0 = it - S_OQKV, i = r0 / I_OQKV, r = r0 % I_OQKV, kb = r / 48, nb = r % 48;
            d.W = a.in[14] + (size_t)i * D * 3072; d.gain = a.in[5] + (2 * i + 1) * D; d.WT = (bf16*)(ws + WS_WQKV_O + (size_t)i * 3072 * D * 2); d.ldw = 3072; d.K = D; d.dst_row0 = 64 * nb; d.k0 = 64 * kb; d.n0 = 64 * nb;
        } else {
            const int r0 = it - S_OO, i = r0 / I_SQ, r = r0 % I_SQ, kb = r / 16, nb = r % 16;
            d.W = a.in[15] + (size_t)i * D * D; d.gain = nullptr; d.WT = (bf16*)(ws + WS_WO_O + (size_t)i * D * D * 2); d.ldw = D; d.K = D; d.dst_row0 = 64 * nb; d.k0 = 64 * kb; d.n0 = 64 * nb;
        }
        return d;
    };
    if (gw < NITEMS) {
        P0Item cur = decode(gw); f32x4 v[16]; float g[16];
        p0_item_load(cur, v, g, lane);
        for (int it = gw; it < NITEMS; it += NGW) {
            const bool more = it + NGW < NITEMS;
            P0Item nxt = cur; f32x4 v2[16]; float g2[16];
            if (more) { nxt = decode(it + NGW); p0_item_load(nxt, v2, g2, lane); }
            p0_item_finish(cur, v, g, scr, lane);
            if (more) { cur = nxt;
#pragma unroll
                for (int i = 0; i < 16; ++i) { v[i] = v2[i]; g[i] = g2[i]; } }
        }
    }
    if (wave == 0) for (int r0 = vcu; r0 < 2 * I_EFO; r0 += G) {
        const int i = r0 / I_EFO, r = r0 % I_EFO, kb = r / 8, nb = r % 8;
        p0_fold_item(a.in[10] + (size_t)i * D * 2048, a.in[11] + (size_t)i * 4 * 128 * 128, a.in[12] + i * 512, a.in[5] + (2 * i) * D, (bf16*)(ws + WS_WIN_E + (size_t)i * 2048 * D * 2), 64 * kb, 64 * nb, scr, lane);
    }
    const float* x = a.in[0]; bf16* XB = (bf16*)(ws + WS_XB); float* SS = (float*)(ws + WS_SS);
    for (int m = gw; m < M; m += NGW) {
        const GAS f32x4* xr = (const GAS f32x4*)(x + (size_t)m * D) + lane;
        f32x4 v[4]; float s = 0.f;
#pragma unroll
        for (int j = 0; j < 4; ++j) { v[j] = xr[64 * j]; s += (v[j].x * v[j].x + v[j].y * v[j].y) + (v[j].z * v[j].z + v[j].w * v[j].w); }
        s = wave_sum(s);
        GAS unsigned long long* o8 = (GAS unsigned long long*)(XB + (size_t)m * D) + lane;
#pragma unroll
        for (int j = 0; j < 4; ++j) o8[64 * j] = (unsigned long long)pk2(v[j].x, v[j].y) | ((unsigned long long)pk2(v[j].z, v[j].w) << 32);
        if (lane < 16) SS[(size_t)m * 16 + lane] = (lane == 0) ? s : 0.f;
    }
}
__device__ __forceinline__ void pool_rows(const bf16* QKV, bf16* O, int vcu, int G, int tid) {
    asm volatile("" : "+v"(tid));
    const int cc = tid & 63, rg = tid >> 6, g = cc >> 4, w = 2 << g;
    for (int R0 = vcu * 64; R0 < M; R0 += G * 64) {
#pragma unroll 1
        for (int rr = 0; rr < 8; ++rr) {
            const int row = R0 + rg * 8 + rr, t = row & (SEQ - 1);
            const int cnt = (t + 1) < w ? (t + 1) : w;
            float s[8];
#pragma unroll
            for (int e = 0; e < 8; ++e) s[e] = 0.f;
            v4u cur = {0u, 0u, 0u, 0u};
            for (int i = 0; i < cnt; ++i) {
                const v4u v = *(const v4u*)(QKV + (size_t)(row - i) * 2048 + 1536 + cc * 8);
                if (i == 0) cur = v;
                s[0] += __builtin_bit_cast(float, v.x << 16); s[1] += __builtin_bit_cast(float, v.x & 0xffff0000u);
                s[2] += __builtin_bit_cast(float, v.y << 16); s[3] += __builtin_bit_cast(float, v.y & 0xffff0000u);
                s[4] += __builtin_bit_cast(float, v.z << 16); s[5] += __builtin_bit_cast(float, v.z & 0xffff0000u);
                s[6] += __builtin_bit_cast(float, v.w << 16); s[7] += __builtin_bit_cast(float, v.w & 0xffff0000u);
            }
            const float rc = 1.0f / (float)cnt;
            v4u o;
            o.x = pk2(s[0] * rc - __builtin_bit_cast(float, cur.x << 16), s[1] * rc - __builtin_bit_cast(float, cur.x & 0xffff0000u));
            o.y = pk2(s[2] * rc - __builtin_bit_cast(float, cur.y << 16), s[3] * rc - __builtin_bit_cast(float, cur.y & 0xffff0000u));
            o.z = pk2(s[4] * rc - __builtin_bit_cast(float, cur.z << 16), s[5] * rc - __builtin_bit_cast(float, cur.z & 0xffff0000u));
            o.w = pk2(s[6] * rc - __builtin_bit_cast(float, cur.w << 16), s[7] * rc - __builtin_bit_cast(float, cur.w & 0xffff0000u));
            *(v4u*)(O + (size_t)row * 1024 + 512 + cc * 8) = o;
        }
    }
}
__device__ __forceinline__ void final_norm(const bf16* XBs, float* out, const float* SS, const float* gfin, int vcu, int G, int wave, int lane) {
    const int gw = vcu * NWAVES + wave, NGW = G * NWAVES;
    f32x4 gv[2][2];
#pragma unroll
    for (int j = 0; j < 2; ++j) { gv[j][0] = *(const f32x4*)(gfin + 512 * j + 8 * lane); gv[j][1] = *(const f32x4*)(gfin + 512 * j + 8 * lane + 4); }
    for (int m = gw; m < M; m += NGW) {
        float s = (lane < 16) ? SS[(size_t)m * 16 + lane] : 0.f;
        s = wave_sum(s);
        const float r = 1.0f / sqrtf(s * (1.0f / D) + 1e-6f);
#pragma unroll
        for (int j = 0; j < 2; ++j) {
            const v4u b = *(const GAS v4u*)(XBs + (size_t)m * D + 512 * j + 8 * lane);
            const f32x4 x0 = {__builtin_bit_cast(float, b.x << 16), __builtin_bit_cast(float, b.x & 0xffff0000u), __builtin_bit_cast(float, b.y << 16), __builtin_bit_cast(float, b.y & 0xffff0000u)};
            const f32x4 x1 = {__builtin_bit_cast(float, b.z << 16), __builtin_bit_cast(float, b.z & 0xffff0000u), __builtin_bit_cast(float, b.w << 16), __builtin_bit_cast(float, b.w & 0xffff0000u)};
            GAS f32x4* o = (GAS f32x4*)(out + (size_t)m * D + 512 * j + 8 * lane);
            o[0] = x0 * r * gv[j][0]; o[1] = x1 * r * gv[j][1];
        }
    }
}

#if defined(CMP_PROBE)
__device__ __forceinline__ void cmp_unit(const bf16* A, const bf16* B, int b, int h, int qb, int cls, gu32* word, int tid) {
    asm volatile("" : "+v"(tid));
    __threadfence(); __syncthreads();
    unsigned bucket = 0u;
    if (tid < 256) {
        float se = 0.f, sx = 0.f;
        for (int c = 0; c < 64; ++c) { const size_t idx = ((size_t)b * SEQ + qb * 256 + tid) * 1024 + h * 64 + c;
            const float x = __builtin_bit_cast(float, (unsigned)A[idx] << 16), y = __builtin_bit_cast(float, (unsigned)B[idx] << 16);
            se += (x - y) * (x - y); sx += x * x; }
        const float rel = sqrtf(se / (sx + 1e-12f));
#if defined(CMP_BUCKETS)
        if (rel > 0.02f) bucket |= 4u; if (rel > 0.05f) bucket |= 8u; if (rel > 0.15f) bucket |= 16u; if (rel > 0.5f) bucket |= 32u; if (rel > 1.5f) bucket |= 64u; if (!(rel == rel)) bucket |= 128u;
#else
        if (!(rel <= CMP_RTOL)) bucket |= 1u << cls;
#endif
    }
    if (bucket) __hip_atomic_fetch_or(word, bucket, __ATOMIC_RELAXED, __HIP_MEMORY_SCOPE_AGENT);
    __syncthreads();
}
#endif
__global__ void __launch_bounds__(NWAVES * 64, 2) mk_fwd(Args args) {
    extern __shared__ __attribute__((aligned(16))) unsigned char lds_raw[];
    LAS unsigned char* lds = (LAS unsigned char*)lds_raw;
    volatile LAS unsigned* MISC = (volatile LAS unsigned*)(lds + MISC_OFF);
    const int tid = threadIdx.x, lane = tid & 63, wave = __builtin_amdgcn_readfirstlane(tid >> 6);
    const int G = gridDim.x; const int bx = blockIdx.x; const int vcu = (G % 8 == 0) ? (bx % 8) * (G / 8) + bx / 8 : bx;
    unsigned char* ws = args.ws;
    gu32* ctl = (gu32*)(ws + WS_CTL);
    for (int u = tid; u < (LDS_BYTES - LDSCTL_OFF) / 4; u += NWAVES * 64) ((LAS unsigned*)(lds + LDSCTL_OFF))[u] = 0u;
    __syncthreads();
    XcdBarrier bar; bar.bar = (unsigned*)(ctl + CW_BAR); bar.x = 0; bar.st = nullptr;
    if (MK_N_LAUNCHES == 1) bar = xcd_barrier_post((unsigned*)(ctl + CW_BAR), MISC + 8);
    const int lo = args.ph_lo, hi = args.ph_hi;
#define IN(k) (lo <= (k) && (k) < hi)
#if defined(BAR_DUP)
#define SEAM(k) do { if (IN(k) && IN((k) + 1)) { xcd_barrier(bar); xcd_barrier(bar); } } while (0)
#else
#define SEAM(k) do { if (IN(k) && IN((k) + 1)) xcd_barrier(bar); } while (0)
#endif

    bf16* XB = (bf16*)(ws + WS_XB); float* SS = (float*)(ws + WS_SS); float* KMP = (float*)(ws + WS_KMP);
    bf16* QKV = (bf16*)(ws + WS_QKV); bf16* HB = (bf16*)(ws + WS_QKV); bf16* OB = (bf16*)(ws + WS_O);

    if ((DBG_MASK & 1) && IN(0)) { for (int rep = 0; rep < NREP(1); ++rep) { p0_prologue(args, ws, lds, vcu, G, wave, lane); __syncthreads(); } }
    SEAM(0);

    for (int layer = 0; layer < DEPTH; ++layer) {
        const int pb = 1 + 7 * layer;
        for (int half = 0; half < 2; ++half) {
            const int f = layer * 2 + half, pg = pb + (half ? 5 : 0);
            if ((DBG_MASK & 2) && IN(pg)) for (int rep = 0; rep < NREP(2); ++rep) {
                pg8::Gemm g{XB, (const bf16*)(ws + WS_WGU + (size_t)f * WGU_BYTES), M, 2 * FF, D}; pg8::StaticOrder S; S.init(M, 2 * FF, G, bx);
#if defined(GU_PROBE_VARIANT)
#if defined(GU_KPROBE)
                if (rep == 1) { pg8::EpiGUProbe<GU_KPROBE> E{}; E.H = HB; E.SS = SS; pg8::gemm_phase<pg8::EpiGUProbe<GU_KPROBE>, pg8::StaticOrder, true, true, GEMM_XDMA>(lds + RING_OFF, g, S, E); } else
#else
                if (rep == 1) { pg8::EpiGU_<GU_PROBE_VARIANT> E{HB, SS}; pg8::gemm_phase<pg8::EpiGU_<GU_PROBE_VARIANT>, pg8::StaticOrder, true, true, GEMM_XDMA>(lds + RING_OFF, g, S, E); } else
#endif
#endif
                { pg8::EpiGU E{HB, SS};
                const int fullr = S.nwg / G, rem = S.nwg - fullr * G; const bool hm = (2 * rem == G) && (G % 16 == 0);
                if (hm) S.maxr = fullr;
                pg8::gemm_phase<pg8::EpiGU, pg8::StaticOrder, GU_ALIGN, true, GEMM_XDMA>(lds + RING_OFF, g, S, E);
                if (hm) { const int j = bx >> 3; pg8::Unit uu; S.unit_of((long)fullr * G + (bx & 7) + 8 * (j >> 1), uu); const pg8::HUnit hu{uu.pm * 2 + (j & 1), uu.pn};
                    pg8::gemm_half_unit<pg8::EpiGU>(lds + RING_OFF, g, hu, E);
#if defined(HM_DUP)
                    __syncthreads(); pg8::gemm_half_unit<pg8::EpiGU>(lds + RING_OFF, g, hu, E);
#endif
                    } }
            }
            SEAM(pg);
            if ((DBG_MASK & 4) && IN(pg + 1)) for (int rep = 0; rep < NREP(4); ++rep) {
                pg8::Gemm g{HB, (const bf16*)(ws + WS_WD + (size_t)f * WD_BYTES), M, D, FF}; pg8::StaticOrder S; S.init(M, D, G, bx);
#if defined(DOWN_NOOP_PROBE)
                if (rep == 1) { pg8::EpiResNoop E; pg8::gemm_phase<pg8::EpiResNoop, pg8::StaticOrder, true, true, GEMM_XDMA>(lds + RING_OFF, g, S, E); } else {
#endif
                pg8::EpiRes E{XB, SS, rep ? 0.0f : 0.5f};
                pg8::gemm_phase<pg8::EpiRes, pg8::StaticOrder, true, true, GEMM_XDMA>(lds + RING_OFF, g, S, E);
#if defined(DOWN_NOOP_PROBE)
                }
#endif
            }
            SEAM(pg + 1);
            if (half == 0) {
                const int i2 = layer >> 1; const bool odd = layer & 1;
                if ((DBG_MASK & 8) && IN(pb + 2)) for (int rep = 0; rep < NREP(8); ++rep) {
                    const int N = odd ? 3072 : 2048;
                    pg8::Gemm g{XB, (const bf16*)(ws + (odd ? WS_WQKV_O + (size_t)i2 * 3072 * D * 2 : WS_WIN_E + (size_t)i2 * 2048 * D * 2)), M, N, D}; pg8::StaticOrder S; S.init(M, N, G, bx);
                    pg8::EpiQKV E{QKV, N, SS, odd ? 4 : 2, QSCALE, odd ? KMP : nullptr, 4, 8};
                    pg8::gemm_phase<pg8::EpiQKV, pg8::StaticOrder, true, true, GEMM_XDMA>(lds + RING_OFF, g, S, E);
                }
                SEAM(pb + 2);
                if (IN(pb + 3)) {
                    if ((DBG_MASK & 16) && !odd) for (int rep = 0; rep < NREP(16); ++rep) {
                        for (int ui = vcu; ui < 512; ui += G) {
                            const int bh = (ui & 255) >> 2, s = ui & 3, qb = (ui >> 8) ? 7 - s : s;
                            att::attn_unit<false>(bh >> 3, bh & 7, qb, QKV, 2048, 512, 1024, OB, lds + RING_OFF, nullptr, 0.f);
                        }
                        pool_rows(QKV, OB, vcu, G, tid);
                    } else if (DBG_MASK & 32) for (int rep = 0; rep < NREP(32); ++rep) {
                        for (int ui = vcu; ui < 1024; ui += G) {
                            const int bh = (ui & 255) >> 1, j = ui & 1, k = ui >> 8;
                            const int qb = (k == 0) ? (j ? 6 : 7) : (k == 1) ? (j ? 5 : 4) : (k == 2) ? (j ? 2 : 3) : (j ? 1 : 0);
                            const int h = bh & 15;
                            const float sl2 = exp2f(-0.5f * (float)(h + 1)) * 1.4426950408889634f;
#if defined(CMP_PROBE)
                            att::attn_unit<true>(bh >> 4, h, qb, QKV, 3072, 1024, 2048, OB, lds + RING_OFF, KMP, sl2);
                            if ((bh >> 4) < 4) {
                                att::attn_unit<true>(bh >> 4, h, qb, QKV, 3072, 1024, 2048, (bf16*)(ws + WS_END), lds + RING_OFF, KMP, CMP_SL2, CMP_FORCE);
#if defined(CMP_EXA)
                                exa::attn_unit<8>(bh >> 4, h, qb, QKV, (bf16*)(ws + WS_END + 16 * MiB), lds + RING_OFF, KMP, CMP_SL2, CMP_FORCE);
#else
                                exa::attn_unit<8>(bh >> 4, h, qb, QKV, (bf16*)(ws + WS_END + 16 * MiB), lds + RING_OFF, KMP, CMP_SL2, CMP_FORCE);
#endif
                                cmp_unit((const bf16*)(ws + WS_END), (const bf16*)(ws + WS_END + 16 * MiB), bh >> 4, h, qb, CMP_PROBE, ctl + 2048, tid); }
#elif defined(MOBA_OLD)
                            att::attn_unit<true>(bh >> 4, h, qb, QKV, 3072, 1024, 2048, OB, lds + RING_OFF, KMP, sl2);
#else
#if defined(UNIT_OVH_PROBE)
                            if (rep == 1) exa::attn_unit<8>(bh >> 4, h, 0, QKV, (bf16*)(ws + WS_END), lds + RING_OFF, KMP, sl2, 0u); else
#endif
                            exa::attn_unit<8>(bh >> 4, h, qb, QKV, OB, lds + RING_OFF, KMP, sl2, 0u);
#endif
                        }
                    }
                }
                SEAM(pb + 3);
                if ((DBG_MASK & 64) && IN(pb + 4)) for (int rep = 0; rep < NREP(64); ++rep) {
                    pg8::Gemm g{OB, (const bf16*)(ws + (odd ? WS_WO_O : WS_WOUT_E) + (size_t)i2 * D * D * 2), M, D, D}; pg8::StaticOrder S; S.init(M, D, G, bx);
                    pg8::EpiRes E{XB, SS, rep ? 0.0f : 1.0f};
                    pg8::gemm_phase<pg8::EpiRes, pg8::StaticOrder, true, true, GEMM_XDMA>(lds + RING_OFF, g, S, E);
                }
                SEAM(pb + 4);
            }
        }
    }
    if ((DBG_MASK & 128) && IN(N_PHASES - 1)) final_norm(XB, args.out, SS, args.in[16], vcu, G, wave, lane);
#if defined(CMP_PROBE)
    xcd_barrier(bar);
    if (blockIdx.x == 0 && tid == 0) { const unsigned w = __hip_atomic_load(ctl + 2048, RLX_AGENT); const unsigned long long t0 = __builtin_amdgcn_s_memrealtime(), dt = (unsigned long long)w * 10000ull;
        while (__builtin_amdgcn_s_memrealtime() - t0 < dt) __builtin_amdgcn_s_sleep(8); }
#endif
#undef IN
#undef SEAM
}

extern "C" void kernel_launch(void* const* d_in, const int* in_sizes, int n_in, void* d_out, int out_size, void* d_ws, size_t ws_size, hipStream_t stream) {
    static int grid = 0;
    if (grid == 0) {
        if (n_in != 17 || in_sizes[0] != M * D || out_size != M * D || ws_size < WS_END) { fprintf(stderr, "kernel_launch: unexpected shapes (n_in %d, in0 %d, out %d, ws %zu); nothing launched\n", n_in, n_in > 0 ? in_sizes[0] : -1, out_size, ws_size); grid = -1; return; }
        int dev = 0, cus = 0, per_cu = 0;
        if (hipGetDevice(&dev) != hipSuccess || hipDeviceGetAttribute(&cus, hipDeviceAttributeMultiprocessorCount, dev) != hipSuccess) { grid = -1; return; }
        if (hipFuncSetAttribute((const void*)mk_fwd, hipFuncAttributeMaxDynamicSharedMemorySize, LDS_BYTES) != hipSuccess) { fprintf(stderr, "kernel_launch: hipFuncSetAttribute failed\n"); grid = -1; return; }
        if (hipOccupancyMaxActiveBlocksPerMultiprocessor(&per_cu, (const void*)mk_fwd, NWAVES * 64, LDS_BYTES) != hipSuccess || per_cu < 1)
            fprintf(stderr, "kernel_launch: note: occupancy query reports %d workgroups per CU\n", per_cu);
        (void)hipGetLastError();
        grid = cus;
    }
    if (grid < 0) return;
    if (hipMemsetAsync((char*)d_ws + WS_CTL, 0, CTL_ZERO_BYTES, stream) != hipSuccess) return;
    Args a{};
    for (int i = 0; i < 17; ++i) a.in[i] = (const float*)d_in[i];
    a.out = (float*)d_out; a.ws = (unsigned char*)d_ws;
#if MK_N_LAUNCHES == 1
    a.ph_lo = 0; a.ph_hi = N_PHASES;
    hipLaunchKernelGGL(mk_fwd, dim3(grid), dim3(NWAVES * 64), LDS_BYTES, stream, a);
#else
    for (int p = 0; p < N_PHASES; ++p) { a.ph_lo = p; a.ph_hi = p + 1; hipLaunchKernelGGL(mk_fwd, dim3(grid), dim3(NWAVES * 64), LDS_BYTES, stream, a); }
#endif
}
```

```cpp
#include <hip/hip_runtime.h>
#include <cstdio>
#include <cstdint>
#define LAS __attribute__((address_space(3)))
#define GAS __attribute__((address_space(1)))
#ifndef MK_N_LAUNCHES
#define MK_N_LAUNCHES 1
#endif
#define P0_NT 1
#define EXA_G1 1
#define EXA_G2 1
#define EXA_G3 1
namespace pg8 {
#define PG8_LAS __attribute__((address_space(3)))
typedef unsigned short bf16_t;
typedef short bf16x8 __attribute__((ext_vector_type(8)));
typedef float f32x4 __attribute__((ext_vector_type(4)));
typedef unsigned u32x4 __attribute__((ext_vector_type(4)));
constexpr int BM = 256, BK = 64, HALF = 128, HTB = HALF * BK * 2  , STAGE_BYTES = 8 * HTB, NXCD = 8, WGM = 8;

__host__ __device__ __forceinline__ int lds_byte(int r, int c) { const int st = (r >> 4) * 2 + (c >> 5), rr = r & 15, cc = c & 31, ob = rr * 64 + cc * 2; return st * 1024 + (ob ^ (((ob >> 9) & 1) << 5)); }
__host__ __device__ __forceinline__ void stage_rc(int b, int& R, int& C) { const int st = b / 1024, sb = b % 1024, swz = sb ^ (((sb >> 9) & 1) << 5); R = (st >> 1) * 16 + swz / 64; C = (st & 1) * 32 + (swz % 64) / 2; }
__host__ __device__ __forceinline__ int perm32(int rho) { const int n = rho >> 4, i = rho & 15; return 8 * (i >> 2) + 4 * n + (i & 3); }

struct Unit { int pm, pn; };
struct HUnit { int pm2, pn; };
struct Gemm { const bf16_t* A; const bf16_t* Bt; int M, N, K; };

struct StaticOrder {
    int nM, nN, nwg, G, c, maxr;
    __host__ __device__ void init(int M, int N, int G_, int c_) { nM = M / BM; nN = N / BM; nwg = nM * nN; G = G_; c = c_; maxr = 1 << 30; }
    __host__ __device__ bool next(int i, Unit& u) const {
        const long L = (long)i * G + c; if (L >= nwg || i >= maxr) return false;
        unit_of(L, u); return true;
    }
    __host__ __device__ void unit_of(long L, Unit& u) const {
        int wgid = (int)L; { const int q = nwg / NXCD, r = nwg % NXCD, xcd = wgid % NXCD, off = wgid / NXCD; wgid = (xcd < r ? xcd * (q + 1) : r * (q + 1) + (xcd - r) * q) + off; }
        const int nig = WGM * nN, gid = wgid / nig, fm = gid * WGM, gsz = (nM - fm) < WGM ? (nM - fm) : WGM;
        u.pm = fm + ((wgid % nig) % gsz); u.pn = (wgid % nig) / gsz;
    }
    __device__ __forceinline__ void a_ready(const Unit&) const {}
    __device__ __forceinline__ void done(const Unit&) const {}
};

__device__ __forceinline__ unsigned cvt_pk_bf16(float lo, float hi) { unsigned r; asm volatile("v_cvt_pk_bf16_f32 %0, %1, %2" : "=v"(r) : "v"(lo), "v"(hi)); return r; }
typedef float f32x2 __attribute__((ext_vector_type(2)));
__device__ __forceinline__ float row_rstd(const float* SS, int row, int fq) {
    const f32x4 v = *(const f32x4*)(SS + (size_t)row * 16 + 4 * fq);
    float s = (v[0] + v[1]) + (v[2] + v[3]);
    s += __shfl_xor(s, 16); s += __shfl_xor(s, 32);
    return __builtin_amdgcn_rsqf(s * (1.0f / 1024.0f) + 1e-6f);
}
__device__ __forceinline__ void row_rstd8(const float* SS, int row0, int fq, float (&r8)[8]) {
    f32x4 sv[8];
#pragma unroll
    for (int k = 0; k < 8; ++k) sv[k] = *(const f32x4*)(SS + (size_t)(row0 + (k >> 2) * HALF + (k & 3) * 16) * 16 + 4 * fq);
#pragma unroll
    for (int k = 0; k < 8; ++k) { float s = (sv[k][0] + sv[k][1]) + (sv[k][2] + sv[k][3]); s += __shfl_xor(s, 16); s += __shfl_xor(s, 32); r8[k] = __builtin_amdgcn_rsqf(s * (1.0f / 1024.0f) + 1e-6f); }
}
__device__ __forceinline__ void row_rstd8v(const float* SS, int row0, int fq, float (&r8)[8], float (&v8)[8]) {
    f32x4 sv[8];
#pragma unroll
    for (int k = 0; k < 8; ++k) sv[k] = *(const f32x4*)(SS + (size_t)(row0 + (k >> 2) * HALF + (k & 3) * 16) * 16 + 4 * fq);
#pragma unroll
    for (int k = 0; k < 8; ++k) { float s = (sv[k][0] + sv[k][1]) + (sv[k][2] + sv[k][3]); s += __shfl_xor(s, 16); s += __shfl_xor(s, 32); v8[k] = s * (1.0f / 1024.0f) + 1e-6f; r8[k] = __builtin_amdgcn_rsqf(v8[k]); }
}
template <int VARIANT = 0> struct EpiGU_ {
    static constexpr bool PERM = true, AFTER_DRAIN = false;
    bf16_t* H; const float* SS;
    __device__ __forceinline__ void gu_row(const f32x4 (&ga)[2], const f32x4 (&ua)[2], float r, float v, bf16_t* dst) const {
        const float rn = r * -1.4426950408889634f;
        const f32x2 rn2 = {rn, rn}, v2 = {v, v};
        f32x2 t[4], p[4];
#pragma unroll
        for (int k = 0; k < 4; ++k) { const f32x2 g = {ga[k >> 1][2 * (k & 1)], ga[k >> 1][2 * (k & 1) + 1]}, uu = {ua[k >> 1][2 * (k & 1)], ua[k >> 1][2 * (k & 1) + 1]};
            t[k] = g * rn2; p[k] = g * uu; }
#pragma unroll
        for (int k = 0; k < 4; ++k) { t[k].x = __builtin_amdgcn_exp2f(t[k].x); t[k].y = __builtin_amdgcn_exp2f(t[k].y); }
#pragma unroll
        for (int k = 0; k < 4; ++k) t[k] = __builtin_elementwise_fma(t[k], v2, v2);
#pragma unroll
        for (int k = 0; k < 4; ++k) { t[k].x = __builtin_amdgcn_rcpf(t[k].x); t[k].y = __builtin_amdgcn_rcpf(t[k].y); }
#pragma unroll
        for (int k = 0; k < 4; ++k) p[k] = p[k] * t[k];
        u32x4 w; w.x = cvt_pk_bf16(p[0].x, p[0].y); w.y = cvt_pk_bf16(p[1].x, p[1].y); w.z = cvt_pk_bf16(p[2].x, p[2].y); w.w = cvt_pk_bf16(p[3].x, p[3].y);
        if (VARIANT == 2) { asm volatile("" :: "v"(w)); } else *(u32x4*)dst = w;
    }
    __device__ __forceinline__ void half(const f32x4 (&acc)[2][4][2], const HUnit& u, int wr, int wc, int fr, int fq) const {
        const int row0 = u.pm2 * HALF + wr * 64 + fr, col0 = u.pn * 128 + wc * 32 + 8 * fq;
        f32x4 sv[4];
#pragma unroll
        for (int k = 0; k < 4; ++k) sv[k] = *(const f32x4*)(SS + (size_t)(row0 + k * 16) * 16 + 4 * fq);
#pragma unroll
        for (int m = 0; m < 4; ++m) { float s = (sv[m][0] + sv[m][1]) + (sv[m][2] + sv[m][3]); s += __shfl_xor(s, 16); s += __shfl_xor(s, 32); const float v = s * (1.0f / 1024.0f) + 1e-6f;
            gu_row(acc[0][m], acc[1][m], __builtin_amdgcn_rsqf(v), v, H + (size_t)(row0 + m * 16) * 2816 + col0); }
    }
    __device__ __forceinline__ void operator()(const f32x4 (&acc)[2][2][4][2], const Unit& u, int wr, int wc, int fr, int fq) const {
        if (VARIANT == 1) {
#pragma unroll
            for (int ai = 0; ai < 2; ++ai)
#pragma unroll
                for (int bj = 0; bj < 2; ++bj)
                    asm volatile("" :: "v"(acc[ai][bj][0][0]), "v"(acc[ai][bj][0][1]), "v"(acc[ai][bj][1][0]), "v"(acc[ai][bj][1][1]), "v"(acc[ai][bj][2][0]), "v"(acc[ai][bj][2][1]), "v"(acc[ai][bj][3][0]), "v"(acc[ai][bj][3][1]));
            return; }
        const int row0 = u.pm * BM + wr * 64 + fr, col0 = u.pn * 128 + wc * 32 + 8 * fq;
        float r8[8], v8[8]; row_rstd8v(SS, row0, fq, r8, v8);
#pragma unroll
        for (int ai = 0; ai < 2; ++ai)
#pragma unroll
            for (int m = 0; m < 4; ++m) {
                gu_row(acc[ai][0][m], acc[ai][1][m], r8[ai * 4 + m], v8[ai * 4 + m], H + (size_t)(row0 + ai * HALF + m * 16) * 2816 + col0);
            }
    }
};
typedef EpiGU_<0> EpiGU;
template <int KP> struct EpiGUProbe : EpiGU_<1> { static constexpr int KPROBE = KP; };
struct EpiRes {
    static constexpr bool PERM = true, AFTER_DRAIN = false;
    bf16_t* XB; float* SS; float alpha;
    __device__ __forceinline__ void operator()(const f32x4 (&acc)[2][2][4][2], const Unit& u, int wr, int wc, int fr, int fq) const {
        const int row0 = u.pm * BM + wr * 64 + fr, col0 = u.pn * BM + wc * 32 + 8 * fq;
#pragma unroll
        for (int ai = 0; ai < 2; ++ai) {
            u32x4 bv[4][2];
#pragma unroll
            for (int m = 0; m < 4; ++m)
#pragma unroll
                for (int bj = 0; bj < 2; ++bj) bv[m][bj] = *(const u32x4*)(XB + (size_t)(row0 + ai * HALF + m * 16) * 1024 + col0 + bj * HALF);
#pragma unroll
            for (int m = 0; m < 4; ++m) {
                const int row = row0 + ai * HALF + m * 16; const size_t off = (size_t)row * 1024 + col0;
                float s = 0.f;
#pragma unroll
                for (int bj = 0; bj < 2; ++bj) {
                    const u32x4 b = bv[m][bj];
                    const f32x4 b0 = {__builtin_bit_cast(float, b.x << 16), __builtin_bit_cast(float, b.x & 0xffff0000u), __builtin_bit_cast(float, b.y << 16), __builtin_bit_cast(float, b.y & 0xffff0000u)};
                    const f32x4 b1 = {__builtin_bit_cast(float, b.z << 16), __builtin_bit_cast(float, b.z & 0xffff0000u), __builtin_bit_cast(float, b.w << 16), __builtin_bit_cast(float, b.w & 0xffff0000u)};
                    const f32x4 v0 = b0 + acc[ai][bj][m][0] * alpha, v1 = b1 + acc[ai][bj][m][1] * alpha;
                    u32x4 w; w.x = cvt_pk_bf16(v0[0], v0[1]); w.y = cvt_pk_bf16(v0[2], v0[3]); w.z = cvt_pk_bf16(v1[0], v1[1]); w.w = cvt_pk_bf16(v1[2], v1[3]);
                    *(u32x4*)(XB + off + bj * HALF) = w;
                    const float r0 = __builtin_bit_cast(float, w.x << 16), r1 = __builtin_bit_cast(float, w.x & 0xffff0000u), r2 = __builtin_bit_cast(float, w.y << 16), r3 = __builtin_bit_cast(float, w.y & 0xffff0000u);
                    const float r4 = __builtin_bit_cast(float, w.z << 16), r5 = __builtin_bit_cast(float, w.z & 0xffff0000u), r6 = __builtin_bit_cast(float, w.w << 16), r7 = __builtin_bit_cast(float, w.w & 0xffff0000u);
                    s += (r0 * r0 + r1 * r1) + (r2 * r2 + r3 * r3) + (r4 * r4 + r5 * r5) + (r6 * r6 + r7 * r7);
                }
                s += __shfl_xor(s, 16); s += __shfl_xor(s, 32);
                if (fq == 0) SS[(size_t)row * 16 + u.pn * 4 + wc] = s;
            }
        }
    }
};
struct EpiResNoop {
    static constexpr bool PERM = true, AFTER_DRAIN = false;
    __device__ __forceinline__ void operator()(const f32x4 (&acc)[2][2][4][2], const Unit&, int, int, int, int) const {
#pragma unroll
        for (int ai = 0; ai < 2; ++ai)
#pragma unroll
            for (int bj = 0; bj < 2; ++bj)
                asm volatile("" :: "v"(acc[ai][bj][0][0]), "v"(acc[ai][bj][0][1]), "v"(acc[ai][bj][1][0]), "v"(acc[ai][bj][1][1]), "v"(acc[ai][bj][2][0]), "v"(acc[ai][bj][2][1]), "v"(acc[ai][bj][3][0]), "v"(acc[ai][bj][3][1]));
    }
};
struct EpiQKV {
    static constexpr bool PERM = true, AFTER_DRAIN = false;
    bf16_t* O; int ldc; const float* SS; int nq_tiles; float qscale; float* KMP; int k_lo, k_hi;
    __device__ __forceinline__ void operator()(const f32x4 (&acc)[2][2][4][2], const Unit& u, int wr, int wc, int fr, int fq) const {
        const int row0 = u.pm * BM + wr * 64 + fr, col0 = u.pn * BM + wc * 32 + 8 * fq;
        const float sc = (u.pn < nq_tiles) ? qscale : 1.0f;
        float r8[8]; row_rstd8(SS, row0, fq, r8);
#pragma unroll
        for (int ai = 0; ai < 2; ++ai)
#pragma unroll
            for (int m = 0; m < 4; ++m) {
                const int row = row0 + ai * HALF + m * 16;
                const float r = r8[ai * 4 + m] * sc;
                bf16_t* rowp = O + (size_t)row * ldc + col0;
#pragma unroll
                for (int bj = 0; bj < 2; ++bj) {
                    const f32x4 v0 = acc[ai][bj][m][0] * r, v1 = acc[ai][bj][m][1] * r;
                    u32x4 w; w.x = cvt_pk_bf16(v0[0], v0[1]); w.y = cvt_pk_bf16(v0[2], v0[3]); w.z = cvt_pk_bf16(v1[0], v1[1]); w.w = cvt_pk_bf16(v1[2], v1[3]);
                    *(u32x4*)(rowp + bj * HALF) = w;
                }
            }
        if (KMP != nullptr && u.pn >= k_lo && u.pn < k_hi) {
            float* dst = KMP + ((size_t)u.pm * 2 + wr) * 1024 + (u.pn - k_lo) * BM + wc * 32 + 8 * fq;
#pragma unroll
            for (int bj = 0; bj < 2; ++bj)
#pragma unroll
                for (int n = 0; n < 2; ++n) {
                    f32x4 cs = {0.f, 0.f, 0.f, 0.f};
#pragma unroll
                    for (int ai = 0; ai < 2; ++ai)
#pragma unroll
                        for (int m = 0; m < 4; ++m) cs += acc[ai][bj][m][n] * r8[ai * 4 + m];
#pragma unroll
                    for (int i = 0; i < 4; ++i) { float c = cs[i]; c += __shfl_xor(c, 1); c += __shfl_xor(c, 2); c += __shfl_xor(c, 4); c += __shfl_xor(c, 8); cs[i] = c; }
                    if (fr == 0) *(f32x4*)(dst + bj * HALF + 4 * n) = cs;
                }
        }
    }
};
#ifndef PG8_PRIO_MMA
#define PG8_PRIO_MMA 1
#define PG8_PRIO_LOAD 0
#endif
template <class E, class = void> struct kprobe_of { static constexpr int value = 0; };
template <class E> struct kprobe_of<E, decltype((void)E::KPROBE)> { static constexpr int value = E::KPROBE; };
template <class Epi, class Sched, bool ALIGN_EPI = false, bool SP2 = false, bool XDMA = false>
__device__ __forceinline__ void gemm_phase(PG8_LAS unsigned char* lds, const Gemm g, const Sched& S, const Epi& E) {
    int tid = threadIdx.x; asm volatile("" : "+v"(tid));
    const int wid = __builtin_amdgcn_readfirstlane(tid >> 6), lane = tid & 63, wr = wid >> 2, wc = wid & 3, fr = lane & 15, fq = lane >> 4;
    const int K = g.K, nt = K / BK;
    unsigned voffA[2], voffB[2];
#pragma unroll
    for (int i = 0; i < 2; ++i) { int R, C; stage_rc(tid * 16 + i * 8192, R, C); const int Rb = Epi::PERM ? ((R & ~31) + perm32(R & 31)) : R;
        voffA[i] = (unsigned)(R * K + C) * 2u; voffB[i] = (unsigned)(Rb * K + C) * 2u; }
    const size_t kstep = (size_t)(BK * 2);
    const size_t hstep = (size_t)HALF * K * 2;
    const size_t tstep = 2 * hstep;
    const unsigned ldsw = (unsigned)wid * 1024u;
    const int aoff = lds_byte(wr * 64 + fr, fq * 8), boff = lds_byte(wc * 32 + fr, fq * 8);
#define PG8_SA(b, h) (((b) * 2 + (h)) * HTB)
#define PG8_SB(b, h) ((4 + (b) * 2 + (h)) * HTB)
#define PG8_STAGE(bufoff, gbase, voff) do { if constexpr (kprobe_of<Epi>::value != 1) _Pragma("unroll") for (int _i = 0; _i < 2; ++_i) \
        __builtin_amdgcn_global_load_lds((const unsigned*)((const char*)(gbase) + (voff)[_i]), (PG8_LAS unsigned*)(lds + (bufoff) + ldsw + _i * 8192), 16, 0, 0); } while (0)
#define PG8_LDA(dst, b, h) do { if constexpr (kprobe_of<Epi>::value != 2) _Pragma("unroll") for (int m = 0; m < 4; ++m) _Pragma("unroll") for (int k = 0; k < 2; ++k) dst[m][k] = *(const PG8_LAS bf16x8*)(lds + PG8_SA(b, h) + aoff + m * 2048 + k * 1024); } while (0)
#define PG8_LDB(dst, b, h) do { if constexpr (kprobe_of<Epi>::value != 2) _Pragma("unroll") for (int n = 0; n < 2; ++n) _Pragma("unroll") for (int k = 0; k < 2; ++k) dst[n][k] = *(const PG8_LAS bf16x8*)(lds + PG8_SB(b, h) + boff + n * 2048 + k * 1024); } while (0)
#define PG8_MMA(ai, bj, At, Bt) do { __builtin_amdgcn_s_setprio(PG8_PRIO_MMA); _Pragma("unroll") for (int m = 0; m < 4; ++m) _Pragma("unroll") for (int n = 0; n < 2; ++n) _Pragma("unroll") for (int k = 0; k < 2; ++k) \
        acc[ai][bj][m][n] = __builtin_amdgcn_mfma_f32_16x16x32_bf16(Bt[n][k], At[m][k], acc[ai][bj][m][n], 0, 0, 0); __builtin_amdgcn_s_setprio(PG8_PRIO_LOAD); } while (0)
#define PG8_WAIT_V(n) asm volatile("s_waitcnt vmcnt(" #n ")" ::: "memory")
#define PG8_WAIT_L(n) asm volatile("s_waitcnt lgkmcnt(" #n ")" ::: "memory")
#define PG8_BAR __builtin_amdgcn_s_barrier()
#define PG8_SCHED __builtin_amdgcn_sched_barrier(0)
    Unit cur, nxt; int ui = 0;
    if (!S.next(0, cur)) return;
    f32x4 acc[2][2][4][2];
#pragma unroll
    for (int a = 0; a < 2; ++a)
#pragma unroll
        for (int b = 0; b < 2; ++b)
#pragma unroll
            for (int m = 0; m < 4; ++m)
#pragma unroll
                for (int n = 0; n < 2; ++n) acc[a][b][m][n] = (f32x4){0.f, 0.f, 0.f, 0.f};
    bf16x8 At[4][2], B0[2][2], B1[2][2];
    const char* cA = (const char*)g.A + (size_t)cur.pm * tstep; const char* cB = (const char*)g.Bt + (size_t)cur.pn * tstep;
    S.a_ready(cur);
    if constexpr (SP2) {
        PG8_STAGE(PG8_SB(0, 0), cB, voffB); PG8_STAGE(PG8_SB(0, 1), cB + hstep, voffB); PG8_STAGE(PG8_SA(0, 0), cA, voffA); PG8_STAGE(PG8_SA(0, 1), cA + hstep, voffA);
        if (wr == 1) PG8_BAR;
        PG8_WAIT_V(2); PG8_BAR;
        PG8_STAGE(PG8_SB(1, 0), cB + kstep, voffB); PG8_STAGE(PG8_SA(1, 0), cA + kstep, voffA); PG8_STAGE(PG8_SB(1, 1), cB + hstep + kstep, voffB);
        PG8_WAIT_V(6); PG8_BAR;
    } else {
        PG8_STAGE(PG8_SB(0, 0), cB, voffB); PG8_STAGE(PG8_SA(0, 0), cA, voffA); PG8_STAGE(PG8_SB(0, 1), cB + hstep, voffB); PG8_STAGE(PG8_SA(0, 1), cA + hstep, voffA);
        if (wr == 1) PG8_BAR;
        PG8_WAIT_V(4); PG8_BAR;
        PG8_STAGE(PG8_SB(1, 0), cB + kstep, voffB); PG8_STAGE(PG8_SA(1, 0), cA + kstep, voffA); PG8_STAGE(PG8_SB(1, 1), cB + hstep + kstep, voffB);
        PG8_WAIT_V(6); PG8_BAR;
    }
    for (;;) {
        const bool has_next = S.next(ui + 1, nxt);
        const char* nA = has_next ? (const char*)g.A + (size_t)nxt.pm * tstep : cA; const char* nB = has_next ? (const char*)g.Bt + (size_t)nxt.pn * tstep : cB;
        for (int t = 0; t < nt; t += 2) {
            const bool last = (t == nt - 2);
            const char* a1 = cA + (size_t)(t + 1) * kstep;
            const char* a2 = last ? nA : cA + (size_t)(t + 2) * kstep; const char* b2 = last ? nB : cB + (size_t)(t + 2) * kstep;
            const char* a3 = a2 + kstep; const char* b3 = b2 + kstep;
            if (last && has_next) S.a_ready(nxt);
            if constexpr (SP2) {
            if constexpr (XDMA) {
            PG8_LDB(B0, 0, 0); PG8_LDB(B1, 0, 1); PG8_SCHED; PG8_LDA(At, 0, 0);
            PG8_WAIT_V(6); PG8_WAIT_L(0); PG8_BAR; PG8_MMA(0, 0, At, B0); PG8_STAGE(PG8_SA(1, 1), a1 + hstep, voffA); PG8_MMA(0, 1, At, B1); PG8_BAR; PG8_SCHED;
            PG8_LDA(At, 0, 1);
            PG8_WAIT_V(2); PG8_WAIT_L(0); PG8_BAR; PG8_MMA(1, 0, At, B0); PG8_STAGE(PG8_SB(0, 0), b2, voffB); PG8_STAGE(PG8_SB(0, 1), b2 + hstep, voffB); PG8_STAGE(PG8_SA(0, 0), a2, voffA); PG8_MMA(1, 1, At, B1); PG8_BAR; PG8_SCHED;
            PG8_LDB(B0, 1, 0); PG8_LDB(B1, 1, 1); PG8_SCHED; PG8_LDA(At, 1, 0);
            PG8_WAIT_V(6); PG8_WAIT_L(0); PG8_BAR; PG8_MMA(0, 0, At, B0); PG8_STAGE(PG8_SA(0, 1), a2 + hstep, voffA); PG8_MMA(0, 1, At, B1); PG8_BAR; PG8_SCHED;
            PG8_LDA(At, 1, 1);
            PG8_WAIT_V(2); PG8_WAIT_L(0); PG8_BAR; PG8_MMA(1, 0, At, B0); PG8_STAGE(PG8_SB(1, 0), b3, voffB); PG8_STAGE(PG8_SB(1, 1), b3 + hstep, voffB); PG8_STAGE(PG8_SA(1, 0), a3, voffA); PG8_MMA(1, 1, At, B1); PG8_BAR; PG8_SCHED;
            } else {
            PG8_LDB(B0, 0, 0); PG8_LDB(B1, 0, 1); PG8_SCHED; PG8_LDA(At, 0, 0); PG8_STAGE(PG8_SA(1, 1), a1 + hstep, voffA);
            PG8_WAIT_V(8); PG8_WAIT_L(0); PG8_BAR; PG8_MMA(0, 0, At, B0); PG8_MMA(0, 1, At, B1); PG8_BAR; PG8_SCHED;
            PG8_LDA(At, 0, 1); PG8_STAGE(PG8_SB(0, 0), b2, voffB); PG8_STAGE(PG8_SB(0, 1), b2 + hstep, voffB); PG8_STAGE(PG8_SA(0, 0), a2, voffA);
            PG8_WAIT_V(8); PG8_WAIT_L(0); PG8_BAR; PG8_MMA(1, 0, At, B0); PG8_MMA(1, 1, At, B1); PG8_BAR; PG8_SCHED;
            PG8_LDB(B0, 1, 0); PG8_LDB(B1, 1, 1); PG8_SCHED; PG8_LDA(At, 1, 0); PG8_STAGE(PG8_SA(0, 1), a2 + hstep, voffA);
            PG8_WAIT_V(8); PG8_WAIT_L(0); PG8_BAR; PG8_MMA(0, 0, At, B0); PG8_MMA(0, 1, At, B1); PG8_BAR; PG8_SCHED;
            PG8_LDA(At, 1, 1); PG8_STAGE(PG8_SB(1, 0), b3, voffB); PG8_STAGE(PG8_SB(1, 1), b3 + hstep, voffB); PG8_STAGE(PG8_SA(1, 0), a3, voffA);
            PG8_WAIT_V(8); PG8_WAIT_L(0); PG8_BAR; PG8_MMA(1, 0, At, B0); PG8_MMA(1, 1, At, B1); PG8_BAR; PG8_SCHED;
            }
            } else {
            PG8_LDB(B0, 0, 0); PG8_SCHED; PG8_LDA(At, 0, 0); PG8_STAGE(PG8_SA(1, 1), a1 + hstep, voffA);
            PG8_WAIT_L(8); PG8_BAR; PG8_WAIT_L(0); PG8_MMA(0, 0, At, B0); PG8_BAR; PG8_SCHED;
            PG8_LDB(B1, 0, 1); PG8_STAGE(PG8_SB(0, 0), b2, voffB);
            PG8_BAR; PG8_WAIT_L(0); PG8_MMA(0, 1, At, B1); PG8_BAR;
            PG8_LDA(At, 0, 1); PG8_STAGE(PG8_SA(0, 0), a2, voffA);
            PG8_BAR; PG8_WAIT_L(0); PG8_MMA(1, 0, At, B0); PG8_BAR; PG8_SCHED;
            PG8_STAGE(PG8_SB(0, 1), b2 + hstep, voffB);
            PG8_WAIT_V(6); PG8_BAR; PG8_MMA(1, 1, At, B1); PG8_BAR;
            PG8_LDB(B0, 1, 0); PG8_SCHED; PG8_LDA(At, 1, 0); PG8_STAGE(PG8_SA(0, 1), a2 + hstep, voffA);
            PG8_WAIT_L(8); PG8_BAR; PG8_WAIT_L(0); PG8_MMA(0, 0, At, B0); PG8_BAR; PG8_SCHED;
            PG8_LDB(B1, 1, 1); PG8_STAGE(PG8_SB(1, 0), b3, voffB);
            PG8_BAR; PG8_WAIT_L(0); PG8_MMA(0, 1, At, B1); PG8_BAR;
            PG8_LDA(At, 1, 1); PG8_STAGE(PG8_SA(1, 0), a3, voffA);
            PG8_BAR; PG8_WAIT_L(0); PG8_MMA(1, 0, At, B0); PG8_BAR; PG8_SCHED;
            PG8_STAGE(PG8_SB(1, 1), b3 + hstep, voffB);
            PG8_WAIT_V(6); PG8_BAR; PG8_MMA(1, 1, At, B1); PG8_BAR;
            }
        }
        if constexpr (ALIGN_EPI) { if (wr == 0) PG8_BAR; }
        if constexpr (!Epi::AFTER_DRAIN) { E(acc, cur, wr, wc, fr, fq); S.done(cur); }
        if (!has_next) break;
#pragma unroll
        for (int a = 0; a < 2; ++a)
#pragma unroll
            for (int b = 0; b < 2; ++b)
#pragma unroll
                for (int m = 0; m < 4; ++m)
#pragma unroll
                    for (int n = 0; n < 2; ++n) acc[a][b][m][n] = (f32x4){0.f, 0.f, 0.f, 0.f};
        cur = nxt; cA = nA; cB = nB; ++ui;
        if constexpr (ALIGN_EPI) { if (wr == 1) PG8_BAR; }
    }
    PG8_WAIT_V(0);
    if constexpr (!ALIGN_EPI) { if (wr == 0) PG8_BAR; }
    PG8_BAR;
    if constexpr (Epi::AFTER_DRAIN) { E.fused(acc, cur, wr, wc, fr, fq, lds, wid, lane); S.done(cur); }
#undef PG8_SA
#undef PG8_SB
#undef PG8_STAGE
#undef PG8_LDA
#undef PG8_LDB
#undef PG8_MMA
#undef PG8_WAIT_V
#undef PG8_WAIT_L
#undef PG8_BAR
#undef PG8_SCHED
}
}
namespace pg8 {
constexpr int HM_STAGE_BYTES = 9 * HTB;
template <class Epi>
__device__ __forceinline__ void gemm_half_unit(PG8_LAS unsigned char* lds, const Gemm g, const HUnit hu, const Epi& E) {
    int tid = threadIdx.x; asm volatile("" : "+v"(tid));
    const int wid = __builtin_amdgcn_readfirstlane(tid >> 6), lane = tid & 63, wr = wid >> 2, wc = wid & 3, fr = lane & 15, fq = lane >> 4;
    const int K = g.K, nt = K / BK;
    unsigned voffA[2], voffB[2];
#pragma unroll
    for (int i = 0; i < 2; ++i) { int R, C; stage_rc(tid * 16 + i * 8192, R, C); const int Rb = Epi::PERM ? ((R & ~31) + perm32(R & 31)) : R;
        voffA[i] = (unsigned)(R * K + C) * 2u; voffB[i] = (unsigned)(Rb * K + C) * 2u; }
    const size_t kstep = (size_t)(BK * 2);
    const size_t hstep = (size_t)HALF * K * 2;
    const unsigned ldsw = (unsigned)wid * 1024u;
    const int aoff = lds_byte(wr * 64 + fr, fq * 8), boff = lds_byte(wc * 32 + fr, fq * 8);
#define HM_SA(b) ((b) * 3 * HTB)
#define HM_SB(b, h) (((b) * 3 + 1 + (h)) * HTB)
#define HM_STAGE(bufoff, gbase, voff) do { _Pragma("unroll") for (int _i = 0; _i < 2; ++_i) \
        __builtin_amdgcn_global_load_lds((const unsigned*)((const char*)(gbase) + (voff)[_i]), (PG8_LAS unsigned*)(lds + (bufoff) + ldsw + _i * 8192), 16, 0, 0); } while (0)
#define HM_LDA(dst, b) do { _Pragma("unroll") for (int m = 0; m < 4; ++m) _Pragma("unroll") for (int k = 0; k < 2; ++k) dst[m][k] = *(const PG8_LAS bf16x8*)(lds + HM_SA(b) + aoff + m * 2048 + k * 1024); } while (0)
#define HM_LDB(dst, b, h) do { _Pragma("unroll") for (int n = 0; n < 2; ++n) _Pragma("unroll") for (int k = 0; k < 2; ++k) dst[n][k] = *(const PG8_LAS bf16x8*)(lds + HM_SB(b, h) + boff + n * 2048 + k * 1024); } while (0)
#define HM_MMA(bj, At, Bt) do { __builtin_amdgcn_s_setprio(PG8_PRIO_MMA); _Pragma("unroll") for (int m = 0; m < 4; ++m) _Pragma("unroll") for (int n = 0; n < 2; ++n) _Pragma("unroll") for (int k = 0; k < 2; ++k) \
        acc[bj][m][n] = __builtin_amdgcn_mfma_f32_16x16x32_bf16(Bt[n][k], At[m][k], acc[bj][m][n], 0, 0, 0); __builtin_amdgcn_s_setprio(PG8_PRIO_LOAD); } while (0)
#define HM_WAIT_V(n) asm volatile("s_waitcnt vmcnt(" #n ")" ::: "memory")
#define HM_WAIT_L(n) asm volatile("s_waitcnt lgkmcnt(" #n ")" ::: "memory")
#define HM_BAR __builtin_amdgcn_s_barrier()
#define HM_SCHED __builtin_amdgcn_sched_barrier(0)
    f32x4 acc[2][4][2];
#pragma unroll
    for (int b = 0; b < 2; ++b)
#pragma unroll
        for (int m = 0; m < 4; ++m)
#pragma unroll
            for (int n = 0; n < 2; ++n) acc[b][m][n] = (f32x4){0.f, 0.f, 0.f, 0.f};
    bf16x8 At[4][2], B0[2][2], B1[2][2];
    const char* cA = (const char*)g.A + (size_t)hu.pm2 * hstep; const char* cB = (const char*)g.Bt + (size_t)hu.pn * 2 * hstep;
    HM_STAGE(HM_SB(0, 0), cB, voffB); HM_STAGE(HM_SB(0, 1), cB + hstep, voffB); HM_STAGE(HM_SA(0), cA, voffA);
    HM_STAGE(HM_SB(1, 0), cB + kstep, voffB); HM_STAGE(HM_SB(1, 1), cB + hstep + kstep, voffB); HM_STAGE(HM_SA(1), cA + kstep, voffA);
    if (wr == 1) HM_BAR;
    HM_WAIT_V(6); HM_BAR; HM_BAR;
#define HM_SP(b, bn2, s) do { \
        HM_LDB(B0, b, 0); HM_LDB(B1, b, 1); HM_SCHED; HM_LDA(At, b); \
        if ((s) + 2 < nt) { const char* a2 = cA + (size_t)((s) + 2) * kstep; const char* b2 = cB + (size_t)((s) + 2) * kstep; \
            HM_STAGE(HM_SB(bn2, 0), b2, voffB); HM_STAGE(HM_SB(bn2, 1), b2 + hstep, voffB); HM_STAGE(HM_SA(bn2), a2, voffA); HM_WAIT_V(6); } \
        else { HM_WAIT_V(0); } \
        HM_WAIT_L(0); HM_BAR; HM_MMA(0, At, B0); HM_MMA(1, At, B1); HM_BAR; HM_SCHED; } while (0)
    for (int s = 0; s < nt; s += 3) {
        HM_SP(0, 2, s);
        if (s + 1 < nt) HM_SP(1, 0, s + 1);
        if (s + 2 < nt) HM_SP(2, 1, s + 2);
    }
    if (wr == 0) HM_BAR;
    E.half(acc, hu, wr, wc, fr, fq);
#undef HM_SA
#undef HM_SB
#undef HM_STAGE
#undef HM_LDA
#undef HM_LDB
#undef HM_MMA
#undef HM_WAIT_V
#undef HM_WAIT_L
#undef HM_BAR
#undef HM_SCHED
#undef HM_SP
}
}
namespace att {
typedef short bf16x8 __attribute__((ext_vector_type(8)));
typedef short s16x4 __attribute__((ext_vector_type(4)));
typedef float f32x16 __attribute__((ext_vector_type(16)));
typedef float f32x4 __attribute__((ext_vector_type(4)));
typedef unsigned u32x4 __attribute__((ext_vector_type(4)));
typedef int int4v __attribute__((ext_vector_type(4)));
typedef unsigned short bf16_t;
constexpr int SEQ = 2048, OPITCH = 1024;
constexpr int SLOTB = 8192, NSLOT = 4;
constexpr int LDS_K = 0, LDS_V = NSLOT * SLOTB, LDS_WS = 2 * NSLOT * SLOTB, LDS_OST = LDS_WS + 8 * 256, LDS_KMT = LDS_OST + 8 * 4096, LDS_END = LDS_KMT + 8 * 64 * 4;
typedef LAS const char* lds_cptr;
#define ATT_SBAR() __builtin_amdgcn_sched_barrier(0)
#define ATT_WAIT_BAR(N) asm volatile("s_waitcnt vmcnt(" #N ") lgkmcnt(0)\n\ts_barrier" ::: "memory")
__device__ __forceinline__ int crow(int r, int hi) { return (r & 3) + 8 * (r >> 2) + 4 * hi; }
__device__ __forceinline__ void glds16(const void* gsrc, unsigned lds_dst) { unsigned keep;
    asm volatile("s_mov_b32 %0, m0\n\ts_mov_b32 m0, %2\n\ts_nop 0\n\tglobal_load_lds_dwordx4 %1, off\n\ts_mov_b32 m0, %0" : "=&s"(keep) : "v"(gsrc), "s"(lds_dst) : "memory"); }
typedef float f32x2_t __attribute__((ext_vector_type(2))); typedef __bf16 bf16x2_t __attribute__((ext_vector_type(2)));
__device__ __forceinline__ unsigned cvtpk(float lo, float hi) { f32x2_t v = {lo, hi}; bf16x2_t b = __builtin_convertvector(v, bf16x2_t); return __builtin_bit_cast(unsigned, b); }
__device__ __forceinline__ float bf2f(short s) { return __builtin_bit_cast(float, (unsigned)(unsigned short)s << 16); }
__device__ __forceinline__ float partner(float x, int hi) {
    auto rr = __builtin_amdgcn_permlane32_swap(__builtin_bit_cast(unsigned, x), __builtin_bit_cast(unsigned, x), false, false);
    return __builtin_bit_cast(float, hi ? rr[0] : rr[1]);
}
typedef short v4i16_t __attribute__((ext_vector_type(4)));
__device__ __forceinline__ s16x4 vtr(lds_cptr p) { return __builtin_bit_cast(s16x4, __builtin_amdgcn_ds_read_tr16_b64_v4i16((LAS v4i16_t*)p)); }
__device__ __forceinline__ void vload16(s16x4* vlo, s16x4* vhi, lds_cptr vp) {
#pragma unroll
    for (int i = 0; i < 8; ++i) { vlo[i] = vtr(vp + ((i >> 2) * 4096 + (i & 3) * 1024)); vhi[i] = vtr(vp + ((i >> 2) * 4096 + (i & 3) * 1024 + 512)); }
}
__device__ __forceinline__ void pv_r(f32x16* o, const s16x4* vlo, const s16x4* vhi, bf16x8 pa0, bf16x8 pa1, bf16x8 pa2, bf16x8 pa3) {
#define ATT_VF(i) (bf16x8){vlo[i][0], vlo[i][1], vlo[i][2], vlo[i][3], vhi[i][0], vhi[i][1], vhi[i][2], vhi[i][3]}
    o[0] = __builtin_amdgcn_mfma_f32_32x32x16_bf16(pa0, ATT_VF(0), o[0], 0, 0, 0); o[1] = __builtin_amdgcn_mfma_f32_32x32x16_bf16(pa0, ATT_VF(4), o[1], 0, 0, 0);
    o[0] = __builtin_amdgcn_mfma_f32_32x32x16_bf16(pa1, ATT_VF(1), o[0], 0, 0, 0); o[1] = __builtin_amdgcn_mfma_f32_32x32x16_bf16(pa1, ATT_VF(5), o[1], 0, 0, 0);
    o[0] = __builtin_amdgcn_mfma_f32_32x32x16_bf16(pa2, ATT_VF(2), o[0], 0, 0, 0); o[1] = __builtin_amdgcn_mfma_f32_32x32x16_bf16(pa2, ATT_VF(6), o[1], 0, 0, 0);
    o[0] = __builtin_amdgcn_mfma_f32_32x32x16_bf16(pa3, ATT_VF(3), o[0], 0, 0, 0); o[1] = __builtin_amdgcn_mfma_f32_32x32x16_bf16(pa3, ATT_VF(7), o[1], 0, 0, 0);
#undef ATT_VF
}
__device__ __forceinline__ void qkt(f32x16& p0, f32x16& p1, lds_cptr kb, const bf16x8* qr) {
    const f32x16 z = {};
#pragma unroll
    for (int d0 = 0; d0 < 4; ++d0) {
        const bf16x8 b0 = *(const LAS bf16x8*)(kb + d0 * 2048);
        const bf16x8 b1 = *(const LAS bf16x8*)(kb + d0 * 2048 + 512);
        if (d0 == 0) { p0 = __builtin_amdgcn_mfma_f32_32x32x16_bf16(b0, qr[0], z, 0, 0, 0); p1 = __builtin_amdgcn_mfma_f32_32x32x16_bf16(b1, qr[0], z, 0, 0, 0); }
        else { p0 = __builtin_amdgcn_mfma_f32_32x32x16_bf16(b0, qr[d0], p0, 0, 0, 0); p1 = __builtin_amdgcn_mfma_f32_32x32x16_bf16(b1, qr[d0], p1, 0, 0, 0); }
    }
}
__device__ __forceinline__ void qkt_aug(f32x16& p0, f32x16& p1, lds_cptr kb, const bf16x8* qr, const f32x16& c, bf16x8 kaug0, bf16x8 kaug1, bf16x8 qaug) {
    p0 = __builtin_amdgcn_mfma_f32_32x32x16_bf16(kaug0, qaug, c, 0, 0, 0); p1 = __builtin_amdgcn_mfma_f32_32x32x16_bf16(kaug1, qaug, c, 0, 0, 0);
#pragma unroll
    for (int d0 = 0; d0 < 4; ++d0) {
        const bf16x8 b0 = *(const LAS bf16x8*)(kb + d0 * 2048);
        const bf16x8 b1 = *(const LAS bf16x8*)(kb + d0 * 2048 + 512);
        p0 = __builtin_amdgcn_mfma_f32_32x32x16_bf16(b0, qr[d0], p0, 0, 0, 0); p1 = __builtin_amdgcn_mfma_f32_32x32x16_bf16(b1, qr[d0], p1, 0, 0, 0);
    }
}
__device__ __forceinline__ void pv(f32x16* o, int vb, bf16x8 pa0, bf16x8 pa1, bf16x8 pa2, bf16x8 pa3) {
#pragma unroll
    for (int d0 = 0; d0 < 2; ++d0) { s16x4 lo[4], hi[4];
#pragma unroll
        for (int ks = 0; ks < 4; ++ks) {
            asm volatile("ds_read_b64_tr_b16 %0,%1 offset:%c2" : "=&v"(lo[ks]) : "v"(vb), "i"(d0 * 4096 + ks * 1024) : "memory");
            asm volatile("ds_read_b64_tr_b16 %0,%1 offset:%c2" : "=&v"(hi[ks]) : "v"(vb), "i"(d0 * 4096 + ks * 1024 + 512) : "memory"); }
        asm volatile("s_waitcnt lgkmcnt(0)" ::: "memory"); ATT_SBAR();
#define ATT_PK(k) (bf16x8){lo[k][0], lo[k][1], lo[k][2], lo[k][3], hi[k][0], hi[k][1], hi[k][2], hi[k][3]}
        o[d0] = __builtin_amdgcn_mfma_f32_32x32x16_bf16(pa0, ATT_PK(0), o[d0], 0, 0, 0);
        o[d0] = __builtin_amdgcn_mfma_f32_32x32x16_bf16(pa1, ATT_PK(1), o[d0], 0, 0, 0);
        o[d0] = __builtin_amdgcn_mfma_f32_32x32x16_bf16(pa2, ATT_PK(2), o[d0], 0, 0, 0);
        o[d0] = __builtin_amdgcn_mfma_f32_32x32x16_bf16(pa3, ATT_PK(3), o[d0], 0, 0, 0);
#undef ATT_PK
    }
}
template <bool MOBA>
__device__ __forceinline__ void attn_unit(const int b, const int h, const int qb, const bf16_t* __restrict__ QKV, const int pitch, const int koff, const int voff,
                                          bf16_t* __restrict__ O, LAS unsigned char* lds, const float* __restrict__ KMP, const float sl2, const unsigned force_sel = 0u) {
    int tid = threadIdx.x; asm volatile("" : "+v"(tid));
    const int lane = tid & 63, r32 = lane & 31, hi = lane >> 5;
    const int wid = __builtin_amdgcn_readfirstlane(tid >> 6);
    const long rowbase = (long)b * SEQ; const int q0 = qb * 256;
    const bf16_t* Qw = QKV + (rowbase + q0 + wid * 32) * pitch + h * 64;
    const bf16_t* Kh = QKV + rowbase * pitch + koff + h * 64;
    const bf16_t* Vh = QKV + rowbase * pitch + voff + h * 64;
    const unsigned lds0 = (unsigned)(uintptr_t)lds;
    const bf16_t* ksrc = Kh + (long)lane * pitch + wid * 8;
    const bf16_t* vsrc = Vh + (long)(16 * (wid & 3) + (lane >> 2)) * pitch + (wid >> 2) * 32 + (lane & 3) * 8;
    const unsigned kdst = lds0 + LDS_K + wid * 1024, vdst = lds0 + LDS_V + wid * 1024;
#define ATT_DMA_KV(t, slot) do { glds16(ksrc + (long)(t) * 64 * pitch, (unsigned)__builtin_amdgcn_readfirstlane(kdst + (slot))); \
                                 glds16(vsrc + (long)(t) * 64 * pitch, (unsigned)__builtin_amdgcn_readfirstlane(vdst + (slot))); } while (0)
    const int NT = 4 * qb + 4;
    const int tdiag = 4 * qb + (wid >> 1);
    LAS float* wsf = (LAS float*)(lds + LDS_WS) + wid * 64;
    const lds_cptr kp0 = (lds_cptr)lds + LDS_K + hi * 1024 + r32 * 16;
    const int vb0 = (int)(lds0 + LDS_V) + ((lane >> 4) & 1) * 32 + (lane & 3) * 8 + (4 * hi + ((lane & 15) >> 2)) * 64;
    ATT_DMA_KV(NT - 1, 0); ATT_DMA_KV(NT - 2, SLOTB);
    bf16x8 qr[4];
#pragma unroll
    for (int d0 = 0; d0 < 4; ++d0) qr[d0] = *(const bf16x8*)(Qw + (long)r32 * pitch + d0 * 16 + hi * 8);
    f32x16 o[2]; o[0] = f32x16{}; o[1] = f32x16{};
    const int qrel = wid * 32 + r32;
    float carry = 1.0f;
    float mhat = 0.f, lrow = 0.f; unsigned selmask = 0u;
    bf16x8 kaug0 = {0, 0, 0, 0, 0, 0, 0, 0}, kaug1 = {0, 0, 0, 0, 0, 0, 0, 0}, qaug = {0, 0, 0, 0, 0, 0, 0, 0};
    if constexpr (MOBA) {
        LAS float* kmt = (LAS float*)(lds + LDS_KMT);
        { const int n = tid >> 6, d = tid & 63;
          if (n < qb) { const float* kp = KMP + ((size_t)(b * 8 + n) * 2) * 1024 + h * 64 + d; kmt[n * 64 + d] = (kp[0] + kp[1024]) * (1.0f / 256.0f); } }
        asm volatile("s_waitcnt lgkmcnt(0)\n\ts_barrier" ::: "memory");
        float gate[7];
#pragma unroll
        for (int n = 0; n < 7; ++n) {
            float g = -INFINITY;
            if (n < qb) {
                float s = 0.f;
#pragma unroll
                for (int d0 = 0; d0 < 4; ++d0) {
                    const f32x4 k0 = *(const LAS f32x4*)(kmt + n * 64 + d0 * 16 + hi * 8), k1 = *(const LAS f32x4*)(kmt + n * 64 + d0 * 16 + hi * 8 + 4);
                    s += bf2f(qr[d0][0]) * k0[0] + bf2f(qr[d0][1]) * k0[1] + bf2f(qr[d0][2]) * k0[2] + bf2f(qr[d0][3]) * k0[3]
                       + bf2f(qr[d0][4]) * k1[0] + bf2f(qr[d0][5]) * k1[1] + bf2f(qr[d0][6]) * k1[2] + bf2f(qr[d0][7]) * k1[3];
                }
                g = s + partner(s, hi);
            }
            gate[n] = g;
        }
#pragma unroll
        for (int r = 0; r < 3; ++r) {
            int best = -1; float bv = -INFINITY;
#pragma unroll
            for (int n = 0; n < 7; ++n) { const bool taken = (selmask >> n) & 1u; if (!taken && gate[n] > bv) { best = n; bv = gate[n]; } }
            if (best >= 0) selmask |= 1u << best;
        }
        selmask |= (1u << qb) | force_sel;
        mhat = sl2 * (float)qrel;
        if (hi == 0) {
            const unsigned sh = __builtin_bit_cast(unsigned, sl2) + 0x7fffu + ((__builtin_bit_cast(unsigned, sl2) >> 16) & 1u), shb = sh >> 16;
            const float rem = sl2 - __builtin_bit_cast(float, shb << 16); const unsigned sl = (__builtin_bit_cast(unsigned, rem) + 0x7fffu + ((__builtin_bit_cast(unsigned, rem) >> 16) & 1u)) >> 16;
            qaug[0] = (short)shb; qaug[1] = (short)sl;
            const short k0s = (short)(__builtin_bit_cast(unsigned, (float)r32) >> 16), k1s = (short)(__builtin_bit_cast(unsigned, (float)(32 + r32)) >> 16);
            kaug0[0] = k0s; kaug0[1] = k0s; kaug1[0] = k1s; kaug1[1] = k1s;
        }
    }
    LAS int* done = (LAS int*)(lds + LDS_KMT);
    bool wdone = false;
    if constexpr (!MOBA) { if (lane == 0) done[wid] = 0x7fffffff; }
    const lds_cptr vp0 = (lds_cptr)lds + LDS_V + ((lane >> 4) & 1) * 32 + (lane & 3) * 8 + (4 * hi + ((lane & 15) >> 2)) * 64;
    int slot = 0;
    for (int i = 0; i < NT; ++i) {
        const int t = NT - 1 - i;
        const int nslot = (slot == (NSLOT - 1) * SLOTB) ? 0 : slot + SLOTB;
        const int n2slot = (nslot == (NSLOT - 1) * SLOTB) ? 0 : nslot + SLOTB;
        if (i + 2 < NT) { ATT_DMA_KV(t - 2, n2slot); ATT_WAIT_BAR(4); } else if (i + 1 < NT) { ATT_WAIT_BAR(2); } else { ATT_WAIT_BAR(0); }
        if constexpr (!MOBA) {
            const int4v d0v = *(const LAS int4v*)(done), d1v = *(const LAS int4v*)(done + 4);
            int dm = max(max(max(d0v[0], d0v[1]), max(d0v[2], d0v[3])), max(max(d1v[0], d1v[1]), max(d1v[2], d1v[3])));
            dm = __builtin_amdgcn_readfirstlane(dm);
            if (dm < i) break;
        }
        if (t <= tdiag && !wdone) {
            f32x16 p0, p1;
            u32x4 pw0 = {0u, 0u, 0u, 0u}, pw1 = pw0, pw2 = pw0, pw3 = pw0; bool dead = false;
            if constexpr (!MOBA) {
                qkt(p0, p1, kp0 + slot, qr);
                s16x4 vlo[8], vhi[8]; vload16(vlo, vhi, vp0 + slot);
                float om[32];
#pragma unroll
                for (int r = 0; r < 16; r += 2) {
                    f32x2_t e0 = {__builtin_amdgcn_exp2f(p0[r]), __builtin_amdgcn_exp2f(p0[r + 1])}, e1 = {__builtin_amdgcn_exp2f(p1[r]), __builtin_amdgcn_exp2f(p1[r + 1])};
                    const f32x2_t one2 = {1.0f, 1.0f}; e0 = e0 + one2; e1 = e1 + one2;
                    om[r] = __builtin_amdgcn_rcpf(e0.x); om[r + 1] = __builtin_amdgcn_rcpf(e0.y); om[16 + r] = __builtin_amdgcn_rcpf(e1.x); om[16 + r + 1] = __builtin_amdgcn_rcpf(e1.y);
                }
                if (t == tdiag) {
                    const int kb = 64 * (t - 4 * qb) + 4 * hi;
#pragma unroll
                    for (int r = 0; r < 16; ++r) { const int kv = kb + (r & 3) + 8 * (r >> 2);
                        if (kv >= qrel) om[r] = 1.0f; if (kv + 32 >= qrel) om[16 + r] = 1.0f; }
                }
                float xin0[8], xin1[8], xin2[8], gp[8], OS[9];
#pragma unroll
                for (int j = 0; j < 8; ++j) { xin2[j] = om[4 * j + 3]; xin1[j] = xin2[j] * om[4 * j + 2]; xin0[j] = xin1[j] * om[4 * j + 1]; gp[j] = xin0[j] * om[4 * j]; }
                OS[8] = 1.0f;
#pragma unroll
                for (int j = 7; j >= 0; --j) OS[j] = gp[j] * OS[j + 1];
                float oth[8];
#pragma unroll
                for (int j = 0; j < 8; ++j) {
                    auto rr = __builtin_amdgcn_permlane32_swap(__builtin_bit_cast(unsigned, OS[j]), __builtin_bit_cast(unsigned, OS[j + 1]), false, false);
                    oth[j] = __builtin_bit_cast(float, hi ? rr[0] : rr[1]);
                }
                float tot = OS[0] * oth[0];
                { auto rr = __builtin_amdgcn_permlane32_swap(__builtin_bit_cast(unsigned, tot), __builtin_bit_cast(unsigned, tot), false, false); tot = hi ? __builtin_bit_cast(float, rr[0]) : tot; }
                float av[32];
#pragma unroll
                for (int j = 0; j < 8; ++j) { const float xc = carry * (OS[j + 1] * oth[j]); const f32x2_t xc2 = {xc, xc};
                    const f32x2_t dlo = {xin0[j] - gp[j], xin1[j] - xin0[j]}, dhi = {xin2[j] - xin1[j], 1.0f - xin2[j]};
                    const f32x2_t alo = dlo * xc2, ahi = dhi * xc2;
                    av[4 * j] = alo.x; av[4 * j + 1] = alo.y; av[4 * j + 2] = ahi.x; av[4 * j + 3] = ahi.y; }
                carry *= tot;
                if (__all(carry == 0.0f)) { wdone = true; if (lane == 0) done[wid] = i; }
                pw0 = (u32x4){cvtpk(av[0], av[1]), cvtpk(av[2], av[3]), cvtpk(av[4], av[5]), cvtpk(av[6], av[7])};
                pw1 = (u32x4){cvtpk(av[8], av[9]), cvtpk(av[10], av[11]), cvtpk(av[12], av[13]), cvtpk(av[14], av[15])};
                pw2 = (u32x4){cvtpk(av[16], av[17]), cvtpk(av[18], av[19]), cvtpk(av[20], av[21]), cvtpk(av[22], av[23])};
                pw3 = (u32x4){cvtpk(av[24], av[25]), cvtpk(av[26], av[27]), cvtpk(av[28], av[29]), cvtpk(av[30], av[31])};
                pv_r(o, vlo, vhi, __builtin_bit_cast(bf16x8, pw0), __builtin_bit_cast(bf16x8, pw1), __builtin_bit_cast(bf16x8, pw2), __builtin_bit_cast(bf16x8, pw3));
            } else {
                const int blk = t >> 2;
                const bool sel = (selmask >> blk) & 1u;
                const float nv = sel ? (sl2 * (float)(64 * t - q0) - mhat) : -INFINITY;
                f32x16 c;
#pragma unroll
                for (int r = 0; r < 16; ++r) c[r] = nv;
                qkt_aug(p0, p1, kp0 + slot, qr, c, kaug0, kaug1, qaug);
                s16x4 vlo[8], vhi[8]; vload16(vlo, vhi, vp0 + slot);
                if (t == tdiag) {
                    const int kb = 64 * (t - 4 * qb) + 4 * hi;
#pragma unroll
                    for (int r = 0; r < 16; ++r) { const int kv = kb + (r & 3) + 8 * (r >> 2);
                        if (kv > qrel) p0[r] = -INFINITY; if (kv + 32 > qrel) p1[r] = -INFINITY; }
                }
                float a0 = __builtin_fmaxf(__builtin_fmaxf(p0[0], p0[1]), p0[2]), a1 = __builtin_fmaxf(__builtin_fmaxf(p1[0], p1[1]), p1[2]);
#pragma unroll
                for (int r = 3; r < 15; r += 2) { a0 = __builtin_fmaxf(__builtin_fmaxf(a0, p0[r]), p0[r + 1]); a1 = __builtin_fmaxf(__builtin_fmaxf(a1, p1[r]), p1[r + 1]); }
                float rm = __builtin_fmaxf(__builtin_fmaxf(a0, p0[15]), __builtin_fmaxf(a1, p1[15]));
                rm = __builtin_fmaxf(rm, partner(rm, hi));
                dead = __all(rm < -160.0f);
                if (!dead && __any(rm > 8.0f)) {
                    const float dl = __builtin_fmaxf(rm, 0.f);
                    mhat += dl;
#pragma unroll
                    for (int r = 0; r < 16; ++r) { p0[r] -= dl; p1[r] -= dl; }
                    const float f = __builtin_amdgcn_exp2f(-dl);
                    lrow *= f;
                    if (hi == 0) wsf[r32] = f;
                    asm volatile("s_waitcnt lgkmcnt(0)" ::: "memory");
#pragma unroll
                    for (int g4 = 0; g4 < 4; ++g4) { const f32x4 fv = *(const LAS f32x4*)(wsf + 8 * g4 + 4 * hi);
#pragma unroll
                        for (int i2 = 0; i2 < 4; ++i2) { o[0][4 * g4 + i2] *= fv[i2]; o[1][4 * g4 + i2] *= fv[i2]; } }
                    asm volatile("s_waitcnt lgkmcnt(0)" ::: "memory");
                }
                if (!dead) {
                float rs = 0.f;
#pragma unroll
                for (int r = 0; r < 16; ++r) { p0[r] = __builtin_amdgcn_exp2f(p0[r]); p1[r] = __builtin_amdgcn_exp2f(p1[r]); rs += p0[r] + p1[r]; }
                lrow += rs;
                pw0 = (u32x4){cvtpk(p0[0], p0[1]), cvtpk(p0[2], p0[3]), cvtpk(p0[4], p0[5]), cvtpk(p0[6], p0[7])};
                pw1 = (u32x4){cvtpk(p0[8], p0[9]), cvtpk(p0[10], p0[11]), cvtpk(p0[12], p0[13]), cvtpk(p0[14], p0[15])};
                pw2 = (u32x4){cvtpk(p1[0], p1[1]), cvtpk(p1[2], p1[3]), cvtpk(p1[4], p1[5]), cvtpk(p1[6], p1[7])};
                pw3 = (u32x4){cvtpk(p1[8], p1[9]), cvtpk(p1[10], p1[11]), cvtpk(p1[12], p1[13]), cvtpk(p1[14], p1[15])};
                pv_r(o, vlo, vhi, __builtin_bit_cast(bf16x8, pw0), __builtin_bit_cast(bf16x8, pw1), __builtin_bit_cast(bf16x8, pw2), __builtin_bit_cast(bf16x8, pw3));
                }
            }
        }
        slot = nslot;
    }
    if constexpr (!MOBA) asm volatile("s_waitcnt vmcnt(0)" ::: "memory");
    float rli[16];
    if constexpr (MOBA) {
        const float lt = lrow + partner(lrow, hi);
        if (hi == 0) wsf[32 + r32] = lt;
        asm volatile("s_waitcnt lgkmcnt(0)" ::: "memory");
#pragma unroll
        for (int g4 = 0; g4 < 4; ++g4) { const f32x4 lv = *(const LAS f32x4*)(wsf + 32 + 8 * g4 + 4 * hi);
#pragma unroll
            for (int i2 = 0; i2 < 4; ++i2) rli[4 * g4 + i2] = __builtin_amdgcn_rcpf(lv[i2]); }
    } else {
#pragma unroll
        for (int r = 0; r < 16; ++r) rli[r] = 1.0f;
    }
    {
        LAS bf16_t* stg = (LAS bf16_t*)(lds + LDS_OST) + wid * 2048;
#pragma unroll
        for (int r = 0; r < 16; ++r) { const int orow = crow(r, hi);
#pragma unroll
            for (int d0 = 0; d0 < 2; ++d0) stg[orow * 64 + d0 * 32 + r32] = (bf16_t)(cvtpk(o[d0][r] * rli[r], 0.f) & 0xffffu); }
        asm volatile("s_waitcnt lgkmcnt(0)" ::: "memory");
        bf16_t* Ow = O + (rowbase + q0 + wid * 32) * OPITCH + h * 64;
#pragma unroll
        for (int i = 0; i < 4; ++i) { const int row = i * 8 + (lane >> 3), ch = lane & 7; const u32x4 v = *(const LAS u32x4*)(stg + row * 64 + ch * 8); *(u32x4*)(Ow + (long)row * OPITCH + ch * 8) = v; }
    }
    asm volatile("s_waitcnt lgkmcnt(0)\n\ts_barrier" ::: "memory");
#undef ATT_DMA_KV
}
#undef ATT_SBAR
#undef ATT_WAIT_BAR
}
namespace exa {
using bf16=unsigned short;
using bf16x8=__attribute__((ext_vector_type(8)))short;
using s16x4=__attribute__((ext_vector_type(4)))short;
using f32x16=__attribute__((ext_vector_type(16)))float;
using u32x4=__attribute__((ext_vector_type(4)))unsigned;
constexpr int SEQ=2048,D=64,DM=3072;
constexpr int NW=8,QBLK=32,QB=QBLK*NW,KVBLK=64;
__device__ __forceinline__ int crow(int r,int hi){return (r&3)+8*(r>>2)+4*hi;}
#define SBAR() __builtin_amdgcn_sched_barrier(0)
__device__ __forceinline__ void cmask(f32x16&p0,f32x16&p1,int jb,int qrel,int hi){
  const float NEG=-INFINITY; int kb=64*jb+4*hi;
  #pragma unroll
  for(int r=0;r<16;++r){int kv=kb+(r&3)+8*(r>>2); if(kv>qrel)p0[r]=NEG; if(kv+32>qrel)p1[r]=NEG;}
}
constexpr int NSLOT=3, SLOTB=8192;
constexpr int LDS_K=0, LDS_V=NSLOT*SLOTB, LDS_WS=2*NSLOT*SLOTB, LDS_OST=LDS_WS+NW*64*4, LDS_BYTES=LDS_OST+NW*4096;
__device__ __forceinline__ void glds16(const void*gsrc,unsigned lds_dst){unsigned keep;
  asm volatile("s_mov_b32 %0, m0\n\ts_mov_b32 m0, %2\n\ts_nop 0\n\tglobal_load_lds_dwordx4 %1, off\n\ts_mov_b32 m0, %0":"=&s"(keep):"v"(gsrc),"s"(lds_dst):"memory");}
__device__ __forceinline__ float max3f(float a,float b,float c){float r;asm("v_max3_f32 %0, %1, %2, %3":"=v"(r):"v"(a),"v"(b),"v"(c));return r;}
__device__ __forceinline__ float max2f(float a,float b){float r;asm("v_max_f32_e32 %0, %1, %2":"=v"(r):"v"(a),"v"(b));return r;}
__device__ __forceinline__ float fadd_s(float a,float b){float r;asm("v_add_f32_e32 %0, %1, %2":"=v"(r):"v"(a),"v"(b));return r;}
__device__ __forceinline__ float fsub_s(float a,float b){float r;asm("v_sub_f32_e32 %0, %1, %2":"=v"(r):"v"(a),"v"(b));return r;}
typedef float f32x2_t __attribute__((ext_vector_type(2))); typedef __bf16 bf16x2_t __attribute__((ext_vector_type(2)));
__device__ __forceinline__ unsigned cvtpk_s(float lo,float hi){f32x2_t v={lo,hi};bf16x2_t b=__builtin_convertvector(v,bf16x2_t);return __builtin_bit_cast(unsigned,b);}
#define WAIT_BAR(N) asm volatile("s_waitcnt vmcnt(" #N ") lgkmcnt(0)\n\ts_barrier":::"memory")
typedef LAS const char* lds_cptr;
__device__ __forceinline__ void qkt(f32x16&p0,f32x16&p1,lds_cptr Kslot,const bf16x8*qr,const f32x16&negm,int r32,int hi){
  const lds_cptr kb=Kslot+hi*1024+r32*16;
  #pragma unroll
  for(int d0=0;d0<4;++d0){
    const bf16x8 b0=*(const LAS bf16x8*)(kb+d0*2048);
    const bf16x8 b1=*(const LAS bf16x8*)(kb+d0*2048+512);
    if(d0==0){p0=__builtin_amdgcn_mfma_f32_32x32x16_bf16(b0,qr[0],negm,0,0,0);p1=__builtin_amdgcn_mfma_f32_32x32x16_bf16(b1,qr[0],negm,0,0,0);}
    else{p0=__builtin_amdgcn_mfma_f32_32x32x16_bf16(b0,qr[d0],p0,0,0,0);p1=__builtin_amdgcn_mfma_f32_32x32x16_bf16(b1,qr[d0],p1,0,0,0);}}
}
typedef short v4i16_t __attribute__((ext_vector_type(4)));
__device__ __forceinline__ void kload8(bf16x8*kf,lds_cptr kp){
  kf[0]=*(const LAS bf16x8*)(kp);      kf[1]=*(const LAS bf16x8*)(kp+512);
  kf[2]=*(const LAS bf16x8*)(kp+2048); kf[3]=*(const LAS bf16x8*)(kp+2560);
  kf[4]=*(const LAS bf16x8*)(kp+4096); kf[5]=*(const LAS bf16x8*)(kp+4608);
  kf[6]=*(const LAS bf16x8*)(kp+6144); kf[7]=*(const LAS bf16x8*)(kp+6656);
}
__device__ __forceinline__ void kload2(bf16x8*kf,lds_cptr kp,int j){ kf[2*j]=*(const LAS bf16x8*)(kp+j*2048); kf[2*j+1]=*(const LAS bf16x8*)(kp+j*2048+512); }
__device__ __forceinline__ s16x4 vtr(lds_cptr p){ return __builtin_bit_cast(s16x4,__builtin_amdgcn_ds_read_tr16_b64_v4i16((LAS v4i16_t*)p)); }
__device__ __forceinline__ float rowmax(const f32x16&p0,const f32x16&p1){
  float a=max3f(p0[0],p0[1],p1[0]),b=max3f(p0[2],p0[3],p1[1]);a=max3f(a,p1[2],p1[3]);
  #pragma unroll
  for(int r=4;r<16;r+=4){a=max3f(a,p0[r],p0[r+1]);b=max3f(b,p0[r+2],p0[r+3]);a=max3f(a,p1[r],p1[r+1]);b=max3f(b,p1[r+2],p1[r+3]);}
  const float m=max2f(a,b);
  auto rr=__builtin_amdgcn_permlane32_swap(__float_as_uint(m),__float_as_uint(m),false,false);
  return max2f(__uint_as_float(rr[0]),__uint_as_float(rr[1]));
}
__device__ __forceinline__ void pv(f32x16*o,int vb,bf16x8 pa0,bf16x8 pa1,bf16x8 pa2,bf16x8 pa3){
  #pragma unroll
  for(int d0=0;d0<2;++d0){s16x4 lo[4],hi[4];
    #pragma unroll
    for(int ks=0;ks<4;++ks){
      asm volatile("ds_read_b64_tr_b16 %0,%1 offset:%c2":"=&v"(lo[ks]):"v"(vb),"i"(d0*4096+ks*1024):"memory");
      asm volatile("ds_read_b64_tr_b16 %0,%1 offset:%c2":"=&v"(hi[ks]):"v"(vb),"i"(d0*4096+ks*1024+512):"memory");}
    asm volatile("s_waitcnt lgkmcnt(0)":::"memory");SBAR();
    #define PK(k) (bf16x8){lo[k][0],lo[k][1],lo[k][2],lo[k][3],hi[k][0],hi[k][1],hi[k][2],hi[k][3]}
    o[d0]=__builtin_amdgcn_mfma_f32_32x32x16_bf16(pa0,PK(0),o[d0],0,0,0);
    o[d0]=__builtin_amdgcn_mfma_f32_32x32x16_bf16(pa1,PK(1),o[d0],0,0,0);
    o[d0]=__builtin_amdgcn_mfma_f32_32x32x16_bf16(pa2,PK(2),o[d0],0,0,0);
    o[d0]=__builtin_amdgcn_mfma_f32_32x32x16_bf16(pa3,PK(3),o[d0],0,0,0);
    #undef PK
  }
}
template<int THRL> __device__ __forceinline__ void attn_unit(int b,int h,int qb,const bf16*QKV,bf16*O,LAS unsigned char*shm,const float*KMP=nullptr,const float sl2=0.f,const unsigned force_sel=0u){
  int tid=threadIdx.x; asm volatile("":"+v"(tid)); const int lane=tid&63,r32=lane&31,hi=lane>>5; const int wid=__builtin_amdgcn_readfirstlane(tid>>6);
  const long rowbase=(long)b*SEQ; const int q0=qb*QB;
  const bf16*Qw=QKV+(rowbase+q0+wid*QBLK)*DM+h*D;
  const bf16*Kh=QKV+rowbase*DM+1024+h*D,*Vh=QKV+rowbase*DM+2048+h*D;
  const unsigned lds0=(unsigned)(uintptr_t)shm;
  LAS float*wsf=(LAS float*)(shm+LDS_WS)+wid*64;
  const bf16*ksrc=Kh+(long)lane*DM+wid*8;
  const bf16*vsrc=Vh+(long)(16*(wid&3)+(lane>>2))*DM+(wid>>2)*32+(lane&3)*8;
  const unsigned kdst=lds0+LDS_K+wid*1024, vdst=lds0+LDS_V+wid*1024;
  #define DMA_K(t,slot) glds16(ksrc+(long)(t)*KVBLK*DM,(unsigned)__builtin_amdgcn_readfirstlane(kdst+(slot)))
  #define DMA_V(t,slot) glds16(vsrc+(long)(t)*KVBLK*DM,(unsigned)__builtin_amdgcn_readfirstlane(vdst+(slot)))
  const int vb0=(int)(lds0+LDS_V)+((lane>>4)&1)*32+(lane&3)*8+(4*hi+((lane&15)>>2))*64;
  bf16x8 kf[8];
  const lds_cptr shm3=(lds_cptr)shm; const lds_cptr kp0=shm3+LDS_K+hi*1024+r32*16; const lds_cptr vp0=shm3+LDS_V+((lane>>4)&1)*32+(lane&3)*8+(4*hi+((lane&15)>>2))*64;
  const int NT=(q0+QB)/KVBLK;
  DMA_K(0,0);DMA_V(0,0);DMA_K(1,SLOTB);DMA_K(2,2*SLOTB);
  bf16x8 qr[4];
  #pragma unroll
  for(int d0=0;d0<4;++d0)qr[d0]=*reinterpret_cast<const bf16x8*>(&Qw[(long)r32*DM+d0*16+hi*8]);
#if defined(EXA_G1)
  unsigned selmask=0u; bf16x8 kaug0={0,0,0,0,0,0,0,0},kaug1={0,0,0,0,0,0,0,0},qaug={0,0,0,0,0,0,0,0};
  { LAS float*kmt=(LAS float*)(shm+LDS_BYTES);
    { const int n=tid>>6,d=tid&63; if(n<qb){ const float*kp=KMP+((size_t)(b*8+n)*2)*1024+h*64+d; kmt[n*64+d]=(kp[0]+kp[1024])*(1.0f/256.0f);} }
    asm volatile("s_waitcnt lgkmcnt(0)\n\ts_barrier":::"memory");
    float gate[7];
    #pragma unroll
    for(int n=0;n<7;++n){ float g=-INFINITY; if(n<qb){ float s=0.f;
        #pragma unroll
        for(int d0=0;d0<4;++d0){ const att::f32x4 k0=*(const LAS att::f32x4*)(kmt+n*64+d0*16+hi*8),k1=*(const LAS att::f32x4*)(kmt+n*64+d0*16+hi*8+4);
          s+=att::bf2f(qr[d0][0])*k0[0]+att::bf2f(qr[d0][1])*k0[1]+att::bf2f(qr[d0][2])*k0[2]+att::bf2f(qr[d0][3])*k0[3]+att::bf2f(qr[d0][4])*k1[0]+att::bf2f(qr[d0][5])*k1[1]+att::bf2f(qr[d0][6])*k1[2]+att::bf2f(qr[d0][7])*k1[3]; }
        g=s+att::partner(s,hi);} gate[n]=g; }
    #pragma unroll
    for(int r=0;r<3;++r){ int best=-1; float bv=-INFINITY;
      #pragma unroll
      for(int n=0;n<7;++n){ const bool taken=(selmask>>n)&1u; if(!taken&&gate[n]>bv){best=n;bv=gate[n];} }
      if(best>=0)selmask|=1u<<best; }
    selmask|=(1u<<qb)|force_sel;
    if(hi==0){ const unsigned sh=__float_as_uint(sl2)+0x7fffu+((__float_as_uint(sl2)>>16)&1u),shb=sh>>16; const float rem=sl2-__uint_as_float(shb<<16); const unsigned sl=(__float_as_uint(rem)+0x7fffu+((__float_as_uint(rem)>>16)&1u))>>16;
      qaug[0]=(short)shb; qaug[1]=(short)sl; const short k0s=(short)(__float_as_uint((float)r32)>>16),k1s=(short)(__float_as_uint((float)(32+r32))>>16); kaug0[0]=k0s;kaug0[1]=k0s;kaug1[0]=k1s;kaug1[1]=k1s; } }
  asm volatile(""::"v"(selmask),"v"(kaug0),"v"(kaug1),"v"(qaug));
#endif
  float mhat=0.f,l_reg=0.f;f32x16 o[2];o[0]=f32x16{};o[1]=f32x16{};f32x16 negm=f32x16{};asm volatile("":"+v"(negm));
  const int qrel=wid*QBLK+r32;
  #define CMASK(P0,P1,t) do{int jb_=(t)-(NT-4); if(jb_>=0)cmask(P0,P1,jb_,qrel,hi);}while(0)
  bool resc=false;
  #define START(P0,P1) do{ const float rm=rowmax(P0,P1); resc=false; \
    { const float dl=rm; mhat=fadd_s(mhat,dl); \
      _Pragma("unroll") for(int r=0;r<16;++r){P0[r]=fsub_s(P0[r],dl);P1[r]=fsub_s(P1[r],dl);} \
      _Pragma("unroll") for(int r=0;r<16;++r)negm[r]=-mhat; asm volatile("":"+v"(negm)); } \
    _Pragma("unroll") for(int r=0;r<16;++r)P0[r]=__builtin_amdgcn_exp2f(P0[r]); }while(0)
  #define RESC() do{ if(resc){ asm volatile("s_waitcnt lgkmcnt(0)":::"memory"); \
      _Pragma("unroll") for(int d_=0;d_<2;++d_) _Pragma("unroll") for(int r=0;r<16;++r)o[d_][r]*=wsf[crow(r,hi)]; } }while(0)
#if defined(EXA_G3)
  const float boff=-sl2*(float)(q0+qrel);
  #define SETNEGM(t) do{ const float nv_=((selmask>>((t)>>2))&1u)?(sl2*(float)(64*(t))+boff-mhat):-INFINITY; _Pragma("unroll") for(int r=0;r<16;++r)negm[r]=nv_; asm volatile("":"+v"(negm)); }while(0)
  #define NEGMUPD() do{}while(0)
#else
  #define SETNEGM(t) do{}while(0)
  #define NEGMUPD() do{ _Pragma("unroll") for(int r=0;r<16;++r)negm[r]=-mhat; asm volatile("":"+v"(negm)); }while(0)
#endif
  f32x16 pA0,pA1,pB0,pB1;
  int sl_prev=0,sl_cur=0,sl_next=SLOTB;
  #define ROT() do{sl_prev=sl_cur;sl_cur=sl_next;sl_next=(sl_next==(NSLOT-1)*SLOTB)?0:sl_next+SLOTB;}while(0)
  WAIT_BAR(3);
  SETNEGM(0);
#if defined(EXA_G2)
  { f32x16 a0_=__builtin_amdgcn_mfma_f32_32x32x16_bf16(kaug0,qaug,negm,0,0,0), a1_=__builtin_amdgcn_mfma_f32_32x32x16_bf16(kaug1,qaug,negm,0,0,0); qkt(pA0,pA1,(lds_cptr)shm+LDS_K,qr,negm,r32,hi);
    (void)a0_; (void)a1_; }
  {
    const lds_cptr kb=(lds_cptr)shm+LDS_K+hi*1024+r32*16;
    pA0=__builtin_amdgcn_mfma_f32_32x32x16_bf16(kaug0,qaug,negm,0,0,0); pA1=__builtin_amdgcn_mfma_f32_32x32x16_bf16(kaug1,qaug,negm,0,0,0);
    #pragma unroll
    for(int d0=0;d0<4;++d0){ const bf16x8 b0=*(const LAS bf16x8*)(kb+d0*2048); const bf16x8 b1=*(const LAS bf16x8*)(kb+d0*2048+512);
      pA0=__builtin_amdgcn_mfma_f32_32x32x16_bf16(b0,qr[d0],pA0,0,0,0); pA1=__builtin_amdgcn_mfma_f32_32x32x16_bf16(b1,qr[d0],pA1,0,0,0); }
  }
#else
  qkt(pA0,pA1,(lds_cptr)shm+LDS_K,qr,negm,r32,hi);
#endif
  asm volatile("s_nop 15\n\ts_nop 7":"+v"(pA0),"+v"(pA1));CMASK(pA0,pA1,0);
#if defined(EXA_G3)
  { const float rm=rowmax(pA0,pA1); if(__builtin_expect(__any(rm>(float)THRL),0)){ const float dl=__builtin_fmaxf(rm,0.f); mhat+=dl;
      #pragma unroll
      for(int r=0;r<16;++r){pA0[r]-=dl;pA1[r]-=dl;} } }
  #pragma unroll
  for(int r=0;r<16;++r)pA0[r]=__builtin_amdgcn_exp2f(pA0[r]);
#else
  START(pA0,pA1);
#endif
  _Pragma("unroll") for(int r=0;r<16;++r)pA1[r]=__builtin_amdgcn_exp2f(pA1[r]);
  WAIT_BAR(0);
  DMA_K(3,0);DMA_V(1,SLOTB);
  ROT();
  kload8(kf,kp0+sl_cur);
  WAIT_BAR(2);
  s16x4 vlo[8],vhi[8]; u32x4 pw0,pw1,pw2,pw3;
  #define PKW(P,B) cvtpk_s(P[B],P[B+1])
  #define PAF(k) __builtin_bit_cast(bf16x8,pw##k)
  #define VFR(i) (bf16x8){vlo[i][0],vlo[i][1],vlo[i][2],vlo[i][3],vhi[i][0],vhi[i][1],vhi[i][2],vhi[i][3]}
  #define PIN(x) asm volatile("":"+v"(x))
  #define MX3(a,b,c) __builtin_fmaxf(__builtin_fmaxf((a),(b)),(c))
  #define GAPA(MF,A0,A1,A2,A3,W0,W1,PW) do{ MF; sacc+=A0; sacc+=A1; sacc+=A2; sacc+=A3; PIN(sacc); W0; W1; PIN(PW); SBAR(); }while(0)
  #define EX(v) __builtin_amdgcn_exp2f(v)
  #define GAPB(MF,X,B) do{ MF; X[B]=EX(X[B]); X[B+1]=EX(X[B+1]); X[B+2]=EX(X[B+2]); X[B+3]=EX(X[B+3]); PIN(X); SBAR(); }while(0)
  #define VRD(i) do{ vlo[i]=vtr(vp_+(((i)>>2)*4096+((i)&3)*1024)); vhi[i]=vtr(vp_+(((i)>>2)*4096+((i)&3)*1024+512)); }while(0)
  #define KRD(G,j) do{ if(G){ kload2(kf,kp0+sl_next,j); SBAR(); } }while(0)
#if defined(EXA_G2)
  #define EXA_AUG(C0,C1) do{ C0=__builtin_amdgcn_mfma_f32_32x32x16_bf16(kaug0,qaug,negm,0,0,0); C1=__builtin_amdgcn_mfma_f32_32x32x16_bf16(kaug1,qaug,negm,0,0,0); SBAR(); }while(0)
  #define EXA_C0IN(C) C
#else
  #define EXA_AUG(C0,C1) do{}while(0)
  #define EXA_C0IN(C) negm
#endif
  #define STEP(C0,C1,P0,P1,t,GK,GV,GL) do{ SBAR(); \
    const lds_cptr vp_=vp0+sl_prev; \
    EXA_AUG(C0,C1); \
    VRD(0); SBAR(); float sacc=(P0[0]+P0[1]); \
    GAPA(C0=__builtin_amdgcn_mfma_f32_32x32x16_bf16(kf[0],qr[0],EXA_C0IN(C0),0,0,0), P0[2],P0[3],P0[4],P0[5],     pw0[0]=PKW(P0,0), pw0[1]=PKW(P0,2), pw0); \
    VRD(4); SBAR(); GAPA(C1=__builtin_amdgcn_mfma_f32_32x32x16_bf16(kf[1],qr[0],EXA_C0IN(C1),0,0,0), P0[6],P0[7],P0[8],P0[9],     pw0[2]=PKW(P0,4), pw0[3]=PKW(P0,6), pw0); \
    VRD(1); SBAR(); GAPA(C0=__builtin_amdgcn_mfma_f32_32x32x16_bf16(kf[2],qr[1],C0,0,0,0),   P0[10],P0[11],P0[12],P0[13], pw1[0]=PKW(P0,8), pw1[1]=PKW(P0,10), pw1); \
    VRD(5); SBAR(); GAPA(C1=__builtin_amdgcn_mfma_f32_32x32x16_bf16(kf[3],qr[1],C1,0,0,0),   P0[14],P0[15],P1[0],P1[1],   pw1[2]=PKW(P0,12),pw1[3]=PKW(P0,14), pw1); \
    VRD(2); SBAR(); GAPA(C0=__builtin_amdgcn_mfma_f32_32x32x16_bf16(kf[4],qr[2],C0,0,0,0),   P1[2],P1[3],P1[4],P1[5],     pw2[0]=PKW(P1,0), pw2[1]=PKW(P1,2), pw2); \
    VRD(6); SBAR(); GAPA(C1=__builtin_amdgcn_mfma_f32_32x32x16_bf16(kf[5],qr[2],C1,0,0,0),   P1[6],P1[7],P1[8],P1[9],     pw2[2]=PKW(P1,4), pw2[3]=PKW(P1,6), pw2); \
    VRD(3); SBAR(); GAPA(C0=__builtin_amdgcn_mfma_f32_32x32x16_bf16(kf[6],qr[3],C0,0,0,0),   P1[10],P1[11],P1[12],P1[13], pw3[0]=PKW(P1,8), pw3[1]=PKW(P1,10), pw3); \
    VRD(7); SBAR(); GAPA(C1=__builtin_amdgcn_mfma_f32_32x32x16_bf16(kf[7],qr[3],C1,0,0,0),   P1[14],P1[15],0.f,0.f,       pw3[2]=PKW(P1,12),pw3[3]=PKW(P1,14), pw3); \
    l_reg+=sacc; \
    if(GK){DMA_K((t)+3,sl_cur);} if(GV){DMA_V((t)+1,sl_next);} \
    CMASK(C0,C1,t); \
    { float a=MX3(C0[0],C0[1],C1[0]),b=MX3(C0[2],C0[3],C1[1]); a=MX3(a,C1[2],C1[3]); \
      _Pragma("unroll") for(int r=4;r<16;r+=4){a=MX3(a,C0[r],C0[r+1]);b=MX3(b,C0[r+2],C0[r+3]);a=MX3(a,C1[r],C1[r+1]);b=MX3(b,C1[r+2],C1[r+3]);} \
      float rm=__builtin_fmaxf(a,b); { auto rr=__builtin_amdgcn_permlane32_swap(__float_as_uint(rm),__float_as_uint(rm),false,false); rm=__builtin_fmaxf(__uint_as_float(rr[0]),__uint_as_float(rr[1])); } \
      resc=false; \
      if(__builtin_expect(__any(rm>(float)THRL),0)){ const float dl=__builtin_fmaxf(rm,0.f); mhat+=dl; \
        _Pragma("unroll") for(int r=0;r<16;++r){C0[r]-=dl;C1[r]-=dl;} \
        NEGMUPD(); \
        const float f=__builtin_amdgcn_exp2f(-dl); l_reg*=f; if(hi==0)wsf[r32]=f; resc=true; } } \
    SBAR(); \
    GAPB(o[0]=__builtin_amdgcn_mfma_f32_32x32x16_bf16(PAF(0),VFR(0),o[0],0,0,0), C0,0); \
    GAPB(o[1]=__builtin_amdgcn_mfma_f32_32x32x16_bf16(PAF(0),VFR(4),o[1],0,0,0), C0,4); \
    KRD(GL,0); GAPB(o[0]=__builtin_amdgcn_mfma_f32_32x32x16_bf16(PAF(1),VFR(1),o[0],0,0,0), C0,8); \
    KRD(GL,1); GAPB(o[1]=__builtin_amdgcn_mfma_f32_32x32x16_bf16(PAF(1),VFR(5),o[1],0,0,0), C0,12); \
    KRD(GL,2); GAPB(o[0]=__builtin_amdgcn_mfma_f32_32x32x16_bf16(PAF(2),VFR(2),o[0],0,0,0), C1,0); \
    KRD(GL,3); GAPB(o[1]=__builtin_amdgcn_mfma_f32_32x32x16_bf16(PAF(2),VFR(6),o[1],0,0,0), C1,4); \
    GAPB(o[0]=__builtin_amdgcn_mfma_f32_32x32x16_bf16(PAF(3),VFR(3),o[0],0,0,0), C1,8); \
    GAPB(o[1]=__builtin_amdgcn_mfma_f32_32x32x16_bf16(PAF(3),VFR(7),o[1],0,0,0), C1,12); \
    }while(0)
  int t=1;
  #undef CMASK
  #define CMASK(P0,P1,t) do{}while(0)
  for(;t+5<NT;t+=2){
    SETNEGM(t); STEP(pB0,pB1,pA0,pA1,t,true,true,true);     WAIT_BAR(2); RESC(); ROT();
    SETNEGM(t+1); STEP(pA0,pA1,pB0,pB1,t+1,true,true,true);   WAIT_BAR(2); RESC(); ROT();
  }
  #undef CMASK
  #define CMASK(P0,P1,t) do{int jb_=(t)-(NT-4); if(jb_>=0)cmask(P0,P1,jb_,qrel,hi);}while(0)
  #define ENDW(tt) do{ if((tt)+3<NT){WAIT_BAR(2);} else if((tt)+2<NT){WAIT_BAR(1);} else {WAIT_BAR(0);} }while(0)
  for(;t+1<NT;t+=2){
    SETNEGM(t); STEP(pB0,pB1,pA0,pA1,t,(t+3<NT),(t+1<NT),(t+1<NT));       ENDW(t);   RESC(); ROT();
    SETNEGM(t+1); STEP(pA0,pA1,pB0,pB1,t+1,(t+4<NT),(t+2<NT),(t+2<NT));     ENDW(t+1); RESC(); ROT();
  }
  SETNEGM(NT-1); STEP(pB0,pB1,pA0,pA1,NT-1,false,false,false); RESC();
  { float sacc=pB0[0]+pB0[1]; _Pragma("unroll") for(int r=2;r<16;++r)sacc+=pB0[r]; _Pragma("unroll") for(int r=0;r<16;++r)sacc+=pB1[r]; l_reg+=sacc;
    pw0=(u32x4){PKW(pB0,0),PKW(pB0,2),PKW(pB0,4),PKW(pB0,6)};pw1=(u32x4){PKW(pB0,8),PKW(pB0,10),PKW(pB0,12),PKW(pB0,14)};pw2=(u32x4){PKW(pB1,0),PKW(pB1,2),PKW(pB1,4),PKW(pB1,6)};pw3=(u32x4){PKW(pB1,8),PKW(pB1,10),PKW(pB1,12),PKW(pB1,14)};
    SBAR(); pv(o,vb0+sl_cur,PAF(0),PAF(1),PAF(2),PAF(3)); }
  #undef PKW
  #undef PAF
  #undef VFR
  #undef PIN
  #undef MX3
  #undef GAPA
  #undef GAPB
  #undef EX
  #undef VRD
  #undef KRD
  #undef STEP
  #undef ENDW
  {auto rr=__builtin_amdgcn_permlane32_swap(__float_as_uint(l_reg),__float_as_uint(l_reg),false,false);l_reg=__uint_as_float(rr[0])+__uint_as_float(rr[1]);}
  if(hi==0)wsf[32+r32]=l_reg;asm volatile("s_waitcnt lgkmcnt(0)":::"memory");
  float rli[16];
  #pragma unroll
  for(int r=0;r<16;++r)rli[r]=__builtin_amdgcn_rcpf(wsf[32+crow(r,hi)]);
  bf16*Ow=O+(rowbase+q0+wid*QBLK)*1024+h*D;
  { LAS bf16*stg=(LAS bf16*)(shm+LDS_OST)+wid*2048;
    #pragma unroll
    for(int r=0;r<16;++r){const int orow=crow(r,hi);
      #pragma unroll
      for(int d0=0;d0<2;++d0)stg[orow*64+d0*32+r32]=(bf16)(cvtpk_s(o[d0][r]*rli[r],0.f)&0xffffu);}
    asm volatile("s_waitcnt lgkmcnt(0)":::"memory");
    #pragma unroll
    for(int i=0;i<4;++i){const int row=i*8+(lane>>3),ch=lane&7; const u32x4 v=*(const LAS u32x4*)(stg+row*64+ch*8); *(u32x4*)(Ow+(long)row*1024+ch*8)=v;} }
  asm volatile("s_waitcnt lgkmcnt(0)\n\ts_barrier":::"memory");
  #undef DMA_K
  #undef DMA_V
  #undef CMASK
  #undef START
  #undef RESC
  #undef ROT
}

#undef SBAR
#undef WAIT_BAR
}
#define XB_TMO      128
#define XB_XCNT(j)  (256  + 64 * (j))
#define XB_XSUB(j)  (1280 + 64 * (j))
#define XB_XGEN(j)  (2304 + 64 * (j))
#define XB_TOP      3328
#define XB_TOPGEN   3392
#define XCD_BAR_WORDS 3456
#define XB_SPIN_CAP (1u << 18)

__device__ __forceinline__ unsigned xb_ld(unsigned* p)              { return __hip_atomic_load(p, __ATOMIC_RELAXED, __HIP_MEMORY_SCOPE_AGENT); }
__device__ __forceinline__ unsigned xb_add(unsigned* p, unsigned v) { return __hip_atomic_fetch_add(p, v, __ATOMIC_RELAXED, __HIP_MEMORY_SCOPE_AGENT); }
__device__ __forceinline__ unsigned xb_xcc_id() { return (unsigned)__builtin_amdgcn_s_getreg((3 << 11) | 20) & 0xFu; }
#define XB_SPIN(cond, bar) do { unsigned _sp = 0; while (cond) { __builtin_amdgcn_s_sleep(1); \
    if ((++_sp & 255u) == 0u) { if (xb_ld(&(bar)[XB_TMO])) break; if (_sp > XB_SPIN_CAP) { atomicAdd(&(bar)[XB_TMO], 1u); break; } } } } while (0)

struct XcdBarrier {
    unsigned* bar; unsigned x;
    volatile LAS unsigned* st;
};

__device__ __forceinline__ XcdBarrier xcd_barrier_post(unsigned* bar, volatile LAS unsigned* st) {
    XcdBarrier b; b.bar = bar; b.x = xb_xcc_id(); b.st = st;
    if (threadIdx.x == 0) (void)xb_add(&bar[XB_XCNT(b.x)], 1u);
    return b;
}
__device__ __forceinline__ void xcd_barrier_complete(unsigned* bar, unsigned x, unsigned& nloc, unsigned& nx) {
    const unsigned G = gridDim.x * gridDim.y * gridDim.z;
    unsigned sum, cnt, mine, sp = 0u;
    for (;;) {
        sum = 0u; cnt = 0u; mine = 0u;
#pragma unroll
        for (unsigned j = 0; j < 16; ++j) { const unsigned c = xb_ld(&bar[XB_XCNT(j)]); sum += c; cnt += (c > 0u) ? 1u : 0u; mine = (j == x) ? c : mine; }
        if (sum == G) break;
        __builtin_amdgcn_s_sleep(1);
        if ((++sp & 255u) == 0u) { if (xb_ld(&bar[XB_TMO])) break; if (sp > XB_SPIN_CAP) { atomicAdd(&bar[XB_TMO], 1u); break; } }
    }
    nloc = mine > 0u ? mine : 1u; nx = cnt > 0u ? cnt : 1u;
}

__device__ __forceinline__ void xcd_barrier(const XcdBarrier& b) {
    asm volatile("s_waitcnt vmcnt(0)" ::: "memory");
    __syncthreads();
    if (threadIdx.x == 0) {
        unsigned* bar = b.bar;
        __builtin_amdgcn_s_waitcnt(0);
        unsigned nloc = b.st[0], nx = b.st[1];
        if (nloc == 0u) { xcd_barrier_complete(bar, b.x, nloc, nx); b.st[0] = nloc; b.st[1] = nx; }
        const unsigned old = xb_add(&bar[XB_XSUB(b.x)], 1u);
        const unsigned gen = old / nloc;
        if (old + 1u == (gen + 1u) * nloc) {
            __builtin_amdgcn_fence(__ATOMIC_RELEASE, "agent");
            asm volatile("s_waitcnt vmcnt(0)" ::: "memory");
            const unsigned og = xb_add(&bar[XB_TOP], 1u);
            const unsigned tg = og / nx;
            if (og + 1u == (tg + 1u) * nx) xb_add(&bar[XB_TOPGEN], 1u);
            else XB_SPIN(xb_ld(&bar[XB_TOPGEN]) == tg, bar);
            __builtin_amdgcn_fence(__ATOMIC_ACQUIRE, "agent");
            xb_add(&bar[XB_XGEN(b.x)], 1u);
            asm volatile("s_waitcnt vmcnt(0)" ::: "memory");
        } else {
            XB_SPIN(xb_ld(&bar[XB_XGEN(b.x)]) == gen, bar);
            __builtin_amdgcn_fence(__ATOMIC_ACQUIRE, "agent");
            asm volatile("s_waitcnt vmcnt(0)" ::: "memory");
        }
    }
    __syncthreads();
}
#ifndef DBG_MASK
#define DBG_MASK 255
#endif
#ifndef GEMM_XDMA
#define GEMM_XDMA false
#endif
#ifndef GU_ALIGN
#define GU_ALIGN true
#endif
#ifndef DUP_MASK
#define DUP_MASK 0
#endif
#define NREP(bit) ((DUP_MASK & (bit)) ? 2 : 1)
constexpr int NWAVES = 8;
constexpr int NBATCH = 8, SEQ = 2048, D = 1024, FF = 2816, M = NBATCH * SEQ, DEPTH = 4;
constexpr int N_PHASES = 2 + 7 * DEPTH;
constexpr float QSCALE = 0.125f * 1.4426950408889634f;
typedef unsigned short bf16;
typedef float f32x4 __attribute__((ext_vector_type(4)));
typedef unsigned v4u __attribute__((ext_vector_type(4)));
typedef GAS unsigned gu32;
#define RLX_AGENT __ATOMIC_RELAXED, __HIP_MEMORY_SCOPE_AGENT
constexpr size_t MiB = 1u << 20;
constexpr size_t WS_CTL = 0, CTL_ZERO_BYTES = 1 * MiB;
constexpr size_t WS_WGU = 1 * MiB;
constexpr size_t WS_WD = 89 * MiB;
constexpr size_t WS_WIN_E = 133 * MiB;
constexpr size_t WS_WOUT_E = 141 * MiB;
constexpr size_t WS_WQKV_O = 145 * MiB;
constexpr size_t WS_WO_O = 157 * MiB;
constexpr size_t WS_XB = 161 * MiB;
constexpr size_t WS_SS = 193 * MiB;
constexpr size_t WS_KMP = 194 * MiB;
constexpr size_t WS_QKV = 195 * MiB;
constexpr size_t WS_O = 291 * MiB;
constexpr size_t WS_END = 323 * MiB;
constexpr size_t WGU_BYTES = (size_t)2 * FF * D * 2, WD_BYTES = (size_t)D * FF * 2;
static_assert(WS_WGU + 8 * WGU_BYTES <= WS_WD && WS_WD + 8 * WD_BYTES <= WS_WIN_E && WS_QKV + (size_t)M * 3072 * 2 <= WS_O && WS_O + (size_t)M * D * 2 <= WS_END, "d_ws map");
constexpr int CW_BAR = 4096;
constexpr int RING_OFF = 0, RING_BYTES = 131072;
constexpr int P0_TS = 65, P0_SCR_BYTES = 64 * P0_TS * 4;
constexpr int LDSCTL_OFF = pg8::HM_STAGE_BYTES, MISC_OFF = LDSCTL_OFF + 320;
constexpr int LDS_BYTES = LDSCTL_OFF + 1024;
static_assert(att::LDS_END <= RING_BYTES && exa::LDS_BYTES + 2048 <= RING_BYTES && MISC_OFF + 128 <= LDS_BYTES && 8 * P0_SCR_BYTES <= LDSCTL_OFF && LDS_BYTES <= 160 * 1024, "LDS map");

__device__ __forceinline__ unsigned f2bf(float f) { unsigned u = __builtin_bit_cast(unsigned, f); return (u + 0x7fffu + ((u >> 16) & 1u)) >> 16; }
__device__ __forceinline__ unsigned pk2(float lo, float hi) { return f2bf(lo) | (f2bf(hi) << 16); }
__device__ __forceinline__ float wave_sum(float v) {
#pragma unroll
    for (int o = 1; o < 64; o <<= 1) v += __shfl_xor(v, o);
    return v;
}
#define LDS_WAIT() asm volatile("s_waitcnt lgkmcnt(0)" ::: "memory")
#define VM_WAIT() asm volatile("s_waitcnt vmcnt(0)" ::: "memory")

__device__ __forceinline__ void p0_write_tile(bf16* WT, int K, int dst_row0, int k0, LAS float* scr, int lane) {
    LDS_WAIT(); asm volatile("" ::: "memory");
    const int c = lane & 7, nn = lane >> 3;
#pragma unroll
    for (int j = 0; j < 8; ++j) { const int n = nn + 8 * j; const LAS float* s = scr + (8 * c) * P0_TS + n;
        v4u o; o.x = pk2(s[0 * P0_TS], s[1 * P0_TS]); o.y = pk2(s[2 * P0_TS], s[3 * P0_TS]); o.z = pk2(s[4 * P0_TS], s[5 * P0_TS]); o.w = pk2(s[6 * P0_TS], s[7 * P0_TS]);
        *(GAS v4u*)(WT + (size_t)(dst_row0 + n) * K + k0 + 8 * c) = o; }
    LDS_WAIT(); asm volatile("" ::: "memory");
}
#if defined(P0_NT)
#define P0_LOADW(p) __builtin_nontemporal_load(p)
#else
#define P0_LOADW(p) (*(p))
#endif
struct P0Item { const float* W; const float* gain; bf16* WT; int ldw, K, dst_row0, k0, n0; };
__device__ __forceinline__ void p0_item_load(const P0Item& d, f32x4 (&v)[16], float (&g)[16], int lane) {
    const int q = lane >> 4, p = lane & 15;
#pragma unroll
    for (int i = 0; i < 16; ++i) { v[i] = P0_LOADW((const GAS f32x4*)(d.W + (size_t)(d.k0 + 4 * i + q) * d.ldw + d.n0 + 4 * p)); g[i] = d.gain ? d.gain[d.k0 + 4 * i + q] : 1.0f; }
}
__device__ __forceinline__ void p0_item_finish(const P0Item& d, const f32x4 (&v)[16], const float (&g)[16], LAS float* scr, int lane) {
    const int q = lane >> 4, p = lane & 15;
#pragma unroll
    for (int i = 0; i < 16; ++i) { LAS float* dd = scr + (4 * i + q) * P0_TS + 4 * p; dd[0] = v[i][0] * g[i]; dd[1] = v[i][1] * g[i]; dd[2] = v[i][2] * g[i]; dd[3] = v[i][3] * g[i]; }
    p0_write_tile(d.WT, d.K, d.dst_row0, d.k0, scr, lane);
}
typedef const float __attribute__((address_space(4))) cfloat_t;
__device__ __forceinline__ void p0_fold_sub(const float* Win  , const float* Wp  , const float* pscale  , const float* gain, bf16* WT, int k0, int n0, int lane) {
    const int g = n0 >> 7, d = (n0 & 127) + lane;
    const float* wpb = Wp + (size_t)g * 128 * 128 + d;
    cfloat_t* wrow = (cfloat_t*)(Win + (size_t)k0 * 2048 + 1536 + g * 128);
    cfloat_t* gk = (cfloat_t*)(gain + k0);
    float acc[8];
#pragma unroll
    for (int k = 0; k < 8; ++k) acc[k] = 0.f;
#pragma unroll 1
    for (int c0 = 0; c0 < 128; c0 += 32) {
        float wp[32];
#pragma unroll
        for (int c = 0; c < 32; ++c) wp[c] = wpb[(size_t)(c0 + c) * 128];
#pragma unroll
        for (int k = 0; k < 8; ++k)
#pragma unroll
            for (int c = 0; c < 32; ++c) acc[k] = __builtin_fmaf(wrow[(size_t)k * 2048 + c0 + c], wp[c], acc[k]);
    }
    const float ps = pscale[g * 128 + d];
    v4u o; o.x = pk2(acc[0] * ps * gk[0], acc[1] * ps * gk[1]); o.y = pk2(acc[2] * ps * gk[2], acc[3] * ps * gk[3]); o.z = pk2(acc[4] * ps * gk[4], acc[5] * ps * gk[5]); o.w = pk2(acc[6] * ps * gk[6], acc[7] * ps * gk[7]);
    *(GAS v4u*)(WT + (size_t)(1536 + n0 + lane) * 1024 + k0) = o;
}

struct Args { const float* in[17]; float* out; unsigned char* ws; int ph_lo, ph_hi; };

__device__ __forceinline__ void p0_prologue(const Args& a, unsigned char* ws, LAS unsigned char* lds, int vcu, int G, int wave, int lane) {
    LAS float* scr = (LAS float*)(lds + wave * P0_SCR_BYTES);
    const int gw = vcu * NWAVES + wave, NGW = G * NWAVES;
    constexpr int I_GU = 16 * 44, I_DN = 44 * 16, I_EIN = 16 * 24, I_EFO = 16 * 8, I_SQ = 16 * 16, I_OQKV = 16 * 48;
    constexpr int S_G = 0, S_U = S_G + 8 * I_GU, S_D = S_U + 8 * I_GU, S_EIN = S_D + 8 * I_DN, S_EOUT = S_EIN + 2 * I_EIN, S_OQKV = S_EOUT + 2 * I_SQ, S_OO = S_OQKV + 2 * I_OQKV, NITEMS = S_OO + 2 * I_SQ;
    auto decode = [&](int it) -> P0Item {
        P0Item d;
        if (it < S_D) {
            const bool up = it >= S_U; const int r0 = it - (up ? S_U : S_G), f = r0 / I_GU, r = r0 % I_GU, layer = f >> 1, half = f & 1, kb = r / 44, nb = r % 44, n0 = 64 * nb;
            d.W = a.in[half ? (up ? 8 : 7) : (up ? 3 : 2)] + (size_t)layer * D * FF; d.gain = a.in[half ? 6 : 1] + layer * D; d.WT = (bf16*)(ws + WS_WGU + (size_t)f * WGU_BYTES);
            d.ldw = FF; d.K = D; d.dst_row0 = (n0 >> 7) * 256 + (up ? 128 : 0) + (n0 & 127); d.k0 = 64 * kb; d.n0 = n0;
        } else if (it < S_EIN) {
            const int r0 = it - S_D, f = r0 / I_DN, r = r0 % I_DN, layer = f >> 1, half = f & 1, kb = r / 16, nb = r % 16;
            d.W = a.in[half ? 9 : 4] + (size_t)layer * FF * D; d.gain = nullptr; d.WT = (bf16*)(ws + WS_WD + (size_t)f * WD_BYTES); d.ldw = D; d.K = FF; d.dst_row0 = 64 * nb; d.k0 = 64 * kb; d.n0 = 64 * nb;
        } else if (it < S_EOUT) {
            const int r0 = it - S_EIN, i = r0 / I_EIN, r = r0 % I_EIN, kb = r / 24, nb = r % 24;
            d.W = a.in[10] + (size_t)i * D * 2048; d.gain = a.in[5] + (2 * i) * D; d.WT = (bf16*)(ws + WS_WIN_E + (size_t)i * 2048 * D * 2); d.ldw = 2048; d.K = D; d.dst_row0 = 64 * nb; d.k0 = 64 * kb; d.n0 = 64 * nb;
        } else if (it < S_OQKV) {
            const int r0 = it - S_EOUT, i = r0 / I_SQ, r = r0 % I_SQ, kb = r / 16, nb = r % 16;
            d.W = a.in[13] + (size_t)i * D * D; d.gain = nullptr; d.WT = (bf16*)(ws + WS_WOUT_E + (size_t)i * D * D * 2); d.ldw = D; d.K = D; d.dst_row0 = 64 * nb; d.k0 = 64 * kb; d.n0 = 64 * nb;
        } else if (it < S_OO) {
            const int r0 = it - S_OQKV, i = r0 / I_OQKV, r = r0 % I_OQKV, kb = r / 48, nb = r % 48;
            d.W = a.in[14] + (size_t)i * D * 3072; d.gain = a.in[5] + (2 * i + 1) * D; d.WT = (bf16*)(ws + WS_WQKV_O + (size_t)i * 3072 * D * 2); d.ldw = 3072; d.K = D; d.dst_row0 = 64 * nb; d.k0 = 64 * kb; d.n0 = 64 * nb;
        } else {
            const int r0 = it - S_OO, i = r0 / I_SQ, r = r0 % I_SQ, kb = r / 16, nb = r % 16;
            d.W = a.in[15] + (size_t)i * D * D; d.gain = nullptr; d.WT = (bf16*)(ws + WS_WO_O + (size_t)i * D * D * 2); d.ldw = D; d.K = D; d.dst_row0 = 64 * nb; d.k0 = 64 * kb; d.n0 = 64 * nb;
        }
        return d;
    };
    if (gw < NITEMS) {
        P0Item cur = decode(gw); f32x4 v[16]; float g[16];
        p0_item_load(cur, v, g, lane);
        for (int it = gw; it < NITEMS; it += NGW) {
            const bool more = it + NGW < NITEMS;
            P0Item nxt = cur; f32x4 v2[16]; float g2[16];
            if (more) { nxt = decode(it + NGW); p0_item_load(nxt, v2, g2, lane); }
            p0_item_finish(cur, v, g, scr, lane);
            if (more) { cur = nxt;
#pragma unroll
                for (int i = 0; i < 16; ++i) { v[i] = v2[i]; g[i] = g2[i]; } }
        }
    }
#if defined(P0_FOLD_DUP)
    for (int rep_ = 0; rep_ < P0_FOLD_DUP; ++rep_)
#endif
    for (int s0 = gw; s0 < 2 * 128 * 8; s0 += NGW) {
        const int i = s0 >> 10, r = s0 & 1023, kb = r >> 3, nb = r & 7;
        p0_fold_sub(a.in[10] + (size_t)i * D * 2048, a.in[11] + (size_t)i * 4 * 128 * 128, a.in[12] + i * 512, a.in[5] + (2 * i) * D, (bf16*)(ws + WS_WIN_E + (size_t)i * 2048 * D * 2), 8 * kb, 64 * nb, lane);
    }
    const float* x = a.in[0]; bf16* XB = (bf16*)(ws + WS_XB); float* SS = (float*)(ws + WS_SS);
#if defined(P0_XB_DUP)
    for (int rep_ = 0; rep_ < P0_XB_DUP; ++rep_)
#endif
    for (int m = gw; m < M; m += NGW) {
        const GAS f32x4* xr = (const GAS f32x4*)(x + (size_t)m * D) + lane;
        f32x4 v[4]; float s = 0.f;
#pragma unroll
        for (int j = 0; j < 4; ++j) { v[j] = xr[64 * j]; s += (v[j].x * v[j].x + v[j].y * v[j].y) + (v[j].z * v[j].z + v[j].w * v[j].w); }
        s = wave_sum(s);
        GAS unsigned long long* o8 = (GAS unsigned long long*)(XB + (size_t)m * D) + lane;
#pragma unroll
        for (int j = 0; j < 4; ++j) o8[64 * j] = (unsigned long long)pk2(v[j].x, v[j].y) | ((unsigned long long)pk2(v[j].z, v[j].w) << 32);
        if (lane < 16) SS[(size_t)m * 16 + lane] = (lane == 0) ? s : 0.f;
    }
}
__device__ __forceinline__ void pool_rows(const bf16* QKV, bf16* O, int vcu, int G, int tid) {
    asm volatile("" : "+v"(tid));
    const int cc = tid & 63, rg = tid >> 6, g = cc >> 4, w = 2 << g;
    for (int R0 = vcu * 64; R0 < M; R0 += G * 64) {
#pragma unroll 1
        for (int rr = 0; rr < 8; ++rr) {
            const int row = R0 + rg * 8 + rr, t = row & (SEQ - 1);
            const int cnt = (t + 1) < w ? (t + 1) : w;
            float s[8];
#pragma unroll
            for (int e = 0; e < 8; ++e) s[e] = 0.f;
            v4u cur = {0u, 0u, 0u, 0u};
            for (int i = 0; i < cnt; ++i) {
                const v4u v = *(const v4u*)(QKV + (size_t)(row - i) * 2048 + 1536 + cc * 8);
                if (i == 0) cur = v;
                s[0] += __builtin_bit_cast(float, v.x << 16); s[1] += __builtin_bit_cast(float, v.x & 0xffff0000u);
                s[2] += __builtin_bit_cast(float, v.y << 16); s[3] += __builtin_bit_cast(float, v.y & 0xffff0000u);
                s[4] += __builtin_bit_cast(float, v.z << 16); s[5] += __builtin_bit_cast(float, v.z & 0xffff0000u);
                s[6] += __builtin_bit_cast(float, v.w << 16); s[7] += __builtin_bit_cast(float, v.w & 0xffff0000u);
            }
            const float rc = 1.0f / (float)cnt;
            v4u o;
            o.x = pk2(s[0] * rc - __builtin_bit_cast(float, cur.x << 16), s[1] * rc - __builtin_bit_cast(float, cur.x & 0xffff0000u));
            o.y = pk2(s[2] * rc - __builtin_bit_cast(float, cur.y << 16), s[3] * rc - __builtin_bit_cast(float, cur.y & 0xffff0000u));
            o.z = pk2(s[4] * rc - __builtin_bit_cast(float, cur.z << 16), s[5] * rc - __builtin_bit_cast(float, cur.z & 0xffff0000u));
            o.w = pk2(s[6] * rc - __builtin_bit_cast(float, cur.w << 16), s[7] * rc - __builtin_bit_cast(float, cur.w & 0xffff0000u));
            *(v4u*)(O + (size_t)row * 1024 + 512 + cc * 8) = o;
        }
    }
}
__device__ __forceinline__ void final_norm(const bf16* XBs, float* out, const float* SS, const float* gfin, int vcu, int G, int wave, int lane) {
    const int gw = vcu * NWAVES + wave, NGW = G * NWAVES;
    f32x4 gv[2][2];
#pragma unroll
    for (int j = 0; j < 2; ++j) { gv[j][0] = *(const f32x4*)(gfin + 512 * j + 8 * lane); gv[j][1] = *(const f32x4*)(gfin + 512 * j + 8 * lane + 4); }
    for (int m = gw; m < M; m += NGW) {
        float s = (lane < 16) ? SS[(size_t)m * 16 + lane] : 0.f;
        s = wave_sum(s);
        const float r = 1.0f / sqrtf(s * (1.0f / D) + 1e-6f);
#pragma unroll
        for (int j = 0; j < 2; ++j) {
            const v4u b = *(const GAS v4u*)(XBs + (size_t)m * D + 512 * j + 8 * lane);
            const f32x4 x0 = {__builtin_bit_cast(float, b.x << 16), __builtin_bit_cast(float, b.x & 0xffff0000u), __builtin_bit_cast(float, b.y << 16), __builtin_bit_cast(float, b.y & 0xffff0000u)};
            const f32x4 x1 = {__builtin_bit_cast(float, b.z << 16), __builtin_bit_cast(float, b.z & 0xffff0000u), __builtin_bit_cast(float, b.w << 16), __builtin_bit_cast(float, b.w & 0xffff0000u)};
            GAS f32x4* o = (GAS f32x4*)(out + (size_t)m * D + 512 * j + 8 * lane);
            o[0] = x0 * r * gv[j][0]; o[1] = x1 * r * gv[j][1];
        }
    }
}

#if defined(CMP_PROBE)
__device__ __forceinline__ void cmp_unit(const bf16* A, const bf16* B, int b, int h, int qb, int cls, gu32* word, int tid) {
    asm volatile("" : "+v"(tid));
    __threadfence(); __syncthreads();
    unsigned bucket = 0u;
    if (tid < 256) {
        float se = 0.f, sx = 0.f;
        for (int c = 0; c < 64; ++c) { const size_t idx = ((size_t)b * SEQ + qb * 256 + tid) * 1024 + h * 64 + c;
            const float x = __builtin_bit_cast(float, (unsigned)A[idx] << 16), y = __builtin_bit_cast(float, (unsigned)B[idx] << 16);
            se += (x - y) * (x - y); sx += x * x; }
        const float rel = sqrtf(se / (sx + 1e-12f));
#if defined(CMP_BUCKETS)
        if (rel > 0.02f) bucket |= 4u; if (rel > 0.05f) bucket |= 8u; if (rel > 0.15f) bucket |= 16u; if (rel > 0.5f) bucket |= 32u; if (rel > 1.5f) bucket |= 64u; if (!(rel == rel)) bucket |= 128u;
#else
        if (!(rel <= CMP_RTOL)) bucket |= 1u << cls;
#endif
    }
    if (bucket) __hip_atomic_fetch_or(word, bucket, __ATOMIC_RELAXED, __HIP_MEMORY_SCOPE_AGENT);
    __syncthreads();
}
#endif
__global__ void __launch_bounds__(NWAVES * 64, 2) mk_fwd(Args args) {
    extern __shared__ __attribute__((aligned(16))) unsigned char lds_raw[];
    LAS unsigned char* lds = (LAS unsigned char*)lds_raw;
    volatile LAS unsigned* MISC = (volatile LAS unsigned*)(lds + MISC_OFF);
    const int tid = threadIdx.x, lane = tid & 63, wave = __builtin_amdgcn_readfirstlane(tid >> 6);
    const int G = gridDim.x; const int bx = blockIdx.x; const int vcu = (G % 8 == 0) ? (bx % 8) * (G / 8) + bx / 8 : bx;
    unsigned char* ws = args.ws;
    gu32* ctl = (gu32*)(ws + WS_CTL);
    for (int u = tid; u < (LDS_BYTES - LDSCTL_OFF) / 4; u += NWAVES * 64) ((LAS unsigned*)(lds + LDSCTL_OFF))[u] = 0u;
    __syncthreads();
    XcdBarrier bar; bar.bar = (unsigned*)(ctl + CW_BAR); bar.x = 0; bar.st = nullptr;
    if (MK_N_LAUNCHES == 1) bar = xcd_barrier_post((unsigned*)(ctl + CW_BAR), MISC + 8);
    const int lo = args.ph_lo, hi = args.ph_hi;
#define IN(k) (lo <= (k) && (k) < hi)
#if defined(BAR_DUP)
#define SEAM(k) do { if (IN(k) && IN((k) + 1)) { xcd_barrier(bar); xcd_barrier(bar); } } while (0)
#else
#define SEAM(k) do { if (IN(k) && IN((k) + 1)) xcd_barrier(bar); } while (0)
#endif

    bf16* XB = (bf16*)(ws + WS_XB); float* SS = (float*)(ws + WS_SS); float* KMP = (float*)(ws + WS_KMP);
    bf16* QKV = (bf16*)(ws + WS_QKV); bf16* HB = (bf16*)(ws + WS_QKV); bf16* OB = (bf16*)(ws + WS_O);

    if ((DBG_MASK & 1) && IN(0)) { for (int rep = 0; rep < NREP(1); ++rep) { p0_prologue(args, ws, lds, vcu, G, wave, lane); __syncthreads(); } }
    SEAM(0);

    for (int layer = 0; layer < DEPTH; ++layer) {
        const int pb = 1 + 7 * layer;
        for (int half = 0; half < 2; ++half) {
            const int f = layer * 2 + half, pg = pb + (half ? 5 : 0);
            if ((DBG_MASK & 2) && IN(pg)) for (int rep = 0; rep < NREP(2); ++rep) {
                pg8::Gemm g{XB, (const bf16*)(ws + WS_WGU + (size_t)f * WGU_BYTES), M, 2 * FF, D}; pg8::StaticOrder S; S.init(M, 2 * FF, G, bx);
#if defined(GU_PROBE_VARIANT)
#if defined(GU_KPROBE)
                if (rep == 1) { pg8::EpiGUProbe<GU_KPROBE> E{}; E.H = HB; E.SS = SS; pg8::gemm_phase<pg8::EpiGUProbe<GU_KPROBE>, pg8::StaticOrder, true, true, GEMM_XDMA>(lds + RING_OFF, g, S, E); } else
#else
                if (rep == 1) { pg8::EpiGU_<GU_PROBE_VARIANT> E{HB, SS}; pg8::gemm_phase<pg8::EpiGU_<GU_PROBE_VARIANT>, pg8::StaticOrder, true, true, GEMM_XDMA>(lds + RING_OFF, g, S, E); } else
#endif
#endif
                { pg8::EpiGU E{HB, SS};
                const int fullr = S.nwg / G, rem = S.nwg - fullr * G; const bool hm = (2 * rem == G) && (G % 16 == 0);
                if (hm) S.maxr = fullr;
                pg8::gemm_phase<pg8::EpiGU, pg8::StaticOrder, GU_ALIGN, true, GEMM_XDMA>(lds + RING_OFF, g, S, E);
                if (hm) { const int j = bx >> 3; pg8::Unit uu; S.unit_of((long)fullr * G + (bx & 7) + 8 * (j >> 1), uu); const pg8::HUnit hu{uu.pm * 2 + (j & 1), uu.pn};
                    pg8::gemm_half_unit<pg8::EpiGU>(lds + RING_OFF, g, hu, E);
#if defined(HM_DUP)
                    __syncthreads(); pg8::gemm_half_unit<pg8::EpiGU>(lds + RING_OFF, g, hu, E);
#endif
                    } }
            }
            SEAM(pg);
            if ((DBG_MASK & 4) && IN(pg + 1)) for (int rep = 0; rep < NREP(4); ++rep) {
                pg8::Gemm g{HB, (const bf16*)(ws + WS_WD + (size_t)f * WD_BYTES), M, D, FF}; pg8::StaticOrder S; S.init(M, D, G, bx);
#if defined(DOWN_NOOP_PROBE)
                if (rep == 1) { pg8::EpiResNoop E; pg8::gemm_phase<pg8::EpiResNoop, pg8::StaticOrder, true, true, GEMM_XDMA>(lds + RING_OFF, g, S, E); } else {
#endif
                pg8::EpiRes E{XB, SS, rep ? 0.0f : 0.5f};
                pg8::gemm_phase<pg8::EpiRes, pg8::StaticOrder, true, true, GEMM_XDMA>(lds + RING_OFF, g, S, E);
#if defined(DOWN_NOOP_PROBE)
                }
#endif
            }
            SEAM(pg + 1);
            if (half == 0) {
                const int i2 = layer >> 1; const bool odd = layer & 1;
                if ((DBG_MASK & 8) && IN(pb + 2)) for (int rep = 0; rep < NREP(8); ++rep) {
                    const int N = odd ? 3072 : 2048;
                    pg8::Gemm g{XB, (const bf16*)(ws + (odd ? WS_WQKV_O + (size_t)i2 * 3072 * D * 2 : WS_WIN_E + (size_t)i2 * 2048 * D * 2)), M, N, D}; pg8::StaticOrder S; S.init(M, N, G, bx);
                    pg8::EpiQKV E{QKV, N, SS, odd ? 4 : 2, QSCALE, odd ? KMP : nullptr, 4, 8};
                    pg8::gemm_phase<pg8::EpiQKV, pg8::StaticOrder, true, true, GEMM_XDMA>(lds + RING_OFF, g, S, E);
                }
                SEAM(pb + 2);
                if (IN(pb + 3)) {
                    if ((DBG_MASK & 16) && !odd) for (int rep = 0; rep < NREP(16); ++rep) {
                        for (int ui = vcu; ui < 512; ui += G) {
                            const int bh = (ui & 255) >> 2, s = ui & 3, qb = (ui >> 8) ? 7 - s : s;
                            att::attn_unit<false>(bh >> 3, bh & 7, qb, QKV, 2048, 512, 1024, OB, lds + RING_OFF, nullptr, 0.f);
                        }
                        pool_rows(QKV, OB, vcu, G, tid);
                    } else if (DBG_MASK & 32) for (int rep = 0; rep < NREP(32); ++rep) {
                        for (int ui = vcu; ui < 1024; ui += G) {
                            const int bh = (ui & 255) >> 1, j = ui & 1, k = ui >> 8;
                            const int qb = (k == 0) ? (j ? 6 : 7) : (k == 1) ? (j ? 5 : 4) : (k == 2) ? (j ? 2 : 3) : (j ? 1 : 0);
                            const int h = bh & 15;
                            const float sl2 = exp2f(-0.5f * (float)(h + 1)) * 1.4426950408889634f;
#if defined(CMP_PROBE)
                            att::attn_unit<true>(bh >> 4, h, qb, QKV, 3072, 1024, 2048, OB, lds + RING_OFF, KMP, sl2);
                            if ((bh >> 4) < 4) {
                                att::attn_unit<true>(bh >> 4, h, qb, QKV, 3072, 1024, 2048, (bf16*)(ws + WS_END), lds + RING_OFF, KMP, CMP_SL2, CMP_FORCE);
#if defined(CMP_EXA)
                                exa::attn_unit<8>(bh >> 4, h, qb, QKV, (bf16*)(ws + WS_END + 16 * MiB), lds + RING_OFF, KMP, CMP_SL2, CMP_FORCE);
#else
                                exa::attn_unit<8>(bh >> 4, h, qb, QKV, (bf16*)(ws + WS_END + 16 * MiB), lds + RING_OFF, KMP, CMP_SL2, CMP_FORCE);
#endif
                                cmp_unit((const bf16*)(ws + WS_END), (const bf16*)(ws + WS_END + 16 * MiB), bh >> 4, h, qb, CMP_PROBE, ctl + 2048, tid); }
#elif defined(MOBA_OLD)
                            att::attn_unit<true>(bh >> 4, h, qb, QKV, 3072, 1024, 2048, OB, lds + RING_OFF, KMP, sl2);
#else
#if defined(UNIT_OVH_PROBE)
                            if (rep == 1) exa::attn_unit<8>(bh >> 4, h, 0, QKV, (bf16*)(ws + WS_END), lds + RING_OFF, KMP, sl2, 0u); else
#endif
                            exa::attn_unit<8>(bh >> 4, h, qb, QKV, OB, lds + RING_OFF, KMP, sl2, 0u);
#endif
                        }
                    }
                }
                SEAM(pb + 3);
                if ((DBG_MASK & 64) && IN(pb + 4)) for (int rep = 0; rep < NREP(64); ++rep) {
                    pg8::Gemm g{OB, (const bf16*)(ws + (odd ? WS_WO_O : WS_WOUT_E) + (size_t)i2 * D * D * 2), M, D, D}; pg8::StaticOrder S; S.init(M, D, G, bx);
                    pg8::EpiRes E{XB, SS, rep ? 0.0f : 1.0f};
                    pg8::gemm_phase<pg8::EpiRes, pg8::StaticOrder, true, true, GEMM_XDMA>(lds + RING_OFF, g, S, E);
                }
                SEAM(pb + 4);
            }
        }
    }
    if ((DBG_MASK & 128) && IN(N_PHASES - 1)) final_norm(XB, args.out, SS, args.in[16], vcu, G, wave, lane);
#if defined(CMP_PROBE)
    xcd_barrier(bar);
    if (blockIdx.x == 0 && tid == 0) { const unsigned w = __hip_atomic_load(ctl + 2048, RLX_AGENT); const unsigned long long t0 = __builtin_amdgcn_s_memrealtime(), dt = (unsigned long long)w * 10000ull;
        while (__builtin_amdgcn_s_memrealtime() - t0 < dt) __builtin_amdgcn_s_sleep(8); }
#endif
#undef IN
#undef SEAM
}

extern "C" void kernel_launch(void* const* d_in, const int* in_sizes, int n_in, void* d_out, int out_size, void* d_ws, size_t ws_size, hipStream_t stream) {
    static int grid = 0;
    if (grid == 0) {
        if (n_in != 17 || in_sizes[0] != M * D || out_size != M * D || ws_size < WS_END) { fprintf(stderr, "kernel_launch: unexpected shapes (n_in %d, in0 %d, out %d, ws %zu); nothing launched\n", n_in, n_in > 0 ? in_sizes[0] : -1, out_size, ws_size); grid = -1; return; }
        int dev = 0, cus = 0, per_cu = 0;
        if (hipGetDevice(&dev) != hipSuccess || hipDeviceGetAttribute(&cus, hipDeviceAttributeMultiprocessorCount, dev) != hipSuccess) { grid = -1; return; }
        if (hipFuncSetAttribute((const void*)mk_fwd, hipFuncAttributeMaxDynamicSharedMemorySize, LDS_BYTES) != hipSuccess) { fprintf(stderr, "kernel_launch: hipFuncSetAttribute failed\n"); grid = -1; return; }
        if (hipOccupancyMaxActiveBlocksPerMultiprocessor(&per_cu, (const void*)mk_fwd, NWAVES * 64, LDS_BYTES) != hipSuccess || per_cu < 1)
            fprintf(stderr, "kernel_launch: note: occupancy query reports %d workgroups per CU\n", per_cu);
        (void)hipGetLastError();
        grid = cus;
    }
    if (grid < 0) return;
    if (hipMemsetAsync((char*)d_ws + WS_CTL, 0, CTL_ZERO_BYTES, stream) != hipSuccess) return;
    Args a{};
    for (int i = 0; i < 17; ++i) a.in[i] = (const float*)d_in[i];
    a.out = (float*)d_out; a.ws = (unsigned char*)d_ws;
#if MK_N_LAUNCHES == 1
    a.ph_lo = 0; a.ph_hi = N_PHASES;
    hipLaunchKernelGGL(mk_fwd, dim3(grid), dim3(NWAVES * 64), LDS_BYTES, stream, a);
#else
    for (int p = 0; p < N_PHASES; ++p) { a.ph_lo = p; a.ph_hi = p + 1; hipLaunchKernelGGL(mk_fwd, dim3(grid), dim3(NWAVES * 64), LDS_BYTES, stream, a); }
#endif
}
```

```cpp
#include <hip/hip_runtime.h>
#include <cstdio>
#include <cstdint>
#define LAS __attribute__((address_space(3)))
#define GAS __attribute__((address_space(1)))
#ifndef MK_N_LAUNCHES
#define MK_N_LAUNCHES 1
#endif
#define P0_NT 1
#define EXA_G1 1
#define EXA_G2 1
#define EXA_G3 1
namespace pg8 {
#define PG8_LAS __attribute__((address_space(3)))
typedef unsigned short bf16_t;
typedef short bf16x8 __attribute__((ext_vector_type(8)));
typedef float f32x4 __attribute__((ext_vector_type(4)));
typedef unsigned u32x4 __attribute__((ext_vector_type(4)));
constexpr int BM = 256, BK = 64, HALF = 128, HTB = HALF * BK * 2  , STAGE_BYTES = 8 * HTB, NXCD = 8, WGM = 8;

__host__ __device__ __forceinline__ int lds_byte(int r, int c) { const int st = (r >> 4) * 2 + (c >> 5), rr = r & 15, cc = c & 31, ob = rr * 64 + cc * 2; return st * 1024 + (ob ^ (((ob >> 9) & 1) << 5)); }
__host__ __device__ __forceinline__ void stage_rc(int b, int& R, int& C) { const int st = b / 1024, sb = b % 1024, swz = sb ^ (((sb >> 9) & 1) << 5); R = (st >> 1) * 16 + swz / 64; C = (st & 1) * 32 + (swz % 64) / 2; }
__host__ __device__ __forceinline__ int perm32(int rho) { const int n = rho >> 4, i = rho & 15; return 8 * (i >> 2) + 4 * n + (i & 3); }

struct Unit { int pm, pn; };
struct HUnit { int pm2, pn; };
struct Gemm { const bf16_t* A; const bf16_t* Bt; int M, N, K; };

struct StaticOrder {
    int nM, nN, nwg, G, c, maxr;
    __host__ __device__ void init(int M, int N, int G_, int c_) { nM = M / BM; nN = N / BM; nwg = nM * nN; G = G_; c = c_; maxr = 1 << 30; }
    __host__ __device__ bool next(int i, Unit& u) const {
        const long L = (long)i * G + c; if (L >= nwg || i >= maxr) return false;
        unit_of(L, u); return true;
    }
    __host__ __device__ void unit_of(long L, Unit& u) const {
        int wgid = (int)L; { const int q = nwg / NXCD, r = nwg % NXCD, xcd = wgid % NXCD, off = wgid / NXCD; wgid = (xcd < r ? xcd * (q + 1) : r * (q + 1) + (xcd - r) * q) + off; }
        const int nig = WGM * nN, gid = wgid / nig, fm = gid * WGM, gsz = (nM - fm) < WGM ? (nM - fm) : WGM;
        u.pm = fm + ((wgid % nig) % gsz); u.pn = (wgid % nig) / gsz;
    }
    __device__ __forceinline__ void a_ready(const Unit&) const {}
    __device__ __forceinline__ void done(const Unit&) const {}
};

__device__ __forceinline__ unsigned cvt_pk_bf16(float lo, float hi) { unsigned r; asm volatile("v_cvt_pk_bf16_f32 %0, %1, %2" : "=v"(r) : "v"(lo), "v"(hi)); return r; }
typedef float f32x2 __attribute__((ext_vector_type(2)));
__device__ __forceinline__ float row_rstd(const float* SS, int row, int fq) {
    const f32x4 v = *(const f32x4*)(SS + (size_t)row * 16 + 4 * fq);
    float s = (v[0] + v[1]) + (v[2] + v[3]);
    s += __shfl_xor(s, 16); s += __shfl_xor(s, 32);
    return __builtin_amdgcn_rsqf(s * (1.0f / 1024.0f) + 1e-6f);
}
__device__ __forceinline__ void row_rstd8(const float* SS, int row0, int fq, float (&r8)[8]) {
    f32x4 sv[8];
#pragma unroll
    for (int k = 0; k < 8; ++k) sv[k] = *(const f32x4*)(SS + (size_t)(row0 + (k >> 2) * HALF + (k & 3) * 16) * 16 + 4 * fq);
#pragma unroll
    for (int k = 0; k < 8; ++k) { float s = (sv[k][0] + sv[k][1]) + (sv[k][2] + sv[k][3]); s += __shfl_xor(s, 16); s += __shfl_xor(s, 32); r8[k] = __builtin_amdgcn_rsqf(s * (1.0f / 1024.0f) + 1e-6f); }
}
__device__ __forceinline__ void row_rstd8v(const float* SS, int row0, int fq, float (&r8)[8], float (&v8)[8]) {
    f32x4 sv[8];
#pragma unroll
    for (int k = 0; k < 8; ++k) sv[k] = *(const f32x4*)(SS + (size_t)(row0 + (k >> 2) * HALF + (k & 3) * 16) * 16 + 4 * fq);
#pragma unroll
    for (int k = 0; k < 8; ++k) { float s = (sv[k][0] + sv[k][1]) + (sv[k][2] + sv[k][3]); s += __shfl_xor(s, 16); s += __shfl_xor(s, 32); v8[k] = s * (1.0f / 1024.0f) + 1e-6f; r8[k] = __builtin_amdgcn_rsqf(v8[k]); }
}
template <int VARIANT = 0> struct EpiGU_ {
    static constexpr bool PERM = true, AFTER_DRAIN = false;
    bf16_t* H; const float* SS;
    __device__ __forceinline__ void gu_row(const f32x4 (&ga)[2], const f32x4 (&ua)[2], float r, float v, bf16_t* dst) const {
        const float rn = r * -1.4426950408889634f;
        const f32x2 rn2 = {rn, rn}, v2 = {v, v};
        f32x2 t[4], p[4];
#pragma unroll
        for (int k = 0; k < 4; ++k) { const f32x2 g = {ga[k >> 1][2 * (k & 1)], ga[k >> 1][2 * (k & 1) + 1]}, uu = {ua[k >> 1][2 * (k & 1)], ua[k >> 1][2 * (k & 1) + 1]};
            t[k] = g * rn2; p[k] = g * uu; }
#pragma unroll
        for (int k = 0; k < 4; ++k) { t[k].x = __builtin_amdgcn_exp2f(t[k].x); t[k].y = __builtin_amdgcn_exp2f(t[k].y); }
#pragma unroll
        for (int k = 0; k < 4; ++k) t[k] = __builtin_elementwise_fma(t[k], v2, v2);
#pragma unroll
        for (int k = 0; k < 4; ++k) { t[k].x = __builtin_amdgcn_rcpf(t[k].x); t[k].y = __builtin_amdgcn_rcpf(t[k].y); }
#pragma unroll
        for (int k = 0; k < 4; ++k) p[k] = p[k] * t[k];
        u32x4 w; w.x = cvt_pk_bf16(p[0].x, p[0].y); w.y = cvt_pk_bf16(p[1].x, p[1].y); w.z = cvt_pk_bf16(p[2].x, p[2].y); w.w = cvt_pk_bf16(p[3].x, p[3].y);
        if (VARIANT == 2) { asm volatile("" :: "v"(w)); } else *(u32x4*)dst = w;
    }
    __device__ __forceinline__ void half(const f32x4 (&acc)[2][4][2], const HUnit& u, int wr, int wc, int fr, int fq) const {
        const int row0 = u.pm2 * HALF + wr * 64 + fr, col0 = u.pn * 128 + wc * 32 + 8 * fq;
        f32x4 sv[4];
#pragma unroll
        for (int k = 0; k < 4; ++k) sv[k] = *(const f32x4*)(SS + (size_t)(row0 + k * 16) * 16 + 4 * fq);
#pragma unroll
        for (int m = 0; m < 4; ++m) { float s = (sv[m][0] + sv[m][1]) + (sv[m][2] + sv[m][3]); s += __shfl_xor(s, 16); s += __shfl_xor(s, 32); const float v = s * (1.0f / 1024.0f) + 1e-6f;
            gu_row(acc[0][m], acc[1][m], __builtin_amdgcn_rsqf(v), v, H + (size_t)(row0 + m * 16) * 2816 + col0); }
    }
    __device__ __forceinline__ void operator()(const f32x4 (&acc)[2][2][4][2], const Unit& u, int wr, int wc, int fr, int fq) const {
        if (VARIANT == 1) {
#pragma unroll
            for (int ai = 0; ai < 2; ++ai)
#pragma unroll
                for (int bj = 0; bj < 2; ++bj)
                    asm volatile("" :: "v"(acc[ai][bj][0][0]), "v"(acc[ai][bj][0][1]), "v"(acc[ai][bj][1][0]), "v"(acc[ai][bj][1][1]), "v"(acc[ai][bj][2][0]), "v"(acc[ai][bj][2][1]), "v"(acc[ai][bj][3][0]), "v"(acc[ai][bj][3][1]));
            return; }
        const int row0 = u.pm * BM + wr * 64 + fr, col0 = u.pn * 128 + wc * 32 + 8 * fq;
        float r8[8], v8[8]; row_rstd8v(SS, row0, fq, r8, v8);
#pragma unroll
        for (int ai = 0; ai < 2; ++ai)
#pragma unroll
            for (int m = 0; m < 4; ++m) {
                gu_row(acc[ai][0][m], acc[ai][1][m], r8[ai * 4 + m], v8[ai * 4 + m], H + (size_t)(row0 + ai * HALF + m * 16) * 2816 + col0);
            }
    }
};
typedef EpiGU_<0> EpiGU;
template <int KP> struct EpiGUProbe : EpiGU_<1> { static constexpr int KPROBE = KP; };
struct EpiRes {
    static constexpr bool PERM = true, AFTER_DRAIN = false;
    bf16_t* XB; float* SS; float alpha;
    __device__ __forceinline__ void operator()(const f32x4 (&acc)[2][2][4][2], const Unit& u, int wr, int wc, int fr, int fq) const {
        const int row0 = u.pm * BM + wr * 64 + fr, col0 = u.pn * BM + wc * 32 + 8 * fq;
#pragma unroll
        for (int ai = 0; ai < 2; ++ai) {
            u32x4 bv[4][2];
#pragma unroll
            for (int m = 0; m < 4; ++m)
#pragma unroll
                for (int bj = 0; bj < 2; ++bj) bv[m][bj] = *(const u32x4*)(XB + (size_t)(row0 + ai * HALF + m * 16) * 1024 + col0 + bj * HALF);
#pragma unroll
            for (int m = 0; m < 4; ++m) {
                const int row = row0 + ai * HALF + m * 16; const size_t off = (size_t)row * 1024 + col0;
                float s = 0.f;
#pragma unroll
                for (int bj = 0; bj < 2; ++bj) {
                    const u32x4 b = bv[m][bj];
                    const f32x4 b0 = {__builtin_bit_cast(float, b.x << 16), __builtin_bit_cast(float, b.x & 0xffff0000u), __builtin_bit_cast(float, b.y << 16), __builtin_bit_cast(float, b.y & 0xffff0000u)};
                    const f32x4 b1 = {__builtin_bit_cast(float, b.z << 16), __builtin_bit_cast(float, b.z & 0xffff0000u), __builtin_bit_cast(float, b.w << 16), __builtin_bit_cast(float, b.w & 0xffff0000u)};
                    const f32x4 v0 = b0 + acc[ai][bj][m][0] * alpha, v1 = b1 + acc[ai][bj][m][1] * alpha;
                    u32x4 w; w.x = cvt_pk_bf16(v0[0], v0[1]); w.y = cvt_pk_bf16(v0[2], v0[3]); w.z = cvt_pk_bf16(v1[0], v1[1]); w.w = cvt_pk_bf16(v1[2], v1[3]);
                    *(u32x4*)(XB + off + bj * HALF) = w;
                    const float r0 = __builtin_bit_cast(float, w.x << 16), r1 = __builtin_bit_cast(float, w.x & 0xffff0000u), r2 = __builtin_bit_cast(float, w.y << 16), r3 = __builtin_bit_cast(float, w.y & 0xffff0000u);
                    const float r4 = __builtin_bit_cast(float, w.z << 16), r5 = __builtin_bit_cast(float, w.z & 0xffff0000u), r6 = __builtin_bit_cast(float, w.w << 16), r7 = __builtin_bit_cast(float, w.w & 0xffff0000u);
                    s += (r0 * r0 + r1 * r1) + (r2 * r2 + r3 * r3) + (r4 * r4 + r5 * r5) + (r6 * r6 + r7 * r7);
                }
                s += __shfl_xor(s, 16); s += __shfl_xor(s, 32);
                if (fq == 0) SS[(size_t)row * 16 + u.pn * 4 + wc] = s;
            }
        }
    }
};
struct EpiResNoop {
    static constexpr bool PERM = true, AFTER_DRAIN = false;
    __device__ __forceinline__ void operator()(const f32x4 (&acc)[2][2][4][2], const Unit&, int, int, int, int) const {
#pragma unroll
        for (int ai = 0; ai < 2; ++ai)
#pragma unroll
            for (int bj = 0; bj < 2; ++bj)
                asm volatile("" :: "v"(acc[ai][bj][0][0]), "v"(acc[ai][bj][0][1]), "v"(acc[ai][bj][1][0]), "v"(acc[ai][bj][1][1]), "v"(acc[ai][bj][2][0]), "v"(acc[ai][bj][2][1]), "v"(acc[ai][bj][3][0]), "v"(acc[ai][bj][3][1]));
    }
};
struct EpiQKV {
    static constexpr bool PERM = true, AFTER_DRAIN = false;
    bf16_t* O; int ldc; const float* SS; int nq_tiles; float qscale; float* KMP; int k_lo, k_hi;
    __device__ __forceinline__ void operator()(const f32x4 (&acc)[2][2][4][2], const Unit& u, int wr, int wc, int fr, int fq) const {
        const int row0 = u.pm * BM + wr * 64 + fr, col0 = u.pn * BM + wc * 32 + 8 * fq;
        const float sc = (u.pn < nq_tiles) ? qscale : 1.0f;
        float r8[8]; row_rstd8(SS, row0, fq, r8);
#pragma unroll
        for (int ai = 0; ai < 2; ++ai)
#pragma unroll
            for (int m = 0; m < 4; ++m) {
                const int row = row0 + ai * HALF + m * 16;
                const float r = r8[ai * 4 + m] * sc;
                bf16_t* rowp = O + (size_t)row * ldc + col0;
#pragma unroll
                for (int bj = 0; bj < 2; ++bj) {
                    const f32x4 v0 = acc[ai][bj][m][0] * r, v1 = acc[ai][bj][m][1] * r;
                    u32x4 w; w.x = cvt_pk_bf16(v0[0], v0[1]); w.y = cvt_pk_bf16(v0[2], v0[3]); w.z = cvt_pk_bf16(v1[0], v1[1]); w.w = cvt_pk_bf16(v1[2], v1[3]);
                    *(u32x4*)(rowp + bj * HALF) = w;
                }
            }
        if (KMP != nullptr && u.pn >= k_lo && u.pn < k_hi) {
            float* dst = KMP + ((size_t)u.pm * 2 + wr) * 1024 + (u.pn - k_lo) * BM + wc * 32 + 8 * fq;
#pragma unroll
            for (int bj = 0; bj < 2; ++bj)
#pragma unroll
                for (int n = 0; n < 2; ++n) {
                    f32x4 cs = {0.f, 0.f, 0.f, 0.f};
#pragma unroll
                    for (int ai = 0; ai < 2; ++ai)
#pragma unroll
                        for (int m = 0; m < 4; ++m) cs += acc[ai][bj][m][n] * r8[ai * 4 + m];
#pragma unroll
                    for (int i = 0; i < 4; ++i) { float c = cs[i]; c += __shfl_xor(c, 1); c += __shfl_xor(c, 2); c += __shfl_xor(c, 4); c += __shfl_xor(c, 8); cs[i] = c; }
                    if (fr == 0) *(f32x4*)(dst + bj * HALF + 4 * n) = cs;
                }
        }
    }
};
#ifndef PG8_PRIO_MMA
#define PG8_PRIO_MMA 1
#define PG8_PRIO_LOAD 0
#endif
template <class E, class = void> struct kprobe_of { static constexpr int value = 0; };
template <class E> struct kprobe_of<E, decltype((void)E::KPROBE)> { static constexpr int value = E::KPROBE; };
template <class Epi, class Sched, bool ALIGN_EPI = false, bool SP2 = false, bool XDMA = false>
__device__ __forceinline__ void gemm_phase(PG8_LAS unsigned char* lds, const Gemm g, const Sched& S, const Epi& E) {
    int tid = threadIdx.x; asm volatile("" : "+v"(tid));
    const int wid = __builtin_amdgcn_readfirstlane(tid >> 6), lane = tid & 63, wr = wid >> 2, wc = wid & 3, fr = lane & 15, fq = lane >> 4;
    const int K = g.K, nt = K / BK;
    unsigned voffA[2], voffB[2];
#pragma unroll
    for (int i = 0; i < 2; ++i) { int R, C; stage_rc(tid * 16 + i * 8192, R, C); const int Rb = Epi::PERM ? ((R & ~31) + perm32(R & 31)) : R;
        voffA[i] = (unsigned)(R * K + C) * 2u; voffB[i] = (unsigned)(Rb * K + C) * 2u; }
    const size_t kstep = (size_t)(BK * 2);
    const size_t hstep = (size_t)HALF * K * 2;
    const size_t tstep = 2 * hstep;
    const unsigned ldsw = (unsigned)wid * 1024u;
    const int aoff = lds_byte(wr * 64 + fr, fq * 8), boff = lds_byte(wc * 32 + fr, fq * 8);
#define PG8_SA(b, h) (((b) * 2 + (h)) * HTB)
#define PG8_SB(b, h) ((4 + (b) * 2 + (h)) * HTB)
#define PG8_STAGE(bufoff, gbase, voff) do { if constexpr (kprobe_of<Epi>::value != 1) _Pragma("unroll") for (int _i = 0; _i < 2; ++_i) \
        __builtin_amdgcn_global_load_lds((const unsigned*)((const char*)(gbase) + (voff)[_i]), (PG8_LAS unsigned*)(lds + (bufoff) + ldsw + _i * 8192), 16, 0, 0); } while (0)
#define PG8_LDA(dst, b, h) do { if constexpr (kprobe_of<Epi>::value != 2) _Pragma("unroll") for (int m = 0; m < 4; ++m) _Pragma("unroll") for (int k = 0; k < 2; ++k) dst[m][k] = *(const PG8_LAS bf16x8*)(lds + PG8_SA(b, h) + aoff + m * 2048 + k * 1024); } while (0)
#define PG8_LDB(dst, b, h) do { if constexpr (kprobe_of<Epi>::value != 2) _Pragma("unroll") for (int n = 0; n < 2; ++n) _Pragma("unroll") for (int k = 0; k < 2; ++k) dst[n][k] = *(const PG8_LAS bf16x8*)(lds + PG8_SB(b, h) + boff + n * 2048 + k * 1024); } while (0)
#define PG8_MMA(ai, bj, At, Bt) do { __builtin_amdgcn_s_setprio(PG8_PRIO_MMA); _Pragma("unroll") for (int m = 0; m < 4; ++m) _Pragma("unroll") for (int n = 0; n < 2; ++n) _Pragma("unroll") for (int k = 0; k < 2; ++k) \
        acc[ai][bj][m][n] = __builtin_amdgcn_mfma_f32_16x16x32_bf16(Bt[n][k], At[m][k], acc[ai][bj][m][n], 0, 0, 0); __builtin_amdgcn_s_setprio(PG8_PRIO_LOAD); } while (0)
#define PG8_WAIT_V(n) asm volatile("s_waitcnt vmcnt(" #n ")" ::: "memory")
#define PG8_WAIT_L(n) asm volatile("s_waitcnt lgkmcnt(" #n ")" ::: "memory")
#define PG8_BAR __builtin_amdgcn_s_barrier()
#define PG8_SCHED __builtin_amdgcn_sched_barrier(0)
    Unit cur, nxt; int ui = 0;
    if (!S.next(0, cur)) return;
    f32x4 acc[2][2][4][2];
#pragma unroll
    for (int a = 0; a < 2; ++a)
#pragma unroll
        for (int b = 0; b < 2; ++b)
#pragma unroll
            for (int m = 0; m < 4; ++m)
#pragma unroll
                for (int n = 0; n < 2; ++n) acc[a][b][m][n] = (f32x4){0.f, 0.f, 0.f, 0.f};
    bf16x8 At[4][2], B0[2][2], B1[2][2];
    const char* cA = (const char*)g.A + (size_t)cur.pm * tstep; const char* cB = (const char*)g.Bt + (size_t)cur.pn * tstep;
    S.a_ready(cur);
    if constexpr (SP2) {
        PG8_STAGE(PG8_SB(0, 0), cB, voffB); PG8_STAGE(PG8_SB(0, 1), cB + hstep, voffB); PG8_STAGE(PG8_SA(0, 0), cA, voffA); PG8_STAGE(PG8_SA(0, 1), cA + hstep, voffA);
        if (wr == 1) PG8_BAR;
        PG8_WAIT_V(2); PG8_BAR;
        PG8_STAGE(PG8_SB(1, 0), cB + kstep, voffB); PG8_STAGE(PG8_SA(1, 0), cA + kstep, voffA); PG8_STAGE(PG8_SB(1, 1), cB + hstep + kstep, voffB);
        PG8_WAIT_V(6); PG8_BAR;
    } else {
        PG8_STAGE(PG8_SB(0, 0), cB, voffB); PG8_STAGE(PG8_SA(0, 0), cA, voffA); PG8_STAGE(PG8_SB(0, 1), cB + hstep, voffB); PG8_STAGE(PG8_SA(0, 1), cA + hstep, voffA);
        if (wr == 1) PG8_BAR;
        PG8_WAIT_V(4); PG8_BAR;
        PG8_STAGE(PG8_SB(1, 0), cB + kstep, voffB); PG8_STAGE(PG8_SA(1, 0), cA + kstep, voffA); PG8_STAGE(PG8_SB(1, 1), cB + hstep + kstep, voffB);
        PG8_WAIT_V(6); PG8_BAR;
    }
    for (;;) {
        const bool has_next = S.next(ui + 1, nxt);
        const char* nA = has_next ? (const char*)g.A + (size_t)nxt.pm * tstep : cA; const char* nB = has_next ? (const char*)g.Bt + (size_t)nxt.pn * tstep : cB;
        for (int t = 0; t < nt; t += 2) {
            const bool last = (t == nt - 2);
            const char* a1 = cA + (size_t)(t + 1) * kstep;
            const char* a2 = last ? nA : cA + (size_t)(t + 2) * kstep; const char* b2 = last ? nB : cB + (size_t)(t + 2) * kstep;
            const char* a3 = a2 + kstep; const char* b3 = b2 + kstep;
            if (last && has_next) S.a_ready(nxt);
            if constexpr (SP2) {
            if constexpr (XDMA) {
            PG8_LDB(B0, 0, 0); PG8_LDB(B1, 0, 1); PG8_SCHED; PG8_LDA(At, 0, 0);
            PG8_WAIT_V(6); PG8_WAIT_L(0); PG8_BAR; PG8_MMA(0, 0, At, B0); PG8_STAGE(PG8_SA(1, 1), a1 + hstep, voffA); PG8_MMA(0, 1, At, B1); PG8_BAR; PG8_SCHED;
            PG8_LDA(At, 0, 1);
            PG8_WAIT_V(2); PG8_WAIT_L(0); PG8_BAR; PG8_MMA(1, 0, At, B0); PG8_STAGE(PG8_SB(0, 0), b2, voffB); PG8_STAGE(PG8_SB(0, 1), b2 + hstep, voffB); PG8_STAGE(PG8_SA(0, 0), a2, voffA); PG8_MMA(1, 1, At, B1); PG8_BAR; PG8_SCHED;
            PG8_LDB(B0, 1, 0); PG8_LDB(B1, 1, 1); PG8_SCHED; PG8_LDA(At, 1, 0);
            PG8_WAIT_V(6); PG8_WAIT_L(0); PG8_BAR; PG8_MMA(0, 0, At, B0); PG8_STAGE(PG8_SA(0, 1), a2 + hstep, voffA); PG8_MMA(0, 1, At, B1); PG8_BAR; PG8_SCHED;
            PG8_LDA(At, 1, 1);
            PG8_WAIT_V(2); PG8_WAIT_L(0); PG8_BAR; PG8_MMA(1, 0, At, B0); PG8_STAGE(PG8_SB(1, 0), b3, voffB); PG8_STAGE(PG8_SB(1, 1), b3 + hstep, voffB); PG8_STAGE(PG8_SA(1, 0), a3, voffA); PG8_MMA(1, 1, At, B1); PG8_BAR; PG8_SCHED;
            } else {
            PG8_LDB(B0, 0, 0); PG8_LDB(B1, 0, 1); PG8_SCHED; PG8_LDA(At, 0, 0); PG8_STAGE(PG8_SA(1, 1), a1 + hstep, voffA);
            PG8_WAIT_V(8); PG8_WAIT_L(0); PG8_BAR; PG8_MMA(0, 0, At, B0); PG8_MMA(0, 1, At, B1); PG8_BAR; PG8_SCHED;
            PG8_LDA(At, 0, 1); PG8_STAGE(PG8_SB(0, 0), b2, voffB); PG8_STAGE(PG8_SB(0, 1), b2 + hstep, voffB); PG8_STAGE(PG8_SA(0, 0), a2, voffA);
            PG8_WAIT_V(8); PG8_WAIT_L(0); PG8_BAR; PG8_MMA(1, 0, At, B0); PG8_MMA(1, 1, At, B1); PG8_BAR; PG8_SCHED;
            PG8_LDB(B0, 1, 0); PG8_LDB(B1, 1, 1); PG8_SCHED; PG8_LDA(At, 1, 0); PG8_STAGE(PG8_SA(0, 1), a2 + hstep, voffA);
            PG8_WAIT_V(8); PG8_WAIT_L(0); PG8_BAR; PG8_MMA(0, 0, At, B0); PG8_MMA(0, 1, At, B1); PG8_BAR; PG8_SCHED;
            PG8_LDA(At, 1, 1); PG8_STAGE(PG8_SB(1, 0), b3, voffB); PG8_STAGE(PG8_SB(1, 1), b3 + hstep, voffB); PG8_STAGE(PG8_SA(1, 0), a3, voffA);
            PG8_WAIT_V(8); PG8_WAIT_L(0); PG8_BAR; PG8_MMA(1, 0, At, B0); PG8_MMA(1, 1, At, B1); PG8_BAR; PG8_SCHED;
            }
            } else {
            PG8_LDB(B0, 0, 0); PG8_SCHED; PG8_LDA(At, 0, 0); PG8_STAGE(PG8_SA(1, 1), a1 + hstep, voffA);
            PG8_WAIT_L(8); PG8_BAR; PG8_WAIT_L(0); PG8_MMA(0, 0, At, B0); PG8_BAR; PG8_SCHED;
            PG8_LDB(B1, 0, 1); PG8_STAGE(PG8_SB(0, 0), b2, voffB);
            PG8_BAR; PG8_WAIT_L(0); PG8_MMA(0, 1, At, B1); PG8_BAR;
            PG8_LDA(At, 0, 1); PG8_STAGE(PG8_SA(0, 0), a2, voffA);
            PG8_BAR; PG8_WAIT_L(0); PG8_MMA(1, 0, At, B0); PG8_BAR; PG8_SCHED;
            PG8_STAGE(PG8_SB(0, 1), b2 + hstep, voffB);
            PG8_WAIT_V(6); PG8_BAR; PG8_MMA(1, 1, At, B1); PG8_BAR;
            PG8_LDB(B0, 1, 0); PG8_SCHED; PG8_LDA(At, 1, 0); PG8_STAGE(PG8_SA(0, 1), a2 + hstep, voffA);
            PG8_WAIT_L(8); PG8_BAR; PG8_WAIT_L(0); PG8_MMA(0, 0, At, B0); PG8_BAR; PG8_SCHED;
            PG8_LDB(B1, 1, 1); PG8_STAGE(PG8_SB(1, 0), b3, voffB);
            PG8_BAR; PG8_WAIT_L(0); PG8_MMA(0, 1, At, B1); PG8_BAR;
            PG8_LDA(At, 1, 1); PG8_STAGE(PG8_SA(1, 0), a3, voffA);
            PG8_BAR; PG8_WAIT_L(0); PG8_MMA(1, 0, At, B0); PG8_BAR; PG8_SCHED;
            PG8_STAGE(PG8_SB(1, 1), b3 + hstep, voffB);
            PG8_WAIT_V(6); PG8_BAR; PG8_MMA(1, 1, At, B1); PG8_BAR;
            }
        }
        if constexpr (ALIGN_EPI) { if (wr == 0) PG8_BAR; }
        if constexpr (!Epi::AFTER_DRAIN) { E(acc, cur, wr, wc, fr, fq); S.done(cur); }
        if (!has_next) break;
#pragma unroll
        for (int a = 0; a < 2; ++a)
#pragma unroll
            for (int b = 0; b < 2; ++b)
#pragma unroll
                for (int m = 0; m < 4; ++m)
#pragma unroll
                    for (int n = 0; n < 2; ++n) acc[a][b][m][n] = (f32x4){0.f, 0.f, 0.f, 0.f};
        cur = nxt; cA = nA; cB = nB; ++ui;
        if constexpr (ALIGN_EPI) { if (wr == 1) PG8_BAR; }
    }
    PG8_WAIT_V(0);
    if constexpr (!ALIGN_EPI) { if (wr == 0) PG8_BAR; }
    PG8_BAR;
    if constexpr (Epi::AFTER_DRAIN) { E.fused(acc, cur, wr, wc, fr, fq, lds, wid, lane); S.done(cur); }
#undef PG8_SA
#undef PG8_SB
#undef PG8_STAGE
#undef PG8_LDA
#undef PG8_LDB
#undef PG8_MMA
#undef PG8_WAIT_V
#undef PG8_WAIT_L
#undef PG8_BAR
#undef PG8_SCHED
}
}
namespace pg8 {
constexpr int HM_STAGE_BYTES = 9 * HTB;
template <class Epi>
__device__ __forceinline__ void gemm_half_unit(PG8_LAS unsigned char* lds, const Gemm g, const HUnit hu, const Epi& E) {
    int tid = threadIdx.x; asm volatile("" : "+v"(tid));
    const int wid = __builtin_amdgcn_readfirstlane(tid >> 6), lane = tid & 63, wr = wid >> 2, wc = wid & 3, fr = lane & 15, fq = lane >> 4;
    const int K = g.K, nt = K / BK;
    unsigned voffA[2], voffB[2];
#pragma unroll
    for (int i = 0; i < 2; ++i) { int R, C; stage_rc(tid * 16 + i * 8192, R, C); const int Rb = Epi::PERM ? ((R & ~31) + perm32(R & 31)) : R;
        voffA[i] = (unsigned)(R * K + C) * 2u; voffB[i] = (unsigned)(Rb * K + C) * 2u; }
    const size_t kstep = (size_t)(BK * 2);
    const size_t hstep = (size_t)HALF * K * 2;
    const unsigned ldsw = (unsigned)wid * 1024u;
    const int aoff = lds_byte(wr * 64 + fr, fq * 8), boff = lds_byte(wc * 32 + fr, fq * 8);
#define HM_SA(b) ((b) * 3 * HTB)
#define HM_SB(b, h) (((b) * 3 + 1 + (h)) * HTB)
#define HM_STAGE(bufoff, gbase, voff) do { _Pragma("unroll") for (int _i = 0; _i < 2; ++_i) \
        __builtin_amdgcn_global_load_lds((const unsigned*)((const char*)(gbase) + (voff)[_i]), (PG8_LAS unsigned*)(lds + (bufoff) + ldsw + _i * 8192), 16, 0, 0); } while (0)
#define HM_LDA(dst, b) do { _Pragma("unroll") for (int m = 0; m < 4; ++m) _Pragma("unroll") for (int k = 0; k < 2; ++k) dst[m][k] = *(const PG8_LAS bf16x8*)(lds + HM_SA(b) + aoff + m * 2048 + k * 1024); } while (0)
#define HM_LDB(dst, b, h) do { _Pragma("unroll") for (int n = 0; n < 2; ++n) _Pragma("unroll") for (int k = 0; k < 2; ++k) dst[n][k] = *(const PG8_LAS bf16x8*)(lds + HM_SB(b, h) + boff + n * 2048 + k * 1024); } while (0)
#define HM_MMA(bj, At, Bt) do { __builtin_amdgcn_s_setprio(PG8_PRIO_MMA); _Pragma("unroll") for (int m = 0; m < 4; ++m) _Pragma("unroll") for (int n = 0; n < 2; ++n) _Pragma("unroll") for (int k = 0; k < 2; ++k) \
        acc[bj][m][n] = __builtin_amdgcn_mfma_f32_16x16x32_bf16(Bt[n][k], At[m][k], acc[bj][m][n], 0, 0, 0); __builtin_amdgcn_s_setprio(PG8_PRIO_LOAD); } while (0)
#define HM_WAIT_V(n) asm volatile("s_waitcnt vmcnt(" #n ")" ::: "memory")
#define HM_WAIT_L(n) asm volatile("s_waitcnt lgkmcnt(" #n ")" ::: "memory")
#define HM_BAR __builtin_amdgcn_s_barrier()
#define HM_SCHED __builtin_amdgcn_sched_barrier(0)
    f32x4 acc[2][4][2];
#pragma unroll
    for (int b = 0; b < 2; ++b)
#pragma unroll
        for (int m = 0; m < 4; ++m)
#pragma unroll
            for (int n = 0; n < 2; ++n) acc[b][m][n] = (f32x4){0.f, 0.f, 0.f, 0.f};
    bf16x8 At[4][2], B0[2][2], B1[2][2];
    const char* cA = (const char*)g.A + (size_t)hu.pm2 * hstep; const char* cB = (const char*)g.Bt + (size_t)hu.pn * 2 * hstep;
    HM_STAGE(HM_SB(0, 0), cB, voffB); HM_STAGE(HM_SB(0, 1), cB + hstep, voffB); HM_STAGE(HM_SA(0), cA, voffA);
    HM_STAGE(HM_SB(1, 0), cB + kstep, voffB); HM_STAGE(HM_SB(1, 1), cB + hstep + kstep, voffB); HM_STAGE(HM_SA(1), cA + kstep, voffA);
    if (wr == 1) HM_BAR;
    HM_WAIT_V(6); HM_BAR; HM_BAR;
#define HM_SP(b, bn2, s) do { \
        HM_LDB(B0, b, 0); HM_LDB(B1, b, 1); HM_SCHED; HM_LDA(At, b); \
        if ((s) + 2 < nt) { const char* a2 = cA + (size_t)((s) + 2) * kstep; const char* b2 = cB + (size_t)((s) + 2) * kstep; \
            HM_STAGE(HM_SB(bn2, 0), b2, voffB); HM_STAGE(HM_SB(bn2, 1), b2 + hstep, voffB); HM_STAGE(HM_SA(bn2), a2, voffA); HM_WAIT_V(6); } \
        else { HM_WAIT_V(0); } \
        HM_WAIT_L(0); HM_BAR; HM_MMA(0, At, B0); HM_MMA(1, At, B1); HM_BAR; HM_SCHED; } while (0)
    for (int s = 0; s < nt; s += 3) {
        HM_SP(0, 2, s);
        if (s + 1 < nt) HM_SP(1, 0, s + 1);
        if (s + 2 < nt) HM_SP(2, 1, s + 2);
    }
    if (wr == 0) HM_BAR;
    E.half(acc, hu, wr, wc, fr, fq);
#undef HM_SA
#undef HM_SB
#undef HM_STAGE
#undef HM_LDA
#undef HM_LDB
#undef HM_MMA
#undef HM_WAIT_V
#undef HM_WAIT_L
#undef HM_BAR
#undef HM_SCHED
#undef HM_SP
}
}
namespace att {
typedef short bf16x8 __attribute__((ext_vector_type(8)));
typedef short s16x4 __attribute__((ext_vector_type(4)));
typedef float f32x16 __attribute__((ext_vector_type(16)));
typedef float f32x4 __attribute__((ext_vector_type(4)));
typedef unsigned u32x4 __attribute__((ext_vector_type(4)));
typedef int int4v __attribute__((ext_vector_type(4)));
typedef unsigned short bf16_t;
constexpr int SEQ = 2048, OPITCH = 1024;
constexpr int SLOTB = 8192, NSLOT = 4;
constexpr int LDS_K = 0, LDS_V = NSLOT * SLOTB, LDS_WS = 2 * NSLOT * SLOTB, LDS_OST = LDS_WS + 8 * 256, LDS_KMT = LDS_OST + 8 * 4096, LDS_END = LDS_KMT + 8 * 64 * 4;
typedef LAS const char* lds_cptr;
#define ATT_SBAR() __builtin_amdgcn_sched_barrier(0)
#define ATT_WAIT_BAR(N) asm volatile("s_waitcnt vmcnt(" #N ") lgkmcnt(0)\n\ts_barrier" ::: "memory")
__device__ __forceinline__ int crow(int r, int hi) { return (r & 3) + 8 * (r >> 2) + 4 * hi; }
__device__ __forceinline__ void glds16(const void* gsrc, unsigned lds_dst) { unsigned keep;
    asm volatile("s_mov_b32 %0, m0\n\ts_mov_b32 m0, %2\n\ts_nop 0\n\tglobal_load_lds_dwordx4 %1, off\n\ts_mov_b32 m0, %0" : "=&s"(keep) : "v"(gsrc), "s"(lds_dst) : "memory"); }
typedef float f32x2_t __attribute__((ext_vector_type(2))); typedef __bf16 bf16x2_t __attribute__((ext_vector_type(2)));
__device__ __forceinline__ unsigned cvtpk(float lo, float hi) { f32x2_t v = {lo, hi}; bf16x2_t b = __builtin_convertvector(v, bf16x2_t); return __builtin_bit_cast(unsigned, b); }
__device__ __forceinline__ float bf2f(short s) { return __builtin_bit_cast(float, (unsigned)(unsigned short)s << 16); }
__device__ __forceinline__ float partner(float x, int hi) {
    auto rr = __builtin_amdgcn_permlane32_swap(__builtin_bit_cast(unsigned, x), __builtin_bit_cast(unsigned, x), false, false);
    return __builtin_bit_cast(float, hi ? rr[0] : rr[1]);
}
typedef short v4i16_t __attribute__((ext_vector_type(4)));
__device__ __forceinline__ s16x4 vtr(lds_cptr p) { return __builtin_bit_cast(s16x4, __builtin_amdgcn_ds_read_tr16_b64_v4i16((LAS v4i16_t*)p)); }
__device__ __forceinline__ void vload16(s16x4* vlo, s16x4* vhi, lds_cptr vp) {
#pragma unroll
    for (int i = 0; i < 8; ++i) { vlo[i] = vtr(vp + ((i >> 2) * 4096 + (i & 3) * 1024)); vhi[i] = vtr(vp + ((i >> 2) * 4096 + (i & 3) * 1024 + 512)); }
}
__device__ __forceinline__ void pv_r(f32x16* o, const s16x4* vlo, const s16x4* vhi, bf16x8 pa0, bf16x8 pa1, bf16x8 pa2, bf16x8 pa3) {
#define ATT_VF(i) (bf16x8){vlo[i][0], vlo[i][1], vlo[i][2], vlo[i][3], vhi[i][0], vhi[i][1], vhi[i][2], vhi[i][3]}
    o[0] = __builtin_amdgcn_mfma_f32_32x32x16_bf16(pa0, ATT_VF(0), o[0], 0, 0, 0); o[1] = __builtin_amdgcn_mfma_f32_32x32x16_bf16(pa0, ATT_VF(4), o[1], 0, 0, 0);
    o[0] = __builtin_amdgcn_mfma_f32_32x32x16_bf16(pa1, ATT_VF(1), o[0], 0, 0, 0); o[1] = __builtin_amdgcn_mfma_f32_32x32x16_bf16(pa1, ATT_VF(5), o[1], 0, 0, 0);
    o[0] = __builtin_amdgcn_mfma_f32_32x32x16_bf16(pa2, ATT_VF(2), o[0], 0, 0, 0); o[1] = __builtin_amdgcn_mfma_f32_32x32x16_bf16(pa2, ATT_VF(6), o[1], 0, 0, 0);
    o[0] = __builtin_amdgcn_mfma_f32_32x32x16_bf16(pa3, ATT_VF(3), o[0], 0, 0, 0); o[1] = __builtin_amdgcn_mfma_f32_32x32x16_bf16(pa3, ATT_VF(7), o[1], 0, 0, 0);
#undef ATT_VF
}
__device__ __forceinline__ void qkt(f32x16& p0, f32x16& p1, lds_cptr kb, const bf16x8* qr) {
    const f32x16 z = {};
#pragma unroll
    for (int d0 = 0; d0 < 4; ++d0) {
        const bf16x8 b0 = *(const LAS bf16x8*)(kb + d0 * 2048);
        const bf16x8 b1 = *(const LAS bf16x8*)(kb + d0 * 2048 + 512);
        if (d0 == 0) { p0 = __builtin_amdgcn_mfma_f32_32x32x16_bf16(b0, qr[0], z, 0, 0, 0); p1 = __builtin_amdgcn_mfma_f32_32x32x16_bf16(b1, qr[0], z, 0, 0, 0); }
        else { p0 = __builtin_amdgcn_mfma_f32_32x32x16_bf16(b0, qr[d0], p0, 0, 0, 0); p1 = __builtin_amdgcn_mfma_f32_32x32x16_bf16(b1, qr[d0], p1, 0, 0, 0); }
    }
}
__device__ __forceinline__ void qkt_aug(f32x16& p0, f32x16& p1, lds_cptr kb, const bf16x8* qr, const f32x16& c, bf16x8 kaug0, bf16x8 kaug1, bf16x8 qaug) {
    p0 = __builtin_amdgcn_mfma_f32_32x32x16_bf16(kaug0, qaug, c, 0, 0, 0); p1 = __builtin_amdgcn_mfma_f32_32x32x16_bf16(kaug1, qaug, c, 0, 0, 0);
#pragma unroll
    for (int d0 = 0; d0 < 4; ++d0) {
        const bf16x8 b0 = *(const LAS bf16x8*)(kb + d0 * 2048);
        const bf16x8 b1 = *(const LAS bf16x8*)(kb + d0 * 2048 + 512);
        p0 = __builtin_amdgcn_mfma_f32_32x32x16_bf16(b0, qr[d0], p0, 0, 0, 0); p1 = __builtin_amdgcn_mfma_f32_32x32x16_bf16(b1, qr[d0], p1, 0, 0, 0);
    }
}
__device__ __forceinline__ void pv(f32x16* o, int vb, bf16x8 pa0, bf16x8 pa1, bf16x8 pa2, bf16x8 pa3) {
#pragma unroll
    for (int d0 = 0; d0 < 2; ++d0) { s16x4 lo[4], hi[4];
#pragma unroll
        for (int ks = 0; ks < 4; ++ks) {
            asm volatile("ds_read_b64_tr_b16 %0,%1 offset:%c2" : "=&v"(lo[ks]) : "v"(vb), "i"(d0 * 4096 + ks * 1024) : "memory");
            asm volatile("ds_read_b64_tr_b16 %0,%1 offset:%c2" : "=&v"(hi[ks]) : "v"(vb), "i"(d0 * 4096 + ks * 1024 + 512) : "memory"); }
        asm volatile("s_waitcnt lgkmcnt(0)" ::: "memory"); ATT_SBAR();
#define ATT_PK(k) (bf16x8){lo[k][0], lo[k][1], lo[k][2], lo[k][3], hi[k][0], hi[k][1], hi[k][2], hi[k][3]}
        o[d0] = __builtin_amdgcn_mfma_f32_32x32x16_bf16(pa0, ATT_PK(0), o[d0], 0, 0, 0);
        o[d0] = __builtin_amdgcn_mfma_f32_32x32x16_bf16(pa1, ATT_PK(1), o[d0], 0, 0, 0);
        o[d0] = __builtin_amdgcn_mfma_f32_32x32x16_bf16(pa2, ATT_PK(2), o[d0], 0, 0, 0);
        o[d0] = __builtin_amdgcn_mfma_f32_32x32x16_bf16(pa3, ATT_PK(3), o[d0], 0, 0, 0);
#undef ATT_PK
    }
}
template <bool MOBA>
__device__ __forceinline__ void attn_unit(const int b, const int h, const int qb, const bf16_t* __restrict__ QKV, const int pitch, const int koff, const int voff,
                                          bf16_t* __restrict__ O, LAS unsigned char* lds, const float* __restrict__ KMP, const float sl2, const unsigned force_sel = 0u) {
    int tid = threadIdx.x; asm volatile("" : "+v"(tid));
    const int lane = tid & 63, r32 = lane & 31, hi = lane >> 5;
    const int wid = __builtin_amdgcn_readfirstlane(tid >> 6);
    const long rowbase = (long)b * SEQ; const int q0 = qb * 256;
    const bf16_t* Qw = QKV + (rowbase + q0 + wid * 32) * pitch + h * 64;
    const bf16_t* Kh = QKV + rowbase * pitch + koff + h * 64;
    const bf16_t* Vh = QKV + rowbase * pitch + voff + h * 64;
    const unsigned lds0 = (unsigned)(uintptr_t)lds;
    const bf16_t* ksrc = Kh + (long)lane * pitch + wid * 8;
    const bf16_t* vsrc = Vh + (long)(16 * (wid & 3) + (lane >> 2)) * pitch + (wid >> 2) * 32 + (lane & 3) * 8;
    const unsigned kdst = lds0 + LDS_K + wid * 1024, vdst = lds0 + LDS_V + wid * 1024;
#define ATT_DMA_KV(t, slot) do { glds16(ksrc + (long)(t) * 64 * pitch, (unsigned)__builtin_amdgcn_readfirstlane(kdst + (slot))); \
                                 glds16(vsrc + (long)(t) * 64 * pitch, (unsigned)__builtin_amdgcn_readfirstlane(vdst + (slot))); } while (0)
    const int NT = 4 * qb + 4;
    const int tdiag = 4 * qb + (wid >> 1);
    LAS float* wsf = (LAS float*)(lds + LDS_WS) + wid * 64;
    const lds_cptr kp0 = (lds_cptr)lds + LDS_K + hi * 1024 + r32 * 16;
    const int vb0 = (int)(lds0 + LDS_V) + ((lane >> 4) & 1) * 32 + (lane & 3) * 8 + (4 * hi + ((lane & 15) >> 2)) * 64;
    ATT_DMA_KV(NT - 1, 0); ATT_DMA_KV(NT - 2, SLOTB);
    bf16x8 qr[4];
#pragma unroll
    for (int d0 = 0; d0 < 4; ++d0) qr[d0] = *(const bf16x8*)(Qw + (long)r32 * pitch + d0 * 16 + hi * 8);
    f32x16 o[2]; o[0] = f32x16{}; o[1] = f32x16{};
    const int qrel = wid * 32 + r32;
    float carry = 1.0f;
    float mhat = 0.f, lrow = 0.f; unsigned selmask = 0u;
    bf16x8 kaug0 = {0, 0, 0, 0, 0, 0, 0, 0}, kaug1 = {0, 0, 0, 0, 0, 0, 0, 0}, qaug = {0, 0, 0, 0, 0, 0, 0, 0};
    if constexpr (MOBA) {
        LAS float* kmt = (LAS float*)(lds + LDS_KMT);
        { const int n = tid >> 6, d = tid & 63;
          if (n < qb) { const float* kp = KMP + ((size_t)(b * 8 + n) * 2) * 1024 + h * 64 + d; kmt[n * 64 + d] = (kp[0] + kp[1024]) * (1.0f / 256.0f); } }
        asm volatile("s_waitcnt lgkmcnt(0)\n\ts_barrier" ::: "memory");
        float gate[7];
#pragma unroll
        for (int n = 0; n < 7; ++n) {
            float g = -INFINITY;
            if (n < qb) {
                float s = 0.f;
#pragma unroll
                for (int d0 = 0; d0 < 4; ++d0) {
                    const f32x4 k0 = *(const LAS f32x4*)(kmt + n * 64 + d0 * 16 + hi * 8), k1 = *(const LAS f32x4*)(kmt + n * 64 + d0 * 16 + hi * 8 + 4);
                    s += bf2f(qr[d0][0]) * k0[0] + bf2f(qr[d0][1]) * k0[1] + bf2f(qr[d0][2]) * k0[2] + bf2f(qr[d0][3]) * k0[3]
                       + bf2f(qr[d0][4]) * k1[0] + bf2f(qr[d0][5]) * k1[1] + bf2f(qr[d0][6]) * k1[2] + bf2f(qr[d0][7]) * k1[3];
                }
                g = s + partner(s, hi);
            }
            gate[n] = g;
        }
#pragma unroll
        for (int r = 0; r < 3; ++r) {
            int best = -1; float bv = -INFINITY;
#pragma unroll
            for (int n = 0; n < 7; ++n) { const bool taken = (selmask >> n) & 1u; if (!taken && gate[n] > bv) { best = n; bv = gate[n]; } }
            if (best >= 0) selmask |= 1u << best;
        }
        selmask |= (1u << qb) | force_sel;
        mhat = sl2 * (float)qrel;
        if (hi == 0) {
            const unsigned sh = __builtin_bit_cast(unsigned, sl2) + 0x7fffu + ((__builtin_bit_cast(unsigned, sl2) >> 16) & 1u), shb = sh >> 16;
            const float rem = sl2 - __builtin_bit_cast(float, shb << 16); const unsigned sl = (__builtin_bit_cast(unsigned, rem) + 0x7fffu + ((__builtin_bit_cast(unsigned, rem) >> 16) & 1u)) >> 16;
            qaug[0] = (short)shb; qaug[1] = (short)sl;
            const short k0s = (short)(__builtin_bit_cast(unsigned, (float)r32) >> 16), k1s = (short)(__builtin_bit_cast(unsigned, (float)(32 + r32)) >> 16);
            kaug0[0] = k0s; kaug0[1] = k0s; kaug1[0] = k1s; kaug1[1] = k1s;
        }
    }
    LAS int* done = (LAS int*)(lds + LDS_KMT);
    bool wdone = false;
    if constexpr (!MOBA) { if (lane == 0) done[wid] = 0x7fffffff; }
    const lds_cptr vp0 = (lds_cptr)lds + LDS_V + ((lane >> 4) & 1) * 32 + (lane & 3) * 8 + (4 * hi + ((lane & 15) >> 2)) * 64;
    int slot = 0;
    for (int i = 0; i < NT; ++i) {
        const int t = NT - 1 - i;
        const int nslot = (slot == (NSLOT - 1) * SLOTB) ? 0 : slot + SLOTB;
        const int n2slot = (nslot == (NSLOT - 1) * SLOTB) ? 0 : nslot + SLOTB;
        if (i + 2 < NT) { ATT_DMA_KV(t - 2, n2slot); ATT_WAIT_BAR(4); } else if (i + 1 < NT) { ATT_WAIT_BAR(2); } else { ATT_WAIT_BAR(0); }
        if constexpr (!MOBA) {
            const int4v d0v = *(const LAS int4v*)(done), d1v = *(const LAS int4v*)(done + 4);
            int dm = max(max(max(d0v[0], d0v[1]), max(d0v[2], d0v[3])), max(max(d1v[0], d1v[1]), max(d1v[2], d1v[3])));
            dm = __builtin_amdgcn_readfirstlane(dm);
            if (dm < i) break;
        }
        if (t <= tdiag && !wdone) {
            f32x16 p0, p1;
            u32x4 pw0 = {0u, 0u, 0u, 0u}, pw1 = pw0, pw2 = pw0, pw3 = pw0; bool dead = false;
            if constexpr (!MOBA) {
                qkt(p0, p1, kp0 + slot, qr);
                s16x4 vlo[8], vhi[8]; vload16(vlo, vhi, vp0 + slot);
                float om[32];
#pragma unroll
                for (int r = 0; r < 16; r += 2) {
                    f32x2_t e0 = {__builtin_amdgcn_exp2f(p0[r]), __builtin_amdgcn_exp2f(p0[r + 1])}, e1 = {__builtin_amdgcn_exp2f(p1[r]), __builtin_amdgcn_exp2f(p1[r + 1])};
                    const f32x2_t one2 = {1.0f, 1.0f}; e0 = e0 + one2; e1 = e1 + one2;
                    om[r] = __builtin_amdgcn_rcpf(e0.x); om[r + 1] = __builtin_amdgcn_rcpf(e0.y); om[16 + r] = __builtin_amdgcn_rcpf(e1.x); om[16 + r + 1] = __builtin_amdgcn_rcpf(e1.y);
                }
                if (t == tdiag) {
                    const int kb = 64 * (t - 4 * qb) + 4 * hi;
#pragma unroll
                    for (int r = 0; r < 16; ++r) { const int kv = kb + (r & 3) + 8 * (r >> 2);
                        if (kv >= qrel) om[r] = 1.0f; if (kv + 32 >= qrel) om[16 + r] = 1.0f; }
                }
                float xin0[8], xin1[8], xin2[8], gp[8], OS[9];
#pragma unroll
                for (int j = 0; j < 8; ++j) { xin2[j] = om[4 * j + 3]; xin1[j] = xin2[j] * om[4 * j + 2]; xin0[j] = xin1[j] * om[4 * j + 1]; gp[j] = xin0[j] * om[4 * j]; }
                OS[8] = 1.0f;
#pragma unroll
                for (int j = 7; j >= 0; --j) OS[j] = gp[j] * OS[j + 1];
                float oth[8];
#pragma unroll
                for (int j = 0; j < 8; ++j) {
                    auto rr = __builtin_amdgcn_permlane32_swap(__builtin_bit_cast(unsigned, OS[j]), __builtin_bit_cast(unsigned, OS[j + 1]), false, false);
                    oth[j] = __builtin_bit_cast(float, hi ? rr[0] : rr[1]);
                }
                float tot = OS[0] * oth[0];
                { auto rr = __builtin_amdgcn_permlane32_swap(__builtin_bit_cast(unsigned, tot), __builtin_bit_cast(unsigned, tot), false, false); tot = hi ? __builtin_bit_cast(float, rr[0]) : tot; }
                float av[32];
#pragma unroll
                for (int j = 0; j < 8; ++j) { const float xc = carry * (OS[j + 1] * oth[j]); const f32x2_t xc2 = {xc, xc};
                    const f32x2_t dlo = {xin0[j] - gp[j], xin1[j] - xin0[j]}, dhi = {xin2[j] - xin1[j], 1.0f - xin2[j]};
                    const f32x2_t alo = dlo * xc2, ahi = dhi * xc2;
                    av[4 * j] = alo.x; av[4 * j + 1] = alo.y; av[4 * j + 2] = ahi.x; av[4 * j + 3] = ahi.y; }
                carry *= tot;
                if (__all(carry == 0.0f)) { wdone = true; if (lane == 0) done[wid] = i; }
                pw0 = (u32x4){cvtpk(av[0], av[1]), cvtpk(av[2], av[3]), cvtpk(av[4], av[5]), cvtpk(av[6], av[7])};
                pw1 = (u32x4){cvtpk(av[8], av[9]), cvtpk(av[10], av[11]), cvtpk(av[12], av[13]), cvtpk(av[14], av[15])};
                pw2 = (u32x4){cvtpk(av[16], av[17]), cvtpk(av[18], av[19]), cvtpk(av[20], av[21]), cvtpk(av[22], av[23])};
                pw3 = (u32x4){cvtpk(av[24], av[25]), cvtpk(av[26], av[27]), cvtpk(av[28], av[29]), cvtpk(av[30], av[31])};
                pv_r(o, vlo, vhi, __builtin_bit_cast(bf16x8, pw0), __builtin_bit_cast(bf16x8, pw1), __builtin_bit_cast(bf16x8, pw2), __builtin_bit_cast(bf16x8, pw3));
            } else {
                const int blk = t >> 2;
                const bool sel = (selmask >> blk) & 1u;
                const float nv = sel ? (sl2 * (float)(64 * t - q0) - mhat) : -INFINITY;
                f32x16 c;
#pragma unroll
                for (int r = 0; r < 16; ++r) c[r] = nv;
                qkt_aug(p0, p1, kp0 + slot, qr, c, kaug0, kaug1, qaug);
                s16x4 vlo[8], vhi[8]; vload16(vlo, vhi, vp0 + slot);
                if (t == tdiag) {
                    const int kb = 64 * (t - 4 * qb) + 4 * hi;
#pragma unroll
                    for (int r = 0; r < 16; ++r) { const int kv = kb + (r & 3) + 8 * (r >> 2);
                        if (kv > qrel) p0[r] = -INFINITY; if (kv + 32 > qrel) p1[r] = -INFINITY; }
                }
                float a0 = __builtin_fmaxf(__builtin_fmaxf(p0[0], p0[1]), p0[2]), a1 = __builtin_fmaxf(__builtin_fmaxf(p1[0], p1[1]), p1[2]);
#pragma unroll
                for (int r = 3; r < 15; r += 2) { a0 = __builtin_fmaxf(__builtin_fmaxf(a0, p0[r]), p0[r + 1]); a1 = __builtin_fmaxf(__builtin_fmaxf(a1, p1[r]), p1[r + 1]); }
                float rm = __builtin_fmaxf(__builtin_fmaxf(a0, p0[15]), __builtin_fmaxf(a1, p1[15]));
                rm = __builtin_fmaxf(rm, partner(rm, hi));
                dead = __all(rm < -160.0f);
                if (!dead && __any(rm > 8.0f)) {
                    const float dl = __builtin_fmaxf(rm, 0.f);
                    mhat += dl;
#pragma unroll
                    for (int r = 0; r < 16; ++r) { p0[r] -= dl; p1[r] -= dl; }
                    const float f = __builtin_amdgcn_exp2f(-dl);
                    lrow *= f;
                    if (hi == 0) wsf[r32] = f;
                    asm volatile("s_waitcnt lgkmcnt(0)" ::: "memory");
#pragma unroll
                    for (int g4 = 0; g4 < 4; ++g4) { const f32x4 fv = *(const LAS f32x4*)(wsf + 8 * g4 + 4 * hi);
#pragma unroll
                        for (int i2 = 0; i2 < 4; ++i2) { o[0][4 * g4 + i2] *= fv[i2]; o[1][4 * g4 + i2] *= fv[i2]; } }
                    asm volatile("s_waitcnt lgkmcnt(0)" ::: "memory");
                }
                if (!dead) {
                float rs = 0.f;
#pragma unroll
                for (int r = 0; r < 16; ++r) { p0[r] = __builtin_amdgcn_exp2f(p0[r]); p1[r] = __builtin_amdgcn_exp2f(p1[r]); rs += p0[r] + p1[r]; }
                lrow += rs;
                pw0 = (u32x4){cvtpk(p0[0], p0[1]), cvtpk(p0[2], p0[3]), cvtpk(p0[4], p0[5]), cvtpk(p0[6], p0[7])};
                pw1 = (u32x4){cvtpk(p0[8], p0[9]), cvtpk(p0[10], p0[11]), cvtpk(p0[12], p0[13]), cvtpk(p0[14], p0[15])};
                pw2 = (u32x4){cvtpk(p1[0], p1[1]), cvtpk(p1[2], p1[3]), cvtpk(p1[4], p1[5]), cvtpk(p1[6], p1[7])};
                pw3 = (u32x4){cvtpk(p1[8], p1[9]), cvtpk(p1[10], p1[11]), cvtpk(p1[12], p1[13]), cvtpk(p1[14], p1[15])};
                pv_r(o, vlo, vhi, __builtin_bit_cast(bf16x8, pw0), __builtin_bit_cast(bf16x8, pw1), __builtin_bit_cast(bf16x8, pw2), __builtin_bit_cast(bf16x8, pw3));
                }
            }
        }
        slot = nslot;
    }
    if constexpr (!MOBA) asm volatile("s_waitcnt vmcnt(0)" ::: "memory");
    float rli[16];
    if constexpr (MOBA) {
        const float lt = lrow + partner(lrow, hi);
        if (hi == 0) wsf[32 + r32] = lt;
        asm volatile("s_waitcnt lgkmcnt(0)" ::: "memory");
#pragma unroll
        for (int g4 = 0; g4 < 4; ++g4) { const f32x4 lv = *(const LAS f32x4*)(wsf + 32 + 8 * g4 + 4 * hi);
#pragma unroll
            for (int i2 = 0; i2 < 4; ++i2) rli[4 * g4 + i2] = __builtin_amdgcn_rcpf(lv[i2]); }
    } else {
#pragma unroll
        for (int r = 0; r < 16; ++r) rli[r] = 1.0f;
    }
    {
        LAS bf16_t* stg = (LAS bf16_t*)(lds + LDS_OST) + wid * 2048;
#pragma unroll
        for (int r = 0; r < 16; ++r) { const int orow = crow(r, hi);
#pragma unroll
            for (int d0 = 0; d0 < 2; ++d0) stg[orow * 64 + d0 * 32 + r32] = (bf16_t)(cvtpk(o[d0][r] * rli[r], 0.f) & 0xffffu); }
        asm volatile("s_waitcnt lgkmcnt(0)" ::: "memory");
        bf16_t* Ow = O + (rowbase + q0 + wid * 32) * OPITCH + h * 64;
#pragma unroll
        for (int i = 0; i < 4; ++i) { const int row = i * 8 + (lane >> 3), ch = lane & 7; const u32x4 v = *(const LAS u32x4*)(stg + row * 64 + ch * 8); *(u32x4*)(Ow + (long)row * OPITCH + ch * 8) = v; }
    }
    asm volatile("s_waitcnt lgkmcnt(0)\n\ts_barrier" ::: "memory");
#undef ATT_DMA_KV
}
#undef ATT_SBAR
#undef ATT_WAIT_BAR
}
namespace exa {
using bf16=unsigned short;
using bf16x8=__attribute__((ext_vector_type(8)))short;
using s16x4=__attribute__((ext_vector_type(4)))short;
using f32x16=__attribute__((ext_vector_type(16)))float;
using u32x4=__attribute__((ext_vector_type(4)))unsigned;
constexpr int SEQ=2048,D=64,DM=3072;
constexpr int NW=8,QBLK=32,QB=QBLK*NW,KVBLK=64;
__device__ __forceinline__ int crow(int r,int hi){return (r&3)+8*(r>>2)+4*hi;}
#define SBAR() __builtin_amdgcn_sched_barrier(0)
__device__ __forceinline__ void cmask(f32x16&p0,f32x16&p1,int jb,int qrel,int hi){
  const float NEG=-INFINITY; int kb=64*jb+4*hi;
  #pragma unroll
  for(int r=0;r<16;++r){int kv=kb+(r&3)+8*(r>>2); if(kv>qrel)p0[r]=NEG; if(kv+32>qrel)p1[r]=NEG;}
}
constexpr int NSLOT=3, SLOTB=8192;
constexpr int LDS_K=0, LDS_V=NSLOT*SLOTB, LDS_WS=2*NSLOT*SLOTB, LDS_OST=LDS_WS+NW*64*4, LDS_BYTES=LDS_OST+NW*4096;
__device__ __forceinline__ void glds16(const void*gsrc,unsigned lds_dst){unsigned keep;
  asm volatile("s_mov_b32 %0, m0\n\ts_mov_b32 m0, %2\n\ts_nop 0\n\tglobal_load_lds_dwordx4 %1, off\n\ts_mov_b32 m0, %0":"=&s"(keep):"v"(gsrc),"s"(lds_dst):"memory");}
__device__ __forceinline__ float max3f(float a,float b,float c){float r;asm("v_max3_f32 %0, %1, %2, %3":"=v"(r):"v"(a),"v"(b),"v"(c));return r;}
__device__ __forceinline__ float max2f(float a,float b){float r;asm("v_max_f32_e32 %0, %1, %2":"=v"(r):"v"(a),"v"(b));return r;}
__device__ __forceinline__ float fadd_s(float a,float b){float r;asm("v_add_f32_e32 %0, %1, %2":"=v"(r):"v"(a),"v"(b));return r;}
__device__ __forceinline__ float fsub_s(float a,float b){float r;asm("v_sub_f32_e32 %0, %1, %2":"=v"(r):"v"(a),"v"(b));return r;}
typedef float f32x2_t __attribute__((ext_vector_type(2))); typedef __bf16 bf16x2_t __attribute__((ext_vector_type(2)));
__device__ __forceinline__ unsigned cvtpk_s(float lo,float hi){f32x2_t v={lo,hi};bf16x2_t b=__builtin_convertvector(v,bf16x2_t);return __builtin_bit_cast(unsigned,b);}
#define WAIT_BAR(N) asm volatile("s_waitcnt vmcnt(" #N ") lgkmcnt(0)\n\ts_barrier":::"memory")
typedef LAS const char* lds_cptr;
__device__ __forceinline__ void qkt(f32x16&p0,f32x16&p1,lds_cptr Kslot,const bf16x8*qr,const f32x16&negm,int r32,int hi){
  const lds_cptr kb=Kslot+hi*1024+r32*16;
  #pragma unroll
  for(int d0=0;d0<4;++d0){
    const bf16x8 b0=*(const LAS bf16x8*)(kb+d0*2048);
    const bf16x8 b1=*(const LAS bf16x8*)(kb+d0*2048+512);
    if(d0==0){p0=__builtin_amdgcn_mfma_f32_32x32x16_bf16(b0,qr[0],negm,0,0,0);p1=__builtin_amdgcn_mfma_f32_32x32x16_bf16(b1,qr[0],negm,0,0,0);}
    else{p0=__builtin_amdgcn_mfma_f32_32x32x16_bf16(b0,qr[d0],p0,0,0,0);p1=__builtin_amdgcn_mfma_f32_32x32x16_bf16(b1,qr[d0],p1,0,0,0);}}
}
typedef short v4i16_t __attribute__((ext_vector_type(4)));
__device__ __forceinline__ void kload8(bf16x8*kf,lds_cptr kp){
  kf[0]=*(const LAS bf16x8*)(kp);      kf[1]=*(const LAS bf16x8*)(kp+512);
  kf[2]=*(const LAS bf16x8*)(kp+2048); kf[3]=*(const LAS bf16x8*)(kp+2560);
  kf[4]=*(const LAS bf16x8*)(kp+4096); kf[5]=*(const LAS bf16x8*)(kp+4608);
  kf[6]=*(const LAS bf16x8*)(kp+6144); kf[7]=*(const LAS bf16x8*)(kp+6656);
}
__device__ __forceinline__ void kload2(bf16x8*kf,lds_cptr kp,int j){ kf[2*j]=*(const LAS bf16x8*)(kp+j*2048); kf[2*j+1]=*(const LAS bf16x8*)(kp+j*2048+512); }
__device__ __forceinline__ s16x4 vtr(lds_cptr p){ return __builtin_bit_cast(s16x4,__builtin_amdgcn_ds_read_tr16_b64_v4i16((LAS v4i16_t*)p)); }
__device__ __forceinline__ float rowmax(const f32x16&p0,const f32x16&p1){
  float a=max3f(p0[0],p0[1],p1[0]),b=max3f(p0[2],p0[3],p1[1]);a=max3f(a,p1[2],p1[3]);
  #pragma unroll
  for(int r=4;r<16;r+=4){a=max3f(a,p0[r],p0[r+1]);b=max3f(b,p0[r+2],p0[r+3]);a=max3f(a,p1[r],p1[r+1]);b=max3f(b,p1[r+2],p1[r+3]);}
  const float m=max2f(a,b);
  auto rr=__builtin_amdgcn_permlane32_swap(__float_as_uint(m),__float_as_uint(m),false,false);
  return max2f(__uint_as_float(rr[0]),__uint_as_float(rr[1]));
}
__device__ __forceinline__ void pv(f32x16*o,int vb,bf16x8 pa0,bf16x8 pa1,bf16x8 pa2,bf16x8 pa3){
  #pragma unroll
  for(int d0=0;d0<2;++d0){s16x4 lo[4],hi[4];
    #pragma unroll
    for(int ks=0;ks<4;++ks){
      asm volatile("ds_read_b64_tr_b16 %0,%1 offset:%c2":"=&v"(lo[ks]):"v"(vb),"i"(d0*4096+ks*1024):"memory");
      asm volatile("ds_read_b64_tr_b16 %0,%1 offset:%c2":"=&v"(hi[ks]):"v"(vb),"i"(d0*4096+ks*1024+512):"memory");}
    asm volatile("s_waitcnt lgkmcnt(0)":::"memory");SBAR();
    #define PK(k) (bf16x8){lo[k][0],lo[k][1],lo[k][2],lo[k][3],hi[k][0],hi[k][1],hi[k][2],hi[k][3]}
    o[d0]=__builtin_amdgcn_mfma_f32_32x32x16_bf16(pa0,PK(0),o[d0],0,0,0);
    o[d0]=__builtin_amdgcn_mfma_f32_32x32x16_bf16(pa1,PK(1),o[d0],0,0,0);
    o[d0]=__builtin_amdgcn_mfma_f32_32x32x16_bf16(pa2,PK(2),o[d0],0,0,0);
    o[d0]=__builtin_amdgcn_mfma_f32_32x32x16_bf16(pa3,PK(3),o[d0],0,0,0);
    #undef PK
  }
}
template<int THRL> __device__ __forceinline__ void attn_unit(int b,int h,int qb,const bf16*QKV,bf16*O,LAS unsigned char*shm,const float*KMP=nullptr,const float sl2=0.f,const unsigned force_sel=0u){
  int tid=threadIdx.x; asm volatile("":"+v"(tid)); const int lane=tid&63,r32=lane&31,hi=lane>>5; const int wid=__builtin_amdgcn_readfirstlane(tid>>6);
  const long rowbase=(long)b*SEQ; const int q0=qb*QB;
  const bf16*Qw=QKV+(rowbase+q0+wid*QBLK)*DM+h*D;
  const bf16*Kh=QKV+rowbase*DM+1024+h*D,*Vh=QKV+rowbase*DM+2048+h*D;
  const unsigned lds0=(unsigned)(uintptr_t)shm;
  LAS float*wsf=(LAS float*)(shm+LDS_WS)+wid*64;
  const bf16*ksrc=Kh+(long)lane*DM+wid*8;
  const bf16*vsrc=Vh+(long)(16*(wid&3)+(lane>>2))*DM+(wid>>2)*32+(lane&3)*8;
  const unsigned kdst=lds0+LDS_K+wid*1024, vdst=lds0+LDS_V+wid*1024;
  #define DMA_K(t,slot) glds16(ksrc+(long)(t)*KVBLK*DM,(unsigned)__builtin_amdgcn_readfirstlane(kdst+(slot)))
  #define DMA_V(t,slot) glds16(vsrc+(long)(t)*KVBLK*DM,(unsigned)__builtin_amdgcn_readfirstlane(vdst+(slot)))
  const int vb0=(int)(lds0+LDS_V)+((lane>>4)&1)*32+(lane&3)*8+(4*hi+((lane&15)>>2))*64;
  bf16x8 kf[8];
  const lds_cptr shm3=(lds_cptr)shm; const lds_cptr kp0=shm3+LDS_K+hi*1024+r32*16; const lds_cptr vp0=shm3+LDS_V+((lane>>4)&1)*32+(lane&3)*8+(4*hi+((lane&15)>>2))*64;
  const int NT=(q0+QB)/KVBLK;
  DMA_K(0,0);DMA_V(0,0);DMA_K(1,SLOTB);DMA_K(2,2*SLOTB);
  bf16x8 qr[4];
  #pragma unroll
  for(int d0=0;d0<4;++d0)qr[d0]=*reinterpret_cast<const bf16x8*>(&Qw[(long)r32*DM+d0*16+hi*8]);
#if defined(EXA_G1)
  unsigned selmask=0u; bf16x8 kaug0={0,0,0,0,0,0,0,0},kaug1={0,0,0,0,0,0,0,0},qaug={0,0,0,0,0,0,0,0};
  { LAS float*kmt=(LAS float*)(shm+LDS_BYTES);
    { const int n=tid>>6,d=tid&63; if(n<qb){ const float*kp=KMP+((size_t)(b*8+n)*2)*1024+h*64+d; kmt[n*64+d]=(kp[0]+kp[1024])*(1.0f/256.0f);} }
    asm volatile("s_waitcnt lgkmcnt(0)\n\ts_barrier":::"memory");
    float gate[7];
    #pragma unroll
    for(int n=0;n<7;++n){ float g=-INFINITY; if(n<qb){ float s=0.f;
        #pragma unroll
        for(int d0=0;d0<4;++d0){ const att::f32x4 k0=*(const LAS att::f32x4*)(kmt+n*64+d0*16+hi*8),k1=*(const LAS att::f32x4*)(kmt+n*64+d0*16+hi*8+4);
          s+=att::bf2f(qr[d0][0])*k0[0]+att::bf2f(qr[d0][1])*k0[1]+att::bf2f(qr[d0][2])*k0[2]+att::bf2f(qr[d0][3])*k0[3]+att::bf2f(qr[d0][4])*k1[0]+att::bf2f(qr[d0][5])*k1[1]+att::bf2f(qr[d0][6])*k1[2]+att::bf2f(qr[d0][7])*k1[3]; }
        g=s+att::partner(s,hi);} gate[n]=g; }
    #pragma unroll
    for(int r=0;r<3;++r){ int best=-1; float bv=-INFINITY;
      #pragma unroll
      for(int n=0;n<7;++n){ const bool taken=(selmask>>n)&1u; if(!taken&&gate[n]>bv){best=n;bv=gate[n];} }
      if(best>=0)selmask|=1u<<best; }
    selmask|=(1u<<qb)|force_sel;
    if(hi==0){ const unsigned sh=__float_as_uint(sl2)+0x7fffu+((__float_as_uint(sl2)>>16)&1u),shb=sh>>16; const float rem=sl2-__uint_as_float(shb<<16); const unsigned sl=(__float_as_uint(rem)+0x7fffu+((__float_as_uint(rem)>>16)&1u))>>16;
      qaug[0]=(short)shb; qaug[1]=(short)sl; const short k0s=(short)(__float_as_uint((float)r32)>>16),k1s=(short)(__float_as_uint((float)(32+r32))>>16); kaug0[0]=k0s;kaug0[1]=k0s;kaug1[0]=k1s;kaug1[1]=k1s; } }
  asm volatile(""::"v"(selmask),"v"(kaug0),"v"(kaug1),"v"(qaug));
#endif
  float mhat=0.f,l_reg=0.f;f32x16 o[2];o[0]=f32x16{};o[1]=f32x16{};f32x16 negm=f32x16{};asm volatile("":"+v"(negm));
  const int qrel=wid*QBLK+r32;
  #define CMASK(P0,P1,t) do{int jb_=(t)-(NT-4); if(jb_>=0)cmask(P0,P1,jb_,qrel,hi);}while(0)
  bool resc=false;
  #define START(P0,P1) do{ const float rm=rowmax(P0,P1); resc=false; \
    { const float dl=rm; mhat=fadd_s(mhat,dl); \
      _Pragma("unroll") for(int r=0;r<16;++r){P0[r]=fsub_s(P0[r],dl);P1[r]=fsub_s(P1[r],dl);} \
      _Pragma("unroll") for(int r=0;r<16;++r)negm[r]=-mhat; asm volatile("":"+v"(negm)); } \
    _Pragma("unroll") for(int r=0;r<16;++r)P0[r]=__builtin_amdgcn_exp2f(P0[r]); }while(0)
  #define RESC() do{ if(resc){ asm volatile("s_waitcnt lgkmcnt(0)":::"memory"); \
      _Pragma("unroll") for(int d_=0;d_<2;++d_) _Pragma("unroll") for(int r=0;r<16;++r)o[d_][r]*=wsf[crow(r,hi)]; } }while(0)
#if defined(EXA_G3)
  const float boff=-sl2*(float)(q0+qrel);
  #define SETNEGM(t) do{ const float nv_=((selmask>>((t)>>2))&1u)?(sl2*(float)(64*(t))+boff-mhat):-INFINITY; _Pragma("unroll") for(int r=0;r<16;++r)negm[r]=nv_; asm volatile("":"+v"(negm)); }while(0)
  #define NEGMUPD() do{}while(0)
#else
  #define SETNEGM(t) do{}while(0)
  #define NEGMUPD() do{ _Pragma("unroll") for(int r=0;r<16;++r)negm[r]=-mhat; asm volatile("":"+v"(negm)); }while(0)
#endif
  f32x16 pA0,pA1,pB0,pB1;
  int sl_prev=0,sl_cur=0,sl_next=SLOTB;
  #define ROT() do{sl_prev=sl_cur;sl_cur=sl_next;sl_next=(sl_next==(NSLOT-1)*SLOTB)?0:sl_next+SLOTB;}while(0)
  WAIT_BAR(3);
  SETNEGM(0);
#if defined(EXA_G2)
  { f32x16 a0_=__builtin_amdgcn_mfma_f32_32x32x16_bf16(kaug0,qaug,negm,0,0,0), a1_=__builtin_amdgcn_mfma_f32_32x32x16_bf16(kaug1,qaug,negm,0,0,0); qkt(pA0,pA1,(lds_cptr)shm+LDS_K,qr,negm,r32,hi);
    (void)a0_; (void)a1_; }
  {
    const lds_cptr kb=(lds_cptr)shm+LDS_K+hi*1024+r32*16;
    pA0=__builtin_amdgcn_mfma_f32_32x32x16_bf16(kaug0,qaug,negm,0,0,0); pA1=__builtin_amdgcn_mfma_f32_32x32x16_bf16(kaug1,qaug,negm,0,0,0);
    #pragma unroll
    for(int d0=0;d0<4;++d0){ const bf16x8 b0=*(const LAS bf16x8*)(kb+d0*2048); const bf16x8 b1=*(const LAS bf16x8*)(kb+d0*2048+512);
      pA0=__builtin_amdgcn_mfma_f32_32x32x16_bf16(b0,qr[d0],pA0,0,0,0); pA1=__builtin_amdgcn_mfma_f32_32x32x16_bf16(b1,qr[d0],pA1,0,0,0); }
  }
#else
  qkt(pA0,pA1,(lds_cptr)shm+LDS_K,qr,negm,r32,hi);
#endif
  asm volatile("s_nop 15\n\ts_nop 7":"+v"(pA0),"+v"(pA1));CMASK(pA0,pA1,0);
#if defined(EXA_G3)
  { const float rm=rowmax(pA0,pA1); if(__builtin_expect(__any(rm>(float)THRL),0)){ const float dl=__builtin_fmaxf(rm,0.f); mhat+=dl;
      #pragma unroll
      for(int r=0;r<16;++r){pA0[r]-=dl;pA1[r]-=dl;} } }
  #pragma unroll
  for(int r=0;r<16;++r)pA0[r]=__builtin_amdgcn_exp2f(pA0[r]);
#else
  START(pA0,pA1);
#endif
  _Pragma("unroll") for(int r=0;r<16;++r)pA1[r]=__builtin_amdgcn_exp2f(pA1[r]);
  WAIT_BAR(0);
  DMA_K(3,0);DMA_V(1,SLOTB);
  ROT();
  kload8(kf,kp0+sl_cur);
  WAIT_BAR(2);
  s16x4 vlo[8],vhi[8]; u32x4 pw0,pw1,pw2,pw3;
  #define PKW(P,B) cvtpk_s(P[B],P[B+1])
  #define PAF(k) __builtin_bit_cast(bf16x8,pw##k)
  #define VFR(i) (bf16x8){vlo[i][0],vlo[i][1],vlo[i][2],vlo[i][3],vhi[i][0],vhi[i][1],vhi[i][2],vhi[i][3]}
  #define PIN(x) asm volatile("":"+v"(x))
  #define MX3(a,b,c) __builtin_fmaxf(__builtin_fmaxf((a),(b)),(c))
  #define GAPA(MF,A0,A1,A2,A3,W0,W1,PW) do{ MF; sacc+=A0; sacc+=A1; sacc+=A2; sacc+=A3; PIN(sacc); W0; W1; PIN(PW); SBAR(); }while(0)
  #define EX(v) __builtin_amdgcn_exp2f(v)
  #define GAPB(MF,X,B) do{ MF; X[B]=EX(X[B]); X[B+1]=EX(X[B+1]); X[B+2]=EX(X[B+2]); X[B+3]=EX(X[B+3]); PIN(X); SBAR(); }while(0)
  #define VRD(i) do{ vlo[i]=vtr(vp_+(((i)>>2)*4096+((i)&3)*1024)); vhi[i]=vtr(vp_+(((i)>>2)*4096+((i)&3)*1024+512)); }while(0)
  #define KRD(G,j) do{ if(G){ kload2(kf,kp0+sl_next,j); SBAR(); } }while(0)
#if defined(EXA_G2)
  #define EXA_AUG(C0,C1) do{ C0=__builtin_amdgcn_mfma_f32_32x32x16_bf16(kaug0,qaug,negm,0,0,0); C1=__builtin_amdgcn_mfma_f32_32x32x16_bf16(kaug1,qaug,negm,0,0,0); SBAR(); }while(0)
  #define EXA_C0IN(C) C
#else
  #define EXA_AUG(C0,C1) do{}while(0)
  #define EXA_C0IN(C) negm
#endif
  #define STEP(C0,C1,P0,P1,t,GK,GV,GL) do{ SBAR(); \
    const lds_cptr vp_=vp0+sl_prev; \
    EXA_AUG(C0,C1); \
    VRD(0); SBAR(); float sacc=(P0[0]+P0[1]); \
    GAPA(C0=__builtin_amdgcn_mfma_f32_32x32x16_bf16(kf[0],qr[0],EXA_C0IN(C0),0,0,0), P0[2],P0[3],P0[4],P0[5],     pw0[0]=PKW(P0,0), pw0[1]=PKW(P0,2), pw0); \
    VRD(4); SBAR(); GAPA(C1=__builtin_amdgcn_mfma_f32_32x32x16_bf16(kf[1],qr[0],EXA_C0IN(C1),0,0,0), P0[6],P0[7],P0[8],P0[9],     pw0[2]=PKW(P0,4), pw0[3]=PKW(P0,6), pw0); \
    VRD(1); SBAR(); GAPA(C0=__builtin_amdgcn_mfma_f32_32x32x16_bf16(kf[2],qr[1],C0,0,0,0),   P0[10],P0[11],P0[12],P0[13], pw1[0]=PKW(P0,8), pw1[1]=PKW(P0,10), pw1); \
    VRD(5); SBAR(); GAPA(C1=__builtin_amdgcn_mfma_f32_32x32x16_bf16(kf[3],qr[1],C1,0,0,0),   P0[14],P0[15],P1[0],P1[1],   pw1[2]=PKW(P0,12),pw1[3]=PKW(P0,14), pw1); \
    VRD(2); SBAR(); GAPA(C0=__builtin_amdgcn_mfma_f32_32x32x16_bf16(kf[4],qr[2],C0,0,0,0),   P1[2],P1[3],P1[4],P1[5],     pw2[0]=PKW(P1,0), pw2[1]=PKW(P1,2), pw2); \
    VRD(6); SBAR(); GAPA(C1=__builtin_amdgcn_mfma_f32_32x32x16_bf16(kf[5],qr[2],C1,0,0,0),   P1[6],P1[7],P1[8],P1[9],     pw2[2]=PKW(P1,4), pw2[3]=PKW(P1,6), pw2); \
    VRD(3); SBAR(); GAPA(C0=__builtin_amdgcn_mfma_f32_32x32x16_bf16(kf[6],qr[3],C0,0,0,0),   P1[10],P1[11],P1[12],P1[13], pw3[0]=PKW(P1,8), pw3[1]=PKW(P1,10), pw3); \
    VRD(7); SBAR(); GAPA(C1=__builtin_amdgcn_mfma_f32_32x32x16_bf16(kf[7],qr[3],C1,0,0,0),   P1[14],P1[15],0.f,0.f,       pw3[2]=PKW(P1,12),pw3[3]=PKW(P1,14), pw3); \
    l_reg+=sacc; \
    if(GK){DMA_K((t)+3,sl_cur);} if(GV){DMA_V((t)+1,sl_next);} \
    CMASK(C0,C1,t); \
    { float a=MX3(C0[0],C0[1],C1[0]),b=MX3(C0[2],C0[3],C1[1]); a=MX3(a,C1[2],C1[3]); \
      _Pragma("unroll") for(int r=4;r<16;r+=4){a=MX3(a,C0[r],C0[r+1]);b=MX3(b,C0[r+2],C0[r+3]);a=MX3(a,C1[r],C1[r+1]);b=MX3(b,C1[r+2],C1[r+3]);} \
      float rm=__builtin_fmaxf(a,b); { auto rr=__builtin_amdgcn_permlane32_swap(__float_as_uint(rm),__float_as_uint(rm),false,false); rm=__builtin_fmaxf(__uint_as_float(rr[0]),__uint_as_float(rr[1])); } \
      resc=false; \
      if(__builtin_expect(__any(rm>(float)THRL),0)){ const float dl=__builtin_fmaxf(rm,0.f); mhat+=dl; \
        _Pragma("unroll") for(int r=0;r<16;++r){C0[r]-=dl;C1[r]-=dl;} \
        NEGMUPD(); \
        const float f=__builtin_amdgcn_exp2f(-dl); l_reg*=f; if(hi==0)wsf[r32]=f; resc=true; } } \
    SBAR(); \
    GAPB(o[0]=__builtin_amdgcn_mfma_f32_32x32x16_bf16(PAF(0),VFR(0),o[0],0,0,0), C0,0); \
    GAPB(o[1]=__builtin_amdgcn_mfma_f32_32x32x16_bf16(PAF(0),VFR(4),o[1],0,0,0), C0,4); \
    KRD(GL,0); GAPB(o[0]=__builtin_amdgcn_mfma_f32_32x32x16_bf16(PAF(1),VFR(1),o[0],0,0,0), C0,8); \
    KRD(GL,1); GAPB(o[1]=__builtin_amdgcn_mfma_f32_32x32x16_bf16(PAF(1),VFR(5),o[1],0,0,0), C0,12); \
    KRD(GL,2); GAPB(o[0]=__builtin_amdgcn_mfma_f32_32x32x16_bf16(PAF(2),VFR(2),o[0],0,0,0), C1,0); \
    KRD(GL,3); GAPB(o[1]=__builtin_amdgcn_mfma_f32_32x32x16_bf16(PAF(2),VFR(6),o[1],0,0,0), C1,4); \
    GAPB(o[0]=__builtin_amdgcn_mfma_f32_32x32x16_bf16(PAF(3),VFR(3),o[0],0,0,0), C1,8); \
    GAPB(o[1]=__builtin_amdgcn_mfma_f32_32x32x16_bf16(PAF(3),VFR(7),o[1],0,0,0), C1,12); \
    }while(0)
  int t=1;
  #undef CMASK
  #define CMASK(P0,P1,t) do{}while(0)
  for(;t+5<NT;t+=2){
    SETNEGM(t); STEP(pB0,pB1,pA0,pA1,t,true,true,true);     WAIT_BAR(2); RESC(); ROT();
    SETNEGM(t+1); STEP(pA0,pA1,pB0,pB1,t+1,true,true,true);   WAIT_BAR(2); RESC(); ROT();
  }
  #undef CMASK
  #define CMASK(P0,P1,t) do{int jb_=(t)-(NT-4); if(jb_>=0)cmask(P0,P1,jb_,qrel,hi);}while(0)
  #define ENDW(tt) do{ if((tt)+3<NT){WAIT_BAR(2);} else if((tt)+2<NT){WAIT_BAR(1);} else {WAIT_BAR(0);} }while(0)
  for(;t+1<NT;t+=2){
    SETNEGM(t); STEP(pB0,pB1,pA0,pA1,t,(t+3<NT),(t+1<NT),(t+1<NT));       ENDW(t);   RESC(); ROT();
    SETNEGM(t+1); STEP(pA0,pA1,pB0,pB1,t+1,(t+4<NT),(t+2<NT),(t+2<NT));     ENDW(t+1); RESC(); ROT();
  }
  SETNEGM(NT-1); STEP(pB0,pB1,pA0,pA1,NT-1,false,false,false); RESC();
  { float sacc=pB0[0]+pB0[1]; _Pragma("unroll") for(int r=2;r<16;++r)sacc+=pB0[r]; _Pragma("unroll") for(int r=0;r<16;++r)sacc+=pB1[r]; l_reg+=sacc;
    pw0=(u32x4){PKW(pB0,0),PKW(pB0,2),PKW(pB0,4),PKW(pB0,6)};pw1=(u32x4){PKW(pB0,8),PKW(pB0,10),PKW(pB0,12),PKW(pB0,14)};pw2=(u32x4){PKW(pB1,0),PKW(pB1,2),PKW(pB1,4),PKW(pB1,6)};pw3=(u32x4){PKW(pB1,8),PKW(pB1,10),PKW(pB1,12),PKW(pB1,14)};
    SBAR(); pv(o,vb0+sl_cur,PAF(0),PAF(1),PAF(2),PAF(3)); }
  #undef PKW
  #undef PAF
  #undef VFR
  #undef PIN
  #undef MX3
  #undef GAPA
  #undef GAPB
  #undef EX
  #undef VRD
  #undef KRD
  #undef STEP
  #undef ENDW
  {auto rr=__builtin_amdgcn_permlane32_swap(__float_as_uint(l_reg),__float_as_uint(l_reg),false,false);l_reg=__uint_as_float(rr[0])+__uint_as_float(rr[1]);}
  if(hi==0)wsf[32+r32]=l_reg;asm volatile("s_waitcnt lgkmcnt(0)":::"memory");
  float rli[16];
  #pragma unroll
  for(int r=0;r<16;++r)rli[r]=__builtin_amdgcn_rcpf(wsf[32+crow(r,hi)]);
  bf16*Ow=O+(rowbase+q0+wid*QBLK)*1024+h*D;
  { LAS bf16*stg=(LAS bf16*)(shm+LDS_OST)+wid*2048;
    #pragma unroll
    for(int r=0;r<16;++r){const int orow=crow(r,hi);
      #pragma unroll
      for(int d0=0;d0<2;++d0)stg[orow*64+d0*32+r32]=(bf16)(cvtpk_s(o[d0][r]*rli[r],0.f)&0xffffu);}
    asm volatile("s_waitcnt lgkmcnt(0)":::"memory");
    #pragma unroll
    for(int i=0;i<4;++i){const int row=i*8+(lane>>3),ch=lane&7; const u32x4 v=*(const LAS u32x4*)(stg+row*64+ch*8); *(u32x4*)(Ow+(long)row*1024+ch*8)=v;} }
  asm volatile("s_waitcnt lgkmcnt(0)\n\ts_barrier":::"memory");
  #undef DMA_K
  #undef DMA_V
  #undef CMASK
  #undef START
  #undef RESC
  #undef ROT
}

#undef SBAR
#undef WAIT_BAR
}
#define XB_TMO      128
#define XB_XCNT(j)  (256  + 64 * (j))
#define XB_XSUB(j)  (1280 + 64 * (j))
#define XB_XGEN(j)  (2304 + 64 * (j))
#define XB_TOP      3328
#define XB_TOPGEN   3392
#define XCD_BAR_WORDS 3456
#define XB_SPIN_CAP (1u << 18)

__device__ __forceinline__ unsigned xb_ld(unsigned* p)              { return __hip_atomic_load(p, __ATOMIC_RELAXED, __HIP_MEMORY_SCOPE_AGENT); }
__device__ __forceinline__ unsigned xb_add(unsigned* p, unsigned v) { return __hip_atomic_fetch_add(p, v, __ATOMIC_RELAXED, __HIP_MEMORY_SCOPE_AGENT); }
__device__ __forceinline__ unsigned xb_xcc_id() { return (unsigned)__builtin_amdgcn_s_getreg((3 << 11) | 20) & 0xFu; }
#define XB_SPIN(cond, bar) do { unsigned _sp = 0; while (cond) { __builtin_amdgcn_s_sleep(1); \
    if ((++_sp & 255u) == 0u) { if (xb_ld(&(bar)[XB_TMO])) break; if (_sp > XB_SPIN_CAP) { atomicAdd(&(bar)[XB_TMO], 1u); break; } } } } while (0)

struct XcdBarrier {
    unsigned* bar; unsigned x;
    volatile LAS unsigned* st;
};

__device__ __forceinline__ XcdBarrier xcd_barrier_post(unsigned* bar, volatile LAS unsigned* st) {
    XcdBarrier b; b.bar = bar; b.x = xb_xcc_id(); b.st = st;
    if (threadIdx.x == 0) (void)xb_add(&bar[XB_XCNT(b.x)], 1u);
    return b;
}
__device__ __forceinline__ void xcd_barrier_complete(unsigned* bar, unsigned x, unsigned& nloc, unsigned& nx) {
    const unsigned G = gridDim.x * gridDim.y * gridDim.z;
    unsigned sum, cnt, mine, sp = 0u;
    for (;;) {
        sum = 0u; cnt = 0u; mine = 0u;
#pragma unroll
        for (unsigned j = 0; j < 16; ++j) { const unsigned c = xb_ld(&bar[XB_XCNT(j)]); sum += c; cnt += (c > 0u) ? 1u : 0u; mine = (j == x) ? c : mine; }
        if (sum == G) break;
        __builtin_amdgcn_s_sleep(1);
        if ((++sp & 255u) == 0u) { if (xb_ld(&bar[XB_TMO])) break; if (sp > XB_SPIN_CAP) { atomicAdd(&bar[XB_TMO], 1u); break; } }
    }
    nloc = mine > 0u ? mine : 1u; nx = cnt > 0u ? cnt : 1u;
}

__device__ __forceinline__ void xcd_barrier(const XcdBarrier& b) {
    asm volatile("s_waitcnt vmcnt(0)" ::: "memory");
    __syncthreads();
    if (threadIdx.x == 0) {
        unsigned* bar = b.bar;
        __builtin_amdgcn_s_waitcnt(0);
        unsigned nloc = b.st[0], nx = b.st[1];
        if (nloc == 0u) { xcd_barrier_complete(bar, b.x, nloc, nx); b.st[0] = nloc; b.st[1] = nx; }
        const unsigned old = xb_add(&bar[XB_XSUB(b.x)], 1u);
        const unsigned gen = old / nloc;
        if (old + 1u == (gen + 1u) * nloc) {
            __builtin_amdgcn_fence(__ATOMIC_RELEASE, "agent");
            asm volatile("s_waitcnt vmcnt(0)" ::: "memory");
            const unsigned og = xb_add(&bar[XB_TOP], 1u);
            const unsigned tg = og / nx;
            if (og + 1u == (tg + 1u) * nx) xb_add(&bar[XB_TOPGEN], 1u);
            else XB_SPIN(xb_ld(&bar[XB_TOPGEN]) == tg, bar);
            __builtin_amdgcn_fence(__ATOMIC_ACQUIRE, "agent");
            xb_add(&bar[XB_XGEN(b.x)], 1u);
            asm volatile("s_waitcnt vmcnt(0)" ::: "memory");
        } else {
            XB_SPIN(xb_ld(&bar[XB_XGEN(b.x)]) == gen, bar);
            __builtin_amdgcn_fence(__ATOMIC_ACQUIRE, "agent");
            asm volatile("s_waitcnt vmcnt(0)" ::: "memory");
        }
    }
    __syncthreads();
}
#ifndef DBG_MASK
#define DBG_MASK 255
#endif
#ifndef GEMM_XDMA
#define GEMM_XDMA false
#endif
#ifndef GU_ALIGN
#define GU_ALIGN true
#endif
#ifndef DUP_MASK
#define DUP_MASK 0
#endif
#define NREP(bit) ((DUP_MASK & (bit)) ? 2 : 1)
constexpr int NWAVES = 8;
constexpr int NBATCH = 8, SEQ = 2048, D = 1024, FF = 2816, M = NBATCH * SEQ, DEPTH = 4;
constexpr int N_PHASES = 2 + 7 * DEPTH;
constexpr float QSCALE = 0.125f * 1.4426950408889634f;
typedef unsigned short bf16;
typedef float f32x4 __attribute__((ext_vector_type(4)));
typedef unsigned v4u __attribute__((ext_vector_type(4)));
typedef GAS unsigned gu32;
#define RLX_AGENT __ATOMIC_RELAXED, __HIP_MEMORY_SCOPE_AGENT
constexpr size_t MiB = 1u << 20;
constexpr size_t WS_CTL = 0, CTL_ZERO_BYTES = 1 * MiB;
constexpr size_t WS_WGU = 1 * MiB;
constexpr size_t WS_WD = 89 * MiB;
constexpr size_t WS_WIN_E = 133 * MiB;
constexpr size_t WS_WOUT_E = 141 * MiB;
constexpr size_t WS_WQKV_O = 145 * MiB;
constexpr size_t WS_WO_O = 157 * MiB;
constexpr size_t WS_XB = 161 * MiB;
constexpr size_t WS_SS = 193 * MiB;
constexpr size_t WS_KMP = 194 * MiB;
constexpr size_t WS_QKV = 195 * MiB;
constexpr size_t WS_O = 291 * MiB;
constexpr size_t WS_END = 323 * MiB;
constexpr size_t WGU_BYTES = (size_t)2 * FF * D * 2, WD_BYTES = (size_t)D * FF * 2;
static_assert(WS_WGU + 8 * WGU_BYTES <= WS_WD && WS_WD + 8 * WD_BYTES <= WS_WIN_E && WS_QKV + (size_t)M * 3072 * 2 <= WS_O && WS_O + (size_t)M * D * 2 <= WS_END, "d_ws map");
constexpr int CW_BAR = 4096;
constexpr int RING_OFF = 0, RING_BYTES = 131072;
constexpr int P0_TS = 65, P0_SCR_BYTES = 64 * P0_TS * 4;
constexpr int LDSCTL_OFF = pg8::HM_STAGE_BYTES, MISC_OFF = LDSCTL_OFF + 320;
constexpr int LDS_BYTES = LDSCTL_OFF + 1024;
static_assert(att::LDS_END <= RING_BYTES && exa::LDS_BYTES + 2048 <= RING_BYTES && MISC_OFF + 128 <= LDS_BYTES && 8 * P0_SCR_BYTES <= LDSCTL_OFF && LDS_BYTES <= 160 * 1024, "LDS map");

__device__ __forceinline__ unsigned f2bf(float f) { unsigned u = __builtin_bit_cast(unsigned, f); return (u + 0x7fffu + ((u >> 16) & 1u)) >> 16; }
__device__ __forceinline__ unsigned pk2(float lo, float hi) { return att::cvtpk(lo, hi); }
__device__ __forceinline__ float wave_sum(float v) {
#pragma unroll
    for (int o = 1; o < 64; o <<= 1) v += __shfl_xor(v, o);
    return v;
}
#define LDS_WAIT() asm volatile("s_waitcnt lgkmcnt(0)" ::: "memory")
#define VM_WAIT() asm volatile("s_waitcnt vmcnt(0)" ::: "memory")

__device__ __forceinline__ void p0_write_tile(bf16* WT, int K, int dst_row0, int k0, LAS float* scr, int lane) {
    LDS_WAIT(); asm volatile("" ::: "memory");
    const int c = lane & 7, nn = lane >> 3;
#pragma unroll
    for (int j = 0; j < 8; ++j) { const int n = nn + 8 * j; const LAS float* s = scr + (8 * c) * P0_TS + n;
        v4u o; o.x = pk2(s[0 * P0_TS], s[1 * P0_TS]); o.y = pk2(s[2 * P0_TS], s[3 * P0_TS]); o.z = pk2(s[4 * P0_TS], s[5 * P0_TS]); o.w = pk2(s[6 * P0_TS], s[7 * P0_TS]);
        *(GAS v4u*)(WT + (size_t)(dst_row0 + n) * K + k0 + 8 * c) = o; }
    LDS_WAIT(); asm volatile("" ::: "memory");
}
#if defined(P0_NT)
#define P0_LOADW(p) __builtin_nontemporal_load(p)
#else
#define P0_LOADW(p) (*(p))
#endif
struct P0Item { const float* W; const float* gain; bf16* WT; int ldw, K, dst_row0, k0, n0; };
__device__ __forceinline__ void p0_item_load(const P0Item& d, f32x4 (&v)[16], float (&g)[16], int lane) {
    const int q = lane >> 4, p = lane & 15;
#pragma unroll
    for (int i = 0; i < 16; ++i) { v[i] = P0_LOADW((const GAS f32x4*)(d.W + (size_t)(d.k0 + 4 * i + q) * d.ldw + d.n0 + 4 * p)); g[i] = d.gain ? d.gain[d.k0 + 4 * i + q] : 1.0f; }
}
__device__ __forceinline__ void p0_item_finish(const P0Item& d, const f32x4 (&v)[16], const float (&g)[16], LAS float* scr, int lane) {
    const int q = lane >> 4, p = lane & 15;
#pragma unroll
    for (int i = 0; i < 16; ++i) { LAS float* dd = scr + (4 * i + q) * P0_TS + 4 * p; dd[0] = v[i][0] * g[i]; dd[1] = v[i][1] * g[i]; dd[2] = v[i][2] * g[i]; dd[3] = v[i][3] * g[i]; }
    p0_write_tile(d.WT, d.K, d.dst_row0, d.k0, scr, lane);
}
typedef const float __attribute__((address_space(4))) cfloat_t;
__device__ __forceinline__ void p0_fold_sub(const float* Win  , const float* Wp  , const float* pscale  , const float* gain, bf16* WT, int k0, int n0, int lane) {
    const int g = n0 >> 7, d = (n0 & 127) + lane;
    const float* wpb = Wp + (size_t)g * 128 * 128 + d;
    cfloat_t* wrow = (cfloat_t*)(Win + (size_t)k0 * 2048 + 1536 + g * 128);
    cfloat_t* gk = (cfloat_t*)(gain + k0);
    float acc[8];
#pragma unroll
    for (int k = 0; k < 8; ++k) acc[k] = 0.f;
#pragma unroll 1
    for (int c0 = 0; c0 < 128; c0 += 32) {
        float wp[32];
#pragma unroll
        for (int c = 0; c < 32; ++c) wp[c] = wpb[(size_t)(c0 + c) * 128];
#pragma unroll
        for (int k = 0; k < 8; ++k)
#pragma unroll
            for (int c = 0; c < 32; ++c) acc[k] = __builtin_fmaf(wrow[(size_t)k * 2048 + c0 + c], wp[c], acc[k]);
    }
    const float ps = pscale[g * 128 + d];
    v4u o; o.x = pk2(acc[0] * ps * gk[0], acc[1] * ps * gk[1]); o.y = pk2(acc[2] * ps * gk[2], acc[3] * ps * gk[3]); o.z = pk2(acc[4] * ps * gk[4], acc[5] * ps * gk[5]); o.w = pk2(acc[6] * ps * gk[6], acc[7] * ps * gk[7]);
    *(GAS v4u*)(WT + (size_t)(1536 + n0 + lane) * 1024 + k0) = o;
}

struct Args { const float* in[17]; float* out; unsigned char* ws; int ph_lo, ph_hi; };

__device__ __forceinline__ void p0_prologue(const Args& a, unsigned char* ws, LAS unsigned char* lds, int vcu, int G, int wave, int lane) {
    LAS float* scr = (LAS float*)(lds + wave * P0_SCR_BYTES);
    const int gw = vcu * NWAVES + wave, NGW = G * NWAVES;
    constexpr int I_GU = 16 * 44, I_DN = 44 * 16, I_EIN = 16 * 24, I_EFO = 16 * 8, I_SQ = 16 * 16, I_OQKV = 16 * 48;
    constexpr int S_G = 0, S_U = S_G + 8 * I_GU, S_D = S_U + 8 * I_GU, S_EIN = S_D + 8 * I_DN, S_EOUT = S_EIN + 2 * I_EIN, S_OQKV = S_EOUT + 2 * I_SQ, S_OO = S_OQKV + 2 * I_OQKV, NITEMS = S_OO + 2 * I_SQ;
    auto decode = [&](int it) -> P0Item {
        P0Item d;
        if (it < S_D) {
            const bool up = it >= S_U; const int r0 = it - (up ? S_U : S_G), f = r0 / I_GU, r = r0 % I_GU, layer = f >> 1, half = f & 1, kb = r / 44, nb = r % 44, n0 = 64 * nb;
            d.W = a.in[half ? (up ? 8 : 7) : (up ? 3 : 2)] + (size_t)layer * D * FF; d.gain = a.in[half ? 6 : 1] + layer * D; d.WT = (bf16*)(ws + WS_WGU + (size_t)f * WGU_BYTES);
            d.ldw = FF; d.K = D; d.dst_row0 = (n0 >> 7) * 256 + (up ? 128 : 0) + (n0 & 127); d.k0 = 64 * kb; d.n0 = n0;
        } else if (it < S_EIN) {
            const int r0 = it - S_D, f = r0 / I_DN, r = r0 % I_DN, layer = f >> 1, half = f & 1, kb = r / 16, nb = r % 16;
            d.W = a.in[half ? 9 : 4] + (size_t)layer * FF * D; d.gain = nullptr; d.WT = (bf16*)(ws + WS_WD + (size_t)f * WD_BYTES); d.ldw = D; d.K = FF; d.dst_row0 = 64 * nb; d.k0 = 64 * kb; d.n0 = 64 * nb;
        } else if (it < S_EOUT) {
            const int r0 = it - S_EIN, i = r0 / I_EIN, r = r0 % I_EIN, kb = r / 24, nb = r % 24;
            d.W = a.in[10] + (size_t)i * D * 2048; d.gain = a.in[5] + (2 * i) * D; d.WT = (bf16*)(ws + WS_WIN_E + (size_t)i * 2048 * D * 2); d.ldw = 2048; d.K = D; d.dst_row0 = 64 * nb; d.k0 = 64 * kb; d.n0 = 64 * nb;
        } else if (it < S_OQKV) {
            const int r0 = it - S_EOUT, i = r0 / I_SQ, r = r0 % I_SQ, kb = r / 16, nb = r % 16;
            d.W = a.in[13] + (size_t)i * D * D; d.gain = nullptr; d.WT = (bf16*)(ws + WS_WOUT_E + (size_t)i * D * D * 2); d.ldw = D; d.K = D; d.dst_row0 = 64 * nb; d.k0 = 64 * kb; d.n0 = 64 * nb;
        } else if (it < S_OO) {
            const int r0 = it - S_OQKV, i = r0 / I_OQKV, r = r0 % I_OQKV, kb = r / 48, nb = r % 48;
            d.W = a.in[14] + (size_t)i * D * 3072; d.gain = a.in[5] + (2 * i + 1) * D; d.WT = (bf16*)(ws + WS_WQKV_O + (size_t)i * 3072 * D * 2); d.ldw = 3072; d.K = D; d.dst_row0 = 64 * nb; d.k0 = 64 * kb; d.n0 = 64 * nb;
        } else {
            const int r0 = it - S_OO, i = r0 / I_SQ, r = r0 % I_SQ, kb = r / 16, nb = r % 16;
            d.W = a.in[15] + (size_t)i * D * D; d.gain = nullptr; d.WT = (bf16*)(ws + WS_WO_O + (size_t)i * D * D * 2); d.ldw = D; d.K = D; d.dst_row0 = 64 * nb; d.k0 = 64 * kb; d.n0 = 64 * nb;
        }
        return d;
    };
    if (gw < NITEMS) {
        P0Item cur = decode(gw); f32x4 v[16]; float g[16];
        p0_item_load(cur, v, g, lane);
        for (int it = gw; it < NITEMS; it += NGW) {
            const bool more = it + NGW < NITEMS;
            P0Item nxt = cur; f32x4 v2[16]; float g2[16];
            if (more) { nxt = decode(it + NGW); p0_item_load(nxt, v2, g2, lane); }
            p0_item_finish(cur, v, g, scr, lane);
            if (more) { cur = nxt;
#pragma unroll
                for (int i = 0; i < 16; ++i) { v[i] = v2[i]; g[i] = g2[i]; } }
        }
    }
#if defined(P0_FOLD_DUP)
    for (int rep_ = 0; rep_ < P0_FOLD_DUP; ++rep_)
#endif
    for (int s0 = gw; s0 < 2 * 128 * 8; s0 += NGW) {
        const int i = s0 >> 10, r = s0 & 1023, kb = r >> 3, nb = r & 7;
        p0_fold_sub(a.in[10] + (size_t)i * D * 2048, a.in[11] + (size_t)i * 4 * 128 * 128, a.in[12] + i * 512, a.in[5] + (2 * i) * D, (bf16*)(ws + WS_WIN_E + (size_t)i * 2048 * D * 2), 8 * kb, 64 * nb, lane);
    }
    const float* x = a.in[0]; bf16* XB = (bf16*)(ws + WS_XB); float* SS = (float*)(ws + WS_SS);
#if defined(P0_XB_DUP)
    for (int rep_ = 0; rep_ < P0_XB_DUP; ++rep_)
#endif
    {
        f32x4 v[4];
        if (gw < M) { const GAS f32x4* xr = (const GAS f32x4*)(x + (size_t)gw * D) + lane;
#pragma unroll
            for (int j = 0; j < 4; ++j) v[j] = xr[64 * j]; }
        for (int m = gw; m < M; m += NGW) {
            f32x4 vn[4];
            if (m + NGW < M) { const GAS f32x4* xr = (const GAS f32x4*)(x + (size_t)(m + NGW) * D) + lane;
#pragma unroll
                for (int j = 0; j < 4; ++j) vn[j] = xr[64 * j]; }
            float s = 0.f;
#pragma unroll
            for (int j = 0; j < 4; ++j) s += (v[j].x * v[j].x + v[j].y * v[j].y) + (v[j].z * v[j].z + v[j].w * v[j].w);
            s = wave_sum(s);
            GAS unsigned long long* o8 = (GAS unsigned long long*)(XB + (size_t)m * D) + lane;
#pragma unroll
            for (int j = 0; j < 4; ++j) o8[64 * j] = (unsigned long long)pk2(v[j].x, v[j].y) | ((unsigned long long)pk2(v[j].z, v[j].w) << 32);
            if (lane < 16) SS[(size_t)m * 16 + lane] = (lane == 0) ? s : 0.f;
            if (m + NGW < M) {
#pragma unroll
                for (int j = 0; j < 4; ++j) v[j] = vn[j]; }
        }
    }
}
__device__ __forceinline__ void pool_rows(const bf16* QKV, bf16* O, int vcu, int G, int tid) {
    asm volatile("" : "+v"(tid));
    const int cc = tid & 63, rg = tid >> 6, g = cc >> 4, w = 2 << g;
    for (int R0 = vcu * 64; R0 < M; R0 += G * 64) {
#pragma unroll 1
        for (int rr = 0; rr < 8; ++rr) {
            const int row = R0 + rg * 8 + rr, t = row & (SEQ - 1);
            const int cnt = (t + 1) < w ? (t + 1) : w;
            float s[8];
#pragma unroll
            for (int e = 0; e < 8; ++e) s[e] = 0.f;
            v4u cur = {0u, 0u, 0u, 0u};
            for (int i = 0; i < cnt; ++i) {
                const v4u v = *(const v4u*)(QKV + (size_t)(row - i) * 2048 + 1536 + cc * 8);
                if (i == 0) cur = v;
                s[0] += __builtin_bit_cast(float, v.x << 16); s[1] += __builtin_bit_cast(float, v.x & 0xffff0000u);
                s[2] += __builtin_bit_cast(float, v.y << 16); s[3] += __builtin_bit_cast(float, v.y & 0xffff0000u);
                s[4] += __builtin_bit_cast(float, v.z << 16); s[5] += __builtin_bit_cast(float, v.z & 0xffff0000u);
                s[6] += __builtin_bit_cast(float, v.w << 16); s[7] += __builtin_bit_cast(float, v.w & 0xffff0000u);
            }
            const float rc = 1.0f / (float)cnt;
            v4u o;
            o.x = pk2(s[0] * rc - __builtin_bit_cast(float, cur.x << 16), s[1] * rc - __builtin_bit_cast(float, cur.x & 0xffff0000u));
            o.y = pk2(s[2] * rc - __builtin_bit_cast(float, cur.y << 16), s[3] * rc - __builtin_bit_cast(float, cur.y & 0xffff0000u));
            o.z = pk2(s[4] * rc - __builtin_bit_cast(float, cur.z << 16), s[5] * rc - __builtin_bit_cast(float, cur.z & 0xffff0000u));
            o.w = pk2(s[6] * rc - __builtin_bit_cast(float, cur.w << 16), s[7] * rc - __builtin_bit_cast(float, cur.w & 0xffff0000u));
            *(v4u*)(O + (size_t)row * 1024 + 512 + cc * 8) = o;
        }
    }
}
__device__ __forceinline__ void final_norm(const bf16* XBs, float* out, const float* SS, const float* gfin, int vcu, int G, int wave, int lane) {
    const int gw = vcu * NWAVES + wave, NGW = G * NWAVES;
    f32x4 gv[2][2];
#pragma unroll
    for (int j = 0; j < 2; ++j) { gv[j][0] = *(const f32x4*)(gfin + 512 * j + 8 * lane); gv[j][1] = *(const f32x4*)(gfin + 512 * j + 8 * lane + 4); }
    for (int m = gw; m < M; m += NGW) {
        float s = (lane < 16) ? SS[(size_t)m * 16 + lane] : 0.f;
        s = wave_sum(s);
        const float r = 1.0f / sqrtf(s * (1.0f / D) + 1e-6f);
#pragma unroll
        for (int j = 0; j < 2; ++j) {
            const v4u b = *(const GAS v4u*)(XBs + (size_t)m * D + 512 * j + 8 * lane);
            const f32x4 x0 = {__builtin_bit_cast(float, b.x << 16), __builtin_bit_cast(float, b.x & 0xffff0000u), __builtin_bit_cast(float, b.y << 16), __builtin_bit_cast(float, b.y & 0xffff0000u)};
            const f32x4 x1 = {__builtin_bit_cast(float, b.z << 16), __builtin_bit_cast(float, b.z & 0xffff0000u), __builtin_bit_cast(float, b.w << 16), __builtin_bit_cast(float, b.w & 0xffff0000u)};
            GAS f32x4* o = (GAS f32x4*)(out + (size_t)m * D + 512 * j + 8 * lane);
            o[0] = x0 * r * gv[j][0]; o[1] = x1 * r * gv[j][1];
        }
    }
}

#if defined(CMP_PROBE)
__device__ __forceinline__ void cmp_unit(const bf16* A, const bf16* B, int b, int h, int qb, int cls, gu32* word, int tid) {
    asm volatile("" : "+v"(tid));
    __threadfence(); __syncthreads();
    unsigned bucket = 0u;
    if (tid < 256) {
        float se = 0.f, sx = 0.f;
        for (int c = 0; c < 64; ++c) { const size_t idx = ((size_t)b * SEQ + qb * 256 + tid) * 1024 + h * 64 + c;
            const float x = __builtin_bit_cast(float, (unsigned)A[idx] << 16), y = __builtin_bit_cast(float, (unsigned)B[idx] << 16);
            se += (x - y) * (x - y); sx += x * x; }
        const float rel = sqrtf(se / (sx + 1e-12f));
#if defined(CMP_BUCKETS)
        if (rel > 0.02f) bucket |= 4u; if (rel > 0.05f) bucket |= 8u; if (rel > 0.15f) bucket |= 16u; if (rel > 0.5f) bucket |= 32u; if (rel > 1.5f) bucket |= 64u; if (!(rel == rel)) bucket |= 128u;
#else
        if (!(rel <= CMP_RTOL)) bucket |= 1u << cls;
#endif
    }
    if (bucket) __hip_atomic_fetch_or(word, bucket, __ATOMIC_RELAXED, __HIP_MEMORY_SCOPE_AGENT);
    __syncthreads();
}
#endif
__global__ void __launch_bounds__(NWAVES * 64, 2) mk_fwd(Args args) {
    extern __shared__ __attribute__((aligned(16))) unsigned char lds_raw[];
    LAS unsigned char* lds = (LAS unsigned char*)lds_raw;
    volatile LAS unsigned* MISC = (volatile LAS unsigned*)(lds + MISC_OFF);
    const int tid = threadIdx.x, lane = tid & 63, wave = __builtin_amdgcn_readfirstlane(tid >> 6);
    const int G = gridDim.x; const int bx = blockIdx.x; const int vcu = (G % 8 == 0) ? (bx % 8) * (G / 8) + bx / 8 : bx;
    unsigned char* ws = args.ws;
    gu32* ctl = (gu32*)(ws + WS_CTL);
    for (int u = tid; u < (LDS_BYTES - LDSCTL_OFF) / 4; u += NWAVES * 64) ((LAS unsigned*)(lds + LDSCTL_OFF))[u] = 0u;
    __syncthreads();
    XcdBarrier bar; bar.bar = (unsigned*)(ctl + CW_BAR); bar.x = 0; bar.st = nullptr;
    if (MK_N_LAUNCHES == 1) bar = xcd_barrier_post((unsigned*)(ctl + CW_BAR), MISC + 8);
    const int lo = args.ph_lo, hi = args.ph_hi;
#define IN(k) (lo <= (k) && (k) < hi)
#if defined(BAR_DUP)
#define SEAM(k) do { if (IN(k) && IN((k) + 1)) { xcd_barrier(bar); xcd_barrier(bar); } } while (0)
#else
#define SEAM(k) do { if (IN(k) && IN((k) + 1)) xcd_barrier(bar); } while (0)
#endif

    bf16* XB = (bf16*)(ws + WS_XB); float* SS = (float*)(ws + WS_SS); float* KMP = (float*)(ws + WS_KMP);
    bf16* QKV = (bf16*)(ws + WS_QKV); bf16* HB = (bf16*)(ws + WS_QKV); bf16* OB = (bf16*)(ws + WS_O);

    if ((DBG_MASK & 1) && IN(0)) { for (int rep = 0; rep < NREP(1); ++rep) { p0_prologue(args, ws, lds, vcu, G, wave, lane); __syncthreads(); } }
    SEAM(0);

    for (int layer = 0; layer < DEPTH; ++layer) {
        const int pb = 1 + 7 * layer;
        for (int half = 0; half < 2; ++half) {
            const int f = layer * 2 + half, pg = pb + (half ? 5 : 0);
            if ((DBG_MASK & 2) && IN(pg)) for (int rep = 0; rep < NREP(2); ++rep) {
                pg8::Gemm g{XB, (const bf16*)(ws + WS_WGU + (size_t)f * WGU_BYTES), M, 2 * FF, D}; pg8::StaticOrder S; S.init(M, 2 * FF, G, bx);
#if defined(GU_PROBE_VARIANT)
#if defined(GU_KPROBE)
                if (rep == 1) { pg8::EpiGUProbe<GU_KPROBE> E{}; E.H = HB; E.SS = SS; pg8::gemm_phase<pg8::EpiGUProbe<GU_KPROBE>, pg8::StaticOrder, true, true, GEMM_XDMA>(lds + RING_OFF, g, S, E); } else
#else
                if (rep == 1) { pg8::EpiGU_<GU_PROBE_VARIANT> E{HB, SS}; pg8::gemm_phase<pg8::EpiGU_<GU_PROBE_VARIANT>, pg8::StaticOrder, true, true, GEMM_XDMA>(lds + RING_OFF, g, S, E); } else
#endif
#endif
                { pg8::EpiGU E{HB, SS};
                const int fullr = S.nwg / G, rem = S.nwg - fullr * G; const bool hm = (2 * rem == G) && (G % 16 == 0);
                if (hm) S.maxr = fullr;
                pg8::gemm_phase<pg8::EpiGU, pg8::StaticOrder, GU_ALIGN, true, GEMM_XDMA>(lds + RING_OFF, g, S, E);
                if (hm) { const int j = bx >> 3; pg8::Unit uu; S.unit_of((long)fullr * G + (bx & 7) + 8 * (j >> 1), uu); const pg8::HUnit hu{uu.pm * 2 + (j & 1), uu.pn};
                    pg8::gemm_half_unit<pg8::EpiGU>(lds + RING_OFF, g, hu, E);
#if defined(HM_DUP)
                    __syncthreads(); pg8::gemm_half_unit<pg8::EpiGU>(lds + RING_OFF, g, hu, E);
#endif
                    } }
            }
            SEAM(pg);
            if ((DBG_MASK & 4) && IN(pg + 1)) for (int rep = 0; rep < NREP(4); ++rep) {
                pg8::Gemm g{HB, (const bf16*)(ws + WS_WD + (size_t)f * WD_BYTES), M, D, FF}; pg8::StaticOrder S; S.init(M, D, G, bx);
#if defined(DOWN_NOOP_PROBE)
                if (rep == 1) { pg8::EpiResNoop E; pg8::gemm_phase<pg8::EpiResNoop, pg8::StaticOrder, true, true, GEMM_XDMA>(lds + RING_OFF, g, S, E); } else {
#endif
                pg8::EpiRes E{XB, SS, rep ? 0.0f : 0.5f};
                pg8::gemm_phase<pg8::EpiRes, pg8::StaticOrder, true, true, GEMM_XDMA>(lds + RING_OFF, g, S, E);
#if defined(DOWN_NOOP_PROBE)
                }
#endif
            }
            SEAM(pg + 1);
            if (half == 0) {
                const int i2 = layer >> 1; const bool odd = layer & 1;
                if ((DBG_MASK & 8) && IN(pb + 2)) for (int rep = 0; rep < NREP(8); ++rep) {
                    const int N = odd ? 3072 : 2048;
                    pg8::Gemm g{XB, (const bf16*)(ws + (odd ? WS_WQKV_O + (size_t)i2 * 3072 * D * 2 : WS_WIN_E + (size_t)i2 * 2048 * D * 2)), M, N, D}; pg8::StaticOrder S; S.init(M, N, G, bx);
                    pg8::EpiQKV E{QKV, N, SS, odd ? 4 : 2, QSCALE, odd ? KMP : nullptr, 4, 8};
                    pg8::gemm_phase<pg8::EpiQKV, pg8::StaticOrder, true, true, GEMM_XDMA>(lds + RING_OFF, g, S, E);
                }
                SEAM(pb + 2);
                if (IN(pb + 3)) {
                    if ((DBG_MASK & 16) && !odd) for (int rep = 0; rep < NREP(16); ++rep) {
                        for (int ui = vcu; ui < 512; ui += G) {
                            const int bh = (ui & 255) >> 2, s = ui & 3, qb = (ui >> 8) ? 7 - s : s;
                            att::attn_unit<false>(bh >> 3, bh & 7, qb, QKV, 2048, 512, 1024, OB, lds + RING_OFF, nullptr, 0.f);
                        }
                        pool_rows(QKV, OB, vcu, G, tid);
                    } else if (DBG_MASK & 32) for (int rep = 0; rep < NREP(32); ++rep) {
                        for (int ui = vcu; ui < 1024; ui += G) {
                            const int bh = (ui & 255) >> 1, j = ui & 1, k = ui >> 8;
                            const int qb = (k == 0) ? (j ? 6 : 7) : (k == 1) ? (j ? 5 : 4) : (k == 2) ? (j ? 2 : 3) : (j ? 1 : 0);
                            const int h = bh & 15;
                            const float sl2 = exp2f(-0.5f * (float)(h + 1)) * 1.4426950408889634f;
#if defined(CMP_PROBE)
                            att::attn_unit<true>(bh >> 4, h, qb, QKV, 3072, 1024, 2048, OB, lds + RING_OFF, KMP, sl2);
                            if ((bh >> 4) < 4) {
                                att::attn_unit<true>(bh >> 4, h, qb, QKV, 3072, 1024, 2048, (bf16*)(ws + WS_END), lds + RING_OFF, KMP, CMP_SL2, CMP_FORCE);
#if defined(CMP_EXA)
                                exa::attn_unit<8>(bh >> 4, h, qb, QKV, (bf16*)(ws + WS_END + 16 * MiB), lds + RING_OFF, KMP, CMP_SL2, CMP_FORCE);
#else
                                exa::attn_unit<8>(bh >> 4, h, qb, QKV, (bf16*)(ws + WS_END + 16 * MiB), lds + RING_OFF, KMP, CMP_SL2, CMP_FORCE);
#endif
                                cmp_unit((const bf16*)(ws + WS_END), (const bf16*)(ws + WS_END + 16 * MiB), bh >> 4, h, qb, CMP_PROBE, ctl + 2048, tid); }
#elif defined(MOBA_OLD)
                            att::attn_unit<true>(bh >> 4, h, qb, QKV, 3072, 1024, 2048, OB, lds + RING_OFF, KMP, sl2);
#else
#if defined(UNIT_OVH_PROBE)
                            if (rep == 1) exa::attn_unit<8>(bh >> 4, h, 0, QKV, (bf16*)(ws + WS_END), lds + RING_OFF, KMP, sl2, 0u); else
#endif
                            exa::attn_unit<8>(bh >> 4, h, qb, QKV, OB, lds + RING_OFF, KMP, sl2, 0u);
#endif
                        }
                    }
                }
                SEAM(pb + 3);
                if ((DBG_MASK & 64) && IN(pb + 4)) for (int rep = 0; rep < NREP(64); ++rep) {
                    pg8::Gemm g{OB, (const bf16*)(ws + (odd ? WS_WO_O : WS_WOUT_E) + (size_t)i2 * D * D * 2), M, D, D}; pg8::StaticOrder S; S.init(M, D, G, bx);
                    pg8::EpiRes E{XB, SS, rep ? 0.0f : 1.0f};
                    pg8::gemm_phase<pg8::EpiRes, pg8::StaticOrder, true, true, GEMM_XDMA>(lds + RING_OFF, g, S, E);
                }
                SEAM(pb + 4);
            }
        }
    }
    if ((DBG_MASK & 128) && IN(N_PHASES - 1)) final_norm(XB, args.out, SS, args.in[16], vcu, G, wave, lane);
#if defined(CMP_PROBE)
    xcd_barrier(bar);
    if (blockIdx.x == 0 && tid == 0) { const unsigned w = __hip_atomic_load(ctl + 2048, RLX_AGENT); const unsigned long long t0 = __builtin_amdgcn_s_memrealtime(), dt = (unsigned long long)w * 10000ull;
        while (__builtin_amdgcn_s_memrealtime() - t0 < dt) __builtin_amdgcn_s_sleep(8); }
#endif
#undef IN
#undef SEAM
}

extern "C" void kernel_launch(void* const* d_in, const int* in_sizes, int n_in, void* d_out, int out_size, void* d_ws, size_t ws_size, hipStream_t stream) {
    static int grid = 0;
    if (grid == 0) {
        if (n_in != 17 || in_sizes[0] != M * D || out_size != M * D || ws_size < WS_END) { fprintf(stderr, "kernel_launch: unexpected shapes (n_in %d, in0 %d, out %d, ws %zu); nothing launched\n", n_in, n_in > 0 ? in_sizes[0] : -1, out_size, ws_size); grid = -1; return; }
        int dev = 0, cus = 0, per_cu = 0;
        if (hipGetDevice(&dev) != hipSuccess || hipDeviceGetAttribute(&cus, hipDeviceAttributeMultiprocessorCount, dev) != hipSuccess) { grid = -1; return; }
        if (hipFuncSetAttribute((const void*)mk_fwd, hipFuncAttributeMaxDynamicSharedMemorySize, LDS_BYTES) != hipSuccess) { fprintf(stderr, "kernel_launch: hipFuncSetAttribute failed\n"); grid = -1; return; }
        if (hipOccupancyMaxActiveBlocksPerMultiprocessor(&per_cu, (const void*)mk_fwd, NWAVES * 64, LDS_BYTES) != hipSuccess || per_cu < 1)
            fprintf(stderr, "kernel_launch: note: occupancy query reports %d workgroups per CU\n", per_cu);
        (void)hipGetLastError();
        grid = cus;
    }
    if (grid < 0) return;
    if (hipMemsetAsync((char*)d_ws + WS_CTL, 0, CTL_ZERO_BYTES, stream) != hipSuccess) return;
    Args a{};
    for (int i = 0; i < 17; ++i) a.in[i] = (const float*)d_in[i];
    a.out = (float*)d_out; a.ws = (unsigned char*)d_ws;
#if MK_N_LAUNCHES == 1
    a.ph_lo = 0; a.ph_hi = N_PHASES;
    hipLaunchKernelGGL(mk_fwd, dim3(grid), dim3(NWAVES * 64), LDS_BYTES, stream, a);
#else
    for (int p = 0; p < N_PHASES; ++p) { a.ph_lo = p; a.ph_hi = p + 1; hipLaunchKernelGGL(mk_fwd, dim3(grid), dim3(NWAVES * 64), LDS_BYTES, stream, a); }
#endif
}
```

```cpp
#include <hip/hip_runtime.h>
#include <cstdio>
#include <cstdint>
#define LAS __attribute__((address_space(3)))
#define GAS __attribute__((address_space(1)))
#ifndef MK_N_LAUNCHES
#define MK_N_LAUNCHES 1
#endif
#define P0_NT 1
#define EXA_G1 1
#define EXA_G2 1
#define EXA_G3 1
namespace pg8 {
#define PG8_LAS __attribute__((address_space(3)))
typedef unsigned short bf16_t;
typedef short bf16x8 __attribute__((ext_vector_type(8)));
typedef float f32x4 __attribute__((ext_vector_type(4)));
typedef unsigned u32x4 __attribute__((ext_vector_type(4)));
constexpr int BM = 256, BK = 64, HALF = 128, HTB = HALF * BK * 2  , STAGE_BYTES = 8 * HTB, NXCD = 8, WGM = 8;

__host__ __device__ __forceinline__ int lds_byte(int r, int c) { const int st = (r >> 4) * 2 + (c >> 5), rr = r & 15, cc = c & 31, ob = rr * 64 + cc * 2; return st * 1024 + (ob ^ (((ob >> 9) & 1) << 5)); }
__host__ __device__ __forceinline__ void stage_rc(int b, int& R, int& C) { const int st = b / 1024, sb = b % 1024, swz = sb ^ (((sb >> 9) & 1) << 5); R = (st >> 1) * 16 + swz / 64; C = (st & 1) * 32 + (swz % 64) / 2; }
__host__ __device__ __forceinline__ int perm32(int rho) { const int n = rho >> 4, i = rho & 15; return 8 * (i >> 2) + 4 * n + (i & 3); }

struct Unit { int pm, pn; };
struct HUnit { int pm2, pn; };
struct Gemm { const bf16_t* A; const bf16_t* Bt; int M, N, K; };

struct StaticOrder {
    int nM, nN, nwg, G, c, maxr;
    __host__ __device__ void init(int M, int N, int G_, int c_) { nM = M / BM; nN = N / BM; nwg = nM * nN; G = G_; c = c_; maxr = 1 << 30; }
    __host__ __device__ bool next(int i, Unit& u) const {
        const long L = (long)i * G + c; if (L >= nwg || i >= maxr) return false;
        unit_of(L, u); return true;
    }
    __host__ __device__ void unit_of(long L, Unit& u) const {
        int wgid = (int)L; { const int q = nwg / NXCD, r = nwg % NXCD, xcd = wgid % NXCD, off = wgid / NXCD; wgid = (xcd < r ? xcd * (q + 1) : r * (q + 1) + (xcd - r) * q) + off; }
        const int nig = WGM * nN, gid = wgid / nig, fm = gid * WGM, gsz = (nM - fm) < WGM ? (nM - fm) : WGM;
        u.pm = fm + ((wgid % nig) % gsz); u.pn = (wgid % nig) / gsz;
    }
    __device__ __forceinline__ void a_ready(const Unit&) const {}
    __device__ __forceinline__ void done(const Unit&) const {}
};

__device__ __forceinline__ unsigned cvt_pk_bf16(float lo, float hi) { unsigned r; asm volatile("v_cvt_pk_bf16_f32 %0, %1, %2" : "=v"(r) : "v"(lo), "v"(hi)); return r; }
typedef float f32x2 __attribute__((ext_vector_type(2)));
__device__ __forceinline__ float row_rstd(const float* SS, int row, int fq) {
    const f32x4 v = *(const f32x4*)(SS + (size_t)row * 16 + 4 * fq);
    float s = (v[0] + v[1]) + (v[2] + v[3]);
    s += __shfl_xor(s, 16); s += __shfl_xor(s, 32);
    return __builtin_amdgcn_rsqf(s * (1.0f / 1024.0f) + 1e-6f);
}
__device__ __forceinline__ void row_rstd8(const float* SS, int row0, int fq, float (&r8)[8]) {
    f32x4 sv[8];
#pragma unroll
    for (int k = 0; k < 8; ++k) sv[k] = *(const f32x4*)(SS + (size_t)(row0 + (k >> 2) * HALF + (k & 3) * 16) * 16 + 4 * fq);
#pragma unroll
    for (int k = 0; k < 8; ++k) { float s = (sv[k][0] + sv[k][1]) + (sv[k][2] + sv[k][3]); s += __shfl_xor(s, 16); s += __shfl_xor(s, 32); r8[k] = __builtin_amdgcn_rsqf(s * (1.0f / 1024.0f) + 1e-6f); }
}
__device__ __forceinline__ void row_rstd8v(const float* SS, int row0, int fq, float (&r8)[8], float (&v8)[8]) {
    f32x4 sv[8];
#pragma unroll
    for (int k = 0; k < 8; ++k) sv[k] = *(const f32x4*)(SS + (size_t)(row0 + (k >> 2) * HALF + (k & 3) * 16) * 16 + 4 * fq);
#pragma unroll
    for (int k = 0; k < 8; ++k) { float s = (sv[k][0] + sv[k][1]) + (sv[k][2] + sv[k][3]); s += __shfl_xor(s, 16); s += __shfl_xor(s, 32); v8[k] = s * (1.0f / 1024.0f) + 1e-6f; r8[k] = __builtin_amdgcn_rsqf(v8[k]); }
}
template <int VARIANT = 0> struct EpiGU_ {
    static constexpr bool PERM = true, AFTER_DRAIN = false;
    bf16_t* H; const float* SS;
    __device__ __forceinline__ void gu_row(const f32x4 (&ga)[2], const f32x4 (&ua)[2], float r, float v, bf16_t* dst) const {
        const float rn = r * -1.4426950408889634f;
        const f32x2 rn2 = {rn, rn}, v2 = {v, v};
        f32x2 t[4], p[4];
#pragma unroll
        for (int k = 0; k < 4; ++k) { const f32x2 g = {ga[k >> 1][2 * (k & 1)], ga[k >> 1][2 * (k & 1) + 1]}, uu = {ua[k >> 1][2 * (k & 1)], ua[k >> 1][2 * (k & 1) + 1]};
            t[k] = g * rn2; p[k] = g * uu; }
#pragma unroll
        for (int k = 0; k < 4; ++k) { t[k].x = __builtin_amdgcn_exp2f(t[k].x); t[k].y = __builtin_amdgcn_exp2f(t[k].y); }
#pragma unroll
        for (int k = 0; k < 4; ++k) t[k] = __builtin_elementwise_fma(t[k], v2, v2);
#pragma unroll
        for (int k = 0; k < 4; ++k) { t[k].x = __builtin_amdgcn_rcpf(t[k].x); t[k].y = __builtin_amdgcn_rcpf(t[k].y); }
#pragma unroll
        for (int k = 0; k < 4; ++k) p[k] = p[k] * t[k];
        u32x4 w; w.x = cvt_pk_bf16(p[0].x, p[0].y); w.y = cvt_pk_bf16(p[1].x, p[1].y); w.z = cvt_pk_bf16(p[2].x, p[2].y); w.w = cvt_pk_bf16(p[3].x, p[3].y);
        if (VARIANT == 2) { asm volatile("" :: "v"(w)); } else *(u32x4*)dst = w;
    }
    __device__ __forceinline__ void half(const f32x4 (&acc)[2][4][2], const HUnit& u, int wr, int wc, int fr, int fq) const {
        const int row0 = u.pm2 * HALF + wr * 64 + fr, col0 = u.pn * 128 + wc * 32 + 8 * fq;
        f32x4 sv[4];
#pragma unroll
        for (int k = 0; k < 4; ++k) sv[k] = *(const f32x4*)(SS + (size_t)(row0 + k * 16) * 16 + 4 * fq);
#pragma unroll
        for (int m = 0; m < 4; ++m) { float s = (sv[m][0] + sv[m][1]) + (sv[m][2] + sv[m][3]); s += __shfl_xor(s, 16); s += __shfl_xor(s, 32); const float v = s * (1.0f / 1024.0f) + 1e-6f;
            gu_row(acc[0][m], acc[1][m], __builtin_amdgcn_rsqf(v), v, H + (size_t)(row0 + m * 16) * 2816 + col0); }
    }
    __device__ __forceinline__ void operator()(const f32x4 (&acc)[2][2][4][2], const Unit& u, int wr, int wc, int fr, int fq) const {
        if (VARIANT == 1) {
#pragma unroll
            for (int ai = 0; ai < 2; ++ai)
#pragma unroll
                for (int bj = 0; bj < 2; ++bj)
                    asm volatile("" :: "v"(acc[ai][bj][0][0]), "v"(acc[ai][bj][0][1]), "v"(acc[ai][bj][1][0]), "v"(acc[ai][bj][1][1]), "v"(acc[ai][bj][2][0]), "v"(acc[ai][bj][2][1]), "v"(acc[ai][bj][3][0]), "v"(acc[ai][bj][3][1]));
            return; }
        const int row0 = u.pm * BM + wr * 64 + fr, col0 = u.pn * 128 + wc * 32 + 8 * fq;
        float r8[8], v8[8]; row_rstd8v(SS, row0, fq, r8, v8);
#pragma unroll
        for (int ai = 0; ai < 2; ++ai)
#pragma unroll
            for (int m = 0; m < 4; ++m) {
                gu_row(acc[ai][0][m], acc[ai][1][m], r8[ai * 4 + m], v8[ai * 4 + m], H + (size_t)(row0 + ai * HALF + m * 16) * 2816 + col0);
            }
    }
};
typedef EpiGU_<0> EpiGU;
template <int KP> struct EpiGUProbe : EpiGU_<1> { static constexpr int KPROBE = KP; };
struct EpiRes {
    static constexpr bool PERM = true, AFTER_DRAIN = false, INIT = true;
    bf16_t* XB; float* SS; float alpha, ialpha;
    __device__ __forceinline__ void init_load(u32x4 (&bv)[2][4][2], const Unit& u, int wr, int wc, int fr, int fq) const {
        const int row0 = u.pm * BM + wr * 64 + fr, col0 = u.pn * BM + wc * 32 + 8 * fq;
#pragma unroll
        for (int ai = 0; ai < 2; ++ai)
#pragma unroll
            for (int m = 0; m < 4; ++m)
#pragma unroll
                for (int bj = 0; bj < 2; ++bj) bv[ai][m][bj] = *(const u32x4*)(XB + (size_t)(row0 + ai * HALF + m * 16) * 1024 + col0 + bj * HALF);
    }
    __device__ __forceinline__ void init_apply(f32x4 (&acc)[2][2][4][2], const u32x4 (&bv)[2][4][2]) const {
#pragma unroll
        for (int ai = 0; ai < 2; ++ai)
#pragma unroll
            for (int m = 0; m < 4; ++m)
#pragma unroll
                for (int bj = 0; bj < 2; ++bj) { const u32x4 b = bv[ai][m][bj];
                    acc[ai][bj][m][0] = (f32x4){__builtin_bit_cast(float, b.x << 16), __builtin_bit_cast(float, b.x & 0xffff0000u), __builtin_bit_cast(float, b.y << 16), __builtin_bit_cast(float, b.y & 0xffff0000u)} * ialpha;
                    acc[ai][bj][m][1] = (f32x4){__builtin_bit_cast(float, b.z << 16), __builtin_bit_cast(float, b.z & 0xffff0000u), __builtin_bit_cast(float, b.w << 16), __builtin_bit_cast(float, b.w & 0xffff0000u)} * ialpha; }
    }
    __device__ __forceinline__ void operator()(const f32x4 (&acc)[2][2][4][2], const Unit& u, int wr, int wc, int fr, int fq) const {
        const int row0 = u.pm * BM + wr * 64 + fr, col0 = u.pn * BM + wc * 32 + 8 * fq;
#pragma unroll
        for (int ai = 0; ai < 2; ++ai) {
#pragma unroll
            for (int m = 0; m < 4; ++m) {
                const int row = row0 + ai * HALF + m * 16; const size_t off = (size_t)row * 1024 + col0;
                float s = 0.f;
#pragma unroll
                for (int bj = 0; bj < 2; ++bj) {
                    const f32x4 v0 = acc[ai][bj][m][0] * alpha, v1 = acc[ai][bj][m][1] * alpha;
                    u32x4 w; w.x = cvt_pk_bf16(v0[0], v0[1]); w.y = cvt_pk_bf16(v0[2], v0[3]); w.z = cvt_pk_bf16(v1[0], v1[1]); w.w = cvt_pk_bf16(v1[2], v1[3]);
                    *(u32x4*)(XB + off + bj * HALF) = w;
                    const float r0 = __builtin_bit_cast(float, w.x << 16), r1 = __builtin_bit_cast(float, w.x & 0xffff0000u), r2 = __builtin_bit_cast(float, w.y << 16), r3 = __builtin_bit_cast(float, w.y & 0xffff0000u);
                    const float r4 = __builtin_bit_cast(float, w.z << 16), r5 = __builtin_bit_cast(float, w.z & 0xffff0000u), r6 = __builtin_bit_cast(float, w.w << 16), r7 = __builtin_bit_cast(float, w.w & 0xffff0000u);
                    s += (r0 * r0 + r1 * r1) + (r2 * r2 + r3 * r3) + (r4 * r4 + r5 * r5) + (r6 * r6 + r7 * r7);
                }
                s += __shfl_xor(s, 16); s += __shfl_xor(s, 32);
                if (fq == 0) SS[(size_t)row * 16 + u.pn * 4 + wc] = s;
            }
        }
    }
};
struct EpiResNoop {
    static constexpr bool PERM = true, AFTER_DRAIN = false;
    __device__ __forceinline__ void operator()(const f32x4 (&acc)[2][2][4][2], const Unit&, int, int, int, int) const {
#pragma unroll
        for (int ai = 0; ai < 2; ++ai)
#pragma unroll
            for (int bj = 0; bj < 2; ++bj)
                asm volatile("" :: "v"(acc[ai][bj][0][0]), "v"(acc[ai][bj][0][1]), "v"(acc[ai][bj][1][0]), "v"(acc[ai][bj][1][1]), "v"(acc[ai][bj][2][0]), "v"(acc[ai][bj][2][1]), "v"(acc[ai][bj][3][0]), "v"(acc[ai][bj][3][1]));
    }
};
struct EpiQKV {
    static constexpr bool PERM = true, AFTER_DRAIN = false;
    bf16_t* O; int ldc; const float* SS; int nq_tiles; float qscale; float* KMP; int k_lo, k_hi;
    __device__ __forceinline__ void operator()(const f32x4 (&acc)[2][2][4][2], const Unit& u, int wr, int wc, int fr, int fq) const {
        const int row0 = u.pm * BM + wr * 64 + fr, col0 = u.pn * BM + wc * 32 + 8 * fq;
        const float sc = (u.pn < nq_tiles) ? qscale : 1.0f;
        float r8[8]; row_rstd8(SS, row0, fq, r8);
#pragma unroll
        for (int ai = 0; ai < 2; ++ai)
#pragma unroll
            for (int m = 0; m < 4; ++m) {
                const int row = row0 + ai * HALF + m * 16;
                const float r = r8[ai * 4 + m] * sc;
                bf16_t* rowp = O + (size_t)row * ldc + col0;
#pragma unroll
                for (int bj = 0; bj < 2; ++bj) {
                    const f32x4 v0 = acc[ai][bj][m][0] * r, v1 = acc[ai][bj][m][1] * r;
                    u32x4 w; w.x = cvt_pk_bf16(v0[0], v0[1]); w.y = cvt_pk_bf16(v0[2], v0[3]); w.z = cvt_pk_bf16(v1[0], v1[1]); w.w = cvt_pk_bf16(v1[2], v1[3]);
                    *(u32x4*)(rowp + bj * HALF) = w;
                }
            }
        if (KMP != nullptr && u.pn >= k_lo && u.pn < k_hi) {
            float* dst = KMP + ((size_t)u.pm * 2 + wr) * 1024 + (u.pn - k_lo) * BM + wc * 32 + 8 * fq;
#pragma unroll
            for (int bj = 0; bj < 2; ++bj)
#pragma unroll
                for (int n = 0; n < 2; ++n) {
                    f32x4 cs = {0.f, 0.f, 0.f, 0.f};
#pragma unroll
                    for (int ai = 0; ai < 2; ++ai)
#pragma unroll
                        for (int m = 0; m < 4; ++m) cs += acc[ai][bj][m][n] * r8[ai * 4 + m];
#pragma unroll
                    for (int i = 0; i < 4; ++i) { float c = cs[i]; c += __shfl_xor(c, 1); c += __shfl_xor(c, 2); c += __shfl_xor(c, 4); c += __shfl_xor(c, 8); cs[i] = c; }
                    if (fr == 0) *(f32x4*)(dst + bj * HALF + 4 * n) = cs;
                }
        }
    }
};
#ifndef PG8_PRIO_MMA
#define PG8_PRIO_MMA 1
#define PG8_PRIO_LOAD 0
#endif
template <class E, class = void> struct kprobe_of { static constexpr int value = 0; };
template <class E> struct kprobe_of<E, decltype((void)E::KPROBE)> { static constexpr int value = E::KPROBE; };
template <class E, class = void> struct init_of { static constexpr bool value = false; };
template <class E> struct init_of<E, decltype((void)E::INIT)> { static constexpr bool value = E::INIT; };
template <class Epi, class Sched, bool ALIGN_EPI = false, bool SP2 = false, bool XDMA = false>
__device__ __forceinline__ void gemm_phase(PG8_LAS unsigned char* lds, const Gemm g, const Sched& S, const Epi& E) {
    int tid = threadIdx.x; asm volatile("" : "+v"(tid));
    const int wid = __builtin_amdgcn_readfirstlane(tid >> 6), lane = tid & 63, wr = wid >> 2, wc = wid & 3, fr = lane & 15, fq = lane >> 4;
    const int K = g.K, nt = K / BK;
    unsigned voffA[2], voffB[2];
#pragma unroll
    for (int i = 0; i < 2; ++i) { int R, C; stage_rc(tid * 16 + i * 8192, R, C); const int Rb = Epi::PERM ? ((R & ~31) + perm32(R & 31)) : R;
        voffA[i] = (unsigned)(R * K + C) * 2u; voffB[i] = (unsigned)(Rb * K + C) * 2u; }
    const size_t kstep = (size_t)(BK * 2);
    const size_t hstep = (size_t)HALF * K * 2;
    const size_t tstep = 2 * hstep;
    const unsigned ldsw = (unsigned)wid * 1024u;
    const int aoff = lds_byte(wr * 64 + fr, fq * 8), boff = lds_byte(wc * 32 + fr, fq * 8);
#define PG8_SA(b, h) (((b) * 2 + (h)) * HTB)
#define PG8_SB(b, h) ((4 + (b) * 2 + (h)) * HTB)
#define PG8_STAGE(bufoff, gbase, voff) do { if constexpr (kprobe_of<Epi>::value != 1) _Pragma("unroll") for (int _i = 0; _i < 2; ++_i) \
        __builtin_amdgcn_global_load_lds((const unsigned*)((const char*)(gbase) + (voff)[_i]), (PG8_LAS unsigned*)(lds + (bufoff) + ldsw + _i * 8192), 16, 0, 0); } while (0)
#define PG8_LDA(dst, b, h) do { if constexpr (kprobe_of<Epi>::value != 2) _Pragma("unroll") for (int m = 0; m < 4; ++m) _Pragma("unroll") for (int k = 0; k < 2; ++k) dst[m][k] = *(const PG8_LAS bf16x8*)(lds + PG8_SA(b, h) + aoff + m * 2048 + k * 1024); } while (0)
#define PG8_LDB(dst, b, h) do { if constexpr (kprobe_of<Epi>::value != 2) _Pragma("unroll") for (int n = 0; n < 2; ++n) _Pragma("unroll") for (int k = 0; k < 2; ++k) dst[n][k] = *(const PG8_LAS bf16x8*)(lds + PG8_SB(b, h) + boff + n * 2048 + k * 1024); } while (0)
#define PG8_MMA(ai, bj, At, Bt) do { __builtin_amdgcn_s_setprio(PG8_PRIO_MMA); _Pragma("unroll") for (int m = 0; m < 4; ++m) _Pragma("unroll") for (int n = 0; n < 2; ++n) _Pragma("unroll") for (int k = 0; k < 2; ++k) \
        acc[ai][bj][m][n] = __builtin_amdgcn_mfma_f32_16x16x32_bf16(Bt[n][k], At[m][k], acc[ai][bj][m][n], 0, 0, 0); __builtin_amdgcn_s_setprio(PG8_PRIO_LOAD); } while (0)
#define PG8_WAIT_V(n) asm volatile("s_waitcnt vmcnt(" #n ")" ::: "memory")
#define PG8_WAIT_L(n) asm volatile("s_waitcnt lgkmcnt(" #n ")" ::: "memory")
#define PG8_BAR __builtin_amdgcn_s_barrier()
#define PG8_SCHED __builtin_amdgcn_sched_barrier(0)
    Unit cur, nxt; int ui = 0;
    if (!S.next(0, cur)) return;
    f32x4 acc[2][2][4][2];
    u32x4 ibv[2][4][2];
    if constexpr (init_of<Epi>::value) E.init_load(ibv, cur, wr, wc, fr, fq);
    else {
#pragma unroll
    for (int a = 0; a < 2; ++a)
#pragma unroll
        for (int b = 0; b < 2; ++b)
#pragma unroll
            for (int m = 0; m < 4; ++m)
#pragma unroll
                for (int n = 0; n < 2; ++n) acc[a][b][m][n] = (f32x4){0.f, 0.f, 0.f, 0.f};
    }
    bf16x8 At[4][2], B0[2][2], B1[2][2];
    const char* cA = (const char*)g.A + (size_t)cur.pm * tstep; const char* cB = (const char*)g.Bt + (size_t)cur.pn * tstep;
    S.a_ready(cur);
    if constexpr (SP2) {
        PG8_STAGE(PG8_SB(0, 0), cB, voffB); PG8_STAGE(PG8_SB(0, 1), cB + hstep, voffB); PG8_STAGE(PG8_SA(0, 0), cA, voffA); PG8_STAGE(PG8_SA(0, 1), cA + hstep, voffA);
        if constexpr (init_of<Epi>::value) E.init_apply(acc, ibv);
        if (wr == 1) PG8_BAR;
        PG8_WAIT_V(2); PG8_BAR;
        PG8_STAGE(PG8_SB(1, 0), cB + kstep, voffB); PG8_STAGE(PG8_SA(1, 0), cA + kstep, voffA); PG8_STAGE(PG8_SB(1, 1), cB + hstep + kstep, voffB);
        PG8_WAIT_V(6); PG8_BAR;
    } else {
        PG8_STAGE(PG8_SB(0, 0), cB, voffB); PG8_STAGE(PG8_SA(0, 0), cA, voffA); PG8_STAGE(PG8_SB(0, 1), cB + hstep, voffB); PG8_STAGE(PG8_SA(0, 1), cA + hstep, voffA);
        if (wr == 1) PG8_BAR;
        PG8_WAIT_V(4); PG8_BAR;
        PG8_STAGE(PG8_SB(1, 0), cB + kstep, voffB); PG8_STAGE(PG8_SA(1, 0), cA + kstep, voffA); PG8_STAGE(PG8_SB(1, 1), cB + hstep + kstep, voffB);
        PG8_WAIT_V(6); PG8_BAR;
    }
    for (;;) {
        const bool has_next = S.next(ui + 1, nxt);
        const char* nA = has_next ? (const char*)g.A + (size_t)nxt.pm * tstep : cA; const char* nB = has_next ? (const char*)g.Bt + (size_t)nxt.pn * tstep : cB;
        for (int t = 0; t < nt; t += 2) {
            const bool last = (t == nt - 2);
            const char* a1 = cA + (size_t)(t + 1) * kstep;
            const char* a2 = last ? nA : cA + (size_t)(t + 2) * kstep; const char* b2 = last ? nB : cB + (size_t)(t + 2) * kstep;
            const char* a3 = a2 + kstep; const char* b3 = b2 + kstep;
            if (last && has_next) S.a_ready(nxt);
            if constexpr (SP2) {
            if constexpr (XDMA) {
            PG8_LDB(B0, 0, 0); PG8_LDB(B1, 0, 1); PG8_SCHED; PG8_LDA(At, 0, 0);
            PG8_WAIT_V(6); PG8_WAIT_L(0); PG8_BAR; PG8_MMA(0, 0, At, B0); PG8_STAGE(PG8_SA(1, 1), a1 + hstep, voffA); PG8_MMA(0, 1, At, B1); PG8_BAR; PG8_SCHED;
            PG8_LDA(At, 0, 1);
            PG8_WAIT_V(2); PG8_WAIT_L(0); PG8_BAR; PG8_MMA(1, 0, At, B0); PG8_STAGE(PG8_SB(0, 0), b2, voffB); PG8_STAGE(PG8_SB(0, 1), b2 + hstep, voffB); PG8_STAGE(PG8_SA(0, 0), a2, voffA); PG8_MMA(1, 1, At, B1); PG8_BAR; PG8_SCHED;
            PG8_LDB(B0, 1, 0); PG8_LDB(B1, 1, 1); PG8_SCHED; PG8_LDA(At, 1, 0);
            PG8_WAIT_V(6); PG8_WAIT_L(0); PG8_BAR; PG8_MMA(0, 0, At, B0); PG8_STAGE(PG8_SA(0, 1), a2 + hstep, voffA); PG8_MMA(0, 1, At, B1); PG8_BAR; PG8_SCHED;
            PG8_LDA(At, 1, 1);
            PG8_WAIT_V(2); PG8_WAIT_L(0); PG8_BAR; PG8_MMA(1, 0, At, B0); PG8_STAGE(PG8_SB(1, 0), b3, voffB); PG8_STAGE(PG8_SB(1, 1), b3 + hstep, voffB); PG8_STAGE(PG8_SA(1, 0), a3, voffA); PG8_MMA(1, 1, At, B1); PG8_BAR; PG8_SCHED;
            } else {
            PG8_LDB(B0, 0, 0); PG8_LDB(B1, 0, 1); PG8_SCHED; PG8_LDA(At, 0, 0); PG8_STAGE(PG8_SA(1, 1), a1 + hstep, voffA);
            PG8_WAIT_V(8); PG8_WAIT_L(0); PG8_BAR; PG8_MMA(0, 0, At, B0); PG8_MMA(0, 1, At, B1); PG8_BAR; PG8_SCHED;
            PG8_LDA(At, 0, 1); PG8_STAGE(PG8_SB(0, 0), b2, voffB); PG8_STAGE(PG8_SB(0, 1), b2 + hstep, voffB); PG8_STAGE(PG8_SA(0, 0), a2, voffA);
            PG8_WAIT_V(8); PG8_WAIT_L(0); PG8_BAR; PG8_MMA(1, 0, At, B0); PG8_MMA(1, 1, At, B1); PG8_BAR; PG8_SCHED;
            PG8_LDB(B0, 1, 0); PG8_LDB(B1, 1, 1); PG8_SCHED; PG8_LDA(At, 1, 0); PG8_STAGE(PG8_SA(0, 1), a2 + hstep, voffA);
            PG8_WAIT_V(8); PG8_WAIT_L(0); PG8_BAR; PG8_MMA(0, 0, At, B0); PG8_MMA(0, 1, At, B1); PG8_BAR; PG8_SCHED;
            PG8_LDA(At, 1, 1); PG8_STAGE(PG8_SB(1, 0), b3, voffB); PG8_STAGE(PG8_SB(1, 1), b3 + hstep, voffB); PG8_STAGE(PG8_SA(1, 0), a3, voffA);
            PG8_WAIT_V(8); PG8_WAIT_L(0); PG8_BAR; PG8_MMA(1, 0, At, B0); PG8_MMA(1, 1, At, B1); PG8_BAR; PG8_SCHED;
            }
            } else {
            PG8_LDB(B0, 0, 0); PG8_SCHED; PG8_LDA(At, 0, 0); PG8_STAGE(PG8_SA(1, 1), a1 + hstep, voffA);
            PG8_WAIT_L(8); PG8_BAR; PG8_WAIT_L(0); PG8_MMA(0, 0, At, B0); PG8_BAR; PG8_SCHED;
            PG8_LDB(B1, 0, 1); PG8_STAGE(PG8_SB(0, 0), b2, voffB);
            PG8_BAR; PG8_WAIT_L(0); PG8_MMA(0, 1, At, B1); PG8_BAR;
            PG8_LDA(At, 0, 1); PG8_STAGE(PG8_SA(0, 0), a2, voffA);
            PG8_BAR; PG8_WAIT_L(0); PG8_MMA(1, 0, At, B0); PG8_BAR; PG8_SCHED;
            PG8_STAGE(PG8_SB(0, 1), b2 + hstep, voffB);
            PG8_WAIT_V(6); PG8_BAR; PG8_MMA(1, 1, At, B1); PG8_BAR;
            PG8_LDB(B0, 1, 0); PG8_SCHED; PG8_LDA(At, 1, 0); PG8_STAGE(PG8_SA(0, 1), a2 + hstep, voffA);
            PG8_WAIT_L(8); PG8_BAR; PG8_WAIT_L(0); PG8_MMA(0, 0, At, B0); PG8_BAR; PG8_SCHED;
            PG8_LDB(B1, 1, 1); PG8_STAGE(PG8_SB(1, 0), b3, voffB);
            PG8_BAR; PG8_WAIT_L(0); PG8_MMA(0, 1, At, B1); PG8_BAR;
            PG8_LDA(At, 1, 1); PG8_STAGE(PG8_SA(1, 0), a3, voffA);
            PG8_BAR; PG8_WAIT_L(0); PG8_MMA(1, 0, At, B0); PG8_BAR; PG8_SCHED;
            PG8_STAGE(PG8_SB(1, 1), b3 + hstep, voffB);
            PG8_WAIT_V(6); PG8_BAR; PG8_MMA(1, 1, At, B1); PG8_BAR;
            }
        }
        if constexpr (ALIGN_EPI) { if (wr == 0) PG8_BAR; }
        if constexpr (!Epi::AFTER_DRAIN) { E(acc, cur, wr, wc, fr, fq); S.done(cur); }
        if (!has_next) break;
        if constexpr (init_of<Epi>::value) { E.init_load(ibv, nxt, wr, wc, fr, fq); E.init_apply(acc, ibv); }
        else {
#pragma unroll
        for (int a = 0; a < 2; ++a)
#pragma unroll
            for (int b = 0; b < 2; ++b)
#pragma unroll
                for (int m = 0; m < 4; ++m)
#pragma unroll
                    for (int n = 0; n < 2; ++n) acc[a][b][m][n] = (f32x4){0.f, 0.f, 0.f, 0.f};
        }
        cur = nxt; cA = nA; cB = nB; ++ui;
        if constexpr (ALIGN_EPI) { if (wr == 1) PG8_BAR; }
    }
    PG8_WAIT_V(0);
    if constexpr (!ALIGN_EPI) { if (wr == 0) PG8_BAR; }
    PG8_BAR;
    if constexpr (Epi::AFTER_DRAIN) { E.fused(acc, cur, wr, wc, fr, fq, lds, wid, lane); S.done(cur); }
#undef PG8_SA
#undef PG8_SB
#undef PG8_STAGE
#undef PG8_LDA
#undef PG8_LDB
#undef PG8_MMA
#undef PG8_WAIT_V
#undef PG8_WAIT_L
#undef PG8_BAR
#undef PG8_SCHED
}
}
namespace pg8 {
constexpr int HM_STAGE_BYTES = 9 * HTB;
template <class Epi>
__device__ __forceinline__ void gemm_half_unit(PG8_LAS unsigned char* lds, const Gemm g, const HUnit hu, const Epi& E) {
    int tid = threadIdx.x; asm volatile("" : "+v"(tid));
    const int wid = __builtin_amdgcn_readfirstlane(tid >> 6), lane = tid & 63, wr = wid >> 2, wc = wid & 3, fr = lane & 15, fq = lane >> 4;
    const int K = g.K, nt = K / BK;
    unsigned voffA[2], voffB[2];
#pragma unroll
    for (int i = 0; i < 2; ++i) { int R, C; stage_rc(tid * 16 + i * 8192, R, C); const int Rb = Epi::PERM ? ((R & ~31) + perm32(R & 31)) : R;
        voffA[i] = (unsigned)(R * K + C) * 2u; voffB[i] = (unsigned)(Rb * K + C) * 2u; }
    const size_t kstep = (size_t)(BK * 2);
    const size_t hstep = (size_t)HALF * K * 2;
    const unsigned ldsw = (unsigned)wid * 1024u;
    const int aoff = lds_byte(wr * 64 + fr, fq * 8), boff = lds_byte(wc * 32 + fr, fq * 8);
#define HM_SA(b) ((b) * 3 * HTB)
#define HM_SB(b, h) (((b) * 3 + 1 + (h)) * HTB)
#define HM_STAGE(bufoff, gbase, voff) do { _Pragma("unroll") for (int _i = 0; _i < 2; ++_i) \
        __builtin_amdgcn_global_load_lds((const unsigned*)((const char*)(gbase) + (voff)[_i]), (PG8_LAS unsigned*)(lds + (bufoff) + ldsw + _i * 8192), 16, 0, 0); } while (0)
#define HM_LDA(dst, b) do { _Pragma("unroll") for (int m = 0; m < 4; ++m) _Pragma("unroll") for (int k = 0; k < 2; ++k) dst[m][k] = *(const PG8_LAS bf16x8*)(lds + HM_SA(b) + aoff + m * 2048 + k * 1024); } while (0)
#define HM_LDB(dst, b, h) do { _Pragma("unroll") for (int n = 0; n < 2; ++n) _Pragma("unroll") for (int k = 0; k < 2; ++k) dst[n][k] = *(const PG8_LAS bf16x8*)(lds + HM_SB(b, h) + boff + n * 2048 + k * 1024); } while (0)
#define HM_MMA(bj, At, Bt) do { __builtin_amdgcn_s_setprio(PG8_PRIO_MMA); _Pragma("unroll") for (int m = 0; m < 4; ++m) _Pragma("unroll") for (int n = 0; n < 2; ++n) _Pragma("unroll") for (int k = 0; k < 2; ++k) \
        acc[bj][m][n] = __builtin_amdgcn_mfma_f32_16x16x32_bf16(Bt[n][k], At[m][k], acc[bj][m][n], 0, 0, 0); __builtin_amdgcn_s_setprio(PG8_PRIO_LOAD); } while (0)
#define HM_WAIT_V(n) asm volatile("s_waitcnt vmcnt(" #n ")" ::: "memory")
#define HM_WAIT_L(n) asm volatile("s_waitcnt lgkmcnt(" #n ")" ::: "memory")
#define HM_BAR __builtin_amdgcn_s_barrier()
#define HM_SCHED __builtin_amdgcn_sched_barrier(0)
    f32x4 acc[2][4][2];
#pragma unroll
    for (int b = 0; b < 2; ++b)
#pragma unroll
        for (int m = 0; m < 4; ++m)
#pragma unroll
            for (int n = 0; n < 2; ++n) acc[b][m][n] = (f32x4){0.f, 0.f, 0.f, 0.f};
    bf16x8 At[4][2], B0[2][2], B1[2][2];
    const char* cA = (const char*)g.A + (size_t)hu.pm2 * hstep; const char* cB = (const char*)g.Bt + (size_t)hu.pn * 2 * hstep;
    HM_STAGE(HM_SB(0, 0), cB, voffB); HM_STAGE(HM_SB(0, 1), cB + hstep, voffB); HM_STAGE(HM_SA(0), cA, voffA);
    HM_STAGE(HM_SB(1, 0), cB + kstep, voffB); HM_STAGE(HM_SB(1, 1), cB + hstep + kstep, voffB); HM_STAGE(HM_SA(1), cA + kstep, voffA);
    if (wr == 1) HM_BAR;
    HM_WAIT_V(6); HM_BAR; HM_BAR;
#define HM_SP(b, bn2, s) do { \
        HM_LDB(B0, b, 0); HM_LDB(B1, b, 1); HM_SCHED; HM_LDA(At, b); \
        if ((s) + 2 < nt) { const char* a2 = cA + (size_t)((s) + 2) * kstep; const char* b2 = cB + (size_t)((s) + 2) * kstep; \
            HM_STAGE(HM_SB(bn2, 0), b2, voffB); HM_STAGE(HM_SB(bn2, 1), b2 + hstep, voffB); HM_STAGE(HM_SA(bn2), a2, voffA); HM_WAIT_V(6); } \
        else { HM_WAIT_V(0); } \
        HM_WAIT_L(0); HM_BAR; HM_MMA(0, At, B0); HM_MMA(1, At, B1); HM_BAR; HM_SCHED; } while (0)
    for (int s = 0; s < nt; s += 3) {
        HM_SP(0, 2, s);
        if (s + 1 < nt) HM_SP(1, 0, s + 1);
        if (s + 2 < nt) HM_SP(2, 1, s + 2);
    }
    if (wr == 0) HM_BAR;
    E.half(acc, hu, wr, wc, fr, fq);
#undef HM_SA
#undef HM_SB
#undef HM_STAGE
#undef HM_LDA
#undef HM_LDB
#undef HM_MMA
#undef HM_WAIT_V
#undef HM_WAIT_L
#undef HM_BAR
#undef HM_SCHED
#undef HM_SP
}
}
namespace att {
typedef short bf16x8 __attribute__((ext_vector_type(8)));
typedef short s16x4 __attribute__((ext_vector_type(4)));
typedef float f32x16 __attribute__((ext_vector_type(16)));
typedef float f32x4 __attribute__((ext_vector_type(4)));
typedef unsigned u32x4 __attribute__((ext_vector_type(4)));
typedef int int4v __attribute__((ext_vector_type(4)));
typedef unsigned short bf16_t;
constexpr int SEQ = 2048, OPITCH = 1024;
constexpr int SLOTB = 8192, NSLOT = 4;
constexpr int LDS_K = 0, LDS_V = NSLOT * SLOTB, LDS_WS = 2 * NSLOT * SLOTB, LDS_OST = LDS_WS + 8 * 256, LDS_KMT = LDS_OST + 8 * 4096, LDS_END = LDS_KMT + 8 * 64 * 4;
typedef LAS const char* lds_cptr;
#define ATT_SBAR() __builtin_amdgcn_sched_barrier(0)
#define ATT_WAIT_BAR(N) asm volatile("s_waitcnt vmcnt(" #N ") lgkmcnt(0)\n\ts_barrier" ::: "memory")
__device__ __forceinline__ int crow(int r, int hi) { return (r & 3) + 8 * (r >> 2) + 4 * hi; }
__device__ __forceinline__ void glds16(const void* gsrc, unsigned lds_dst) { unsigned keep;
    asm volatile("s_mov_b32 %0, m0\n\ts_mov_b32 m0, %2\n\ts_nop 0\n\tglobal_load_lds_dwordx4 %1, off\n\ts_mov_b32 m0, %0" : "=&s"(keep) : "v"(gsrc), "s"(lds_dst) : "memory"); }
typedef float f32x2_t __attribute__((ext_vector_type(2))); typedef __bf16 bf16x2_t __attribute__((ext_vector_type(2)));
__device__ __forceinline__ unsigned cvtpk(float lo, float hi) { f32x2_t v = {lo, hi}; bf16x2_t b = __builtin_convertvector(v, bf16x2_t); return __builtin_bit_cast(unsigned, b); }
__device__ __forceinline__ float bf2f(short s) { return __builtin_bit_cast(float, (unsigned)(unsigned short)s << 16); }
__device__ __forceinline__ float partner(float x, int hi) {
    auto rr = __builtin_amdgcn_permlane32_swap(__builtin_bit_cast(unsigned, x), __builtin_bit_cast(unsigned, x), false, false);
    return __builtin_bit_cast(float, hi ? rr[0] : rr[1]);
}
typedef short v4i16_t __attribute__((ext_vector_type(4)));
__device__ __forceinline__ s16x4 vtr(lds_cptr p) { return __builtin_bit_cast(s16x4, __builtin_amdgcn_ds_read_tr16_b64_v4i16((LAS v4i16_t*)p)); }
__device__ __forceinline__ void vload16(s16x4* vlo, s16x4* vhi, lds_cptr vp) {
#pragma unroll
    for (int i = 0; i < 8; ++i) { vlo[i] = vtr(vp + ((i >> 2) * 4096 + (i & 3) * 1024)); vhi[i] = vtr(vp + ((i >> 2) * 4096 + (i & 3) * 1024 + 512)); }
}
__device__ __forceinline__ void pv_r(f32x16* o, const s16x4* vlo, const s16x4* vhi, bf16x8 pa0, bf16x8 pa1, bf16x8 pa2, bf16x8 pa3) {
#define ATT_VF(i) (bf16x8){vlo[i][0], vlo[i][1], vlo[i][2], vlo[i][3], vhi[i][0], vhi[i][1], vhi[i][2], vhi[i][3]}
    o[0] = __builtin_amdgcn_mfma_f32_32x32x16_bf16(pa0, ATT_VF(0), o[0], 0, 0, 0); o[1] = __builtin_amdgcn_mfma_f32_32x32x16_bf16(pa0, ATT_VF(4), o[1], 0, 0, 0);
    o[0] = __builtin_amdgcn_mfma_f32_32x32x16_bf16(pa1, ATT_VF(1), o[0], 0, 0, 0); o[1] = __builtin_amdgcn_mfma_f32_32x32x16_bf16(pa1, ATT_VF(5), o[1], 0, 0, 0);
    o[0] = __builtin_amdgcn_mfma_f32_32x32x16_bf16(pa2, ATT_VF(2), o[0], 0, 0, 0); o[1] = __builtin_amdgcn_mfma_f32_32x32x16_bf16(pa2, ATT_VF(6), o[1], 0, 0, 0);
    o[0] = __builtin_amdgcn_mfma_f32_32x32x16_bf16(pa3, ATT_VF(3), o[0], 0, 0, 0); o[1] = __builtin_amdgcn_mfma_f32_32x32x16_bf16(pa3, ATT_VF(7), o[1], 0, 0, 0);
#undef ATT_VF
}
__device__ __forceinline__ void qkt(f32x16& p0, f32x16& p1, lds_cptr kb, const bf16x8* qr) {
    const f32x16 z = {};
#pragma unroll
    for (int d0 = 0; d0 < 4; ++d0) {
        const bf16x8 b0 = *(const LAS bf16x8*)(kb + d0 * 2048);
        const bf16x8 b1 = *(const LAS bf16x8*)(kb + d0 * 2048 + 512);
        if (d0 == 0) { p0 = __builtin_amdgcn_mfma_f32_32x32x16_bf16(b0, qr[0], z, 0, 0, 0); p1 = __builtin_amdgcn_mfma_f32_32x32x16_bf16(b1, qr[0], z, 0, 0, 0); }
        else { p0 = __builtin_amdgcn_mfma_f32_32x32x16_bf16(b0, qr[d0], p0, 0, 0, 0); p1 = __builtin_amdgcn_mfma_f32_32x32x16_bf16(b1, qr[d0], p1, 0, 0, 0); }
    }
}
__device__ __forceinline__ void qkt_aug(f32x16& p0, f32x16& p1, lds_cptr kb, const bf16x8* qr, const f32x16& c, bf16x8 kaug0, bf16x8 kaug1, bf16x8 qaug) {
    p0 = __builtin_amdgcn_mfma_f32_32x32x16_bf16(kaug0, qaug, c, 0, 0, 0); p1 = __builtin_amdgcn_mfma_f32_32x32x16_bf16(kaug1, qaug, c, 0, 0, 0);
#pragma unroll
    for (int d0 = 0; d0 < 4; ++d0) {
        const bf16x8 b0 = *(const LAS bf16x8*)(kb + d0 * 2048);
        const bf16x8 b1 = *(const LAS bf16x8*)(kb + d0 * 2048 + 512);
        p0 = __builtin_amdgcn_mfma_f32_32x32x16_bf16(b0, qr[d0], p0, 0, 0, 0); p1 = __builtin_amdgcn_mfma_f32_32x32x16_bf16(b1, qr[d0], p1, 0, 0, 0);
    }
}
__device__ __forceinline__ void pv(f32x16* o, int vb, bf16x8 pa0, bf16x8 pa1, bf16x8 pa2, bf16x8 pa3) {
#pragma unroll
    for (int d0 = 0; d0 < 2; ++d0) { s16x4 lo[4], hi[4];
#pragma unroll
        for (int ks = 0; ks < 4; ++ks) {
            asm volatile("ds_read_b64_tr_b16 %0,%1 offset:%c2" : "=&v"(lo[ks]) : "v"(vb), "i"(d0 * 4096 + ks * 1024) : "memory");
            asm volatile("ds_read_b64_tr_b16 %0,%1 offset:%c2" : "=&v"(hi[ks]) : "v"(vb), "i"(d0 * 4096 + ks * 1024 + 512) : "memory"); }
        asm volatile("s_waitcnt lgkmcnt(0)" ::: "memory"); ATT_SBAR();
#define ATT_PK(k) (bf16x8){lo[k][0], lo[k][1], lo[k][2], lo[k][3], hi[k][0], hi[k][1], hi[k][2], hi[k][3]}
        o[d0] = __builtin_amdgcn_mfma_f32_32x32x16_bf16(pa0, ATT_PK(0), o[d0], 0, 0, 0);
        o[d0] = __builtin_amdgcn_mfma_f32_32x32x16_bf16(pa1, ATT_PK(1), o[d0], 0, 0, 0);
        o[d0] = __builtin_amdgcn_mfma_f32_32x32x16_bf16(pa2, ATT_PK(2), o[d0], 0, 0, 0);
        o[d0] = __builtin_amdgcn_mfma_f32_32x32x16_bf16(pa3, ATT_PK(3), o[d0], 0, 0, 0);
#undef ATT_PK
    }
}
template <bool MOBA>
__device__ __forceinline__ void attn_unit(const int b, const int h, const int qb, const bf16_t* __restrict__ QKV, const int pitch, const int koff, const int voff,
                                          bf16_t* __restrict__ O, LAS unsigned char* lds, const float* __restrict__ KMP, const float sl2, const unsigned force_sel = 0u) {
    int tid = threadIdx.x; asm volatile("" : "+v"(tid));
    const int lane = tid & 63, r32 = lane & 31, hi = lane >> 5;
    const int wid = __builtin_amdgcn_readfirstlane(tid >> 6);
    const long rowbase = (long)b * SEQ; const int q0 = qb * 256;
    const bf16_t* Qw = QKV + (rowbase + q0 + wid * 32) * pitch + h * 64;
    const bf16_t* Kh = QKV + rowbase * pitch + koff + h * 64;
    const bf16_t* Vh = QKV + rowbase * pitch + voff + h * 64;
    const unsigned lds0 = (unsigned)(uintptr_t)lds;
    const bf16_t* ksrc = Kh + (long)lane * pitch + wid * 8;
    const bf16_t* vsrc = Vh + (long)(16 * (wid & 3) + (lane >> 2)) * pitch + (wid >> 2) * 32 + (lane & 3) * 8;
    const unsigned kdst = lds0 + LDS_K + wid * 1024, vdst = lds0 + LDS_V + wid * 1024;
#define ATT_DMA_KV(t, slot) do { glds16(ksrc + (long)(t) * 64 * pitch, (unsigned)__builtin_amdgcn_readfirstlane(kdst + (slot))); \
                                 glds16(vsrc + (long)(t) * 64 * pitch, (unsigned)__builtin_amdgcn_readfirstlane(vdst + (slot))); } while (0)
    const int NT = 4 * qb + 4;
    const int tdiag = 4 * qb + (wid >> 1);
    LAS float* wsf = (LAS float*)(lds + LDS_WS) + wid * 64;
    const lds_cptr kp0 = (lds_cptr)lds + LDS_K + hi * 1024 + r32 * 16;
    const int vb0 = (int)(lds0 + LDS_V) + ((lane >> 4) & 1) * 32 + (lane & 3) * 8 + (4 * hi + ((lane & 15) >> 2)) * 64;
    ATT_DMA_KV(NT - 1, 0); ATT_DMA_KV(NT - 2, SLOTB);
    bf16x8 qr[4];
#pragma unroll
    for (int d0 = 0; d0 < 4; ++d0) qr[d0] = *(const bf16x8*)(Qw + (long)r32 * pitch + d0 * 16 + hi * 8);
    f32x16 o[2]; o[0] = f32x16{}; o[1] = f32x16{};
    const int qrel = wid * 32 + r32;
    float carry = 1.0f;
    float mhat = 0.f, lrow = 0.f; unsigned selmask = 0u;
    bf16x8 kaug0 = {0, 0, 0, 0, 0, 0, 0, 0}, kaug1 = {0, 0, 0, 0, 0, 0, 0, 0}, qaug = {0, 0, 0, 0, 0, 0, 0, 0};
    if constexpr (MOBA) {
        LAS float* kmt = (LAS float*)(lds + LDS_KMT);
        { const int n = tid >> 6, d = tid & 63;
          if (n < qb) { const float* kp = KMP + ((size_t)(b * 8 + n) * 2) * 1024 + h * 64 + d; kmt[n * 64 + d] = (kp[0] + kp[1024]) * (1.0f / 256.0f); } }
        asm volatile("s_waitcnt lgkmcnt(0)\n\ts_barrier" ::: "memory");
        float gate[7];
#pragma unroll
        for (int n = 0; n < 7; ++n) {
            float g = -INFINITY;
            if (n < qb) {
                float s = 0.f;
#pragma unroll
                for (int d0 = 0; d0 < 4; ++d0) {
                    const f32x4 k0 = *(const LAS f32x4*)(kmt + n * 64 + d0 * 16 + hi * 8), k1 = *(const LAS f32x4*)(kmt + n * 64 + d0 * 16 + hi * 8 + 4);
                    s += bf2f(qr[d0][0]) * k0[0] + bf2f(qr[d0][1]) * k0[1] + bf2f(qr[d0][2]) * k0[2] + bf2f(qr[d0][3]) * k0[3]
                       + bf2f(qr[d0][4]) * k1[0] + bf2f(qr[d0][5]) * k1[1] + bf2f(qr[d0][6]) * k1[2] + bf2f(qr[d0][7]) * k1[3];
                }
                g = s + partner(s, hi);
            }
            gate[n] = g;
        }
#pragma unroll
        for (int r = 0; r < 3; ++r) {
            int best = -1; float bv = -INFINITY;
#pragma unroll
            for (int n = 0; n < 7; ++n) { const bool taken = (selmask >> n) & 1u; if (!taken && gate[n] > bv) { best = n; bv = gate[n]; } }
            if (best >= 0) selmask |= 1u << best;
        }
        selmask |= (1u << qb) | force_sel;
        mhat = sl2 * (float)qrel;
        if (hi == 0) {
            const unsigned sh = __builtin_bit_cast(unsigned, sl2) + 0x7fffu + ((__builtin_bit_cast(unsigned, sl2) >> 16) & 1u), shb = sh >> 16;
            const float rem = sl2 - __builtin_bit_cast(float, shb << 16); const unsigned sl = (__builtin_bit_cast(unsigned, rem) + 0x7fffu + ((__builtin_bit_cast(unsigned, rem) >> 16) & 1u)) >> 16;
            qaug[0] = (short)shb; qaug[1] = (short)sl;
            const short k0s = (short)(__builtin_bit_cast(unsigned, (float)r32) >> 16), k1s = (short)(__builtin_bit_cast(unsigned, (float)(32 + r32)) >> 16);
            kaug0[0] = k0s; kaug0[1] = k0s; kaug1[0] = k1s; kaug1[1] = k1s;
        }
    }
    LAS int* done = (LAS int*)(lds + LDS_KMT);
    bool wdone = false;
    if constexpr (!MOBA) { if (lane == 0) done[wid] = 0x7fffffff; }
    const lds_cptr vp0 = (lds_cptr)lds + LDS_V + ((lane >> 4) & 1) * 32 + (lane & 3) * 8 + (4 * hi + ((lane & 15) >> 2)) * 64;
    int slot = 0;
    for (int i = 0; i < NT; ++i) {
        const int t = NT - 1 - i;
        const int nslot = (slot == (NSLOT - 1) * SLOTB) ? 0 : slot + SLOTB;
        const int n2slot = (nslot == (NSLOT - 1) * SLOTB) ? 0 : nslot + SLOTB;
        if (i + 2 < NT) { ATT_DMA_KV(t - 2, n2slot); ATT_WAIT_BAR(4); } else if (i + 1 < NT) { ATT_WAIT_BAR(2); } else { ATT_WAIT_BAR(0); }
        if constexpr (!MOBA) {
            const int4v d0v = *(const LAS int4v*)(done), d1v = *(const LAS int4v*)(done + 4);
            int dm = max(max(max(d0v[0], d0v[1]), max(d0v[2], d0v[3])), max(max(d1v[0], d1v[1]), max(d1v[2], d1v[3])));
            dm = __builtin_amdgcn_readfirstlane(dm);
            if (dm < i) break;
        }
        if (t <= tdiag && !wdone) {
            f32x16 p0, p1;
            u32x4 pw0 = {0u, 0u, 0u, 0u}, pw1 = pw0, pw2 = pw0, pw3 = pw0; bool dead = false;
            if constexpr (!MOBA) {
                qkt(p0, p1, kp0 + slot, qr);
                s16x4 vlo[8], vhi[8]; vload16(vlo, vhi, vp0 + slot);
                float om[32];
#pragma unroll
                for (int r = 0; r < 16; r += 2) {
                    f32x2_t e0 = {__builtin_amdgcn_exp2f(p0[r]), __builtin_amdgcn_exp2f(p0[r + 1])}, e1 = {__builtin_amdgcn_exp2f(p1[r]), __builtin_amdgcn_exp2f(p1[r + 1])};
                    const f32x2_t one2 = {1.0f, 1.0f}; e0 = e0 + one2; e1 = e1 + one2;
                    om[r] = __builtin_amdgcn_rcpf(e0.x); om[r + 1] = __builtin_amdgcn_rcpf(e0.y); om[16 + r] = __builtin_amdgcn_rcpf(e1.x); om[16 + r + 1] = __builtin_amdgcn_rcpf(e1.y);
                }
                if (t == tdiag) {
                    const int kb = 64 * (t - 4 * qb) + 4 * hi;
#pragma unroll
                    for (int r = 0; r < 16; ++r) { const int kv = kb + (r & 3) + 8 * (r >> 2);
                        if (kv >= qrel) om[r] = 1.0f; if (kv + 32 >= qrel) om[16 + r] = 1.0f; }
                }
                float xin0[8], xin1[8], xin2[8], gp[8], OS[9];
#pragma unroll
                for (int j = 0; j < 8; ++j) { xin2[j] = om[4 * j + 3]; xin1[j] = xin2[j] * om[4 * j + 2]; xin0[j] = xin1[j] * om[4 * j + 1]; gp[j] = xin0[j] * om[4 * j]; }
                OS[8] = 1.0f;
#pragma unroll
                for (int j = 7; j >= 0; --j) OS[j] = gp[j] * OS[j + 1];
                float oth[8];
#pragma unroll
                for (int j = 0; j < 8; ++j) {
                    auto rr = __builtin_amdgcn_permlane32_swap(__builtin_bit_cast(unsigned, OS[j]), __builtin_bit_cast(unsigned, OS[j + 1]), false, false);
                    oth[j] = __builtin_bit_cast(float, hi ? rr[0] : rr[1]);
                }
                float tot = OS[0] * oth[0];
                { auto rr = __builtin_amdgcn_permlane32_swap(__builtin_bit_cast(unsigned, tot), __builtin_bit_cast(unsigned, tot), false, false); tot = hi ? __builtin_bit_cast(float, rr[0]) : tot; }
                float av[32];
#pragma unroll
                for (int j = 0; j < 8; ++j) { const float xc = carry * (OS[j + 1] * oth[j]); const f32x2_t xc2 = {xc, xc};
                    const f32x2_t dlo = {xin0[j] - gp[j], xin1[j] - xin0[j]}, dhi = {xin2[j] - xin1[j], 1.0f - xin2[j]};
                    const f32x2_t alo = dlo * xc2, ahi = dhi * xc2;
                    av[4 * j] = alo.x; av[4 * j + 1] = alo.y; av[4 * j + 2] = ahi.x; av[4 * j + 3] = ahi.y; }
                carry *= tot;
                if (__all(carry == 0.0f)) { wdone = true; if (lane == 0) done[wid] = i; }
                pw0 = (u32x4){cvtpk(av[0], av[1]), cvtpk(av[2], av[3]), cvtpk(av[4], av[5]), cvtpk(av[6], av[7])};
                pw1 = (u32x4){cvtpk(av[8], av[9]), cvtpk(av[10], av[11]), cvtpk(av[12], av[13]), cvtpk(av[14], av[15])};
                pw2 = (u32x4){cvtpk(av[16], av[17]), cvtpk(av[18], av[19]), cvtpk(av[20], av[21]), cvtpk(av[22], av[23])};
                pw3 = (u32x4){cvtpk(av[24], av[25]), cvtpk(av[26], av[27]), cvtpk(av[28], av[29]), cvtpk(av[30], av[31])};
                pv_r(o, vlo, vhi, __builtin_bit_cast(bf16x8, pw0), __builtin_bit_cast(bf16x8, pw1), __builtin_bit_cast(bf16x8, pw2), __builtin_bit_cast(bf16x8, pw3));
            } else {
                const int blk = t >> 2;
                const bool sel = (selmask >> blk) & 1u;
                const float nv = sel ? (sl2 * (float)(64 * t - q0) - mhat) : -INFINITY;
                f32x16 c;
#pragma unroll
                for (int r = 0; r < 16; ++r) c[r] = nv;
                qkt_aug(p0, p1, kp0 + slot, qr, c, kaug0, kaug1, qaug);
                s16x4 vlo[8], vhi[8]; vload16(vlo, vhi, vp0 + slot);
                if (t == tdiag) {
                    const int kb = 64 * (t - 4 * qb) + 4 * hi;
#pragma unroll
                    for (int r = 0; r < 16; ++r) { const int kv = kb + (r & 3) + 8 * (r >> 2);
                        if (kv > qrel) p0[r] = -INFINITY; if (kv + 32 > qrel) p1[r] = -INFINITY; }
                }
                float a0 = __builtin_fmaxf(__builtin_fmaxf(p0[0], p0[1]), p0[2]), a1 = __builtin_fmaxf(__builtin_fmaxf(p1[0], p1[1]), p1[2]);
#pragma unroll
                for (int r = 3; r < 15; r += 2) { a0 = __builtin_fmaxf(__builtin_fmaxf(a0, p0[r]), p0[r + 1]); a1 = __builtin_fmaxf(__builtin_fmaxf(a1, p1[r]), p1[r + 1]); }
                float rm = __builtin_fmaxf(__builtin_fmaxf(a0, p0[15]), __builtin_fmaxf(a1, p1[15]));
                rm = __builtin_fmaxf(rm, partner(rm, hi));
                dead = __all(rm < -160.0f);
                if (!dead && __any(rm > 8.0f)) {
                    const float dl = __builtin_fmaxf(rm, 0.f);
                    mhat += dl;
#pragma unroll
                    for (int r = 0; r < 16; ++r) { p0[r] -= dl; p1[r] -= dl; }
                    const float f = __builtin_amdgcn_exp2f(-dl);
                    lrow *= f;
                    if (hi == 0) wsf[r32] = f;
                    asm volatile("s_waitcnt lgkmcnt(0)" ::: "memory");
#pragma unroll
                    for (int g4 = 0; g4 < 4; ++g4) { const f32x4 fv = *(const LAS f32x4*)(wsf + 8 * g4 + 4 * hi);
#pragma unroll
                        for (int i2 = 0; i2 < 4; ++i2) { o[0][4 * g4 + i2] *= fv[i2]; o[1][4 * g4 + i2] *= fv[i2]; } }
                    asm volatile("s_waitcnt lgkmcnt(0)" ::: "memory");
                }
                if (!dead) {
                float rs = 0.f;
#pragma unroll
                for (int r = 0; r < 16; ++r) { p0[r] = __builtin_amdgcn_exp2f(p0[r]); p1[r] = __builtin_amdgcn_exp2f(p1[r]); rs += p0[r] + p1[r]; }
                lrow += rs;
                pw0 = (u32x4){cvtpk(p0[0], p0[1]), cvtpk(p0[2], p0[3]), cvtpk(p0[4], p0[5]), cvtpk(p0[6], p0[7])};
                pw1 = (u32x4){cvtpk(p0[8], p0[9]), cvtpk(p0[10], p0[11]), cvtpk(p0[12], p0[13]), cvtpk(p0[14], p0[15])};
                pw2 = (u32x4){cvtpk(p1[0], p1[1]), cvtpk(p1[2], p1[3]), cvtpk(p1[4], p1[5]), cvtpk(p1[6], p1[7])};
                pw3 = (u32x4){cvtpk(p1[8], p1[9]), cvtpk(p1[10], p1[11]), cvtpk(p1[12], p1[13]), cvtpk(p1[14], p1[15])};
                pv_r(o, vlo, vhi, __builtin_bit_cast(bf16x8, pw0), __builtin_bit_cast(bf16x8, pw1), __builtin_bit_cast(bf16x8, pw2), __builtin_bit_cast(bf16x8, pw3));
                }
            }
        }
        slot = nslot;
    }
    if constexpr (!MOBA) asm volatile("s_waitcnt vmcnt(0)" ::: "memory");
    float rli[16];
    if constexpr (MOBA) {
        const float lt = lrow + partner(lrow, hi);
        if (hi == 0) wsf[32 + r32] = lt;
        asm volatile("s_waitcnt lgkmcnt(0)" ::: "memory");
#pragma unroll
        for (int g4 = 0; g4 < 4; ++g4) { const f32x4 lv = *(const LAS f32x4*)(wsf + 32 + 8 * g4 + 4 * hi);
#pragma unroll
            for (int i2 = 0; i2 < 4; ++i2) rli[4 * g4 + i2] = __builtin_amdgcn_rcpf(lv[i2]); }
    } else {
#pragma unroll
        for (int r = 0; r < 16; ++r) rli[r] = 1.0f;
    }
    {
        LAS bf16_t* stg = (LAS bf16_t*)(lds + LDS_OST) + wid * 2048;
#pragma unroll
        for (int r = 0; r < 16; ++r) { const int orow = crow(r, hi);
#pragma unroll
            for (int d0 = 0; d0 < 2; ++d0) stg[orow * 64 + d0 * 32 + r32] = (bf16_t)(cvtpk(o[d0][r] * rli[r], 0.f) & 0xffffu); }
        asm volatile("s_waitcnt lgkmcnt(0)" ::: "memory");
        bf16_t* Ow = O + (rowbase + q0 + wid * 32) * OPITCH + h * 64;
#pragma unroll
        for (int i = 0; i < 4; ++i) { const int row = i * 8 + (lane >> 3), ch = lane & 7; const u32x4 v = *(const LAS u32x4*)(stg + row * 64 + ch * 8); *(u32x4*)(Ow + (long)row * OPITCH + ch * 8) = v; }
    }
    asm volatile("s_waitcnt lgkmcnt(0)\n\ts_barrier" ::: "memory");
#undef ATT_DMA_KV
}
#undef ATT_SBAR
#undef ATT_WAIT_BAR
}
namespace exa {
using bf16=unsigned short;
using bf16x8=__attribute__((ext_vector_type(8)))short;
using s16x4=__attribute__((ext_vector_type(4)))short;
using f32x16=__attribute__((ext_vector_type(16)))float;
using u32x4=__attribute__((ext_vector_type(4)))unsigned;
constexpr int SEQ=2048,D=64,DM=3072;
constexpr int NW=8,QBLK=32,QB=QBLK*NW,KVBLK=64;
__device__ __forceinline__ int crow(int r,int hi){return (r&3)+8*(r>>2)+4*hi;}
#define SBAR() __builtin_amdgcn_sched_barrier(0)
__device__ __forceinline__ void cmask(f32x16&p0,f32x16&p1,int jb,int qrel,int hi){
  const float NEG=-INFINITY; int kb=64*jb+4*hi;
  #pragma unroll
  for(int r=0;r<16;++r){int kv=kb+(r&3)+8*(r>>2); if(kv>qrel)p0[r]=NEG; if(kv+32>qrel)p1[r]=NEG;}
}
constexpr int NSLOT=3, SLOTB=8192;
constexpr int LDS_K=0, LDS_V=NSLOT*SLOTB, LDS_WS=2*NSLOT*SLOTB, LDS_OST=LDS_WS+NW*64*4, LDS_BYTES=LDS_OST+NW*4096;
__device__ __forceinline__ void glds16(const void*gsrc,unsigned lds_dst){unsigned keep;
  asm volatile("s_mov_b32 %0, m0\n\ts_mov_b32 m0, %2\n\ts_nop 0\n\tglobal_load_lds_dwordx4 %1, off\n\ts_mov_b32 m0, %0":"=&s"(keep):"v"(gsrc),"s"(lds_dst):"memory");}
__device__ __forceinline__ float max3f(float a,float b,float c){float r;asm("v_max3_f32 %0, %1, %2, %3":"=v"(r):"v"(a),"v"(b),"v"(c));return r;}
__device__ __forceinline__ float max2f(float a,float b){float r;asm("v_max_f32_e32 %0, %1, %2":"=v"(r):"v"(a),"v"(b));return r;}
__device__ __forceinline__ float fadd_s(float a,float b){float r;asm("v_add_f32_e32 %0, %1, %2":"=v"(r):"v"(a),"v"(b));return r;}
__device__ __forceinline__ float fsub_s(float a,float b){float r;asm("v_sub_f32_e32 %0, %1, %2":"=v"(r):"v"(a),"v"(b));return r;}
typedef float f32x2_t __attribute__((ext_vector_type(2))); typedef __bf16 bf16x2_t __attribute__((ext_vector_type(2)));
__device__ __forceinline__ unsigned cvtpk_s(float lo,float hi){f32x2_t v={lo,hi};bf16x2_t b=__builtin_convertvector(v,bf16x2_t);return __builtin_bit_cast(unsigned,b);}
#define WAIT_BAR(N) asm volatile("s_waitcnt vmcnt(" #N ") lgkmcnt(0)\n\ts_barrier":::"memory")
typedef LAS const char* lds_cptr;
__device__ __forceinline__ void qkt(f32x16&p0,f32x16&p1,lds_cptr Kslot,const bf16x8*qr,const f32x16&negm,int r32,int hi){
  const lds_cptr kb=Kslot+hi*1024+r32*16;
  #pragma unroll
  for(int d0=0;d0<4;++d0){
    const bf16x8 b0=*(const LAS bf16x8*)(kb+d0*2048);
    const bf16x8 b1=*(const LAS bf16x8*)(kb+d0*2048+512);
    if(d0==0){p0=__builtin_amdgcn_mfma_f32_32x32x16_bf16(b0,qr[0],negm,0,0,0);p1=__builtin_amdgcn_mfma_f32_32x32x16_bf16(b1,qr[0],negm,0,0,0);}
    else{p0=__builtin_amdgcn_mfma_f32_32x32x16_bf16(b0,qr[d0],p0,0,0,0);p1=__builtin_amdgcn_mfma_f32_32x32x16_bf16(b1,qr[d0],p1,0,0,0);}}
}
typedef short v4i16_t __attribute__((ext_vector_type(4)));
__device__ __forceinline__ void kload8(bf16x8*kf,lds_cptr kp){
  kf[0]=*(const LAS bf16x8*)(kp);      kf[1]=*(const LAS bf16x8*)(kp+512);
  kf[2]=*(const LAS bf16x8*)(kp+2048); kf[3]=*(const LAS bf16x8*)(kp+2560);
  kf[4]=*(const LAS bf16x8*)(kp+4096); kf[5]=*(const LAS bf16x8*)(kp+4608);
  kf[6]=*(const LAS bf16x8*)(kp+6144); kf[7]=*(const LAS bf16x8*)(kp+6656);
}
__device__ __forceinline__ void kload2(bf16x8*kf,lds_cptr kp,int j){ kf[2*j]=*(const LAS bf16x8*)(kp+j*2048); kf[2*j+1]=*(const LAS bf16x8*)(kp+j*2048+512); }
__device__ __forceinline__ s16x4 vtr(lds_cptr p){ return __builtin_bit_cast(s16x4,__builtin_amdgcn_ds_read_tr16_b64_v4i16((LAS v4i16_t*)p)); }
__device__ __forceinline__ float rowmax(const f32x16&p0,const f32x16&p1){
  float a=max3f(p0[0],p0[1],p1[0]),b=max3f(p0[2],p0[3],p1[1]);a=max3f(a,p1[2],p1[3]);
  #pragma unroll
  for(int r=4;r<16;r+=4){a=max3f(a,p0[r],p0[r+1]);b=max3f(b,p0[r+2],p0[r+3]);a=max3f(a,p1[r],p1[r+1]);b=max3f(b,p1[r+2],p1[r+3]);}
  const float m=max2f(a,b);
  auto rr=__builtin_amdgcn_permlane32_swap(__float_as_uint(m),__float_as_uint(m),false,false);
  return max2f(__uint_as_float(rr[0]),__uint_as_float(rr[1]));
}
__device__ __forceinline__ void pv(f32x16*o,int vb,bf16x8 pa0,bf16x8 pa1,bf16x8 pa2,bf16x8 pa3){
  #pragma unroll
  for(int d0=0;d0<2;++d0){s16x4 lo[4],hi[4];
    #pragma unroll
    for(int ks=0;ks<4;++ks){
      asm volatile("ds_read_b64_tr_b16 %0,%1 offset:%c2":"=&v"(lo[ks]):"v"(vb),"i"(d0*4096+ks*1024):"memory");
      asm volatile("ds_read_b64_tr_b16 %0,%1 offset:%c2":"=&v"(hi[ks]):"v"(vb),"i"(d0*4096+ks*1024+512):"memory");}
    asm volatile("s_waitcnt lgkmcnt(0)":::"memory");SBAR();
    #define PK(k) (bf16x8){lo[k][0],lo[k][1],lo[k][2],lo[k][3],hi[k][0],hi[k][1],hi[k][2],hi[k][3]}
    o[d0]=__builtin_amdgcn_mfma_f32_32x32x16_bf16(pa0,PK(0),o[d0],0,0,0);
    o[d0]=__builtin_amdgcn_mfma_f32_32x32x16_bf16(pa1,PK(1),o[d0],0,0,0);
    o[d0]=__builtin_amdgcn_mfma_f32_32x32x16_bf16(pa2,PK(2),o[d0],0,0,0);
    o[d0]=__builtin_amdgcn_mfma_f32_32x32x16_bf16(pa3,PK(3),o[d0],0,0,0);
    #undef PK
  }
}
template<int THRL> __device__ __forceinline__ void attn_unit(int b,int h,int qb,const bf16*QKV,bf16*O,LAS unsigned char*shm,const float*KMP=nullptr,const float sl2=0.f,const unsigned force_sel=0u){
  int tid=threadIdx.x; asm volatile("":"+v"(tid)); const int lane=tid&63,r32=lane&31,hi=lane>>5; const int wid=__builtin_amdgcn_readfirstlane(tid>>6);
  const long rowbase=(long)b*SEQ; const int q0=qb*QB;
  const bf16*Qw=QKV+(rowbase+q0+wid*QBLK)*DM+h*D;
  const bf16*Kh=QKV+rowbase*DM+1024+h*D,*Vh=QKV+rowbase*DM+2048+h*D;
  const unsigned lds0=(unsigned)(uintptr_t)shm;
  LAS float*wsf=(LAS float*)(shm+LDS_WS)+wid*64;
  const bf16*ksrc=Kh+(long)lane*DM+wid*8;
  const bf16*vsrc=Vh+(long)(16*(wid&3)+(lane>>2))*DM+(wid>>2)*32+(lane&3)*8;
  const unsigned kdst=lds0+LDS_K+wid*1024, vdst=lds0+LDS_V+wid*1024;
  #define DMA_K(t,slot) glds16(ksrc+(long)(t)*KVBLK*DM,(unsigned)__builtin_amdgcn_readfirstlane(kdst+(slot)))
  #define DMA_V(t,slot) glds16(vsrc+(long)(t)*KVBLK*DM,(unsigned)__builtin_amdgcn_readfirstlane(vdst+(slot)))
  const int vb0=(int)(lds0+LDS_V)+((lane>>4)&1)*32+(lane&3)*8+(4*hi+((lane&15)>>2))*64;
  bf16x8 kf[8];
  const lds_cptr shm3=(lds_cptr)shm; const lds_cptr kp0=shm3+LDS_K+hi*1024+r32*16; const lds_cptr vp0=shm3+LDS_V+((lane>>4)&1)*32+(lane&3)*8+(4*hi+((lane&15)>>2))*64;
  const int NT=(q0+QB)/KVBLK;
  DMA_K(0,0);DMA_V(0,0);DMA_K(1,SLOTB);DMA_K(2,2*SLOTB);
  bf16x8 qr[4];
  #pragma unroll
  for(int d0=0;d0<4;++d0)qr[d0]=*reinterpret_cast<const bf16x8*>(&Qw[(long)r32*DM+d0*16+hi*8]);
#if defined(EXA_G1)
  unsigned selmask=0u; bf16x8 kaug0={0,0,0,0,0,0,0,0},kaug1={0,0,0,0,0,0,0,0},qaug={0,0,0,0,0,0,0,0};
  { LAS float*kmt=(LAS float*)(shm+LDS_BYTES);
    { const int n=tid>>6,d=tid&63; if(n<qb){ const float*kp=KMP+((size_t)(b*8+n)*2)*1024+h*64+d; kmt[n*64+d]=(kp[0]+kp[1024])*(1.0f/256.0f);} }
    asm volatile("s_waitcnt lgkmcnt(0)\n\ts_barrier":::"memory");
    float gate[7];
    #pragma unroll
    for(int n=0;n<7;++n){ float g=-INFINITY; if(n<qb){ float s=0.f;
        #pragma unroll
        for(int d0=0;d0<4;++d0){ const att::f32x4 k0=*(const LAS att::f32x4*)(kmt+n*64+d0*16+hi*8),k1=*(const LAS att::f32x4*)(kmt+n*64+d0*16+hi*8+4);
          s+=att::bf2f(qr[d0][0])*k0[0]+att::bf2f(qr[d0][1])*k0[1]+att::bf2f(qr[d0][2])*k0[2]+att::bf2f(qr[d0][3])*k0[3]+att::bf2f(qr[d0][4])*k1[0]+att::bf2f(qr[d0][5])*k1[1]+att::bf2f(qr[d0][6])*k1[2]+att::bf2f(qr[d0][7])*k1[3]; }
        g=s+att::partner(s,hi);} gate[n]=g; }
    #pragma unroll
    for(int r=0;r<3;++r){ int best=-1; float bv=-INFINITY;
      #pragma unroll
      for(int n=0;n<7;++n){ const bool taken=(selmask>>n)&1u; if(!taken&&gate[n]>bv){best=n;bv=gate[n];} }
      if(best>=0)selmask|=1u<<best; }
    selmask|=(1u<<qb)|force_sel;
    if(hi==0){ const unsigned sh=__float_as_uint(sl2)+0x7fffu+((__float_as_uint(sl2)>>16)&1u),shb=sh>>16; const float rem=sl2-__uint_as_float(shb<<16); const unsigned sl=(__float_as_uint(rem)+0x7fffu+((__float_as_uint(rem)>>16)&1u))>>16;
      qaug[0]=(short)shb; qaug[1]=(short)sl; const short k0s=(short)(__float_as_uint((float)r32)>>16),k1s=(short)(__float_as_uint((float)(32+r32))>>16); kaug0[0]=k0s;kaug0[1]=k0s;kaug1[0]=k1s;kaug1[1]=k1s; } }
  asm volatile(""::"v"(selmask),"v"(kaug0),"v"(kaug1),"v"(qaug));
#endif
  float mhat=0.f,l_reg=0.f;f32x16 o[2];o[0]=f32x16{};o[1]=f32x16{};f32x16 negm=f32x16{};asm volatile("":"+v"(negm));
  const int qrel=wid*QBLK+r32;
  #define CMASK(P0,P1,t) do{int jb_=(t)-(NT-4); if(jb_>=0)cmask(P0,P1,jb_,qrel,hi);}while(0)
  bool resc=false;
  #define START(P0,P1) do{ const float rm=rowmax(P0,P1); resc=false; \
    { const float dl=rm; mhat=fadd_s(mhat,dl); \
      _Pragma("unroll") for(int r=0;r<16;++r){P0[r]=fsub_s(P0[r],dl);P1[r]=fsub_s(P1[r],dl);} \
      _Pragma("unroll") for(int r=0;r<16;++r)negm[r]=-mhat; asm volatile("":"+v"(negm)); } \
    _Pragma("unroll") for(int r=0;r<16;++r)P0[r]=__builtin_amdgcn_exp2f(P0[r]); }while(0)
  #define RESC() do{ if(resc){ asm volatile("s_waitcnt lgkmcnt(0)":::"memory"); \
      _Pragma("unroll") for(int d_=0;d_<2;++d_) _Pragma("unroll") for(int r=0;r<16;++r)o[d_][r]*=wsf[crow(r,hi)]; } }while(0)
#if defined(EXA_G3)
  const float boff=-sl2*(float)(q0+qrel);
  #define SETNEGM(t) do{ const float nv_=((selmask>>((t)>>2))&1u)?(sl2*(float)(64*(t))+boff-mhat):-INFINITY; _Pragma("unroll") for(int r=0;r<16;++r)negm[r]=nv_; asm volatile("":"+v"(negm)); }while(0)
  #define NEGMUPD() do{}while(0)
#else
  #define SETNEGM(t) do{}while(0)
  #define NEGMUPD() do{ _Pragma("unroll") for(int r=0;r<16;++r)negm[r]=-mhat; asm volatile("":"+v"(negm)); }while(0)
#endif
  f32x16 pA0,pA1,pB0,pB1;
  int sl_prev=0,sl_cur=0,sl_next=SLOTB;
  #define ROT() do{sl_prev=sl_cur;sl_cur=sl_next;sl_next=(sl_next==(NSLOT-1)*SLOTB)?0:sl_next+SLOTB;}while(0)
  WAIT_BAR(3);
  SETNEGM(0);
#if defined(EXA_G2)
  { f32x16 a0_=__builtin_amdgcn_mfma_f32_32x32x16_bf16(kaug0,qaug,negm,0,0,0), a1_=__builtin_amdgcn_mfma_f32_32x32x16_bf16(kaug1,qaug,negm,0,0,0); qkt(pA0,pA1,(lds_cptr)shm+LDS_K,qr,negm,r32,hi);
    (void)a0_; (void)a1_; }
  {
    const lds_cptr kb=(lds_cptr)shm+LDS_K+hi*1024+r32*16;
    pA0=__builtin_amdgcn_mfma_f32_32x32x16_bf16(kaug0,qaug,negm,0,0,0); pA1=__builtin_amdgcn_mfma_f32_32x32x16_bf16(kaug1,qaug,negm,0,0,0);
    #pragma unroll
    for(int d0=0;d0<4;++d0){ const bf16x8 b0=*(const LAS bf16x8*)(kb+d0*2048); const bf16x8 b1=*(const LAS bf16x8*)(kb+d0*2048+512);
      pA0=__builtin_amdgcn_mfma_f32_32x32x16_bf16(b0,qr[d0],pA0,0,0,0); pA1=__builtin_amdgcn_mfma_f32_32x32x16_bf16(b1,qr[d0],pA1,0,0,0); }
  }
#else
  qkt(pA0,pA1,(lds_cptr)shm+LDS_K,qr,negm,r32,hi);
#endif
  asm volatile("s_nop 15\n\ts_nop 7":"+v"(pA0),"+v"(pA1));CMASK(pA0,pA1,0);
#if defined(EXA_G3)
  { const float rm=rowmax(pA0,pA1); if(__builtin_expect(__any(rm>(float)THRL),0)){ const float dl=__builtin_fmaxf(rm,0.f); mhat+=dl;
      #pragma unroll
      for(int r=0;r<16;++r){pA0[r]-=dl;pA1[r]-=dl;} } }
  #pragma unroll
  for(int r=0;r<16;++r)pA0[r]=__builtin_amdgcn_exp2f(pA0[r]);
#else
  START(pA0,pA1);
#endif
  _Pragma("unroll") for(int r=0;r<16;++r)pA1[r]=__builtin_amdgcn_exp2f(pA1[r]);
  WAIT_BAR(0);
  DMA_K(3,0);DMA_V(1,SLOTB);
  ROT();
  kload8(kf,kp0+sl_cur);
  WAIT_BAR(2);
  s16x4 vlo[8],vhi[8]; u32x4 pw0,pw1,pw2,pw3;
  #define PKW(P,B) cvtpk_s(P[B],P[B+1])
  #define PAF(k) __builtin_bit_cast(bf16x8,pw##k)
  #define VFR(i) (bf16x8){vlo[i][0],vlo[i][1],vlo[i][2],vlo[i][3],vhi[i][0],vhi[i][1],vhi[i][2],vhi[i][3]}
  #define PIN(x) asm volatile("":"+v"(x))
  #define MX3(a,b,c) __builtin_fmaxf(__builtin_fmaxf((a),(b)),(c))
  #define GAPA(MF,A0,A1,A2,A3,W0,W1,PW) do{ MF; sacc+=A0; sacc+=A1; sacc+=A2; sacc+=A3; PIN(sacc); W0; W1; PIN(PW); SBAR(); }while(0)
  #define EX(v) __builtin_amdgcn_exp2f(v)
  #define GAPB(MF,X,B) do{ MF; X[B]=EX(X[B]); X[B+1]=EX(X[B+1]); X[B+2]=EX(X[B+2]); X[B+3]=EX(X[B+3]); PIN(X); SBAR(); }while(0)
  #define VRD(i) do{ vlo[i]=vtr(vp_+(((i)>>2)*4096+((i)&3)*1024)); vhi[i]=vtr(vp_+(((i)>>2)*4096+((i)&3)*1024+512)); }while(0)
  #define KRD(G,j) do{ if(G){ kload2(kf,kp0+sl_next,j); SBAR(); } }while(0)
#if defined(EXA_G2)
  #define EXA_AUG(C0,C1) do{ C0=__builtin_amdgcn_mfma_f32_32x32x16_bf16(kaug0,qaug,negm,0,0,0); C1=__builtin_amdgcn_mfma_f32_32x32x16_bf16(kaug1,qaug,negm,0,0,0); SBAR(); }while(0)
  #define EXA_C0IN(C) C
#else
  #define EXA_AUG(C0,C1) do{}while(0)
  #define EXA_C0IN(C) negm
#endif
  #define STEP(C0,C1,P0,P1,t,GK,GV,GL) do{ SBAR(); \
    const lds_cptr vp_=vp0+sl_prev; \
    EXA_AUG(C0,C1); \
    VRD(0); SBAR(); float sacc=(P0[0]+P0[1]); \
    GAPA(C0=__builtin_amdgcn_mfma_f32_32x32x16_bf16(kf[0],qr[0],EXA_C0IN(C0),0,0,0), P0[2],P0[3],P0[4],P0[5],     pw0[0]=PKW(P0,0), pw0[1]=PKW(P0,2), pw0); \
    VRD(4); SBAR(); GAPA(C1=__builtin_amdgcn_mfma_f32_32x32x16_bf16(kf[1],qr[0],EXA_C0IN(C1),0,0,0), P0[6],P0[7],P0[8],P0[9],     pw0[2]=PKW(P0,4), pw0[3]=PKW(P0,6), pw0); \
    VRD(1); SBAR(); GAPA(C0=__builtin_amdgcn_mfma_f32_32x32x16_bf16(kf[2],qr[1],C0,0,0,0),   P0[10],P0[11],P0[12],P0[13], pw1[0]=PKW(P0,8), pw1[1]=PKW(P0,10), pw1); \
    VRD(5); SBAR(); GAPA(C1=__builtin_amdgcn_mfma_f32_32x32x16_bf16(kf[3],qr[1],C1,0,0,0),   P0[14],P0[15],P1[0],P1[1],   pw1[2]=PKW(P0,12),pw1[3]=PKW(P0,14), pw1); \
    VRD(2); SBAR(); GAPA(C0=__builtin_amdgcn_mfma_f32_32x32x16_bf16(kf[4],qr[2],C0,0,0,0),   P1[2],P1[3],P1[4],P1[5],     pw2[0]=PKW(P1,0), pw2[1]=PKW(P1,2), pw2); \
    VRD(6); SBAR(); GAPA(C1=__builtin_amdgcn_mfma_f32_32x32x16_bf16(kf[5],qr[2],C1,0,0,0),   P1[6],P1[7],P1[8],P1[9],     pw2[2]=PKW(P1,4), pw2[3]=PKW(P1,6), pw2); \
    VRD(3); SBAR(); GAPA(C0=__builtin_amdgcn_mfma_f32_32x32x16_bf16(kf[6],qr[3],C0,0,0,0),   P1[10],P1[11],P1[12],P1[13], pw3[0]=PKW(P1,8), pw3[1]=PKW(P1,10), pw3); \
    VRD(7); SBAR(); GAPA(C1=__builtin_amdgcn_mfma_f32_32x32x16_bf16(kf[7],qr[3],C1,0,0,0),   P1[14],P1[15],0.f,0.f,       pw3[2]=PKW(P1,12),pw3[3]=PKW(P1,14), pw3); \
    l_reg+=sacc; \
    if(GK){DMA_K((t)+3,sl_cur);} if(GV){DMA_V((t)+1,sl_next);} \
    CMASK(C0,C1,t); \
    { float a=MX3(C0[0],C0[1],C1[0]),b=MX3(C0[2],C0[3],C1[1]); a=MX3(a,C1[2],C1[3]); \
      _Pragma("unroll") for(int r=4;r<16;r+=4){a=MX3(a,C0[r],C0[r+1]);b=MX3(b,C0[r+2],C0[r+3]);a=MX3(a,C1[r],C1[r+1]);b=MX3(b,C1[r+2],C1[r+3]);} \
      float rm=__builtin_fmaxf(a,b); { auto rr=__builtin_amdgcn_permlane32_swap(__float_as_uint(rm),__float_as_uint(rm),false,false); rm=__builtin_fmaxf(__uint_as_float(rr[0]),__uint_as_float(rr[1])); } \
      resc=false; \
      if(__builtin_expect(__any(rm>(float)THRL),0)){ const float dl=__builtin_fmaxf(rm,0.f); mhat+=dl; \
        _Pragma("unroll") for(int r=0;r<16;++r){C0[r]-=dl;C1[r]-=dl;} \
        NEGMUPD(); \
        const float f=__builtin_amdgcn_exp2f(-dl); l_reg*=f; if(hi==0)wsf[r32]=f; resc=true; } } \
    SBAR(); \
    GAPB(o[0]=__builtin_amdgcn_mfma_f32_32x32x16_bf16(PAF(0),VFR(0),o[0],0,0,0), C0,0); \
    GAPB(o[1]=__builtin_amdgcn_mfma_f32_32x32x16_bf16(PAF(0),VFR(4),o[1],0,0,0), C0,4); \
    KRD(GL,0); GAPB(o[0]=__builtin_amdgcn_mfma_f32_32x32x16_bf16(PAF(1),VFR(1),o[0],0,0,0), C0,8); \
    KRD(GL,1); GAPB(o[1]=__builtin_amdgcn_mfma_f32_32x32x16_bf16(PAF(1),VFR(5),o[1],0,0,0), C0,12); \
    KRD(GL,2); GAPB(o[0]=__builtin_amdgcn_mfma_f32_32x32x16_bf16(PAF(2),VFR(2),o[0],0,0,0), C1,0); \
    KRD(GL,3); GAPB(o[1]=__builtin_amdgcn_mfma_f32_32x32x16_bf16(PAF(2),VFR(6),o[1],0,0,0), C1,4); \
    GAPB(o[0]=__builtin_amdgcn_mfma_f32_32x32x16_bf16(PAF(3),VFR(3),o[0],0,0,0), C1,8); \
    GAPB(o[1]=__builtin_amdgcn_mfma_f32_32x32x16_bf16(PAF(3),VFR(7),o[1],0,0,0), C1,12); \
    }while(0)
  int t=1;
  #undef CMASK
  #define CMASK(P0,P1,t) do{}while(0)
  for(;t+5<NT;t+=2){
    SETNEGM(t); STEP(pB0,pB1,pA0,pA1,t,true,true,true);     WAIT_BAR(2); RESC(); ROT();
    SETNEGM(t+1); STEP(pA0,pA1,pB0,pB1,t+1,true,true,true);   WAIT_BAR(2); RESC(); ROT();
  }
  #undef CMASK
  #define CMASK(P0,P1,t) do{int jb_=(t)-(NT-4); if(jb_>=0)cmask(P0,P1,jb_,qrel,hi);}while(0)
  #define ENDW(tt) do{ if((tt)+3<NT){WAIT_BAR(2);} else if((tt)+2<NT){WAIT_BAR(1);} else {WAIT_BAR(0);} }while(0)
  for(;t+1<NT;t+=2){
    SETNEGM(t); STEP(pB0,pB1,pA0,pA1,t,(t+3<NT),(t+1<NT),(t+1<NT));       ENDW(t);   RESC(); ROT();
    SETNEGM(t+1); STEP(pA0,pA1,pB0,pB1,t+1,(t+4<NT),(t+2<NT),(t+2<NT));     ENDW(t+1); RESC(); ROT();
  }
  SETNEGM(NT-1); STEP(pB0,pB1,pA0,pA1,NT-1,false,false,false); RESC();
  { float sacc=pB0[0]+pB0[1]; _Pragma("unroll") for(int r=2;r<16;++r)sacc+=pB0[r]; _Pragma("unroll") for(int r=0;r<16;++r)sacc+=pB1[r]; l_reg+=sacc;
    pw0=(u32x4){PKW(pB0,0),PKW(pB0,2),PKW(pB0,4),PKW(pB0,6)};pw1=(u32x4){PKW(pB0,8),PKW(pB0,10),PKW(pB0,12),PKW(pB0,14)};pw2=(u32x4){PKW(pB1,0),PKW(pB1,2),PKW(pB1,4),PKW(pB1,6)};pw3=(u32x4){PKW(pB1,8),PKW(pB1,10),PKW(pB1,12),PKW(pB1,14)};
    SBAR(); pv(o,vb0+sl_cur,PAF(0),PAF(1),PAF(2),PAF(3)); }
  #undef PKW
  #undef PAF
  #undef VFR
  #undef PIN
  #undef MX3
  #undef GAPA
  #undef GAPB
  #undef EX
  #undef VRD
  #undef KRD
  #undef STEP
  #undef ENDW
  {auto rr=__builtin_amdgcn_permlane32_swap(__float_as_uint(l_reg),__float_as_uint(l_reg),false,false);l_reg=__uint_as_float(rr[0])+__uint_as_float(rr[1]);}
  if(hi==0)wsf[32+r32]=l_reg;asm volatile("s_waitcnt lgkmcnt(0)":::"memory");
  float rli[16];
  #pragma unroll
  for(int r=0;r<16;++r)rli[r]=__builtin_amdgcn_rcpf(wsf[32+crow(r,hi)]);
  bf16*Ow=O+(rowbase+q0+wid*QBLK)*1024+h*D;
  { LAS bf16*stg=(LAS bf16*)(shm+LDS_OST)+wid*2048;
    #pragma unroll
    for(int r=0;r<16;++r){const int orow=crow(r,hi);
      #pragma unroll
      for(int d0=0;d0<2;++d0)stg[orow*64+d0*32+r32]=(bf16)(cvtpk_s(o[d0][r]*rli[r],0.f)&0xffffu);}
    asm volatile("s_waitcnt lgkmcnt(0)":::"memory");
    #pragma unroll
    for(int i=0;i<4;++i){const int row=i*8+(lane>>3),ch=lane&7; const u32x4 v=*(const LAS u32x4*)(stg+row*64+ch*8); *(u32x4*)(Ow+(long)row*1024+ch*8)=v;} }
  asm volatile("s_waitcnt lgkmcnt(0)\n\ts_barrier":::"memory");
  #undef DMA_K
  #undef DMA_V
  #undef CMASK
  #undef START
  #undef RESC
  #undef ROT
}

#undef SBAR
#undef WAIT_BAR
}
#define XB_TMO      128
#define XB_XCNT(j)  (256  + 64 * (j))
#define XB_XSUB(j)  (1280 + 64 * (j))
#define XB_XGEN(j)  (2304 + 64 * (j))
#define XB_TOP      3328
#define XB_TOPGEN   3392
#define XCD_BAR_WORDS 3456
#define XB_SPIN_CAP (1u << 18)

__device__ __forceinline__ unsigned xb_ld(unsigned* p)              { return __hip_atomic_load(p, __ATOMIC_RELAXED, __HIP_MEMORY_SCOPE_AGENT); }
__device__ __forceinline__ unsigned xb_add(unsigned* p, unsigned v) { return __hip_atomic_fetch_add(p, v, __ATOMIC_RELAXED, __HIP_MEMORY_SCOPE_AGENT); }
__device__ __forceinline__ unsigned xb_xcc_id() { return (unsigned)__builtin_amdgcn_s_getreg((3 << 11) | 20) & 0xFu; }
#define XB_SPIN(cond, bar) do { unsigned _sp = 0; while (cond) { __builtin_amdgcn_s_sleep(1); \
    if ((++_sp & 255u) == 0u) { if (xb_ld(&(bar)[XB_TMO])) break; if (_sp > XB_SPIN_CAP) { atomicAdd(&(bar)[XB_TMO], 1u); break; } } } } while (0)

struct XcdBarrier {
    unsigned* bar; unsigned x;
    volatile LAS unsigned* st;
};

__device__ __forceinline__ XcdBarrier xcd_barrier_post(unsigned* bar, volatile LAS unsigned* st) {
    XcdBarrier b; b.bar = bar; b.x = xb_xcc_id(); b.st = st;
    if (threadIdx.x == 0) (void)xb_add(&bar[XB_XCNT(b.x)], 1u);
    return b;
}
__device__ __forceinline__ void xcd_barrier_complete(unsigned* bar, unsigned x, unsigned& nloc, unsigned& nx) {
    const unsigned G = gridDim.x * gridDim.y * gridDim.z;
    unsigned sum, cnt, mine, sp = 0u;
    for (;;) {
        sum = 0u; cnt = 0u; mine = 0u;
#pragma unroll
        for (unsigned j = 0; j < 16; ++j) { const unsigned c = xb_ld(&bar[XB_XCNT(j)]); sum += c; cnt += (c > 0u) ? 1u : 0u; mine = (j == x) ? c : mine; }
        if (sum == G) break;
        __builtin_amdgcn_s_sleep(1);
        if ((++sp & 255u) == 0u) { if (xb_ld(&bar[XB_TMO])) break; if (sp > XB_SPIN_CAP) { atomicAdd(&bar[XB_TMO], 1u); break; } }
    }
    nloc = mine > 0u ? mine : 1u; nx = cnt > 0u ? cnt : 1u;
}

__device__ __forceinline__ void xcd_barrier(const XcdBarrier& b) {
    asm volatile("s_waitcnt vmcnt(0)" ::: "memory");
    __syncthreads();
    if (threadIdx.x == 0) {
        unsigned* bar = b.bar;
        __builtin_amdgcn_s_waitcnt(0);
        unsigned nloc = b.st[0], nx = b.st[1];
        if (nloc == 0u) { xcd_barrier_complete(bar, b.x, nloc, nx); b.st[0] = nloc; b.st[1] = nx; }
        const unsigned old = xb_add(&bar[XB_XSUB(b.x)], 1u);
        const unsigned gen = old / nloc;
        if (old + 1u == (gen + 1u) * nloc) {
            __builtin_amdgcn_fence(__ATOMIC_RELEASE, "agent");
            asm volatile("s_waitcnt vmcnt(0)" ::: "memory");
            const unsigned og = xb_add(&bar[XB_TOP], 1u);
            const unsigned tg = og / nx;
            if (og + 1u == (tg + 1u) * nx) xb_add(&bar[XB_TOPGEN], 1u);
            else XB_SPIN(xb_ld(&bar[XB_TOPGEN]) == tg, bar);
            __builtin_amdgcn_fence(__ATOMIC_ACQUIRE, "agent");
            xb_add(&bar[XB_XGEN(b.x)], 1u);
            asm volatile("s_waitcnt vmcnt(0)" ::: "memory");
        } else {
            XB_SPIN(xb_ld(&bar[XB_XGEN(b.x)]) == gen, bar);
            __builtin_amdgcn_fence(__ATOMIC_ACQUIRE, "agent");
            asm volatile("s_waitcnt vmcnt(0)" ::: "memory");
        }
    }
    __syncthreads();
}
#ifndef DBG_MASK
#define DBG_MASK 255
#endif
#ifndef GEMM_XDMA
#define GEMM_XDMA false
#endif
#ifndef GU_ALIGN
#define GU_ALIGN true
#endif
#ifndef DUP_MASK
#define DUP_MASK 0
#endif
#define NREP(bit) ((DUP_MASK & (bit)) ? 2 : 1)
constexpr int NWAVES = 8;
constexpr int NBATCH = 8, SEQ = 2048, D = 1024, FF = 2816, M = NBATCH * SEQ, DEPTH = 4;
constexpr int N_PHASES = 2 + 7 * DEPTH;
constexpr float QSCALE = 0.125f * 1.4426950408889634f;
typedef unsigned short bf16;
typedef float f32x4 __attribute__((ext_vector_type(4)));
typedef unsigned v4u __attribute__((ext_vector_type(4)));
typedef GAS unsigned gu32;
#define RLX_AGENT __ATOMIC_RELAXED, __HIP_MEMORY_SCOPE_AGENT
constexpr size_t MiB = 1u << 20;
constexpr size_t WS_CTL = 0, CTL_ZERO_BYTES = 1 * MiB;
constexpr size_t WS_WGU = 1 * MiB;
constexpr size_t WS_WD = 89 * MiB;
constexpr size_t WS_WIN_E = 133 * MiB;
constexpr size_t WS_WOUT_E = 141 * MiB;
constexpr size_t WS_WQKV_O = 145 * MiB;
constexpr size_t WS_WO_O = 157 * MiB;
constexpr size_t WS_XB = 161 * MiB;
constexpr size_t WS_SS = 193 * MiB;
constexpr size_t WS_KMP = 194 * MiB;
constexpr size_t WS_QKV = 195 * MiB;
constexpr size_t WS_O = 291 * MiB;
constexpr size_t WS_END = 323 * MiB;
constexpr size_t WGU_BYTES = (size_t)2 * FF * D * 2, WD_BYTES = (size_t)D * FF * 2;
static_assert(WS_WGU + 8 * WGU_BYTES <= WS_WD && WS_WD + 8 * WD_BYTES <= WS_WIN_E && WS_QKV + (size_t)M * 3072 * 2 <= WS_O && WS_O + (size_t)M * D * 2 <= WS_END, "d_ws map");
constexpr int CW_BAR = 4096;
constexpr int RING_OFF = 0, RING_BYTES = 131072;
constexpr int P0_TS = 65, P0_SCR_BYTES = 64 * P0_TS * 4;
constexpr int LDSCTL_OFF = pg8::HM_STAGE_BYTES, MISC_OFF = LDSCTL_OFF + 320;
constexpr int LDS_BYTES = LDSCTL_OFF + 1024;
static_assert(att::LDS_END <= RING_BYTES && exa::LDS_BYTES + 2048 <= RING_BYTES && MISC_OFF + 128 <= LDS_BYTES && 8 * P0_SCR_BYTES <= LDSCTL_OFF && LDS_BYTES <= 160 * 1024, "LDS map");

__device__ __forceinline__ unsigned f2bf(float f) { unsigned u = __builtin_bit_cast(unsigned, f); return (u + 0x7fffu + ((u >> 16) & 1u)) >> 16; }
__device__ __forceinline__ unsigned pk2(float lo, float hi) { return att::cvtpk(lo, hi); }
__device__ __forceinline__ float wave_sum(float v) {
#pragma unroll
    for (int o = 1; o < 64; o <<= 1) v += __shfl_xor(v, o);
    return v;
}
#define LDS_WAIT() asm volatile("s_waitcnt lgkmcnt(0)" ::: "memory")
#define VM_WAIT() asm volatile("s_waitcnt vmcnt(0)" ::: "memory")

__device__ __forceinline__ void p0_write_tile(bf16* WT, int K, int dst_row0, int k0, LAS float* scr, int lane) {
    LDS_WAIT(); asm volatile("" ::: "memory");
    const int c = lane & 7, nn = lane >> 3;
#pragma unroll
    for (int j = 0; j < 8; ++j) { const int n = nn + 8 * j; const LAS float* s = scr + (8 * c) * P0_TS + n;
        v4u o; o.x = pk2(s[0 * P0_TS], s[1 * P0_TS]); o.y = pk2(s[2 * P0_TS], s[3 * P0_TS]); o.z = pk2(s[4 * P0_TS], s[5 * P0_TS]); o.w = pk2(s[6 * P0_TS], s[7 * P0_TS]);
        *(GAS v4u*)(WT + (size_t)(dst_row0 + n) * K + k0 + 8 * c) = o; }
    LDS_WAIT(); asm volatile("" ::: "memory");
}
#if defined(P0_NT)
#define P0_LOADW(p) __builtin_nontemporal_load(p)
#else
#define P0_LOADW(p) (*(p))
#endif
struct P0Item { const float* W; const float* gain; bf16* WT; int ldw, K, dst_row0, k0, n0; };
__device__ __forceinline__ void p0_item_load(const P0Item& d, f32x4 (&v)[16], float (&g)[16], int lane) {
    const int q = lane >> 4, p = lane & 15;
#pragma unroll
    for (int i = 0; i < 16; ++i) { v[i] = P0_LOADW((const GAS f32x4*)(d.W + (size_t)(d.k0 + 4 * i + q) * d.ldw + d.n0 + 4 * p)); g[i] = d.gain ? d.gain[d.k0 + 4 * i + q] : 1.0f; }
}
__device__ __forceinline__ void p0_item_finish(const P0Item& d, const f32x4 (&v)[16], const float (&g)[16], LAS float* scr, int lane) {
    const int q = lane >> 4, p = lane & 15;
#pragma unroll
    for (int i = 0; i < 16; ++i) { LAS float* dd = scr + (4 * i + q) * P0_TS + 4 * p; dd[0] = v[i][0] * g[i]; dd[1] = v[i][1] * g[i]; dd[2] = v[i][2] * g[i]; dd[3] = v[i][3] * g[i]; }
    p0_write_tile(d.WT, d.K, d.dst_row0, d.k0, scr, lane);
}
typedef const float __attribute__((address_space(4))) cfloat_t;
__device__ __forceinline__ void p0_fold_sub(const float* Win  , const float* Wp  , const float* pscale  , const float* gain, bf16* WT, int k0, int n0, int lane) {
    const int g = n0 >> 7, d = (n0 & 127) + lane;
    const float* wpb = Wp + (size_t)g * 128 * 128 + d;
    cfloat_t* wrow = (cfloat_t*)(Win + (size_t)k0 * 2048 + 1536 + g * 128);
    cfloat_t* gk = (cfloat_t*)(gain + k0);
    float acc[8];
#pragma unroll
    for (int k = 0; k < 8; ++k) acc[k] = 0.f;
#pragma unroll 1
    for (int c0 = 0; c0 < 128; c0 += 32) {
        float wp[32];
#pragma unroll
        for (int c = 0; c < 32; ++c) wp[c] = wpb[(size_t)(c0 + c) * 128];
#pragma unroll
        for (int k = 0; k < 8; ++k)
#pragma unroll
            for (int c = 0; c < 32; ++c) acc[k] = __builtin_fmaf(wrow[(size_t)k * 2048 + c0 + c], wp[c], acc[k]);
    }
    const float ps = pscale[g * 128 + d];
    v4u o; o.x = pk2(acc[0] * ps * gk[0], acc[1] * ps * gk[1]); o.y = pk2(acc[2] * ps * gk[2], acc[3] * ps * gk[3]); o.z = pk2(acc[4] * ps * gk[4], acc[5] * ps * gk[5]); o.w = pk2(acc[6] * ps * gk[6], acc[7] * ps * gk[7]);
    *(GAS v4u*)(WT + (size_t)(1536 + n0 + lane) * 1024 + k0) = o;
}

struct Args { const float* in[17]; float* out; unsigned char* ws; int ph_lo, ph_hi; };

__device__ __forceinline__ void p0_prologue(const Args& a, unsigned char* ws, LAS unsigned char* lds, int vcu, int G, int wave, int lane) {
    LAS float* scr = (LAS float*)(lds + wave * P0_SCR_BYTES);
    const int gw = vcu * NWAVES + wave, NGW = G * NWAVES;
    constexpr int I_GU = 16 * 44, I_DN = 44 * 16, I_EIN = 16 * 24, I_EFO = 16 * 8, I_SQ = 16 * 16, I_OQKV = 16 * 48;
    constexpr int S_G = 0, S_U = S_G + 8 * I_GU, S_D = S_U + 8 * I_GU, S_EIN = S_D + 8 * I_DN, S_EOUT = S_EIN + 2 * I_EIN, S_OQKV = S_EOUT + 2 * I_SQ, S_OO = S_OQKV + 2 * I_OQKV, NITEMS = S_OO + 2 * I_SQ;
    auto decode = [&](int it) -> P0Item {
        P0Item d;
        if (it < S_D) {
            const bool up = it >= S_U; const int r0 = it - (up ? S_U : S_G), f = r0 / I_GU, r = r0 % I_GU, layer = f >> 1, half = f & 1, kb = r / 44, nb = r % 44, n0 = 64 * nb;
            d.W = a.in[half ? (up ? 8 : 7) : (up ? 3 : 2)] + (size_t)layer * D * FF; d.gain = a.in[half ? 6 : 1] + layer * D; d.WT = (bf16*)(ws + WS_WGU + (size_t)f * WGU_BYTES);
            d.ldw = FF; d.K = D; d.dst_row0 = (n0 >> 7) * 256 + (up ? 128 : 0) + (n0 & 127); d.k0 = 64 * kb; d.n0 = n0;
        } else if (it < S_EIN) {
            const int r0 = it - S_D, f = r0 / I_DN, r = r0 % I_DN, layer = f >> 1, half = f & 1, kb = r / 16, nb = r % 16;
            d.W = a.in[half ? 9 : 4] + (size_t)layer * FF * D; d.gain = nullptr; d.WT = (bf16*)(ws + WS_WD + (size_t)f * WD_BYTES); d.ldw = D; d.K = FF; d.dst_row0 = 64 * nb; d.k0 = 64 * kb; d.n0 = 64 * nb;
        } else if (it < S_EOUT) {
            const int r0 = it - S_EIN, i = r0 / I_EIN, r = r0 % I_EIN, kb = r / 24, nb = r % 24;
            d.W = a.in[10] + (size_t)i * D * 2048; d.gain = a.in[5] + (2 * i) * D; d.WT = (bf16*)(ws + WS_WIN_E + (size_t)i * 2048 * D * 2); d.ldw = 2048; d.K = D; d.dst_row0 = 64 * nb; d.k0 = 64 * kb; d.n0 = 64 * nb;
        } else if (it < S_OQKV) {
            const int r0 = it - S_EOUT, i = r0 / I_SQ, r = r0 % I_SQ, kb = r / 16, nb = r % 16;
            d.W = a.in[13] + (size_t)i * D * D; d.gain = nullptr; d.WT = (bf16*)(ws + WS_WOUT_E + (size_t)i * D * D * 2); d.ldw = D; d.K = D; d.dst_row0 = 64 * nb; d.k0 = 64 * kb; d.n0 = 64 * nb;
        } else if (it < S_OO) {
            const int r0 = it - S_OQKV, i = r0 / I_OQKV, r = r0 % I_OQKV, kb = r / 48, nb = r % 48;
            d.W = a.in[14] + (size_t)i * D * 3072; d.gain = a.in[5] + (2 * i + 1) * D; d.WT = (bf16*)(ws + WS_WQKV_O + (size_t)i * 3072 * D * 2); d.ldw = 3072; d.K = D; d.dst_row0 = 64 * nb; d.k0 = 64 * kb; d.n0 = 64 * nb;
        } else {
            const int r0 = it - S_OO, i = r0 / I_SQ, r = r0 % I_SQ, kb = r / 16, nb = r % 16;
            d.W = a.in[15] + (size_t)i * D * D; d.gain = nullptr; d.WT = (bf16*)(ws + WS_WO_O + (size_t)i * D * D * 2); d.ldw = D; d.K = D; d.dst_row0 = 64 * nb; d.k0 = 64 * kb; d.n0 = 64 * nb;
        }
        return d;
    };
    if (gw < NITEMS) {
        P0Item cur = decode(gw); f32x4 v[16]; float g[16];
        p0_item_load(cur, v, g, lane);
        for (int it = gw; it < NITEMS; it += NGW) {
            const bool more = it + NGW < NITEMS;
            P0Item nxt = cur; f32x4 v2[16]; float g2[16];
            if (more) { nxt = decode(it + NGW); p0_item_load(nxt, v2, g2, lane); }
            p0_item_finish(cur, v, g, scr, lane);
            if (more) { cur = nxt;
#pragma unroll
                for (int i = 0; i < 16; ++i) { v[i] = v2[i]; g[i] = g2[i]; } }
        }
    }
#if defined(P0_FOLD_DUP)
    for (int rep_ = 0; rep_ < P0_FOLD_DUP; ++rep_)
#endif
    for (int s0 = gw; s0 < 2 * 128 * 8; s0 += NGW) {
        const int i = s0 >> 10, r = s0 & 1023, kb = r >> 3, nb = r & 7;
        p0_fold_sub(a.in[10] + (size_t)i * D * 2048, a.in[11] + (size_t)i * 4 * 128 * 128, a.in[12] + i * 512, a.in[5] + (2 * i) * D, (bf16*)(ws + WS_WIN_E + (size_t)i * 2048 * D * 2), 8 * kb, 64 * nb, lane);
    }
    const float* x = a.in[0]; bf16* XB = (bf16*)(ws + WS_XB); float* SS = (float*)(ws + WS_SS);
#if defined(P0_XB_DUP)
    for (int rep_ = 0; rep_ < P0_XB_DUP; ++rep_)
#endif
    {
        f32x4 v[4];
        if (gw < M) { const GAS f32x4* xr = (const GAS f32x4*)(x + (size_t)gw * D) + lane;
#pragma unroll
            for (int j = 0; j < 4; ++j) v[j] = xr[64 * j]; }
        for (int m = gw; m < M; m += NGW) {
            f32x4 vn[4];
            if (m + NGW < M) { const GAS f32x4* xr = (const GAS f32x4*)(x + (size_t)(m + NGW) * D) + lane;
#pragma unroll
                for (int j = 0; j < 4; ++j) vn[j] = xr[64 * j]; }
            float s = 0.f;
#pragma unroll
            for (int j = 0; j < 4; ++j) s += (v[j].x * v[j].x + v[j].y * v[j].y) + (v[j].z * v[j].z + v[j].w * v[j].w);
            s = wave_sum(s);
            GAS unsigned long long* o8 = (GAS unsigned long long*)(XB + (size_t)m * D) + lane;
#pragma unroll
            for (int j = 0; j < 4; ++j) o8[64 * j] = (unsigned long long)pk2(v[j].x, v[j].y) | ((unsigned long long)pk2(v[j].z, v[j].w) << 32);
            if (lane < 16) SS[(size_t)m * 16 + lane] = (lane == 0) ? s : 0.f;
            if (m + NGW < M) {
#pragma unroll
                for (int j = 0; j < 4; ++j) v[j] = vn[j]; }
        }
    }
}
__device__ __forceinline__ void pool_rows(const bf16* QKV, bf16* O, int vcu, int G, int tid) {
    asm volatile("" : "+v"(tid));
    const int cc = tid & 63, rg = tid >> 6, g = cc >> 4, w = 2 << g;
    for (int R0 = vcu * 64; R0 < M; R0 += G * 64) {
#pragma unroll 1
        for (int rr = 0; rr < 8; ++rr) {
            const int row = R0 + rg * 8 + rr, t = row & (SEQ - 1);
            const int cnt = (t + 1) < w ? (t + 1) : w;
            float s[8];
#pragma unroll
            for (int e = 0; e < 8; ++e) s[e] = 0.f;
            v4u cur = {0u, 0u, 0u, 0u};
            for (int i = 0; i < cnt; ++i) {
                const v4u v = *(const v4u*)(QKV + (size_t)(row - i) * 2048 + 1536 + cc * 8);
                if (i == 0) cur = v;
                s[0] += __builtin_bit_cast(float, v.x << 16); s[1] += __builtin_bit_cast(float, v.x & 0xffff0000u);
                s[2] += __builtin_bit_cast(float, v.y << 16); s[3] += __builtin_bit_cast(float, v.y & 0xffff0000u);
                s[4] += __builtin_bit_cast(float, v.z << 16); s[5] += __builtin_bit_cast(float, v.z & 0xffff0000u);
                s[6] += __builtin_bit_cast(float, v.w << 16); s[7] += __builtin_bit_cast(float, v.w & 0xffff0000u);
            }
            const float rc = 1.0f / (float)cnt;
            v4u o;
            o.x = pk2(s[0] * rc - __builtin_bit_cast(float, cur.x << 16), s[1] * rc - __builtin_bit_cast(float, cur.x & 0xffff0000u));
            o.y = pk2(s[2] * rc - __builtin_bit_cast(float, cur.y << 16), s[3] * rc - __builtin_bit_cast(float, cur.y & 0xffff0000u));
            o.z = pk2(s[4] * rc - __builtin_bit_cast(float, cur.z << 16), s[5] * rc - __builtin_bit_cast(float, cur.z & 0xffff0000u));
            o.w = pk2(s[6] * rc - __builtin_bit_cast(float, cur.w << 16), s[7] * rc - __builtin_bit_cast(float, cur.w & 0xffff0000u));
            *(v4u*)(O + (size_t)row * 1024 + 512 + cc * 8) = o;
        }
    }
}
__device__ __forceinline__ void final_norm(const bf16* XBs, float* out, const float* SS, const float* gfin, int vcu, int G, int wave, int lane) {
    const int gw = vcu * NWAVES + wave, NGW = G * NWAVES;
    f32x4 gv[2][2];
#pragma unroll
    for (int j = 0; j < 2; ++j) { gv[j][0] = *(const f32x4*)(gfin + 512 * j + 8 * lane); gv[j][1] = *(const f32x4*)(gfin + 512 * j + 8 * lane + 4); }
    for (int m = gw; m < M; m += NGW) {
        float s = (lane < 16) ? SS[(size_t)m * 16 + lane] : 0.f;
        s = wave_sum(s);
        const float r = 1.0f / sqrtf(s * (1.0f / D) + 1e-6f);
#pragma unroll
        for (int j = 0; j < 2; ++j) {
            const v4u b = *(const GAS v4u*)(XBs + (size_t)m * D + 512 * j + 8 * lane);
            const f32x4 x0 = {__builtin_bit_cast(float, b.x << 16), __builtin_bit_cast(float, b.x & 0xffff0000u), __builtin_bit_cast(float, b.y << 16), __builtin_bit_cast(float, b.y & 0xffff0000u)};
            const f32x4 x1 = {__builtin_bit_cast(float, b.z << 16), __builtin_bit_cast(float, b.z & 0xffff0000u), __builtin_bit_cast(float, b.w << 16), __builtin_bit_cast(float, b.w & 0xffff0000u)};
            GAS f32x4* o = (GAS f32x4*)(out + (size_t)m * D + 512 * j + 8 * lane);
            o[0] = x0 * r * gv[j][0]; o[1] = x1 * r * gv[j][1];
        }
    }
}

#if defined(CMP_PROBE)
__device__ __forceinline__ void cmp_unit(const bf16* A, const bf16* B, int b, int h, int qb, int cls, gu32* word, int tid) {
    asm volatile("" : "+v"(tid));
    __threadfence(); __syncthreads();
    unsigned bucket = 0u;
    if (tid < 256) {
        float se = 0.f, sx = 0.f;
        for (int c = 0; c < 64; ++c) { const size_t idx = ((size_t)b * SEQ + qb * 256 + tid) * 1024 + h * 64 + c;
            const float x = __builtin_bit_cast(float, (unsigned)A[idx] << 16), y = __builtin_bit_cast(float, (unsigned)B[idx] << 16);
            se += (x - y) * (x - y); sx += x * x; }
        const float rel = sqrtf(se / (sx + 1e-12f));
#if defined(CMP_BUCKETS)
        if (rel > 0.02f) bucket |= 4u; if (rel > 0.05f) bucket |= 8u; if (rel > 0.15f) bucket |= 16u; if (rel > 0.5f) bucket |= 32u; if (rel > 1.5f) bucket |= 64u; if (!(rel == rel)) bucket |= 128u;
#else
        if (!(rel <= CMP_RTOL)) bucket |= 1u << cls;
#endif
    }
    if (bucket) __hip_atomic_fetch_or(word, bucket, __ATOMIC_RELAXED, __HIP_MEMORY_SCOPE_AGENT);
    __syncthreads();
}
#endif
__global__ void __launch_bounds__(NWAVES * 64, 2) mk_fwd(Args args) {
    extern __shared__ __attribute__((aligned(16))) unsigned char lds_raw[];
    LAS unsigned char* lds = (LAS unsigned char*)lds_raw;
    volatile LAS unsigned* MISC = (volatile LAS unsigned*)(lds + MISC_OFF);
    const int tid = threadIdx.x, lane = tid & 63, wave = __builtin_amdgcn_readfirstlane(tid >> 6);
    const int G = gridDim.x; const int bx = blockIdx.x; const int vcu = (G % 8 == 0) ? (bx % 8) * (G / 8) + bx / 8 : bx;
    unsigned char* ws = args.ws;
    gu32* ctl = (gu32*)(ws + WS_CTL);
    for (int u = tid; u < (LDS_BYTES - LDSCTL_OFF) / 4; u += NWAVES * 64) ((LAS unsigned*)(lds + LDSCTL_OFF))[u] = 0u;
    __syncthreads();
    XcdBarrier bar; bar.bar = (unsigned*)(ctl + CW_BAR); bar.x = 0; bar.st = nullptr;
    if (MK_N_LAUNCHES == 1) bar = xcd_barrier_post((unsigned*)(ctl + CW_BAR), MISC + 8);
    const int lo = args.ph_lo, hi = args.ph_hi;
#define IN(k) (lo <= (k) && (k) < hi)
#if defined(BAR_DUP)
#define SEAM(k) do { if (IN(k) && IN((k) + 1)) { xcd_barrier(bar); xcd_barrier(bar); } } while (0)
#else
#define SEAM(k) do { if (IN(k) && IN((k) + 1)) xcd_barrier(bar); } while (0)
#endif

    bf16* XB = (bf16*)(ws + WS_XB); float* SS = (float*)(ws + WS_SS); float* KMP = (float*)(ws + WS_KMP);
    bf16* QKV = (bf16*)(ws + WS_QKV); bf16* HB = (bf16*)(ws + WS_QKV); bf16* OB = (bf16*)(ws + WS_O);

#if defined(P0_TIME_PROBE)
    const unsigned long long p0_t0 = __builtin_amdgcn_s_memrealtime();
#endif
    if ((DBG_MASK & 1) && IN(0)) { for (int rep = 0; rep < NREP(1); ++rep) { p0_prologue(args, ws, lds, vcu, G, wave, lane); __syncthreads(); } }
    SEAM(0);
#if defined(P0_TIME_PROBE)
    const unsigned long long p0_dt = __builtin_amdgcn_s_memrealtime() - p0_t0;
#endif

    for (int layer = 0; layer < DEPTH; ++layer) {
        const int pb = 1 + 7 * layer;
        for (int half = 0; half < 2; ++half) {
            const int f = layer * 2 + half, pg = pb + (half ? 5 : 0);
            if ((DBG_MASK & 2) && IN(pg)) for (int rep = 0; rep < NREP(2); ++rep) {
                pg8::Gemm g{XB, (const bf16*)(ws + WS_WGU + (size_t)f * WGU_BYTES), M, 2 * FF, D}; pg8::StaticOrder S; S.init(M, 2 * FF, G, bx);
#if defined(GU_PROBE_VARIANT)
#if defined(GU_KPROBE)
                if (rep == 1) { pg8::EpiGUProbe<GU_KPROBE> E{}; E.H = HB; E.SS = SS; pg8::gemm_phase<pg8::EpiGUProbe<GU_KPROBE>, pg8::StaticOrder, true, true, GEMM_XDMA>(lds + RING_OFF, g, S, E); } else
#else
                if (rep == 1) { pg8::EpiGU_<GU_PROBE_VARIANT> E{HB, SS}; pg8::gemm_phase<pg8::EpiGU_<GU_PROBE_VARIANT>, pg8::StaticOrder, true, true, GEMM_XDMA>(lds + RING_OFF, g, S, E); } else
#endif
#endif
                { pg8::EpiGU E{HB, SS};
                const int fullr = S.nwg / G, rem = S.nwg - fullr * G; const bool hm = (2 * rem == G) && (G % 16 == 0);
                if (hm) S.maxr = fullr;
                pg8::gemm_phase<pg8::EpiGU, pg8::StaticOrder, GU_ALIGN, true, GEMM_XDMA>(lds + RING_OFF, g, S, E);
                if (hm) { const int j = bx >> 3; pg8::Unit uu; S.unit_of((long)fullr * G + (bx & 7) + 8 * (j >> 1), uu); const pg8::HUnit hu{uu.pm * 2 + (j & 1), uu.pn};
                    pg8::gemm_half_unit<pg8::EpiGU>(lds + RING_OFF, g, hu, E);
#if defined(HM_DUP)
                    __syncthreads(); pg8::gemm_half_unit<pg8::EpiGU>(lds + RING_OFF, g, hu, E);
#endif
                    } }
            }
            SEAM(pg);
            if ((DBG_MASK & 4) && IN(pg + 1)) for (int rep = 0; rep < NREP(4); ++rep) {
                pg8::Gemm g{HB, (const bf16*)(ws + WS_WD + (size_t)f * WD_BYTES), M, D, FF}; pg8::StaticOrder S; S.init(M, D, G, bx);
#if defined(DOWN_NOOP_PROBE)
                if (rep == 1) { pg8::EpiResNoop E; pg8::gemm_phase<pg8::EpiResNoop, pg8::StaticOrder, true, true, GEMM_XDMA>(lds + RING_OFF, g, S, E); } else {
#endif
                pg8::EpiRes E{XB, SS, rep ? 0x1p-60f : 0.5f, rep ? 0x1p60f : 2.0f};
                pg8::gemm_phase<pg8::EpiRes, pg8::StaticOrder, true, true, GEMM_XDMA>(lds + RING_OFF, g, S, E);
#if defined(DOWN_NOOP_PROBE)
                }
#endif
            }
            SEAM(pg + 1);
            if (half == 0) {
                const int i2 = layer >> 1; const bool odd = layer & 1;
                if ((DBG_MASK & 8) && IN(pb + 2)) for (int rep = 0; rep < NREP(8); ++rep) {
                    const int N = odd ? 3072 : 2048;
                    pg8::Gemm g{XB, (const bf16*)(ws + (odd ? WS_WQKV_O + (size_t)i2 * 3072 * D * 2 : WS_WIN_E + (size_t)i2 * 2048 * D * 2)), M, N, D}; pg8::StaticOrder S; S.init(M, N, G, bx);
                    pg8::EpiQKV E{QKV, N, SS, odd ? 4 : 2, QSCALE, odd ? KMP : nullptr, 4, 8};
                    pg8::gemm_phase<pg8::EpiQKV, pg8::StaticOrder, true, true, GEMM_XDMA>(lds + RING_OFF, g, S, E);
                }
                SEAM(pb + 2);
                if (IN(pb + 3)) {
                    if ((DBG_MASK & 16) && !odd) for (int rep = 0; rep < NREP(16); ++rep) {
                        for (int ui = vcu; ui < 512; ui += G) {
                            const int bh = (ui & 255) >> 2, s = ui & 3, qb = (ui >> 8) ? 7 - s : s;
                            att::attn_unit<false>(bh >> 3, bh & 7, qb, QKV, 2048, 512, 1024, OB, lds + RING_OFF, nullptr, 0.f);
                        }
                        pool_rows(QKV, OB, vcu, G, tid);
                    } else if (DBG_MASK & 32) for (int rep = 0; rep < NREP(32); ++rep) {
                        for (int ui = vcu; ui < 1024; ui += G) {
                            const int bh = (ui & 255) >> 1, j = ui & 1, k = ui >> 8;
                            const int qb = (k == 0) ? (j ? 6 : 7) : (k == 1) ? (j ? 5 : 4) : (k == 2) ? (j ? 2 : 3) : (j ? 1 : 0);
                            const int h = bh & 15;
                            const float sl2 = exp2f(-0.5f * (float)(h + 1)) * 1.4426950408889634f;
#if defined(CMP_PROBE)
                            att::attn_unit<true>(bh >> 4, h, qb, QKV, 3072, 1024, 2048, OB, lds + RING_OFF, KMP, sl2);
                            if ((bh >> 4) < 4) {
                                att::attn_unit<true>(bh >> 4, h, qb, QKV, 3072, 1024, 2048, (bf16*)(ws + WS_END), lds + RING_OFF, KMP, CMP_SL2, CMP_FORCE);
#if defined(CMP_EXA)
                                exa::attn_unit<8>(bh >> 4, h, qb, QKV, (bf16*)(ws + WS_END + 16 * MiB), lds + RING_OFF, KMP, CMP_SL2, CMP_FORCE);
#else
                                exa::attn_unit<8>(bh >> 4, h, qb, QKV, (bf16*)(ws + WS_END + 16 * MiB), lds + RING_OFF, KMP, CMP_SL2, CMP_FORCE);
#endif
                                cmp_unit((const bf16*)(ws + WS_END), (const bf16*)(ws + WS_END + 16 * MiB), bh >> 4, h, qb, CMP_PROBE, ctl + 2048, tid); }
#elif defined(MOBA_OLD)
                            att::attn_unit<true>(bh >> 4, h, qb, QKV, 3072, 1024, 2048, OB, lds + RING_OFF, KMP, sl2);
#else
#if defined(UNIT_OVH_PROBE)
                            if (rep == 1) exa::attn_unit<8>(bh >> 4, h, 0, QKV, (bf16*)(ws + WS_END), lds + RING_OFF, KMP, sl2, 0u); else
#endif
                            exa::attn_unit<8>(bh >> 4, h, qb, QKV, OB, lds + RING_OFF, KMP, sl2, 0u);
#endif
                        }
                    }
                }
                SEAM(pb + 3);
                if ((DBG_MASK & 64) && IN(pb + 4)) for (int rep = 0; rep < NREP(64); ++rep) {
                    pg8::Gemm g{OB, (const bf16*)(ws + (odd ? WS_WO_O : WS_WOUT_E) + (size_t)i2 * D * D * 2), M, D, D}; pg8::StaticOrder S; S.init(M, D, G, bx);
                    pg8::EpiRes E{XB, SS, rep ? 0x1p-60f : 1.0f, rep ? 0x1p60f : 1.0f};
                    pg8::gemm_phase<pg8::EpiRes, pg8::StaticOrder, true, true, GEMM_XDMA>(lds + RING_OFF, g, S, E);
                }
                SEAM(pb + 4);
            }
        }
    }
    if ((DBG_MASK & 128) && IN(N_PHASES - 1)) final_norm(XB, args.out, SS, args.in[16], vcu, G, wave, lane);
#if defined(P0_TIME_PROBE)
    if (blockIdx.x == 0 && tid == 0) { const unsigned long long t0 = __builtin_amdgcn_s_memrealtime(), dt = p0_dt * (unsigned long long)(P0_TIME_PROBE);
        while (__builtin_amdgcn_s_memrealtime() - t0 < dt) __builtin_amdgcn_s_sleep(8); }
#endif
#if defined(CMP_PROBE)
    xcd_barrier(bar);
    if (blockIdx.x == 0 && tid == 0) { const unsigned w = __hip_atomic_load(ctl + 2048, RLX_AGENT); const unsigned long long t0 = __builtin_amdgcn_s_memrealtime(), dt = (unsigned long long)w * 10000ull;
        while (__builtin_amdgcn_s_memrealtime() - t0 < dt) __builtin_amdgcn_s_sleep(8); }
#endif
#undef IN
#undef SEAM
}

extern "C" void kernel_launch(void* const* d_in, const int* in_sizes, int n_in, void* d_out, int out_size, void* d_ws, size_t ws_size, hipStream_t stream) {
    static int grid = 0;
    if (grid == 0) {
        if (n_in != 17 || in_sizes[0] != M * D || out_size != M * D || ws_size < WS_END) { fprintf(stderr, "kernel_launch: unexpected shapes (n_in %d, in0 %d, out %d, ws %zu); nothing launched\n", n_in, n_in > 0 ? in_sizes[0] : -1, out_size, ws_size); grid = -1; return; }
        int dev = 0, cus = 0, per_cu = 0;
        if (hipGetDevice(&dev) != hipSuccess || hipDeviceGetAttribute(&cus, hipDeviceAttributeMultiprocessorCount, dev) != hipSuccess) { grid = -1; return; }
        if (hipFuncSetAttribute((const void*)mk_fwd, hipFuncAttributeMaxDynamicSharedMemorySize, LDS_BYTES) != hipSuccess) { fprintf(stderr, "kernel_launch: hipFuncSetAttribute failed\n"); grid = -1; return; }
        if (hipOccupancyMaxActiveBlocksPerMultiprocessor(&per_cu, (const void*)mk_fwd, NWAVES * 64, LDS_BYTES) != hipSuccess || per_cu < 1)
            fprintf(stderr, "kernel_launch: note: occupancy query reports %d workgroups per CU\n", per_cu);
        (void)hipGetLastError();
        grid = cus;
    }
    if (grid < 0) return;
    if (hipMemsetAsync((char*)d_ws + WS_CTL, 0, CTL_ZERO_BYTES, stream) != hipSuccess) return;
    Args a{};
    for (int i = 0; i < 17; ++i) a.in[i] = (const float*)d_in[i];
    a.out = (float*)d_out; a.ws = (unsigned char*)d_ws;
#if MK_N_LAUNCHES == 1
    a.ph_lo = 0; a.ph_hi = N_PHASES;
    hipLaunchKernelGGL(mk_fwd, dim3(grid), dim3(NWAVES * 64), LDS_BYTES, stream, a);
#else
    for (int p = 0; p < N_PHASES; ++p) { a.ph_lo = p; a.ph_hi = p + 1; hipLaunchKernelGGL(mk_fwd, dim3(grid), dim3(NWAVES * 64), LDS_BYTES, stream, a); }
#endif
}
```

```cpp
#include <hip/hip_runtime.h>
#include <cstdio>
#include <cstdint>
#define LAS __attribute__((address_space(3)))
#define GAS __attribute__((address_space(1)))
#ifndef MK_N_LAUNCHES
#define MK_N_LAUNCHES 1
#endif
#define P0_NT 1
#define EXA_G1 1
#define EXA_G2 1
#define EXA_G3 1
namespace pg8 {
#define PG8_LAS __attribute__((address_space(3)))
typedef unsigned short bf16_t;
typedef short bf16x8 __attribute__((ext_vector_type(8)));
typedef float f32x4 __attribute__((ext_vector_type(4)));
typedef unsigned u32x4 __attribute__((ext_vector_type(4)));
constexpr int BM = 256, BK = 64, HALF = 128, HTB = HALF * BK * 2  , STAGE_BYTES = 8 * HTB, NXCD = 8, WGM = 8;

__host__ __device__ __forceinline__ int lds_byte(int r, int c) { const int st = (r >> 4) * 2 + (c >> 5), rr = r & 15, cc = c & 31, ob = rr * 64 + cc * 2; return st * 1024 + (ob ^ (((ob >> 9) & 1) << 5)); }
__host__ __device__ __forceinline__ void stage_rc(int b, int& R, int& C) { const int st = b / 1024, sb = b % 1024, swz = sb ^ (((sb >> 9) & 1) << 5); R = (st >> 1) * 16 + swz / 64; C = (st & 1) * 32 + (swz % 64) / 2; }
__host__ __device__ __forceinline__ int perm32(int rho) { const int n = rho >> 4, i = rho & 15; return 8 * (i >> 2) + 4 * n + (i & 3); }

struct Unit { int pm, pn; };
struct HUnit { int pm2, pn; };
struct Gemm { const bf16_t* A; const bf16_t* Bt; int M, N, K; };

struct StaticOrder {
    int nM, nN, nwg, G, c, maxr;
    __host__ __device__ void init(int M, int N, int G_, int c_) { nM = M / BM; nN = N / BM; nwg = nM * nN; G = G_; c = c_; maxr = 1 << 30; }
    __host__ __device__ bool next(int i, Unit& u) const {
        const long L = (long)i * G + c; if (L >= nwg || i >= maxr) return false;
        unit_of(L, u); return true;
    }
    __host__ __device__ void unit_of(long L, Unit& u) const {
        int wgid = (int)L; { const int q = nwg / NXCD, r = nwg % NXCD, xcd = wgid % NXCD, off = wgid / NXCD; wgid = (xcd < r ? xcd * (q + 1) : r * (q + 1) + (xcd - r) * q) + off; }
        const int nig = WGM * nN, gid = wgid / nig, fm = gid * WGM, gsz = (nM - fm) < WGM ? (nM - fm) : WGM;
        u.pm = fm + ((wgid % nig) % gsz); u.pn = (wgid % nig) / gsz;
    }
    __device__ __forceinline__ void a_ready(const Unit&) const {}
    __device__ __forceinline__ void done(const Unit&) const {}
};

__device__ __forceinline__ unsigned cvt_pk_bf16(float lo, float hi) { unsigned r; asm volatile("v_cvt_pk_bf16_f32 %0, %1, %2" : "=v"(r) : "v"(lo), "v"(hi)); return r; }
typedef float f32x2 __attribute__((ext_vector_type(2)));
__device__ __forceinline__ float row_rstd(const float* SS, int row, int fq) {
    const f32x4 v = *(const f32x4*)(SS + (size_t)row * 16 + 4 * fq);
    float s = (v[0] + v[1]) + (v[2] + v[3]);
    s += __shfl_xor(s, 16); s += __shfl_xor(s, 32);
    return __builtin_amdgcn_rsqf(s * (1.0f / 1024.0f) + 1e-6f);
}
__device__ __forceinline__ void row_rstd8(const float* SS, int row0, int fq, float (&r8)[8]) {
    f32x4 sv[8];
#pragma unroll
    for (int k = 0; k < 8; ++k) sv[k] = *(const f32x4*)(SS + (size_t)(row0 + (k >> 2) * HALF + (k & 3) * 16) * 16 + 4 * fq);
#pragma unroll
    for (int k = 0; k < 8; ++k) { float s = (sv[k][0] + sv[k][1]) + (sv[k][2] + sv[k][3]); s += __shfl_xor(s, 16); s += __shfl_xor(s, 32); r8[k] = __builtin_amdgcn_rsqf(s * (1.0f / 1024.0f) + 1e-6f); }
}
__device__ __forceinline__ void row_rstd8v(const float* SS, int row0, int fq, float (&r8)[8], float (&v8)[8]) {
    f32x4 sv[8];
#pragma unroll
    for (int k = 0; k < 8; ++k) sv[k] = *(const f32x4*)(SS + (size_t)(row0 + (k >> 2) * HALF + (k & 3) * 16) * 16 + 4 * fq);
#pragma unroll
    for (int k = 0; k < 8; ++k) { float s = (sv[k][0] + sv[k][1]) + (sv[k][2] + sv[k][3]); s += __shfl_xor(s, 16); s += __shfl_xor(s, 32); v8[k] = s * (1.0f / 1024.0f) + 1e-6f; r8[k] = __builtin_amdgcn_rsqf(v8[k]); }
}
template <int VARIANT = 0> struct EpiGU_ {
    static constexpr bool PERM = true, AFTER_DRAIN = false;
    bf16_t* H; const float* SS;
    __device__ __forceinline__ void gu_row(const f32x4 (&ga)[2], const f32x4 (&ua)[2], float r, float v, bf16_t* dst) const {
        const float rn = r * -1.4426950408889634f;
        const f32x2 rn2 = {rn, rn}, v2 = {v, v};
        f32x2 t[4], p[4];
#pragma unroll
        for (int k = 0; k < 4; ++k) { const f32x2 g = {ga[k >> 1][2 * (k & 1)], ga[k >> 1][2 * (k & 1) + 1]}, uu = {ua[k >> 1][2 * (k & 1)], ua[k >> 1][2 * (k & 1) + 1]};
            t[k] = g * rn2; p[k] = g * uu; }
#pragma unroll
        for (int k = 0; k < 4; ++k) { t[k].x = __builtin_amdgcn_exp2f(t[k].x); t[k].y = __builtin_amdgcn_exp2f(t[k].y); }
#pragma unroll
        for (int k = 0; k < 4; ++k) t[k] = __builtin_elementwise_fma(t[k], v2, v2);
#pragma unroll
        for (int k = 0; k < 4; ++k) { t[k].x = __builtin_amdgcn_rcpf(t[k].x); t[k].y = __builtin_amdgcn_rcpf(t[k].y); }
#pragma unroll
        for (int k = 0; k < 4; ++k) p[k] = p[k] * t[k];
        u32x4 w; w.x = cvt_pk_bf16(p[0].x, p[0].y); w.y = cvt_pk_bf16(p[1].x, p[1].y); w.z = cvt_pk_bf16(p[2].x, p[2].y); w.w = cvt_pk_bf16(p[3].x, p[3].y);
        if (VARIANT == 2) { asm volatile("" :: "v"(w)); } else *(u32x4*)dst = w;
    }
    __device__ __forceinline__ void half(const f32x4 (&acc)[2][4][2], const HUnit& u, int wr, int wc, int fr, int fq) const {
        const int row0 = u.pm2 * HALF + wr * 64 + fr, col0 = u.pn * 128 + wc * 32 + 8 * fq;
        f32x4 sv[4];
#pragma unroll
        for (int k = 0; k < 4; ++k) sv[k] = *(const f32x4*)(SS + (size_t)(row0 + k * 16) * 16 + 4 * fq);
#pragma unroll
        for (int m = 0; m < 4; ++m) { float s = (sv[m][0] + sv[m][1]) + (sv[m][2] + sv[m][3]); s += __shfl_xor(s, 16); s += __shfl_xor(s, 32); const float v = s * (1.0f / 1024.0f) + 1e-6f;
            gu_row(acc[0][m], acc[1][m], __builtin_amdgcn_rsqf(v), v, H + (size_t)(row0 + m * 16) * 2816 + col0); }
    }
    __device__ __forceinline__ void operator()(const f32x4 (&acc)[2][2][4][2], const Unit& u, int wr, int wc, int fr, int fq) const {
        if (VARIANT == 1) {
#pragma unroll
            for (int ai = 0; ai < 2; ++ai)
#pragma unroll
                for (int bj = 0; bj < 2; ++bj)
                    asm volatile("" :: "v"(acc[ai][bj][0][0]), "v"(acc[ai][bj][0][1]), "v"(acc[ai][bj][1][0]), "v"(acc[ai][bj][1][1]), "v"(acc[ai][bj][2][0]), "v"(acc[ai][bj][2][1]), "v"(acc[ai][bj][3][0]), "v"(acc[ai][bj][3][1]));
            return; }
        const int row0 = u.pm * BM + wr * 64 + fr, col0 = u.pn * 128 + wc * 32 + 8 * fq;
        float r8[8], v8[8]; row_rstd8v(SS, row0, fq, r8, v8);
#pragma unroll
        for (int ai = 0; ai < 2; ++ai)
#pragma unroll
            for (int m = 0; m < 4; ++m) {
                gu_row(acc[ai][0][m], acc[ai][1][m], r8[ai * 4 + m], v8[ai * 4 + m], H + (size_t)(row0 + ai * HALF + m * 16) * 2816 + col0);
            }
    }
};
typedef EpiGU_<0> EpiGU;
template <int KP> struct EpiGUProbe : EpiGU_<1> { static constexpr int KPROBE = KP; };
struct EpiRes {
    static constexpr bool PERM = true, AFTER_DRAIN = false;
    bf16_t* XB; float* SS; float alpha;
    __device__ __forceinline__ void operator()(const f32x4 (&acc)[2][2][4][2], const Unit& u, int wr, int wc, int fr, int fq) const {
        const int row0 = u.pm * BM + wr * 64 + fr, col0 = u.pn * BM + wc * 32 + 8 * fq;
#pragma unroll
        for (int ai = 0; ai < 2; ++ai) {
            u32x4 bv[4][2];
#pragma unroll
            for (int m = 0; m < 4; ++m)
#pragma unroll
                for (int bj = 0; bj < 2; ++bj) bv[m][bj] = *(const u32x4*)(XB + (size_t)(row0 + ai * HALF + m * 16) * 1024 + col0 + bj * HALF);
#pragma unroll
            for (int m = 0; m < 4; ++m) {
                const int row = row0 + ai * HALF + m * 16; const size_t off = (size_t)row * 1024 + col0;
                float s = 0.f;
#pragma unroll
                for (int bj = 0; bj < 2; ++bj) {
                    const u32x4 b = bv[m][bj];
                    const f32x4 b0 = {__builtin_bit_cast(float, b.x << 16), __builtin_bit_cast(float, b.x & 0xffff0000u), __builtin_bit_cast(float, b.y << 16), __builtin_bit_cast(float, b.y & 0xffff0000u)};
                    const f32x4 b1 = {__builtin_bit_cast(float, b.z << 16), __builtin_bit_cast(float, b.z & 0xffff0000u), __builtin_bit_cast(float, b.w << 16), __builtin_bit_cast(float, b.w & 0xffff0000u)};
                    const f32x4 v0 = b0 + acc[ai][bj][m][0] * alpha, v1 = b1 + acc[ai][bj][m][1] * alpha;
                    u32x4 w; w.x = cvt_pk_bf16(v0[0], v0[1]); w.y = cvt_pk_bf16(v0[2], v0[3]); w.z = cvt_pk_bf16(v1[0], v1[1]); w.w = cvt_pk_bf16(v1[2], v1[3]);
                    *(u32x4*)(XB + off + bj * HALF) = w;
                    const float r0 = __builtin_bit_cast(float, w.x << 16), r1 = __builtin_bit_cast(float, w.x & 0xffff0000u), r2 = __builtin_bit_cast(float, w.y << 16), r3 = __builtin_bit_cast(float, w.y & 0xffff0000u);
                    const float r4 = __builtin_bit_cast(float, w.z << 16), r5 = __builtin_bit_cast(float, w.z & 0xffff0000u), r6 = __builtin_bit_cast(float, w.w << 16), r7 = __builtin_bit_cast(float, w.w & 0xffff0000u);
                    s += (r0 * r0 + r1 * r1) + (r2 * r2 + r3 * r3) + (r4 * r4 + r5 * r5) + (r6 * r6 + r7 * r7);
                }
                s += __shfl_xor(s, 16); s += __shfl_xor(s, 32);
                if (fq == 0) SS[(size_t)row * 16 + u.pn * 4 + wc] = s;
            }
        }
    }
};
struct EpiResNoop {
    static constexpr bool PERM = true, AFTER_DRAIN = false;
    __device__ __forceinline__ void operator()(const f32x4 (&acc)[2][2][4][2], const Unit&, int, int, int, int) const {
#pragma unroll
        for (int ai = 0; ai < 2; ++ai)
#pragma unroll
            for (int bj = 0; bj < 2; ++bj)
                asm volatile("" :: "v"(acc[ai][bj][0][0]), "v"(acc[ai][bj][0][1]), "v"(acc[ai][bj][1][0]), "v"(acc[ai][bj][1][1]), "v"(acc[ai][bj][2][0]), "v"(acc[ai][bj][2][1]), "v"(acc[ai][bj][3][0]), "v"(acc[ai][bj][3][1]));
    }
};
struct EpiQKV {
    static constexpr bool PERM = true, AFTER_DRAIN = false;
    bf16_t* O; int ldc; const float* SS; int nq_tiles; float qscale; float* KMP; int k_lo, k_hi;
    __device__ __forceinline__ void operator()(const f32x4 (&acc)[2][2][4][2], const Unit& u, int wr, int wc, int fr, int fq) const {
        const int row0 = u.pm * BM + wr * 64 + fr, col0 = u.pn * BM + wc * 32 + 8 * fq;
        const float sc = (u.pn < nq_tiles) ? qscale : 1.0f;
        float r8[8]; row_rstd8(SS, row0, fq, r8);
#pragma unroll
        for (int ai = 0; ai < 2; ++ai)
#pragma unroll
            for (int m = 0; m < 4; ++m) {
                const int row = row0 + ai * HALF + m * 16;
                const float r = r8[ai * 4 + m] * sc;
                bf16_t* rowp = O + (size_t)row * ldc + col0;
#pragma unroll
                for (int bj = 0; bj < 2; ++bj) {
                    const f32x4 v0 = acc[ai][bj][m][0] * r, v1 = acc[ai][bj][m][1] * r;
                    u32x4 w; w.x = cvt_pk_bf16(v0[0], v0[1]); w.y = cvt_pk_bf16(v0[2], v0[3]); w.z = cvt_pk_bf16(v1[0], v1[1]); w.w = cvt_pk_bf16(v1[2], v1[3]);
                    *(u32x4*)(rowp + bj * HALF) = w;
                }
            }
        if (KMP != nullptr && u.pn >= k_lo && u.pn < k_hi) {
            float* dst = KMP + ((size_t)u.pm * 2 + wr) * 1024 + (u.pn - k_lo) * BM + wc * 32 + 8 * fq;
#pragma unroll
            for (int bj = 0; bj < 2; ++bj)
#pragma unroll
                for (int n = 0; n < 2; ++n) {
                    f32x4 cs = {0.f, 0.f, 0.f, 0.f};
#pragma unroll
                    for (int ai = 0; ai < 2; ++ai)
#pragma unroll
                        for (int m = 0; m < 4; ++m) cs += acc[ai][bj][m][n] * r8[ai * 4 + m];
#pragma unroll
                    for (int i = 0; i < 4; ++i) { float c = cs[i]; c += __shfl_xor(c, 1); c += __shfl_xor(c, 2); c += __shfl_xor(c, 4); c += __shfl_xor(c, 8); cs[i] = c; }
                    if (fr == 0) *(f32x4*)(dst + bj * HALF + 4 * n) = cs;
                }
        }
    }
};
#ifndef PG8_PRIO_MMA
#define PG8_PRIO_MMA 1
#define PG8_PRIO_LOAD 0
#endif
template <class E, class = void> struct kprobe_of { static constexpr int value = 0; };
template <class E> struct kprobe_of<E, decltype((void)E::KPROBE)> { static constexpr int value = E::KPROBE; };
template <class Epi, class Sched, bool ALIGN_EPI = false, bool SP2 = false, bool XDMA = false>
__device__ __forceinline__ void gemm_phase(PG8_LAS unsigned char* lds, const Gemm g, const Sched& S, const Epi& E) {
    int tid = threadIdx.x; asm volatile("" : "+v"(tid));
    const int wid = __builtin_amdgcn_readfirstlane(tid >> 6), lane = tid & 63, wr = wid >> 2, wc = wid & 3, fr = lane & 15, fq = lane >> 4;
    const int K = g.K, nt = K / BK;
    unsigned voffA[2], voffB[2];
#pragma unroll
    for (int i = 0; i < 2; ++i) { int R, C; stage_rc(tid * 16 + i * 8192, R, C); const int Rb = Epi::PERM ? ((R & ~31) + perm32(R & 31)) : R;
        voffA[i] = (unsigned)(R * K + C) * 2u; voffB[i] = (unsigned)(Rb * K + C) * 2u; }
    const size_t kstep = (size_t)(BK * 2);
    const size_t hstep = (size_t)HALF * K * 2;
    const size_t tstep = 2 * hstep;
    const unsigned ldsw = (unsigned)wid * 1024u;
    const int aoff = lds_byte(wr * 64 + fr, fq * 8), boff = lds_byte(wc * 32 + fr, fq * 8);
#define PG8_SA(b, h) (((b) * 2 + (h)) * HTB)
#define PG8_SB(b, h) ((4 + (b) * 2 + (h)) * HTB)
#define PG8_STAGE(bufoff, gbase, voff) do { if constexpr (kprobe_of<Epi>::value != 1) _Pragma("unroll") for (int _i = 0; _i < 2; ++_i) \
        __builtin_amdgcn_global_load_lds((const unsigned*)((const char*)(gbase) + (voff)[_i]), (PG8_LAS unsigned*)(lds + (bufoff) + ldsw + _i * 8192), 16, 0, 0); } while (0)
#define PG8_LDA(dst, b, h) do { if constexpr (kprobe_of<Epi>::value != 2) _Pragma("unroll") for (int m = 0; m < 4; ++m) _Pragma("unroll") for (int k = 0; k < 2; ++k) dst[m][k] = *(const PG8_LAS bf16x8*)(lds + PG8_SA(b, h) + aoff + m * 2048 + k * 1024); } while (0)
#define PG8_LDB(dst, b, h) do { if constexpr (kprobe_of<Epi>::value != 2) _Pragma("unroll") for (int n = 0; n < 2; ++n) _Pragma("unroll") for (int k = 0; k < 2; ++k) dst[n][k] = *(const PG8_LAS bf16x8*)(lds + PG8_SB(b, h) + boff + n * 2048 + k * 1024); } while (0)
#define PG8_MMA(ai, bj, At, Bt) do { __builtin_amdgcn_s_setprio(PG8_PRIO_MMA); _Pragma("unroll") for (int m = 0; m < 4; ++m) _Pragma("unroll") for (int n = 0; n < 2; ++n) _Pragma("unroll") for (int k = 0; k < 2; ++k) \
        acc[ai][bj][m][n] = __builtin_amdgcn_mfma_f32_16x16x32_bf16(Bt[n][k], At[m][k], acc[ai][bj][m][n], 0, 0, 0); __builtin_amdgcn_s_setprio(PG8_PRIO_LOAD); } while (0)
#define PG8_WAIT_V(n) asm volatile("s_waitcnt vmcnt(" #n ")" ::: "memory")
#define PG8_WAIT_L(n) asm volatile("s_waitcnt lgkmcnt(" #n ")" ::: "memory")
#define PG8_BAR __builtin_amdgcn_s_barrier()
#define PG8_SCHED __builtin_amdgcn_sched_barrier(0)
    Unit cur, nxt; int ui = 0;
    if (!S.next(0, cur)) return;
    f32x4 acc[2][2][4][2];
#pragma unroll
    for (int a = 0; a < 2; ++a)
#pragma unroll
        for (int b = 0; b < 2; ++b)
#pragma unroll
            for (int m = 0; m < 4; ++m)
#pragma unroll
                for (int n = 0; n < 2; ++n) acc[a][b][m][n] = (f32x4){0.f, 0.f, 0.f, 0.f};
    bf16x8 At[4][2], B0[2][2], B1[2][2];
    const char* cA = (const char*)g.A + (size_t)cur.pm * tstep; const char* cB = (const char*)g.Bt + (size_t)cur.pn * tstep;
    S.a_ready(cur);
    if constexpr (SP2) {
        PG8_STAGE(PG8_SB(0, 0), cB, voffB); PG8_STAGE(PG8_SB(0, 1), cB + hstep, voffB); PG8_STAGE(PG8_SA(0, 0), cA, voffA); PG8_STAGE(PG8_SA(0, 1), cA + hstep, voffA);
        if (wr == 1) PG8_BAR;
        PG8_WAIT_V(2); PG8_BAR;
        PG8_STAGE(PG8_SB(1, 0), cB + kstep, voffB); PG8_STAGE(PG8_SA(1, 0), cA + kstep, voffA); PG8_STAGE(PG8_SB(1, 1), cB + hstep + kstep, voffB);
        PG8_WAIT_V(6); PG8_BAR;
    } else {
        PG8_STAGE(PG8_SB(0, 0), cB, voffB); PG8_STAGE(PG8_SA(0, 0), cA, voffA); PG8_STAGE(PG8_SB(0, 1), cB + hstep, voffB); PG8_STAGE(PG8_SA(0, 1), cA + hstep, voffA);
        if (wr == 1) PG8_BAR;
        PG8_WAIT_V(4); PG8_BAR;
        PG8_STAGE(PG8_SB(1, 0), cB + kstep, voffB); PG8_STAGE(PG8_SA(1, 0), cA + kstep, voffA); PG8_STAGE(PG8_SB(1, 1), cB + hstep + kstep, voffB);
        PG8_WAIT_V(6); PG8_BAR;
    }
    for (;;) {
        const bool has_next = S.next(ui + 1, nxt);
        const char* nA = has_next ? (const char*)g.A + (size_t)nxt.pm * tstep : cA; const char* nB = has_next ? (const char*)g.Bt + (size_t)nxt.pn * tstep : cB;
        for (int t = 0; t < nt; t += 2) {
            const bool last = (t == nt - 2);
            const char* a1 = cA + (size_t)(t + 1) * kstep;
            const char* a2 = last ? nA : cA + (size_t)(t + 2) * kstep; const char* b2 = last ? nB : cB + (size_t)(t + 2) * kstep;
            const char* a3 = a2 + kstep; const char* b3 = b2 + kstep;
            if (last && has_next) S.a_ready(nxt);
            if constexpr (SP2) {
            if constexpr (XDMA) {
            PG8_LDB(B0, 0, 0); PG8_LDB(B1, 0, 1); PG8_SCHED; PG8_LDA(At, 0, 0);
            PG8_WAIT_V(6); PG8_WAIT_L(0); PG8_BAR; PG8_MMA(0, 0, At, B0); PG8_STAGE(PG8_SA(1, 1), a1 + hstep, voffA); PG8_MMA(0, 1, At, B1); PG8_BAR; PG8_SCHED;
            PG8_LDA(At, 0, 1);
            PG8_WAIT_V(2); PG8_WAIT_L(0); PG8_BAR; PG8_MMA(1, 0, At, B0); PG8_STAGE(PG8_SB(0, 0), b2, voffB); PG8_STAGE(PG8_SB(0, 1), b2 + hstep, voffB); PG8_STAGE(PG8_SA(0, 0), a2, voffA); PG8_MMA(1, 1, At, B1); PG8_BAR; PG8_SCHED;
            PG8_LDB(B0, 1, 0); PG8_LDB(B1, 1, 1); PG8_SCHED; PG8_LDA(At, 1, 0);
            PG8_WAIT_V(6); PG8_WAIT_L(0); PG8_BAR; PG8_MMA(0, 0, At, B0); PG8_STAGE(PG8_SA(0, 1), a2 + hstep, voffA); PG8_MMA(0, 1, At, B1); PG8_BAR; PG8_SCHED;
            PG8_LDA(At, 1, 1);
            PG8_WAIT_V(2); PG8_WAIT_L(0); PG8_BAR; PG8_MMA(1, 0, At, B0); PG8_STAGE(PG8_SB(1, 0), b3, voffB); PG8_STAGE(PG8_SB(1, 1), b3 + hstep, voffB); PG8_STAGE(PG8_SA(1, 0), a3, voffA); PG8_MMA(1, 1, At, B1); PG8_BAR; PG8_SCHED;
            } else {
            PG8_LDB(B0, 0, 0); PG8_LDB(B1, 0, 1); PG8_SCHED; PG8_LDA(At, 0, 0); PG8_STAGE(PG8_SA(1, 1), a1 + hstep, voffA);
            PG8_WAIT_V(8); PG8_WAIT_L(0); PG8_BAR; PG8_MMA(0, 0, At, B0); PG8_MMA(0, 1, At, B1); PG8_BAR; PG8_SCHED;
            PG8_LDA(At, 0, 1); PG8_STAGE(PG8_SB(0, 0), b2, voffB); PG8_STAGE(PG8_SB(0, 1), b2 + hstep, voffB); PG8_STAGE(PG8_SA(0, 0), a2, voffA);
            PG8_WAIT_V(8); PG8_WAIT_L(0); PG8_BAR; PG8_MMA(1, 0, At, B0); PG8_MMA(1, 1, At, B1); PG8_BAR; PG8_SCHED;
            PG8_LDB(B0, 1, 0); PG8_LDB(B1, 1, 1); PG8_SCHED; PG8_LDA(At, 1, 0); PG8_STAGE(PG8_SA(0, 1), a2 + hstep, voffA);
            PG8_WAIT_V(8); PG8_WAIT_L(0); PG8_BAR; PG8_MMA(0, 0, At, B0); PG8_MMA(0, 1, At, B1); PG8_BAR; PG8_SCHED;
            PG8_LDA(At, 1, 1); PG8_STAGE(PG8_SB(1, 0), b3, voffB); PG8_STAGE(PG8_SB(1, 1), b3 + hstep, voffB); PG8_STAGE(PG8_SA(1, 0), a3, voffA);
            PG8_WAIT_V(8); PG8_WAIT_L(0); PG8_BAR; PG8_MMA(1, 0, At, B0); PG8_MMA(1, 1, At, B1); PG8_BAR; PG8_SCHED;
            }
            } else {
            PG8_LDB(B0, 0, 0); PG8_SCHED; PG8_LDA(At, 0, 0); PG8_STAGE(PG8_SA(1, 1), a1 + hstep, voffA);
            PG8_WAIT_L(8); PG8_BAR; PG8_WAIT_L(0); PG8_MMA(0, 0, At, B0); PG8_BAR; PG8_SCHED;
            PG8_LDB(B1, 0, 1); PG8_STAGE(PG8_SB(0, 0), b2, voffB);
            PG8_BAR; PG8_WAIT_L(0); PG8_MMA(0, 1, At, B1); PG8_BAR;
            PG8_LDA(At, 0, 1); PG8_STAGE(PG8_SA(0, 0), a2, voffA);
            PG8_BAR; PG8_WAIT_L(0); PG8_MMA(1, 0, At, B0); PG8_BAR; PG8_SCHED;
            PG8_STAGE(PG8_SB(0, 1), b2 + hstep, voffB);
            PG8_WAIT_V(6); PG8_BAR; PG8_MMA(1, 1, At, B1); PG8_BAR;
            PG8_LDB(B0, 1, 0); PG8_SCHED; PG8_LDA(At, 1, 0); PG8_STAGE(PG8_SA(0, 1), a2 + hstep, voffA);
            PG8_WAIT_L(8); PG8_BAR; PG8_WAIT_L(0); PG8_MMA(0, 0, At, B0); PG8_BAR; PG8_SCHED;
            PG8_LDB(B1, 1, 1); PG8_STAGE(PG8_SB(1, 0), b3, voffB);
            PG8_BAR; PG8_WAIT_L(0); PG8_MMA(0, 1, At, B1); PG8_BAR;
            PG8_LDA(At, 1, 1); PG8_STAGE(PG8_SA(1, 0), a3, voffA);
            PG8_BAR; PG8_WAIT_L(0); PG8_MMA(1, 0, At, B0); PG8_BAR; PG8_SCHED;
            PG8_STAGE(PG8_SB(1, 1), b3 + hstep, voffB);
            PG8_WAIT_V(6); PG8_BAR; PG8_MMA(1, 1, At, B1); PG8_BAR;
            }
        }
        if constexpr (ALIGN_EPI) { if (wr == 0) PG8_BAR; }
        if constexpr (!Epi::AFTER_DRAIN) { E(acc, cur, wr, wc, fr, fq); S.done(cur); }
        if (!has_next) break;
#pragma unroll
        for (int a = 0; a < 2; ++a)
#pragma unroll
            for (int b = 0; b < 2; ++b)
#pragma unroll
                for (int m = 0; m < 4; ++m)
#pragma unroll
                    for (int n = 0; n < 2; ++n) acc[a][b][m][n] = (f32x4){0.f, 0.f, 0.f, 0.f};
        cur = nxt; cA = nA; cB = nB; ++ui;
        if constexpr (ALIGN_EPI) { if (wr == 1) PG8_BAR; }
    }
    PG8_WAIT_V(0);
    if constexpr (!ALIGN_EPI) { if (wr == 0) PG8_BAR; }
    PG8_BAR;
    if constexpr (Epi::AFTER_DRAIN) { E.fused(acc, cur, wr, wc, fr, fq, lds, wid, lane); S.done(cur); }
#undef PG8_SA
#undef PG8_SB
#undef PG8_STAGE
#undef PG8_LDA
#undef PG8_LDB
#undef PG8_MMA
#undef PG8_WAIT_V
#undef PG8_WAIT_L
#undef PG8_BAR
#undef PG8_SCHED
}
}
namespace pg8 {
constexpr int HM_STAGE_BYTES = 9 * HTB;
template <class Epi>
__device__ __forceinline__ void gemm_half_unit(PG8_LAS unsigned char* lds, const Gemm g, const HUnit hu, const Epi& E) {
    int tid = threadIdx.x; asm volatile("" : "+v"(tid));
    const int wid = __builtin_amdgcn_readfirstlane(tid >> 6), lane = tid & 63, wr = wid >> 2, wc = wid & 3, fr = lane & 15, fq = lane >> 4;
    const int K = g.K, nt = K / BK;
    unsigned voffA[2], voffB[2];
#pragma unroll
    for (int i = 0; i < 2; ++i) { int R, C; stage_rc(tid * 16 + i * 8192, R, C); const int Rb = Epi::PERM ? ((R & ~31) + perm32(R & 31)) : R;
        voffA[i] = (unsigned)(R * K + C) * 2u; voffB[i] = (unsigned)(Rb * K + C) * 2u; }
    const size_t kstep = (size_t)(BK * 2);
    const size_t hstep = (size_t)HALF * K * 2;
    const unsigned ldsw = (unsigned)wid * 1024u;
    const int aoff = lds_byte(wr * 64 + fr, fq * 8), boff = lds_byte(wc * 32 + fr, fq * 8);
#define HM_SA(b) ((b) * 3 * HTB)
#define HM_SB(b, h) (((b) * 3 + 1 + (h)) * HTB)
#define HM_STAGE(bufoff, gbase, voff) do { _Pragma("unroll") for (int _i = 0; _i < 2; ++_i) \
        __builtin_amdgcn_global_load_lds((const unsigned*)((const char*)(gbase) + (voff)[_i]), (PG8_LAS unsigned*)(lds + (bufoff) + ldsw + _i * 8192), 16, 0, 0); } while (0)
#define HM_LDA(dst, b) do { _Pragma("unroll") for (int m = 0; m < 4; ++m) _Pragma("unroll") for (int k = 0; k < 2; ++k) dst[m][k] = *(const PG8_LAS bf16x8*)(lds + HM_SA(b) + aoff + m * 2048 + k * 1024); } while (0)
#define HM_LDB(dst, b, h) do { _Pragma("unroll") for (int n = 0; n < 2; ++n) _Pragma("unroll") for (int k = 0; k < 2; ++k) dst[n][k] = *(const PG8_LAS bf16x8*)(lds + HM_SB(b, h) + boff + n * 2048 + k * 1024); } while (0)
#define HM_MMA(bj, At, Bt) do { __builtin_amdgcn_s_setprio(PG8_PRIO_MMA); _Pragma("unroll") for (int m = 0; m < 4; ++m) _Pragma("unroll") for (int n = 0; n < 2; ++n) _Pragma("unroll") for (int k = 0; k < 2; ++k) \
        acc[bj][m][n] = __builtin_amdgcn_mfma_f32_16x16x32_bf16(Bt[n][k], At[m][k], acc[bj][m][n], 0, 0, 0); __builtin_amdgcn_s_setprio(PG8_PRIO_LOAD); } while (0)
#define HM_WAIT_V(n) asm volatile("s_waitcnt vmcnt(" #n ")" ::: "memory")
#define HM_WAIT_L(n) asm volatile("s_waitcnt lgkmcnt(" #n ")" ::: "memory")
#define HM_BAR __builtin_amdgcn_s_barrier()
#define HM_SCHED __builtin_amdgcn_sched_barrier(0)
    f32x4 acc[2][4][2];
#pragma unroll
    for (int b = 0; b < 2; ++b)
#pragma unroll
        for (int m = 0; m < 4; ++m)
#pragma unroll
            for (int n = 0; n < 2; ++n) acc[b][m][n] = (f32x4){0.f, 0.f, 0.f, 0.f};
    bf16x8 At[4][2], B0[2][2], B1[2][2];
    const char* cA = (const char*)g.A + (size_t)hu.pm2 * hstep; const char* cB = (const char*)g.Bt + (size_t)hu.pn * 2 * hstep;
    HM_STAGE(HM_SB(0, 0), cB, voffB); HM_STAGE(HM_SB(0, 1), cB + hstep, voffB); HM_STAGE(HM_SA(0), cA, voffA);
    HM_STAGE(HM_SB(1, 0), cB + kstep, voffB); HM_STAGE(HM_SB(1, 1), cB + hstep + kstep, voffB); HM_STAGE(HM_SA(1), cA + kstep, voffA);
    if (wr == 1) HM_BAR;
    HM_WAIT_V(6); HM_BAR; HM_BAR;
#define HM_SP(b, bn2, s) do { \
        HM_LDB(B0, b, 0); HM_LDB(B1, b, 1); HM_SCHED; HM_LDA(At, b); \
        if ((s) + 2 < nt) { const char* a2 = cA + (size_t)((s) + 2) * kstep; const char* b2 = cB + (size_t)((s) + 2) * kstep; \
            HM_STAGE(HM_SB(bn2, 0), b2, voffB); HM_STAGE(HM_SB(bn2, 1), b2 + hstep, voffB); HM_STAGE(HM_SA(bn2), a2, voffA); HM_WAIT_V(6); } \
        else { HM_WAIT_V(0); } \
        HM_WAIT_L(0); HM_BAR; HM_MMA(0, At, B0); HM_MMA(1, At, B1); HM_BAR; HM_SCHED; } while (0)
    for (int s = 0; s < nt; s += 3) {
        HM_SP(0, 2, s);
        if (s + 1 < nt) HM_SP(1, 0, s + 1);
        if (s + 2 < nt) HM_SP(2, 1, s + 2);
    }
    if (wr == 0) HM_BAR;
    E.half(acc, hu, wr, wc, fr, fq);
#undef HM_SA
#undef HM_SB
#undef HM_STAGE
#undef HM_LDA
#undef HM_LDB
#undef HM_MMA
#undef HM_WAIT_V
#undef HM_WAIT_L
#undef HM_BAR
#undef HM_SCHED
#undef HM_SP
}
}
namespace att {
typedef short bf16x8 __attribute__((ext_vector_type(8)));
typedef short s16x4 __attribute__((ext_vector_type(4)));
typedef float f32x16 __attribute__((ext_vector_type(16)));
typedef float f32x4 __attribute__((ext_vector_type(4)));
typedef unsigned u32x4 __attribute__((ext_vector_type(4)));
typedef int int4v __attribute__((ext_vector_type(4)));
typedef unsigned short bf16_t;
constexpr int SEQ = 2048, OPITCH = 1024;
constexpr int SLOTB = 8192, NSLOT = 4;
constexpr int LDS_K = 0, LDS_V = NSLOT * SLOTB, LDS_WS = 2 * NSLOT * SLOTB, LDS_OST = LDS_WS + 8 * 256, LDS_KMT = LDS_OST + 8 * 4096, LDS_END = LDS_KMT + 8 * 64 * 4;
typedef LAS const char* lds_cptr;
#define ATT_SBAR() __builtin_amdgcn_sched_barrier(0)
#define ATT_WAIT_BAR(N) asm volatile("s_waitcnt vmcnt(" #N ") lgkmcnt(0)\n\ts_barrier" ::: "memory")
__device__ __forceinline__ int crow(int r, int hi) { return (r & 3) + 8 * (r >> 2) + 4 * hi; }
__device__ __forceinline__ void glds16(const void* gsrc, unsigned lds_dst) { unsigned keep;
    asm volatile("s_mov_b32 %0, m0\n\ts_mov_b32 m0, %2\n\ts_nop 0\n\tglobal_load_lds_dwordx4 %1, off\n\ts_mov_b32 m0, %0" : "=&s"(keep) : "v"(gsrc), "s"(lds_dst) : "memory"); }
typedef float f32x2_t __attribute__((ext_vector_type(2))); typedef __bf16 bf16x2_t __attribute__((ext_vector_type(2)));
__device__ __forceinline__ unsigned cvtpk(float lo, float hi) { f32x2_t v = {lo, hi}; bf16x2_t b = __builtin_convertvector(v, bf16x2_t); return __builtin_bit_cast(unsigned, b); }
__device__ __forceinline__ float bf2f(short s) { return __builtin_bit_cast(float, (unsigned)(unsigned short)s << 16); }
__device__ __forceinline__ float partner(float x, int hi) {
    auto rr = __builtin_amdgcn_permlane32_swap(__builtin_bit_cast(unsigned, x), __builtin_bit_cast(unsigned, x), false, false);
    return __builtin_bit_cast(float, hi ? rr[0] : rr[1]);
}
typedef short v4i16_t __attribute__((ext_vector_type(4)));
__device__ __forceinline__ s16x4 vtr(lds_cptr p) { return __builtin_bit_cast(s16x4, __builtin_amdgcn_ds_read_tr16_b64_v4i16((LAS v4i16_t*)p)); }
__device__ __forceinline__ void vload16(s16x4* vlo, s16x4* vhi, lds_cptr vp) {
#pragma unroll
    for (int i = 0; i < 8; ++i) { vlo[i] = vtr(vp + ((i >> 2) * 4096 + (i & 3) * 1024)); vhi[i] = vtr(vp + ((i >> 2) * 4096 + (i & 3) * 1024 + 512)); }
}
__device__ __forceinline__ void pv_r(f32x16* o, const s16x4* vlo, const s16x4* vhi, bf16x8 pa0, bf16x8 pa1, bf16x8 pa2, bf16x8 pa3) {
#define ATT_VF(i) (bf16x8){vlo[i][0], vlo[i][1], vlo[i][2], vlo[i][3], vhi[i][0], vhi[i][1], vhi[i][2], vhi[i][3]}
    o[0] = __builtin_amdgcn_mfma_f32_32x32x16_bf16(pa0, ATT_VF(0), o[0], 0, 0, 0); o[1] = __builtin_amdgcn_mfma_f32_32x32x16_bf16(pa0, ATT_VF(4), o[1], 0, 0, 0);
    o[0] = __builtin_amdgcn_mfma_f32_32x32x16_bf16(pa1, ATT_VF(1), o[0], 0, 0, 0); o[1] = __builtin_amdgcn_mfma_f32_32x32x16_bf16(pa1, ATT_VF(5), o[1], 0, 0, 0);
    o[0] = __builtin_amdgcn_mfma_f32_32x32x16_bf16(pa2, ATT_VF(2), o[0], 0, 0, 0); o[1] = __builtin_amdgcn_mfma_f32_32x32x16_bf16(pa2, ATT_VF(6), o[1], 0, 0, 0);
    o[0] = __builtin_amdgcn_mfma_f32_32x32x16_bf16(pa3, ATT_VF(3), o[0], 0, 0, 0); o[1] = __builtin_amdgcn_mfma_f32_32x32x16_bf16(pa3, ATT_VF(7), o[1], 0, 0, 0);
#undef ATT_VF
}
__device__ __forceinline__ void qkt(f32x16& p0, f32x16& p1, lds_cptr kb, const bf16x8* qr) {
    const f32x16 z = {};
#pragma unroll
    for (int d0 = 0; d0 < 4; ++d0) {
        const bf16x8 b0 = *(const LAS bf16x8*)(kb + d0 * 2048);
        const bf16x8 b1 = *(const LAS bf16x8*)(kb + d0 * 2048 + 512);
        if (d0 == 0) { p0 = __builtin_amdgcn_mfma_f32_32x32x16_bf16(b0, qr[0], z, 0, 0, 0); p1 = __builtin_amdgcn_mfma_f32_32x32x16_bf16(b1, qr[0], z, 0, 0, 0); }
        else { p0 = __builtin_amdgcn_mfma_f32_32x32x16_bf16(b0, qr[d0], p0, 0, 0, 0); p1 = __builtin_amdgcn_mfma_f32_32x32x16_bf16(b1, qr[d0], p1, 0, 0, 0); }
    }
}
__device__ __forceinline__ void qkt_aug(f32x16& p0, f32x16& p1, lds_cptr kb, const bf16x8* qr, const f32x16& c, bf16x8 kaug0, bf16x8 kaug1, bf16x8 qaug) {
    p0 = __builtin_amdgcn_mfma_f32_32x32x16_bf16(kaug0, qaug, c, 0, 0, 0); p1 = __builtin_amdgcn_mfma_f32_32x32x16_bf16(kaug1, qaug, c, 0, 0, 0);
#pragma unroll
    for (int d0 = 0; d0 < 4; ++d0) {
        const bf16x8 b0 = *(const LAS bf16x8*)(kb + d0 * 2048);
        const bf16x8 b1 = *(const LAS bf16x8*)(kb + d0 * 2048 + 512);
        p0 = __builtin_amdgcn_mfma_f32_32x32x16_bf16(b0, qr[d0], p0, 0, 0, 0); p1 = __builtin_amdgcn_mfma_f32_32x32x16_bf16(b1, qr[d0], p1, 0, 0, 0);
    }
}
__device__ __forceinline__ void pv(f32x16* o, int vb, bf16x8 pa0, bf16x8 pa1, bf16x8 pa2, bf16x8 pa3) {
#pragma unroll
    for (int d0 = 0; d0 < 2; ++d0) { s16x4 lo[4], hi[4];
#pragma unroll
        for (int ks = 0; ks < 4; ++ks) {
            asm volatile("ds_read_b64_tr_b16 %0,%1 offset:%c2" : "=&v"(lo[ks]) : "v"(vb), "i"(d0 * 4096 + ks * 1024) : "memory");
            asm volatile("ds_read_b64_tr_b16 %0,%1 offset:%c2" : "=&v"(hi[ks]) : "v"(vb), "i"(d0 * 4096 + ks * 1024 + 512) : "memory"); }
        asm volatile("s_waitcnt lgkmcnt(0)" ::: "memory"); ATT_SBAR();
#define ATT_PK(k) (bf16x8){lo[k][0], lo[k][1], lo[k][2], lo[k][3], hi[k][0], hi[k][1], hi[k][2], hi[k][3]}
        o[d0] = __builtin_amdgcn_mfma_f32_32x32x16_bf16(pa0, ATT_PK(0), o[d0], 0, 0, 0);
        o[d0] = __builtin_amdgcn_mfma_f32_32x32x16_bf16(pa1, ATT_PK(1), o[d0], 0, 0, 0);
        o[d0] = __builtin_amdgcn_mfma_f32_32x32x16_bf16(pa2, ATT_PK(2), o[d0], 0, 0, 0);
        o[d0] = __builtin_amdgcn_mfma_f32_32x32x16_bf16(pa3, ATT_PK(3), o[d0], 0, 0, 0);
#undef ATT_PK
    }
}
template <bool MOBA>
__device__ __forceinline__ void attn_unit(const int b, const int h, const int qb, const bf16_t* __restrict__ QKV, const int pitch, const int koff, const int voff,
                                          bf16_t* __restrict__ O, LAS unsigned char* lds, const float* __restrict__ KMP, const float sl2, const unsigned force_sel = 0u) {
    int tid = threadIdx.x; asm volatile("" : "+v"(tid));
    const int lane = tid & 63, r32 = lane & 31, hi = lane >> 5;
    const int wid = __builtin_amdgcn_readfirstlane(tid >> 6);
    const long rowbase = (long)b * SEQ; const int q0 = qb * 256;
    const bf16_t* Qw = QKV + (rowbase + q0 + wid * 32) * pitch + h * 64;
    const bf16_t* Kh = QKV + rowbase * pitch + koff + h * 64;
    const bf16_t* Vh = QKV + rowbase * pitch + voff + h * 64;
    const unsigned lds0 = (unsigned)(uintptr_t)lds;
    const bf16_t* ksrc = Kh + (long)lane * pitch + wid * 8;
    const bf16_t* vsrc = Vh + (long)(16 * (wid & 3) + (lane >> 2)) * pitch + (wid >> 2) * 32 + (lane & 3) * 8;
    const unsigned kdst = lds0 + LDS_K + wid * 1024, vdst = lds0 + LDS_V + wid * 1024;
#define ATT_DMA_KV(t, slot) do { glds16(ksrc + (long)(t) * 64 * pitch, (unsigned)__builtin_amdgcn_readfirstlane(kdst + (slot))); \
                                 glds16(vsrc + (long)(t) * 64 * pitch, (unsigned)__builtin_amdgcn_readfirstlane(vdst + (slot))); } while (0)
    const int NT = 4 * qb + 4;
    const int tdiag = 4 * qb + (wid >> 1);
    LAS float* wsf = (LAS float*)(lds + LDS_WS) + wid * 64;
    const lds_cptr kp0 = (lds_cptr)lds + LDS_K + hi * 1024 + r32 * 16;
    const int vb0 = (int)(lds0 + LDS_V) + ((lane >> 4) & 1) * 32 + (lane & 3) * 8 + (4 * hi + ((lane & 15) >> 2)) * 64;
    ATT_DMA_KV(NT - 1, 0); ATT_DMA_KV(NT - 2, SLOTB);
    bf16x8 qr[4];
#pragma unroll
    for (int d0 = 0; d0 < 4; ++d0) qr[d0] = *(const bf16x8*)(Qw + (long)r32 * pitch + d0 * 16 + hi * 8);
    f32x16 o[2]; o[0] = f32x16{}; o[1] = f32x16{};
    const int qrel = wid * 32 + r32;
    float carry = 1.0f;
    float mhat = 0.f, lrow = 0.f; unsigned selmask = 0u;
    bf16x8 kaug0 = {0, 0, 0, 0, 0, 0, 0, 0}, kaug1 = {0, 0, 0, 0, 0, 0, 0, 0}, qaug = {0, 0, 0, 0, 0, 0, 0, 0};
    if constexpr (MOBA) {
        LAS float* kmt = (LAS float*)(lds + LDS_KMT);
        { const int n = tid >> 6, d = tid & 63;
          if (n < qb) { const float* kp = KMP + ((size_t)(b * 8 + n) * 2) * 1024 + h * 64 + d; kmt[n * 64 + d] = (kp[0] + kp[1024]) * (1.0f / 256.0f); } }
        asm volatile("s_waitcnt lgkmcnt(0)\n\ts_barrier" ::: "memory");
        float gate[7];
#pragma unroll
        for (int n = 0; n < 7; ++n) {
            float g = -INFINITY;
            if (n < qb) {
                float s = 0.f;
#pragma unroll
                for (int d0 = 0; d0 < 4; ++d0) {
                    const f32x4 k0 = *(const LAS f32x4*)(kmt + n * 64 + d0 * 16 + hi * 8), k1 = *(const LAS f32x4*)(kmt + n * 64 + d0 * 16 + hi * 8 + 4);
                    s += bf2f(qr[d0][0]) * k0[0] + bf2f(qr[d0][1]) * k0[1] + bf2f(qr[d0][2]) * k0[2] + bf2f(qr[d0][3]) * k0[3]
                       + bf2f(qr[d0][4]) * k1[0] + bf2f(qr[d0][5]) * k1[1] + bf2f(qr[d0][6]) * k1[2] + bf2f(qr[d0][7]) * k1[3];
                }
                g = s + partner(s, hi);
            }
            gate[n] = g;
        }
#pragma unroll
        for (int r = 0; r < 3; ++r) {
            int best = -1; float bv = -INFINITY;
#pragma unroll
            for (int n = 0; n < 7; ++n) { const bool taken = (selmask >> n) & 1u; if (!taken && gate[n] > bv) { best = n; bv = gate[n]; } }
            if (best >= 0) selmask |= 1u << best;
        }
        selmask |= (1u << qb) | force_sel;
        mhat = sl2 * (float)qrel;
        if (hi == 0) {
            const unsigned sh = __builtin_bit_cast(unsigned, sl2) + 0x7fffu + ((__builtin_bit_cast(unsigned, sl2) >> 16) & 1u), shb = sh >> 16;
            const float rem = sl2 - __builtin_bit_cast(float, shb << 16); const unsigned sl = (__builtin_bit_cast(unsigned, rem) + 0x7fffu + ((__builtin_bit_cast(unsigned, rem) >> 16) & 1u)) >> 16;
            qaug[0] = (short)shb; qaug[1] = (short)sl;
            const short k0s = (short)(__builtin_bit_cast(unsigned, (float)r32) >> 16), k1s = (short)(__builtin_bit_cast(unsigned, (float)(32 + r32)) >> 16);
            kaug0[0] = k0s; kaug0[1] = k0s; kaug1[0] = k1s; kaug1[1] = k1s;
        }
    }
    LAS int* done = (LAS int*)(lds + LDS_KMT);
    bool wdone = false;
    if constexpr (!MOBA) { if (lane == 0) done[wid] = 0x7fffffff; }
    const lds_cptr vp0 = (lds_cptr)lds + LDS_V + ((lane >> 4) & 1) * 32 + (lane & 3) * 8 + (4 * hi + ((lane & 15) >> 2)) * 64;
    int slot = 0;
    for (int i = 0; i < NT; ++i) {
        const int t = NT - 1 - i;
        const int nslot = (slot == (NSLOT - 1) * SLOTB) ? 0 : slot + SLOTB;
        const int n2slot = (nslot == (NSLOT - 1) * SLOTB) ? 0 : nslot + SLOTB;
        if (i + 2 < NT) { ATT_DMA_KV(t - 2, n2slot); ATT_WAIT_BAR(4); } else if (i + 1 < NT) { ATT_WAIT_BAR(2); } else { ATT_WAIT_BAR(0); }
        if constexpr (!MOBA) {
            const int4v d0v = *(const LAS int4v*)(done), d1v = *(const LAS int4v*)(done + 4);
            int dm = max(max(max(d0v[0], d0v[1]), max(d0v[2], d0v[3])), max(max(d1v[0], d1v[1]), max(d1v[2], d1v[3])));
            dm = __builtin_amdgcn_readfirstlane(dm);
            if (dm < i) break;
        }
        if (t <= tdiag && !wdone) {
            f32x16 p0, p1;
            u32x4 pw0 = {0u, 0u, 0u, 0u}, pw1 = pw0, pw2 = pw0, pw3 = pw0; bool dead = false;
            if constexpr (!MOBA) {
                qkt(p0, p1, kp0 + slot, qr);
                s16x4 vlo[8], vhi[8]; vload16(vlo, vhi, vp0 + slot);
                float om[32];
#pragma unroll
                for (int r = 0; r < 16; r += 2) {
                    f32x2_t e0 = {__builtin_amdgcn_exp2f(p0[r]), __builtin_amdgcn_exp2f(p0[r + 1])}, e1 = {__builtin_amdgcn_exp2f(p1[r]), __builtin_amdgcn_exp2f(p1[r + 1])};
                    const f32x2_t one2 = {1.0f, 1.0f}; e0 = e0 + one2; e1 = e1 + one2;
                    om[r] = __builtin_amdgcn_rcpf(e0.x); om[r + 1] = __builtin_amdgcn_rcpf(e0.y); om[16 + r] = __builtin_amdgcn_rcpf(e1.x); om[16 + r + 1] = __builtin_amdgcn_rcpf(e1.y);
                }
                if (t == tdiag) {
                    const int kb = 64 * (t - 4 * qb) + 4 * hi;
#pragma unroll
                    for (int r = 0; r < 16; ++r) { const int kv = kb + (r & 3) + 8 * (r >> 2);
                        if (kv >= qrel) om[r] = 1.0f; if (kv + 32 >= qrel) om[16 + r] = 1.0f; }
                }
                float xin0[8], xin1[8], xin2[8], gp[8], OS[9];
#pragma unroll
                for (int j = 0; j < 8; ++j) { xin2[j] = om[4 * j + 3]; xin1[j] = xin2[j] * om[4 * j + 2]; xin0[j] = xin1[j] * om[4 * j + 1]; gp[j] = xin0[j] * om[4 * j]; }
                OS[8] = 1.0f;
#pragma unroll
                for (int j = 7; j >= 0; --j) OS[j] = gp[j] * OS[j + 1];
                float oth[8];
#pragma unroll
                for (int j = 0; j < 8; ++j) {
                    auto rr = __builtin_amdgcn_permlane32_swap(__builtin_bit_cast(unsigned, OS[j]), __builtin_bit_cast(unsigned, OS[j + 1]), false, false);
                    oth[j] = __builtin_bit_cast(float, hi ? rr[0] : rr[1]);
                }
                float tot = OS[0] * oth[0];
                { auto rr = __builtin_amdgcn_permlane32_swap(__builtin_bit_cast(unsigned, tot), __builtin_bit_cast(unsigned, tot), false, false); tot = hi ? __builtin_bit_cast(float, rr[0]) : tot; }
                float av[32];
#pragma unroll
                for (int j = 0; j < 8; ++j) { const float xc = carry * (OS[j + 1] * oth[j]); const f32x2_t xc2 = {xc, xc};
                    const f32x2_t dlo = {xin0[j] - gp[j], xin1[j] - xin0[j]}, dhi = {xin2[j] - xin1[j], 1.0f - xin2[j]};
                    const f32x2_t alo = dlo * xc2, ahi = dhi * xc2;
                    av[4 * j] = alo.x; av[4 * j + 1] = alo.y; av[4 * j + 2] = ahi.x; av[4 * j + 3] = ahi.y; }
                carry *= tot;
                if (__all(carry == 0.0f)) { wdone = true; if (lane == 0) done[wid] = i; }
                pw0 = (u32x4){cvtpk(av[0], av[1]), cvtpk(av[2], av[3]), cvtpk(av[4], av[5]), cvtpk(av[6], av[7])};
                pw1 = (u32x4){cvtpk(av[8], av[9]), cvtpk(av[10], av[11]), cvtpk(av[12], av[13]), cvtpk(av[14], av[15])};
                pw2 = (u32x4){cvtpk(av[16], av[17]), cvtpk(av[18], av[19]), cvtpk(av[20], av[21]), cvtpk(av[22], av[23])};
                pw3 = (u32x4){cvtpk(av[24], av[25]), cvtpk(av[26], av[27]), cvtpk(av[28], av[29]), cvtpk(av[30], av[31])};
                pv_r(o, vlo, vhi, __builtin_bit_cast(bf16x8, pw0), __builtin_bit_cast(bf16x8, pw1), __builtin_bit_cast(bf16x8, pw2), __builtin_bit_cast(bf16x8, pw3));
            } else {
                const int blk = t >> 2;
                const bool sel = (selmask >> blk) & 1u;
                const float nv = sel ? (sl2 * (float)(64 * t - q0) - mhat) : -INFINITY;
                f32x16 c;
#pragma unroll
                for (int r = 0; r < 16; ++r) c[r] = nv;
                qkt_aug(p0, p1, kp0 + slot, qr, c, kaug0, kaug1, qaug);
                s16x4 vlo[8], vhi[8]; vload16(vlo, vhi, vp0 + slot);
                if (t == tdiag) {
                    const int kb = 64 * (t - 4 * qb) + 4 * hi;
#pragma unroll
                    for (int r = 0; r < 16; ++r) { const int kv = kb + (r & 3) + 8 * (r >> 2);
                        if (kv > qrel) p0[r] = -INFINITY; if (kv + 32 > qrel) p1[r] = -INFINITY; }
                }
                float a0 = __builtin_fmaxf(__builtin_fmaxf(p0[0], p0[1]), p0[2]), a1 = __builtin_fmaxf(__builtin_fmaxf(p1[0], p1[1]), p1[2]);
#pragma unroll
                for (int r = 3; r < 15; r += 2) { a0 = __builtin_fmaxf(__builtin_fmaxf(a0, p0[r]), p0[r + 1]); a1 = __builtin_fmaxf(__builtin_fmaxf(a1, p1[r]), p1[r + 1]); }
                float rm = __builtin_fmaxf(__builtin_fmaxf(a0, p0[15]), __builtin_fmaxf(a1, p1[15]));
                rm = __builtin_fmaxf(rm, partner(rm, hi));
                dead = __all(rm < -160.0f);
                if (!dead && __any(rm > 8.0f)) {
                    const float dl = __builtin_fmaxf(rm, 0.f);
                    mhat += dl;
#pragma unroll
                    for (int r = 0; r < 16; ++r) { p0[r] -= dl; p1[r] -= dl; }
                    const float f = __builtin_amdgcn_exp2f(-dl);
                    lrow *= f;
                    if (hi == 0) wsf[r32] = f;
                    asm volatile("s_waitcnt lgkmcnt(0)" ::: "memory");
#pragma unroll
                    for (int g4 = 0; g4 < 4; ++g4) { const f32x4 fv = *(const LAS f32x4*)(wsf + 8 * g4 + 4 * hi);
#pragma unroll
                        for (int i2 = 0; i2 < 4; ++i2) { o[0][4 * g4 + i2] *= fv[i2]; o[1][4 * g4 + i2] *= fv[i2]; } }
                    asm volatile("s_waitcnt lgkmcnt(0)" ::: "memory");
                }
                if (!dead) {
                float rs = 0.f;
#pragma unroll
                for (int r = 0; r < 16; ++r) { p0[r] = __builtin_amdgcn_exp2f(p0[r]); p1[r] = __builtin_amdgcn_exp2f(p1[r]); rs += p0[r] + p1[r]; }
                lrow += rs;
                pw0 = (u32x4){cvtpk(p0[0], p0[1]), cvtpk(p0[2], p0[3]), cvtpk(p0[4], p0[5]), cvtpk(p0[6], p0[7])};
                pw1 = (u32x4){cvtpk(p0[8], p0[9]), cvtpk(p0[10], p0[11]), cvtpk(p0[12], p0[13]), cvtpk(p0[14], p0[15])};
                pw2 = (u32x4){cvtpk(p1[0], p1[1]), cvtpk(p1[2], p1[3]), cvtpk(p1[4], p1[5]), cvtpk(p1[6], p1[7])};
                pw3 = (u32x4){cvtpk(p1[8], p1[9]), cvtpk(p1[10], p1[11]), cvtpk(p1[12], p1[13]), cvtpk(p1[14], p1[15])};
                pv_r(o, vlo, vhi, __builtin_bit_cast(bf16x8, pw0), __builtin_bit_cast(bf16x8, pw1), __builtin_bit_cast(bf16x8, pw2), __builtin_bit_cast(bf16x8, pw3));
                }
            }
        }
        slot = nslot;
    }
    if constexpr (!MOBA) asm volatile("s_waitcnt vmcnt(0)" ::: "memory");
    float rli[16];
    if constexpr (MOBA) {
        const float lt = lrow + partner(lrow, hi);
        if (hi == 0) wsf[32 + r32] = lt;
        asm volatile("s_waitcnt lgkmcnt(0)" ::: "memory");
#pragma unroll
        for (int g4 = 0; g4 < 4; ++g4) { const f32x4 lv = *(const LAS f32x4*)(wsf + 32 + 8 * g4 + 4 * hi);
#pragma unroll
            for (int i2 = 0; i2 < 4; ++i2) rli[4 * g4 + i2] = __builtin_amdgcn_rcpf(lv[i2]); }
    } else {
#pragma unroll
        for (int r = 0; r < 16; ++r) rli[r] = 1.0f;
    }
    {
        LAS bf16_t* stg = (LAS bf16_t*)(lds + LDS_OST) + wid * 2048;
#pragma unroll
        for (int r = 0; r < 16; ++r) { const int orow = crow(r, hi);
#pragma unroll
            for (int d0 = 0; d0 < 2; ++d0) stg[orow * 64 + d0 * 32 + r32] = (bf16_t)(cvtpk(o[d0][r] * rli[r], 0.f) & 0xffffu); }
        asm volatile("s_waitcnt lgkmcnt(0)" ::: "memory");
        bf16_t* Ow = O + (rowbase + q0 + wid * 32) * OPITCH + h * 64;
#pragma unroll
        for (int i = 0; i < 4; ++i) { const int row = i * 8 + (lane >> 3), ch = lane & 7; const u32x4 v = *(const LAS u32x4*)(stg + row * 64 + ch * 8); *(u32x4*)(Ow + (long)row * OPITCH + ch * 8) = v; }
    }
    asm volatile("s_waitcnt lgkmcnt(0)\n\ts_barrier" ::: "memory");
#undef ATT_DMA_KV
}
#undef ATT_SBAR
#undef ATT_WAIT_BAR
}
namespace exa {
using bf16=unsigned short;
using bf16x8=__attribute__((ext_vector_type(8)))short;
using s16x4=__attribute__((ext_vector_type(4)))short;
using f32x16=__attribute__((ext_vector_type(16)))float;
using u32x4=__attribute__((ext_vector_type(4)))unsigned;
constexpr int SEQ=2048,D=64,DM=3072;
constexpr int NW=8,QBLK=32,QB=QBLK*NW,KVBLK=64;
__device__ __forceinline__ int crow(int r,int hi){return (r&3)+8*(r>>2)+4*hi;}
#define SBAR() __builtin_amdgcn_sched_barrier(0)
__device__ __forceinline__ void cmask(f32x16&p0,f32x16&p1,int jb,int qrel,int hi){
  const float NEG=-INFINITY; int kb=64*jb+4*hi;
  #pragma unroll
  for(int r=0;r<16;++r){int kv=kb+(r&3)+8*(r>>2); if(kv>qrel)p0[r]=NEG; if(kv+32>qrel)p1[r]=NEG;}
}
constexpr int NSLOT=3, SLOTB=8192;
constexpr int LDS_K=0, LDS_V=NSLOT*SLOTB, LDS_WS=2*NSLOT*SLOTB, LDS_OST=LDS_WS+NW*64*4, LDS_BYTES=LDS_OST+NW*4096;
__device__ __forceinline__ void glds16(const void*gsrc,unsigned lds_dst){unsigned keep;
  asm volatile("s_mov_b32 %0, m0\n\ts_mov_b32 m0, %2\n\ts_nop 0\n\tglobal_load_lds_dwordx4 %1, off\n\ts_mov_b32 m0, %0":"=&s"(keep):"v"(gsrc),"s"(lds_dst):"memory");}
__device__ __forceinline__ float max3f(float a,float b,float c){float r;asm("v_max3_f32 %0, %1, %2, %3":"=v"(r):"v"(a),"v"(b),"v"(c));return r;}
__device__ __forceinline__ float max2f(float a,float b){float r;asm("v_max_f32_e32 %0, %1, %2":"=v"(r):"v"(a),"v"(b));return r;}
__device__ __forceinline__ float fadd_s(float a,float b){float r;asm("v_add_f32_e32 %0, %1, %2":"=v"(r):"v"(a),"v"(b));return r;}
__device__ __forceinline__ float fsub_s(float a,float b){float r;asm("v_sub_f32_e32 %0, %1, %2":"=v"(r):"v"(a),"v"(b));return r;}
typedef float f32x2_t __attribute__((ext_vector_type(2))); typedef __bf16 bf16x2_t __attribute__((ext_vector_type(2)));
__device__ __forceinline__ unsigned cvtpk_s(float lo,float hi){f32x2_t v={lo,hi};bf16x2_t b=__builtin_convertvector(v,bf16x2_t);return __builtin_bit_cast(unsigned,b);}
#define WAIT_BAR(N) asm volatile("s_waitcnt vmcnt(" #N ") lgkmcnt(0)\n\ts_barrier":::"memory")
typedef LAS const char* lds_cptr;
__device__ __forceinline__ void qkt(f32x16&p0,f32x16&p1,lds_cptr Kslot,const bf16x8*qr,const f32x16&negm,int r32,int hi){
  const lds_cptr kb=Kslot+hi*1024+r32*16;
  #pragma unroll
  for(int d0=0;d0<4;++d0){
    const bf16x8 b0=*(const LAS bf16x8*)(kb+d0*2048);
    const bf16x8 b1=*(const LAS bf16x8*)(kb+d0*2048+512);
    if(d0==0){p0=__builtin_amdgcn_mfma_f32_32x32x16_bf16(b0,qr[0],negm,0,0,0);p1=__builtin_amdgcn_mfma_f32_32x32x16_bf16(b1,qr[0],negm,0,0,0);}
    else{p0=__builtin_amdgcn_mfma_f32_32x32x16_bf16(b0,qr[d0],p0,0,0,0);p1=__builtin_amdgcn_mfma_f32_32x32x16_bf16(b1,qr[d0],p1,0,0,0);}}
}
typedef short v4i16_t __attribute__((ext_vector_type(4)));
__device__ __forceinline__ void kload8(bf16x8*kf,lds_cptr kp){
  kf[0]=*(const LAS bf16x8*)(kp);      kf[1]=*(const LAS bf16x8*)(kp+512);
  kf[2]=*(const LAS bf16x8*)(kp+2048); kf[3]=*(const LAS bf16x8*)(kp+2560);
  kf[4]=*(const LAS bf16x8*)(kp+4096); kf[5]=*(const LAS bf16x8*)(kp+4608);
  kf[6]=*(const LAS bf16x8*)(kp+6144); kf[7]=*(const LAS bf16x8*)(kp+6656);
}
__device__ __forceinline__ void kload2(bf16x8*kf,lds_cptr kp,int j){ kf[2*j]=*(const LAS bf16x8*)(kp+j*2048); kf[2*j+1]=*(const LAS bf16x8*)(kp+j*2048+512); }
__device__ __forceinline__ s16x4 vtr(lds_cptr p){ return __builtin_bit_cast(s16x4,__builtin_amdgcn_ds_read_tr16_b64_v4i16((LAS v4i16_t*)p)); }
__device__ __forceinline__ float rowmax(const f32x16&p0,const f32x16&p1){
  float a=max3f(p0[0],p0[1],p1[0]),b=max3f(p0[2],p0[3],p1[1]);a=max3f(a,p1[2],p1[3]);
  #pragma unroll
  for(int r=4;r<16;r+=4){a=max3f(a,p0[r],p0[r+1]);b=max3f(b,p0[r+2],p0[r+3]);a=max3f(a,p1[r],p1[r+1]);b=max3f(b,p1[r+2],p1[r+3]);}
  const float m=max2f(a,b);
  auto rr=__builtin_amdgcn_permlane32_swap(__float_as_uint(m),__float_as_uint(m),false,false);
  return max2f(__uint_as_float(rr[0]),__uint_as_float(rr[1]));
}
__device__ __forceinline__ void pv(f32x16*o,int vb,bf16x8 pa0,bf16x8 pa1,bf16x8 pa2,bf16x8 pa3){
  #pragma unroll
  for(int d0=0;d0<2;++d0){s16x4 lo[4],hi[4];
    #pragma unroll
    for(int ks=0;ks<4;++ks){
      asm volatile("ds_read_b64_tr_b16 %0,%1 offset:%c2":"=&v"(lo[ks]):"v"(vb),"i"(d0*4096+ks*1024):"memory");
      asm volatile("ds_read_b64_tr_b16 %0,%1 offset:%c2":"=&v"(hi[ks]):"v"(vb),"i"(d0*4096+ks*1024+512):"memory");}
    asm volatile("s_waitcnt lgkmcnt(0)":::"memory");SBAR();
    #define PK(k) (bf16x8){lo[k][0],lo[k][1],lo[k][2],lo[k][3],hi[k][0],hi[k][1],hi[k][2],hi[k][3]}
    o[d0]=__builtin_amdgcn_mfma_f32_32x32x16_bf16(pa0,PK(0),o[d0],0,0,0);
    o[d0]=__builtin_amdgcn_mfma_f32_32x32x16_bf16(pa1,PK(1),o[d0],0,0,0);
    o[d0]=__builtin_amdgcn_mfma_f32_32x32x16_bf16(pa2,PK(2),o[d0],0,0,0);
    o[d0]=__builtin_amdgcn_mfma_f32_32x32x16_bf16(pa3,PK(3),o[d0],0,0,0);
    #undef PK
  }
}
template<int THRL> __device__ __forceinline__ void attn_unit(int b,int h,int qb,const bf16*QKV,bf16*O,LAS unsigned char*shm,const float*KMP=nullptr,const float sl2=0.f,const unsigned force_sel=0u){
  int tid=threadIdx.x; asm volatile("":"+v"(tid)); const int lane=tid&63,r32=lane&31,hi=lane>>5; const int wid=__builtin_amdgcn_readfirstlane(tid>>6);
  const long rowbase=(long)b*SEQ; const int q0=qb*QB;
  const bf16*Qw=QKV+(rowbase+q0+wid*QBLK)*DM+h*D;
  const bf16*Kh=QKV+rowbase*DM+1024+h*D,*Vh=QKV+rowbase*DM+2048+h*D;
  const unsigned lds0=(unsigned)(uintptr_t)shm;
  LAS float*wsf=(LAS float*)(shm+LDS_WS)+wid*64;
  const bf16*ksrc=Kh+(long)lane*DM+wid*8;
  const bf16*vsrc=Vh+(long)(16*(wid&3)+(lane>>2))*DM+(wid>>2)*32+(lane&3)*8;
  const unsigned kdst=lds0+LDS_K+wid*1024, vdst=lds0+LDS_V+wid*1024;
  #define DMA_K(t,slot) glds16(ksrc+(long)(t)*KVBLK*DM,(unsigned)__builtin_amdgcn_readfirstlane(kdst+(slot)))
  #define DMA_V(t,slot) glds16(vsrc+(long)(t)*KVBLK*DM,(unsigned)__builtin_amdgcn_readfirstlane(vdst+(slot)))
  const int vb0=(int)(lds0+LDS_V)+((lane>>4)&1)*32+(lane&3)*8+(4*hi+((lane&15)>>2))*64;
  bf16x8 kf[8];
  const lds_cptr shm3=(lds_cptr)shm; const lds_cptr kp0=shm3+LDS_K+hi*1024+r32*16; const lds_cptr vp0=shm3+LDS_V+((lane>>4)&1)*32+(lane&3)*8+(4*hi+((lane&15)>>2))*64;
  const int NT=(q0+QB)/KVBLK;
  DMA_K(0,0);DMA_V(0,0);DMA_K(1,SLOTB);DMA_K(2,2*SLOTB);
  bf16x8 qr[4];
  #pragma unroll
  for(int d0=0;d0<4;++d0)qr[d0]=*reinterpret_cast<const bf16x8*>(&Qw[(long)r32*DM+d0*16+hi*8]);
#if defined(EXA_G1)
  unsigned selmask=0u; bf16x8 kaug0={0,0,0,0,0,0,0,0},kaug1={0,0,0,0,0,0,0,0},qaug={0,0,0,0,0,0,0,0};
  { LAS float*kmt=(LAS float*)(shm+LDS_BYTES);
    { const int n=tid>>6,d=tid&63; if(n<qb){ const float*kp=KMP+((size_t)(b*8+n)*2)*1024+h*64+d; kmt[n*64+d]=(kp[0]+kp[1024])*(1.0f/256.0f);} }
    asm volatile("s_waitcnt lgkmcnt(0)\n\ts_barrier":::"memory");
    float gate[7];
    #pragma unroll
    for(int n=0;n<7;++n){ float g=-INFINITY; if(n<qb){ float s=0.f;
        #pragma unroll
        for(int d0=0;d0<4;++d0){ const att::f32x4 k0=*(const LAS att::f32x4*)(kmt+n*64+d0*16+hi*8),k1=*(const LAS att::f32x4*)(kmt+n*64+d0*16+hi*8+4);
          s+=att::bf2f(qr[d0][0])*k0[0]+att::bf2f(qr[d0][1])*k0[1]+att::bf2f(qr[d0][2])*k0[2]+att::bf2f(qr[d0][3])*k0[3]+att::bf2f(qr[d0][4])*k1[0]+att::bf2f(qr[d0][5])*k1[1]+att::bf2f(qr[d0][6])*k1[2]+att::bf2f(qr[d0][7])*k1[3]; }
        g=s+att::partner(s,hi);} gate[n]=g; }
    #pragma unroll
    for(int r=0;r<3;++r){ int best=-1; float bv=-INFINITY;
      #pragma unroll
      for(int n=0;n<7;++n){ const bool taken=(selmask>>n)&1u; if(!taken&&gate[n]>bv){best=n;bv=gate[n];} }
      if(best>=0)selmask|=1u<<best; }
    selmask|=(1u<<qb)|force_sel;
    if(hi==0){ const unsigned sh=__float_as_uint(sl2)+0x7fffu+((__float_as_uint(sl2)>>16)&1u),shb=sh>>16; const float rem=sl2-__uint_as_float(shb<<16); const unsigned sl=(__float_as_uint(rem)+0x7fffu+((__float_as_uint(rem)>>16)&1u))>>16;
      qaug[0]=(short)shb; qaug[1]=(short)sl; const short k0s=(short)(__float_as_uint((float)r32)>>16),k1s=(short)(__float_as_uint((float)(32+r32))>>16); kaug0[0]=k0s;kaug0[1]=k0s;kaug1[0]=k1s;kaug1[1]=k1s; } }
  asm volatile(""::"v"(selmask),"v"(kaug0),"v"(kaug1),"v"(qaug));
#endif
  float mhat=0.f,l_reg=0.f;f32x16 o[2];o[0]=f32x16{};o[1]=f32x16{};f32x16 negm=f32x16{};asm volatile("":"+v"(negm));
  const int qrel=wid*QBLK+r32;
  #define CMASK(P0,P1,t) do{int jb_=(t)-(NT-4); if(jb_>=0)cmask(P0,P1,jb_,qrel,hi);}while(0)
  bool resc=false;
  #define START(P0,P1) do{ const float rm=rowmax(P0,P1); resc=false; \
    { const float dl=rm; mhat=fadd_s(mhat,dl); \
      _Pragma("unroll") for(int r=0;r<16;++r){P0[r]=fsub_s(P0[r],dl);P1[r]=fsub_s(P1[r],dl);} \
      _Pragma("unroll") for(int r=0;r<16;++r)negm[r]=-mhat; asm volatile("":"+v"(negm)); } \
    _Pragma("unroll") for(int r=0;r<16;++r)P0[r]=__builtin_amdgcn_exp2f(P0[r]); }while(0)
  #define RESC() do{ if(resc){ asm volatile("s_waitcnt lgkmcnt(0)":::"memory"); \
      _Pragma("unroll") for(int d_=0;d_<2;++d_) _Pragma("unroll") for(int r=0;r<16;++r)o[d_][r]*=wsf[crow(r,hi)]; } }while(0)
#if defined(EXA_G3)
  const float boff=-sl2*(float)(q0+qrel);
  #define SETNEGM(t) do{ const float nv_=((selmask>>((t)>>2))&1u)?(sl2*(float)(64*(t))+boff-mhat):-INFINITY; _Pragma("unroll") for(int r=0;r<16;++r)negm[r]=nv_; asm volatile("":"+v"(negm)); }while(0)
  #define NEGMUPD() do{}while(0)
#else
  #define SETNEGM(t) do{}while(0)
  #define NEGMUPD() do{ _Pragma("unroll") for(int r=0;r<16;++r)negm[r]=-mhat; asm volatile("":"+v"(negm)); }while(0)
#endif
  f32x16 pA0,pA1,pB0,pB1;
  int sl_prev=0,sl_cur=0,sl_next=SLOTB;
  #define ROT() do{sl_prev=sl_cur;sl_cur=sl_next;sl_next=(sl_next==(NSLOT-1)*SLOTB)?0:sl_next+SLOTB;}while(0)
  WAIT_BAR(3);
  SETNEGM(0);
#if defined(EXA_G2)
  { f32x16 a0_=__builtin_amdgcn_mfma_f32_32x32x16_bf16(kaug0,qaug,negm,0,0,0), a1_=__builtin_amdgcn_mfma_f32_32x32x16_bf16(kaug1,qaug,negm,0,0,0); qkt(pA0,pA1,(lds_cptr)shm+LDS_K,qr,negm,r32,hi);
    (void)a0_; (void)a1_; }
  {
    const lds_cptr kb=(lds_cptr)shm+LDS_K+hi*1024+r32*16;
    pA0=__builtin_amdgcn_mfma_f32_32x32x16_bf16(kaug0,qaug,negm,0,0,0); pA1=__builtin_amdgcn_mfma_f32_32x32x16_bf16(kaug1,qaug,negm,0,0,0);
    #pragma unroll
    for(int d0=0;d0<4;++d0){ const bf16x8 b0=*(const LAS bf16x8*)(kb+d0*2048); const bf16x8 b1=*(const LAS bf16x8*)(kb+d0*2048+512);
      pA0=__builtin_amdgcn_mfma_f32_32x32x16_bf16(b0,qr[d0],pA0,0,0,0); pA1=__builtin_amdgcn_mfma_f32_32x32x16_bf16(b1,qr[d0],pA1,0,0,0); }
  }
#else
  qkt(pA0,pA1,(lds_cptr)shm+LDS_K,qr,negm,r32,hi);
#endif
  asm volatile("s_nop 15\n\ts_nop 7":"+v"(pA0),"+v"(pA1));CMASK(pA0,pA1,0);
#if defined(EXA_G3)
  { const float rm=rowmax(pA0,pA1); if(__builtin_expect(__any(rm>(float)THRL),0)){ const float dl=__builtin_fmaxf(rm,0.f); mhat+=dl;
      #pragma unroll
      for(int r=0;r<16;++r){pA0[r]-=dl;pA1[r]-=dl;} } }
  #pragma unroll
  for(int r=0;r<16;++r)pA0[r]=__builtin_amdgcn_exp2f(pA0[r]);
#else
  START(pA0,pA1);
#endif
  _Pragma("unroll") for(int r=0;r<16;++r)pA1[r]=__builtin_amdgcn_exp2f(pA1[r]);
  WAIT_BAR(0);
  DMA_K(3,0);DMA_V(1,SLOTB);
  ROT();
  kload8(kf,kp0+sl_cur);
  WAIT_BAR(2);
  s16x4 vlo[8],vhi[8]; u32x4 pw0,pw1,pw2,pw3;
  #define PKW(P,B) cvtpk_s(P[B],P[B+1])
  #define PAF(k) __builtin_bit_cast(bf16x8,pw##k)
  #define VFR(i) (bf16x8){vlo[i][0],vlo[i][1],vlo[i][2],vlo[i][3],vhi[i][0],vhi[i][1],vhi[i][2],vhi[i][3]}
  #define PIN(x) asm volatile("":"+v"(x))
  #define MX3(a,b,c) __builtin_fmaxf(__builtin_fmaxf((a),(b)),(c))
  #define GAPA(MF,A0,A1,A2,A3,W0,W1,PW) do{ MF; sacc+=A0; sacc+=A1; sacc+=A2; sacc+=A3; PIN(sacc); W0; W1; PIN(PW); SBAR(); }while(0)
  #define EX(v) __builtin_amdgcn_exp2f(v)
  #define GAPB(MF,X,B) do{ MF; X[B]=EX(X[B]); X[B+1]=EX(X[B+1]); X[B+2]=EX(X[B+2]); X[B+3]=EX(X[B+3]); PIN(X); SBAR(); }while(0)
  #define VRD(i) do{ vlo[i]=vtr(vp_+(((i)>>2)*4096+((i)&3)*1024)); vhi[i]=vtr(vp_+(((i)>>2)*4096+((i)&3)*1024+512)); }while(0)
  #define KRD(G,j) do{ if(G){ kload2(kf,kp0+sl_next,j); SBAR(); } }while(0)
#if defined(EXA_G2)
  #define EXA_AUG(C0,C1) do{ C0=__builtin_amdgcn_mfma_f32_32x32x16_bf16(kaug0,qaug,negm,0,0,0); C1=__builtin_amdgcn_mfma_f32_32x32x16_bf16(kaug1,qaug,negm,0,0,0); SBAR(); }while(0)
  #define EXA_C0IN(C) C
#else
  #define EXA_AUG(C0,C1) do{}while(0)
  #define EXA_C0IN(C) negm
#endif
  #define STEP(C0,C1,P0,P1,t,GK,GV,GL) do{ SBAR(); \
    const lds_cptr vp_=vp0+sl_prev; \
    EXA_AUG(C0,C1); \
    VRD(0); SBAR(); float sacc=(P0[0]+P0[1]); \
    GAPA(C0=__builtin_amdgcn_mfma_f32_32x32x16_bf16(kf[0],qr[0],EXA_C0IN(C0),0,0,0), P0[2],P0[3],P0[4],P0[5],     pw0[0]=PKW(P0,0), pw0[1]=PKW(P0,2), pw0); \
    VRD(4); SBAR(); GAPA(C1=__builtin_amdgcn_mfma_f32_32x32x16_bf16(kf[1],qr[0],EXA_C0IN(C1),0,0,0), P0[6],P0[7],P0[8],P0[9],     pw0[2]=PKW(P0,4), pw0[3]=PKW(P0,6), pw0); \
    VRD(1); SBAR(); GAPA(C0=__builtin_amdgcn_mfma_f32_32x32x16_bf16(kf[2],qr[1],C0,0,0,0),   P0[10],P0[11],P0[12],P0[13], pw1[0]=PKW(P0,8), pw1[1]=PKW(P0,10), pw1); \
    VRD(5); SBAR(); GAPA(C1=__builtin_amdgcn_mfma_f32_32x32x16_bf16(kf[3],qr[1],C1,0,0,0),   P0[14],P0[15],P1[0],P1[1],   pw1[2]=PKW(P0,12),pw1[3]=PKW(P0,14), pw1); \
    VRD(2); SBAR(); GAPA(C0=__builtin_amdgcn_mfma_f32_32x32x16_bf16(kf[4],qr[2],C0,0,0,0),   P1[2],P1[3],P1[4],P1[5],     pw2[0]=PKW(P1,0), pw2[1]=PKW(P1,2), pw2); \
    VRD(6); SBAR(); GAPA(C1=__builtin_amdgcn_mfma_f32_32x32x16_bf16(kf[5],qr[2],C1,0,0,0),   P1[6],P1[7],P1[8],P1[9],     pw2[2]=PKW(P1,4), pw2[3]=PKW(P1,6), pw2); \
    VRD(3); SBAR(); GAPA(C0=__builtin_amdgcn_mfma_f32_32x32x16_bf16(kf[6],qr[3],C0,0,0,0),   P1[10],P1[11],P1[12],P1[13], pw3[0]=PKW(P1,8), pw3[1]=PKW(P1,10), pw3); \
    VRD(7); SBAR(); GAPA(C1=__builtin_amdgcn_mfma_f32_32x32x16_bf16(kf[7],qr[3],C1,0,0,0),   P1[14],P1[15],0.f,0.f,       pw3[2]=PKW(P1,12),pw3[3]=PKW(P1,14), pw3); \
    l_reg+=sacc; \
    if(GK){DMA_K((t)+3,sl_cur);} if(GV){DMA_V((t)+1,sl_next);} \
    CMASK(C0,C1,t); \
    { float a=MX3(C0[0],C0[1],C1[0]),b=MX3(C0[2],C0[3],C1[1]); a=MX3(a,C1[2],C1[3]); \
      _Pragma("unroll") for(int r=4;r<16;r+=4){a=MX3(a,C0[r],C0[r+1]);b=MX3(b,C0[r+2],C0[r+3]);a=MX3(a,C1[r],C1[r+1]);b=MX3(b,C1[r+2],C1[r+3]);} \
      float rm=__builtin_fmaxf(a,b); { auto rr=__builtin_amdgcn_permlane32_swap(__float_as_uint(rm),__float_as_uint(rm),false,false); rm=__builtin_fmaxf(__uint_as_float(rr[0]),__uint_as_float(rr[1])); } \
      resc=false; \
      if(__builtin_expect(__any(rm>(float)THRL),0)){ const float dl=__builtin_fmaxf(rm,0.f); mhat+=dl; \
        _Pragma("unroll") for(int r=0;r<16;++r){C0[r]-=dl;C1[r]-=dl;} \
        NEGMUPD(); \
        const float f=__builtin_amdgcn_exp2f(-dl); l_reg*=f; if(hi==0)wsf[r32]=f; resc=true; } } \
    SBAR(); \
    GAPB(o[0]=__builtin_amdgcn_mfma_f32_32x32x16_bf16(PAF(0),VFR(0),o[0],0,0,0), C0,0); \
    GAPB(o[1]=__builtin_amdgcn_mfma_f32_32x32x16_bf16(PAF(0),VFR(4),o[1],0,0,0), C0,4); \
    KRD(GL,0); GAPB(o[0]=__builtin_amdgcn_mfma_f32_32x32x16_bf16(PAF(1),VFR(1),o[0],0,0,0), C0,8); \
    KRD(GL,1); GAPB(o[1]=__builtin_amdgcn_mfma_f32_32x32x16_bf16(PAF(1),VFR(5),o[1],0,0,0), C0,12); \
    KRD(GL,2); GAPB(o[0]=__builtin_amdgcn_mfma_f32_32x32x16_bf16(PAF(2),VFR(2),o[0],0,0,0), C1,0); \
    KRD(GL,3); GAPB(o[1]=__builtin_amdgcn_mfma_f32_32x32x16_bf16(PAF(2),VFR(6),o[1],0,0,0), C1,4); \
    GAPB(o[0]=__builtin_amdgcn_mfma_f32_32x32x16_bf16(PAF(3),VFR(3),o[0],0,0,0), C1,8); \
    GAPB(o[1]=__builtin_amdgcn_mfma_f32_32x32x16_bf16(PAF(3),VFR(7),o[1],0,0,0), C1,12); \
    }while(0)
  int t=1;
  #undef CMASK
  #define CMASK(P0,P1,t) do{}while(0)
  for(;t+5<NT;t+=2){
    SETNEGM(t); STEP(pB0,pB1,pA0,pA1,t,true,true,true);     WAIT_BAR(2); RESC(); ROT();
    SETNEGM(t+1); STEP(pA0,pA1,pB0,pB1,t+1,true,true,true);   WAIT_BAR(2); RESC(); ROT();
  }
  #undef CMASK
  #define CMASK(P0,P1,t) do{int jb_=(t)-(NT-4); if(jb_>=0)cmask(P0,P1,jb_,qrel,hi);}while(0)
  #define ENDW(tt) do{ if((tt)+3<NT){WAIT_BAR(2);} else if((tt)+2<NT){WAIT_BAR(1);} else {WAIT_BAR(0);} }while(0)
  for(;t+1<NT;t+=2){
    SETNEGM(t); STEP(pB0,pB1,pA0,pA1,t,(t+3<NT),(t+1<NT),(t+1<NT));       ENDW(t);   RESC(); ROT();
    SETNEGM(t+1); STEP(pA0,pA1,pB0,pB1,t+1,(t+4<NT),(t+2<NT),(t+2<NT));     ENDW(t+1); RESC(); ROT();
  }
  SETNEGM(NT-1); STEP(pB0,pB1,pA0,pA1,NT-1,false,false,false); RESC();
  { float sacc=pB0[0]+pB0[1]; _Pragma("unroll") for(int r=2;r<16;++r)sacc+=pB0[r]; _Pragma("unroll") for(int r=0;r<16;++r)sacc+=pB1[r]; l_reg+=sacc;
    pw0=(u32x4){PKW(pB0,0),PKW(pB0,2),PKW(pB0,4),PKW(pB0,6)};pw1=(u32x4){PKW(pB0,8),PKW(pB0,10),PKW(pB0,12),PKW(pB0,14)};pw2=(u32x4){PKW(pB1,0),PKW(pB1,2),PKW(pB1,4),PKW(pB1,6)};pw3=(u32x4){PKW(pB1,8),PKW(pB1,10),PKW(pB1,12),PKW(pB1,14)};
    SBAR(); pv(o,vb0+sl_cur,PAF(0),PAF(1),PAF(2),PAF(3)); }
  #undef PKW
  #undef PAF
  #undef VFR
  #undef PIN
  #undef MX3
  #undef GAPA
  #undef GAPB
  #undef EX
  #undef VRD
  #undef KRD
  #undef STEP
  #undef ENDW
  {auto rr=__builtin_amdgcn_permlane32_swap(__float_as_uint(l_reg),__float_as_uint(l_reg),false,false);l_reg=__uint_as_float(rr[0])+__uint_as_float(rr[1]);}
  if(hi==0)wsf[32+r32]=l_reg;asm volatile("s_waitcnt lgkmcnt(0)":::"memory");
  float rli[16];
  #pragma unroll
  for(int r=0;r<16;++r)rli[r]=__builtin_amdgcn_rcpf(wsf[32+crow(r,hi)]);
  bf16*Ow=O+(rowbase+q0+wid*QBLK)*1024+h*D;
  { LAS bf16*stg=(LAS bf16*)(shm+LDS_OST)+wid*2048;
    #pragma unroll
    for(int r=0;r<16;++r){const int orow=crow(r,hi);
      #pragma unroll
      for(int d0=0;d0<2;++d0)stg[orow*64+d0*32+r32]=(bf16)(cvtpk_s(o[d0][r]*rli[r],0.f)&0xffffu);}
    asm volatile("s_waitcnt lgkmcnt(0)":::"memory");
    #pragma unroll
    for(int i=0;i<4;++i){const int row=i*8+(lane>>3),ch=lane&7; const u32x4 v=*(const LAS u32x4*)(stg+row*64+ch*8); *(u32x4*)(Ow+(long)row*1024+ch*8)=v;} }
  asm volatile("s_waitcnt lgkmcnt(0)\n\ts_barrier":::"memory");
  #undef DMA_K
  #undef DMA_V
  #undef CMASK
  #undef START
  #undef RESC
  #undef ROT
}

#undef SBAR
#undef WAIT_BAR
}
#define XB_TMO      128
#define XB_XCNT(j)  (256  + 64 * (j))
#define XB_XSUB(j)  (1280 + 64 * (j))
#define XB_XGEN(j)  (2304 + 64 * (j))
#define XB_TOP      3328
#define XB_TOPGEN   3392
#define XCD_BAR_WORDS 3456
#define XB_SPIN_CAP (1u << 18)

__device__ __forceinline__ unsigned xb_ld(unsigned* p)              { return __hip_atomic_load(p, __ATOMIC_RELAXED, __HIP_MEMORY_SCOPE_AGENT); }
__device__ __forceinline__ unsigned xb_add(unsigned* p, unsigned v) { return __hip_atomic_fetch_add(p, v, __ATOMIC_RELAXED, __HIP_MEMORY_SCOPE_AGENT); }
__device__ __forceinline__ unsigned xb_xcc_id() { return (unsigned)__builtin_amdgcn_s_getreg((3 << 11) | 20) & 0xFu; }
#define XB_SPIN(cond, bar) do { unsigned _sp = 0; while (cond) { __builtin_amdgcn_s_sleep(1); \
    if ((++_sp & 255u) == 0u) { if (xb_ld(&(bar)[XB_TMO])) break; if (_sp > XB_SPIN_CAP) { atomicAdd(&(bar)[XB_TMO], 1u); break; } } } } while (0)

struct XcdBarrier {
    unsigned* bar; unsigned x;
    volatile LAS unsigned* st;
};

__device__ __forceinline__ XcdBarrier xcd_barrier_post(unsigned* bar, volatile LAS unsigned* st) {
    XcdBarrier b; b.bar = bar; b.x = xb_xcc_id(); b.st = st;
    if (threadIdx.x == 0) (void)xb_add(&bar[XB_XCNT(b.x)], 1u);
    return b;
}
__device__ __forceinline__ void xcd_barrier_complete(unsigned* bar, unsigned x, unsigned& nloc, unsigned& nx) {
    const unsigned G = gridDim.x * gridDim.y * gridDim.z;
    unsigned sum, cnt, mine, sp = 0u;
    for (;;) {
        sum = 0u; cnt = 0u; mine = 0u;
#pragma unroll
        for (unsigned j = 0; j < 16; ++j) { const unsigned c = xb_ld(&bar[XB_XCNT(j)]); sum += c; cnt += (c > 0u) ? 1u : 0u; mine = (j == x) ? c : mine; }
        if (sum == G) break;
        __builtin_amdgcn_s_sleep(1);
        if ((++sp & 255u) == 0u) { if (xb_ld(&bar[XB_TMO])) break; if (sp > XB_SPIN_CAP) { atomicAdd(&bar[XB_TMO], 1u); break; } }
    }
    nloc = mine > 0u ? mine : 1u; nx = cnt > 0u ? cnt : 1u;
}

__device__ __forceinline__ void xcd_barrier(const XcdBarrier& b) {
    asm volatile("s_waitcnt vmcnt(0)" ::: "memory");
    __syncthreads();
    if (threadIdx.x == 0) {
        unsigned* bar = b.bar;
        __builtin_amdgcn_s_waitcnt(0);
        unsigned nloc = b.st[0], nx = b.st[1];
        if (nloc == 0u) { xcd_barrier_complete(bar, b.x, nloc, nx); b.st[0] = nloc; b.st[1] = nx; }
        const unsigned old = xb_add(&bar[XB_XSUB(b.x)], 1u);
        const unsigned gen = old / nloc;
        if (old + 1u == (gen + 1u) * nloc) {
            __builtin_amdgcn_fence(__ATOMIC_RELEASE, "agent");
            asm volatile("s_waitcnt vmcnt(0)" ::: "memory");
            const unsigned og = xb_add(&bar[XB_TOP], 1u);
            const unsigned tg = og / nx;
            if (og + 1u == (tg + 1u) * nx) xb_add(&bar[XB_TOPGEN], 1u);
            else XB_SPIN(xb_ld(&bar[XB_TOPGEN]) == tg, bar);
            __builtin_amdgcn_fence(__ATOMIC_ACQUIRE, "agent");
            xb_add(&bar[XB_XGEN(b.x)], 1u);
            asm volatile("s_waitcnt vmcnt(0)" ::: "memory");
        } else {
            XB_SPIN(xb_ld(&bar[XB_XGEN(b.x)]) == gen, bar);
            __builtin_amdgcn_fence(__ATOMIC_ACQUIRE, "agent");
            asm volatile("s_waitcnt vmcnt(0)" ::: "memory");
        }
    }
    __syncthreads();
}

__device__ __forceinline__ void xcd_local_barrier(unsigned* lb, unsigned* gbar, unsigned x, unsigned nloc) {
    asm volatile("s_waitcnt vmcnt(0)" ::: "memory");
    __syncthreads();
    if (threadIdx.x == 0) {
        __builtin_amdgcn_s_waitcnt(0);
        const unsigned old = xb_add(&lb[64 * x], 1u);
        const unsigned gen = old / nloc;
        if (old + 1u == (gen + 1u) * nloc) xb_add(&lb[1024 + 64 * x], 1u);
        else XB_SPIN(xb_ld(&lb[1024 + 64 * x]) == gen, gbar);
        __builtin_amdgcn_fence(__ATOMIC_ACQUIRE, "agent");
        asm volatile("s_waitcnt vmcnt(0)" ::: "memory");
    }
    __syncthreads();
}
#ifndef DBG_MASK
#define DBG_MASK 255
#endif
#ifndef GEMM_XDMA
#define GEMM_XDMA false
#endif
#ifndef GU_ALIGN
#define GU_ALIGN true
#endif
#ifndef DUP_MASK
#define DUP_MASK 0
#endif
#define NREP(bit) ((DUP_MASK & (bit)) ? 2 : 1)
constexpr int NWAVES = 8;
constexpr int NBATCH = 8, SEQ = 2048, D = 1024, FF = 2816, M = NBATCH * SEQ, DEPTH = 4;
constexpr int N_PHASES = 2 + 7 * DEPTH;
constexpr float QSCALE = 0.125f * 1.4426950408889634f;
typedef unsigned short bf16;
typedef float f32x4 __attribute__((ext_vector_type(4)));
typedef unsigned v4u __attribute__((ext_vector_type(4)));
typedef GAS unsigned gu32;
#define RLX_AGENT __ATOMIC_RELAXED, __HIP_MEMORY_SCOPE_AGENT
constexpr size_t MiB = 1u << 20;
constexpr size_t WS_CTL = 0, CTL_ZERO_BYTES = 1 * MiB;
constexpr size_t WS_WGU = 1 * MiB;
constexpr size_t WS_WD = 89 * MiB;
constexpr size_t WS_WIN_E = 133 * MiB;
constexpr size_t WS_WOUT_E = 141 * MiB;
constexpr size_t WS_WQKV_O = 145 * MiB;
constexpr size_t WS_WO_O = 157 * MiB;
constexpr size_t WS_XB = 161 * MiB;
constexpr size_t WS_SS = 193 * MiB;
constexpr size_t WS_KMP = 194 * MiB;
constexpr size_t WS_QKV = 195 * MiB;
constexpr size_t WS_O = 291 * MiB;
constexpr size_t WS_END = 323 * MiB;
constexpr size_t WGU_BYTES = (size_t)2 * FF * D * 2, WD_BYTES = (size_t)D * FF * 2;
static_assert(WS_WGU + 8 * WGU_BYTES <= WS_WD && WS_WD + 8 * WD_BYTES <= WS_WIN_E && WS_QKV + (size_t)M * 3072 * 2 <= WS_O && WS_O + (size_t)M * D * 2 <= WS_END, "d_ws map");
constexpr int CW_BAR = 4096;
constexpr int CW_LBAR = 16384, CW_TICKET = 20480;
#ifndef LOCAL_BARRIERS
#define LOCAL_BARRIERS 1
#endif
constexpr int RING_OFF = 0, RING_BYTES = 131072;
constexpr int P0_TS = 65, P0_SCR_BYTES = 64 * P0_TS * 4;
constexpr int LDSCTL_OFF = pg8::HM_STAGE_BYTES, MISC_OFF = LDSCTL_OFF + 320;
constexpr int LDS_BYTES = LDSCTL_OFF + 1024;
static_assert(att::LDS_END <= RING_BYTES && exa::LDS_BYTES + 2048 <= RING_BYTES && MISC_OFF + 128 <= LDS_BYTES && 8 * P0_SCR_BYTES <= LDSCTL_OFF && LDS_BYTES <= 160 * 1024, "LDS map");

__device__ __forceinline__ unsigned f2bf(float f) { unsigned u = __builtin_bit_cast(unsigned, f); return (u + 0x7fffu + ((u >> 16) & 1u)) >> 16; }
__device__ __forceinline__ unsigned pk2(float lo, float hi) { return att::cvtpk(lo, hi); }
__device__ __forceinline__ float wave_sum(float v) {
#pragma unroll
    for (int o = 1; o < 64; o <<= 1) v += __shfl_xor(v, o);
    return v;
}
#define LDS_WAIT() asm volatile("s_waitcnt lgkmcnt(0)" ::: "memory")
#define VM_WAIT() asm volatile("s_waitcnt vmcnt(0)" ::: "memory")

__device__ __forceinline__ void p0_write_tile(bf16* WT, int K, int dst_row0, int k0, LAS float* scr, int lane) {
    LDS_WAIT(); asm volatile("" ::: "memory");
    const int c = lane & 7, nn = lane >> 3;
#pragma unroll
    for (int j = 0; j < 8; ++j) { const int n = nn + 8 * j; const LAS float* s = scr + (8 * c) * P0_TS + n;
        v4u o; o.x = pk2(s[0 * P0_TS], s[1 * P0_TS]); o.y = pk2(s[2 * P0_TS], s[3 * P0_TS]); o.z = pk2(s[4 * P0_TS], s[5 * P0_TS]); o.w = pk2(s[6 * P0_TS], s[7 * P0_TS]);
        *(GAS v4u*)(WT + (size_t)(dst_row0 + n) * K + k0 + 8 * c) = o; }
    LDS_WAIT(); asm volatile("" ::: "memory");
}
#if defined(P0_NT)
#define P0_LOADW(p) __builtin_nontemporal_load(p)
#else
#define P0_LOADW(p) (*(p))
#endif
struct P0Item { const float* W; const float* gain; bf16* WT; int ldw, K, dst_row0, k0, n0; };
__device__ __forceinline__ void p0_item_load(const P0Item& d, f32x4 (&v)[16], float (&g)[16], int lane) {
    const int q = lane >> 4, p = lane & 15;
#pragma unroll
    for (int i = 0; i < 16; ++i) { v[i] = P0_LOADW((const GAS f32x4*)(d.W + (size_t)(d.k0 + 4 * i + q) * d.ldw + d.n0 + 4 * p)); g[i] = d.gain ? d.gain[d.k0 + 4 * i + q] : 1.0f; }
}
__device__ __forceinline__ void p0_item_finish(const P0Item& d, const f32x4 (&v)[16], const float (&g)[16], LAS float* scr, int lane) {
    const int q = lane >> 4, p = lane & 15;
#pragma unroll
    for (int i = 0; i < 16; ++i) { LAS float* dd = scr + (4 * i + q) * P0_TS + 4 * p; dd[0] = v[i][0] * g[i]; dd[1] = v[i][1] * g[i]; dd[2] = v[i][2] * g[i]; dd[3] = v[i][3] * g[i]; }
    p0_write_tile(d.WT, d.K, d.dst_row0, d.k0, scr, lane);
}
typedef const float __attribute__((address_space(4))) cfloat_t;
__device__ __forceinline__ void p0_fold_sub(const float* Win  , const float* Wp  , const float* pscale  , const float* gain, bf16* WT, int k0, int n0, int lane) {
    const int g = n0 >> 7, d = (n0 & 127) + lane;
    const float* wpb = Wp + (size_t)g * 128 * 128 + d;
    cfloat_t* wrow = (cfloat_t*)(Win + (size_t)k0 * 2048 + 1536 + g * 128);
    cfloat_t* gk = (cfloat_t*)(gain + k0);
    float acc[8];
#pragma unroll
    for (int k = 0; k < 8; ++k) acc[k] = 0.f;
#pragma unroll 1
    for (int c0 = 0; c0 < 128; c0 += 32) {
        float wp[32];
#pragma unroll
        for (int c = 0; c < 32; ++c) wp[c] = wpb[(size_t)(c0 + c) * 128];
#pragma unroll
        for (int k = 0; k < 8; ++k)
#pragma unroll
            for (int c = 0; c < 32; ++c) acc[k] = __builtin_fmaf(wrow[(size_t)k * 2048 + c0 + c], wp[c], acc[k]);
    }
    const float ps = pscale[g * 128 + d];
    v4u o; o.x = pk2(acc[0] * ps * gk[0], acc[1] * ps * gk[1]); o.y = pk2(acc[2] * ps * gk[2], acc[3] * ps * gk[3]); o.z = pk2(acc[4] * ps * gk[4], acc[5] * ps * gk[5]); o.w = pk2(acc[6] * ps * gk[6], acc[7] * ps * gk[7]);
    *(GAS v4u*)(WT + (size_t)(1536 + n0 + lane) * 1024 + k0) = o;
}

struct Args { const float* in[17]; float* out; unsigned char* ws; int ph_lo, ph_hi; };

__device__ __forceinline__ void p0_prologue(const Args& a, unsigned char* ws, LAS unsigned char* lds, int vcu, int G, int wave, int lane) {
    LAS float* scr = (LAS float*)(lds + wave * P0_SCR_BYTES);
    const int gw = vcu * NWAVES + wave, NGW = G * NWAVES;
    constexpr int I_GU = 16 * 44, I_DN = 44 * 16, I_EIN = 16 * 24, I_EFO = 16 * 8, I_SQ = 16 * 16, I_OQKV = 16 * 48;
    constexpr int S_G = 0, S_U = S_G + 8 * I_GU, S_D = S_U + 8 * I_GU, S_EIN = S_D + 8 * I_DN, S_EOUT = S_EIN + 2 * I_EIN, S_OQKV = S_EOUT + 2 * I_SQ, S_OO = S_OQKV + 2 * I_OQKV, NITEMS = S_OO + 2 * I_SQ;
    auto decode = [&](int it) -> P0Item {
        P0Item d;
        if (it < S_D) {
            const bool up = it >= S_U; const int r0 = it - (up ? S_U : S_G), f = r0 / I_GU, r = r0 % I_GU, layer = f >> 1, half = f & 1, kb = r / 44, nb = r % 44, n0 = 64 * nb;
            d.W = a.in[half ? (up ? 8 : 7) : (up ? 3 : 2)] + (size_t)layer * D * FF; d.gain = a.in[half ? 6 : 1] + layer * D; d.WT = (bf16*)(ws + WS_WGU + (size_t)f * WGU_BYTES);
            d.ldw = FF; d.K = D; d.dst_row0 = (n0 >> 7) * 256 + (up ? 128 : 0) + (n0 & 127); d.k0 = 64 * kb; d.n0 = n0;
        } else if (it < S_EIN) {
            const int r0 = it - S_D, f = r0 / I_DN, r = r0 % I_DN, layer = f >> 1, half = f & 1, kb = r / 16, nb = r % 16;
            d.W = a.in[half ? 9 : 4] + (size_t)layer * FF * D; d.gain = nullptr; d.WT = (bf16*)(ws + WS_WD + (size_t)f * WD_BYTES); d.ldw = D; d.K = FF; d.dst_row0 = 64 * nb; d.k0 = 64 * kb; d.n0 = 64 * nb;
        } else if (it < S_EOUT) {
            const int r0 = it - S_EIN, i = r0 / I_EIN, r = r0 % I_EIN, kb = r / 24, nb = r % 24;
            d.W = a.in[10] + (size_t)i * D * 2048; d.gain = a.in[5] + (2 * i) * D; d.WT = (bf16*)(ws + WS_WIN_E + (size_t)i * 2048 * D * 2); d.ldw = 2048; d.K = D; d.dst_row0 = 64 * nb; d.k0 = 64 * kb; d.n0 = 64 * nb;
        } else if (it < S_OQKV) {
            const int r0 = it - S_EOUT, i = r0 / I_SQ, r = r0 % I_SQ, kb = r / 16, nb = r % 16;
            d.W = a.in[13] + (size_t)i * D * D; d.gain = nullptr; d.WT = (bf16*)(ws + WS_WOUT_E + (size_t)i * D * D * 2); d.ldw = D; d.K = D; d.dst_row0 = 64 * nb; d.k0 = 64 * kb; d.n0 = 64 * nb;
        } else if (it < S_OO) {
            const int r0 = it - S_OQKV, i = r0 / I_OQKV, r = r0 % I_OQKV, kb = r / 48, nb = r % 48;
            d.W = a.in[14] + (size_t)i * D * 3072; d.gain = a.in[5] + (2 * i + 1) * D; d.WT = (bf16*)(ws + WS_WQKV_O + (size_t)i * 3072 * D * 2); d.ldw = 3072; d.K = D; d.dst_row0 = 64 * nb; d.k0 = 64 * kb; d.n0 = 64 * nb;
        } else {
            const int r0 = it - S_OO, i = r0 / I_SQ, r = r0 % I_SQ, kb = r / 16, nb = r % 16;
            d.W = a.in[15] + (size_t)i * D * D; d.gain = nullptr; d.WT = (bf16*)(ws + WS_WO_O + (size_t)i * D * D * 2); d.ldw = D; d.K = D; d.dst_row0 = 64 * nb; d.k0 = 64 * kb; d.n0 = 64 * nb;
        }
        return d;
    };
    if (gw < NITEMS) {
        P0Item cur = decode(gw); f32x4 v[16]; float g[16];
        p0_item_load(cur, v, g, lane);
        for (int it = gw; it < NITEMS; it += NGW) {
            const bool more = it + NGW < NITEMS;
            P0Item nxt = cur; f32x4 v2[16]; float g2[16];
            if (more) { nxt = decode(it + NGW); p0_item_load(nxt, v2, g2, lane); }
            p0_item_finish(cur, v, g, scr, lane);
            if (more) { cur = nxt;
#pragma unroll
                for (int i = 0; i < 16; ++i) { v[i] = v2[i]; g[i] = g2[i]; } }
        }
    }
#if defined(P0_FOLD_DUP)
    for (int rep_ = 0; rep_ < P0_FOLD_DUP; ++rep_)
#endif
    for (int s0 = gw; s0 < 2 * 128 * 8; s0 += NGW) {
        const int i = s0 >> 10, r = s0 & 1023, kb = r >> 3, nb = r & 7;
        p0_fold_sub(a.in[10] + (size_t)i * D * 2048, a.in[11] + (size_t)i * 4 * 128 * 128, a.in[12] + i * 512, a.in[5] + (2 * i) * D, (bf16*)(ws + WS_WIN_E + (size_t)i * 2048 * D * 2), 8 * kb, 64 * nb, lane);
    }
    const float* x = a.in[0]; bf16* XB = (bf16*)(ws + WS_XB); float* SS = (float*)(ws + WS_SS);
#if defined(P0_XB_DUP)
    for (int rep_ = 0; rep_ < P0_XB_DUP; ++rep_)
#endif
    {
        f32x4 v[4];
        if (gw < M) { const GAS f32x4* xr = (const GAS f32x4*)(x + (size_t)gw * D) + lane;
#pragma unroll
            for (int j = 0; j < 4; ++j) v[j] = xr[64 * j]; }
        for (int m = gw; m < M; m += NGW) {
            f32x4 vn[4];
            if (m + NGW < M) { const GAS f32x4* xr = (const GAS f32x4*)(x + (size_t)(m + NGW) * D) + lane;
#pragma unroll
                for (int j = 0; j < 4; ++j) vn[j] = xr[64 * j]; }
            float s = 0.f;
#pragma unroll
            for (int j = 0; j < 4; ++j) s += (v[j].x * v[j].x + v[j].y * v[j].y) + (v[j].z * v[j].z + v[j].w * v[j].w);
            s = wave_sum(s);
            GAS unsigned long long* o8 = (GAS unsigned long long*)(XB + (size_t)m * D) + lane;
#pragma unroll
            for (int j = 0; j < 4; ++j) o8[64 * j] = (unsigned long long)pk2(v[j].x, v[j].y) | ((unsigned long long)pk2(v[j].z, v[j].w) << 32);
            if (lane < 16) SS[(size_t)m * 16 + lane] = (lane == 0) ? s : 0.f;
            if (m + NGW < M) {
#pragma unroll
                for (int j = 0; j < 4; ++j) v[j] = vn[j]; }
        }
    }
}
__device__ __forceinline__ void pool_rows(const bf16* QKV, bf16* O, int vcu, int G, int tid) {
    asm volatile("" : "+v"(tid));
    const int cc = tid & 63, rg = tid >> 6, g = cc >> 4, w = 2 << g;
    for (int R0 = vcu * 64; R0 < M; R0 += G * 64) {
#pragma unroll 1
        for (int rr = 0; rr < 8; ++rr) {
            const int row = R0 + rg * 8 + rr, t = row & (SEQ - 1);
            const int cnt = (t + 1) < w ? (t + 1) : w;
            float s[8];
#pragma unroll
            for (int e = 0; e < 8; ++e) s[e] = 0.f;
            v4u cur = {0u, 0u, 0u, 0u};
            for (int i = 0; i < cnt; ++i) {
                const v4u v = *(const v4u*)(QKV + (size_t)(row - i) * 2048 + 1536 + cc * 8);
                if (i == 0) cur = v;
                s[0] += __builtin_bit_cast(float, v.x << 16); s[1] += __builtin_bit_cast(float, v.x & 0xffff0000u);
                s[2] += __builtin_bit_cast(float, v.y << 16); s[3] += __builtin_bit_cast(float, v.y & 0xffff0000u);
                s[4] += __builtin_bit_cast(float, v.z << 16); s[5] += __builtin_bit_cast(float, v.z & 0xffff0000u);
                s[6] += __builtin_bit_cast(float, v.w << 16); s[7] += __builtin_bit_cast(float, v.w & 0xffff0000u);
            }
            const float rc = 1.0f / (float)cnt;
            v4u o;
            o.x = pk2(s[0] * rc - __builtin_bit_cast(float, cur.x << 16), s[1] * rc - __builtin_bit_cast(float, cur.x & 0xffff0000u));
            o.y = pk2(s[2] * rc - __builtin_bit_cast(float, cur.y << 16), s[3] * rc - __builtin_bit_cast(float, cur.y & 0xffff0000u));
            o.z = pk2(s[4] * rc - __builtin_bit_cast(float, cur.z << 16), s[5] * rc - __builtin_bit_cast(float, cur.z & 0xffff0000u));
            o.w = pk2(s[6] * rc - __builtin_bit_cast(float, cur.w << 16), s[7] * rc - __builtin_bit_cast(float, cur.w & 0xffff0000u));
            *(v4u*)(O + (size_t)row * 1024 + 512 + cc * 8) = o;
        }
    }
}
__device__ __forceinline__ void final_norm(const bf16* XBs, float* out, const float* SS, const float* gfin, int vcu, int G, int wave, int lane) {
    const int gw = vcu * NWAVES + wave, NGW = G * NWAVES;
    f32x4 gv[2][2];
#pragma unroll
    for (int j = 0; j < 2; ++j) { gv[j][0] = *(const f32x4*)(gfin + 512 * j + 8 * lane); gv[j][1] = *(const f32x4*)(gfin + 512 * j + 8 * lane + 4); }
    for (int m0 = gw * 8; m0 < M; m0 += NGW * 8) for (int m = m0; m < m0 + 8; ++m) {
        float s = (lane < 16) ? SS[(size_t)m * 16 + lane] : 0.f;
        s = wave_sum(s);
        const float r = 1.0f / sqrtf(s * (1.0f / D) + 1e-6f);
#pragma unroll
        for (int j = 0; j < 2; ++j) {
            const v4u b = *(const GAS v4u*)(XBs + (size_t)m * D + 512 * j + 8 * lane);
            const f32x4 x0 = {__builtin_bit_cast(float, b.x << 16), __builtin_bit_cast(float, b.x & 0xffff0000u), __builtin_bit_cast(float, b.y << 16), __builtin_bit_cast(float, b.y & 0xffff0000u)};
            const f32x4 x1 = {__builtin_bit_cast(float, b.z << 16), __builtin_bit_cast(float, b.z & 0xffff0000u), __builtin_bit_cast(float, b.w << 16), __builtin_bit_cast(float, b.w & 0xffff0000u)};
            GAS f32x4* o = (GAS f32x4*)(out + (size_t)m * D + 512 * j + 8 * lane);
            o[0] = x0 * r * gv[j][0]; o[1] = x1 * r * gv[j][1];
        }
    }
}

#if defined(CMP_PROBE)
__device__ __forceinline__ void cmp_unit(const bf16* A, const bf16* B, int b, int h, int qb, int cls, gu32* word, int tid) {
    asm volatile("" : "+v"(tid));
    __threadfence(); __syncthreads();
    unsigned bucket = 0u;
    if (tid < 256) {
        float se = 0.f, sx = 0.f;
        for (int c = 0; c < 64; ++c) { const size_t idx = ((size_t)b * SEQ + qb * 256 + tid) * 1024 + h * 64 + c;
            const float x = __builtin_bit_cast(float, (unsigned)A[idx] << 16), y = __builtin_bit_cast(float, (unsigned)B[idx] << 16);
            se += (x - y) * (x - y); sx += x * x; }
        const float rel = sqrtf(se / (sx + 1e-12f));
#if defined(CMP_BUCKETS)
        if (rel > 0.02f) bucket |= 4u; if (rel > 0.05f) bucket |= 8u; if (rel > 0.15f) bucket |= 16u; if (rel > 0.5f) bucket |= 32u; if (rel > 1.5f) bucket |= 64u; if (!(rel == rel)) bucket |= 128u;
#else
        if (!(rel <= CMP_RTOL)) bucket |= 1u << cls;
#endif
    }
    if (bucket) __hip_atomic_fetch_or(word, bucket, __ATOMIC_RELAXED, __HIP_MEMORY_SCOPE_AGENT);
    __syncthreads();
}
#endif
__global__ void __launch_bounds__(NWAVES * 64, 2) mk_fwd(Args args) {
    extern __shared__ __attribute__((aligned(16))) unsigned char lds_raw[];
    LAS unsigned char* lds = (LAS unsigned char*)lds_raw;
    volatile LAS unsigned* MISC = (volatile LAS unsigned*)(lds + MISC_OFF);
    const int tid = threadIdx.x, lane = tid & 63, wave = __builtin_amdgcn_readfirstlane(tid >> 6);
    const int G = gridDim.x; int bx = blockIdx.x; int vcu = (G % 8 == 0) ? (bx % 8) * (G / 8) + bx / 8 : bx;
    unsigned char* ws = args.ws;
    gu32* ctl = (gu32*)(ws + WS_CTL);
    for (int u = tid; u < (LDS_BYTES - LDSCTL_OFF) / 4; u += NWAVES * 64) ((LAS unsigned*)(lds + LDSCTL_OFF))[u] = 0u;
    __syncthreads();
    XcdBarrier bar; bar.bar = (unsigned*)(ctl + CW_BAR); bar.x = 0; bar.st = nullptr;
    if (MK_N_LAUNCHES == 1) bar = xcd_barrier_post((unsigned*)(ctl + CW_BAR), MISC + 8);
    if (LOCAL_BARRIERS && MK_N_LAUNCHES == 1 && tid == 0) MISC[12] = xb_add((unsigned*)(ctl + CW_TICKET) + 64 * bar.x, 1u);
    const int lo = args.ph_lo, hi = args.ph_hi;
#define IN(k) (lo <= (k) && (k) < hi)
#if defined(BAR_DUP)
#define SEAM(k) do { if (IN(k) && IN((k) + 1)) { xcd_barrier(bar); xcd_barrier(bar); } } while (0)
#else
#define SEAM(k) do { if (IN(k) && IN((k) + 1)) { if (local_mode) xcd_local_barrier((unsigned*)(ctl + CW_LBAR), bar.bar, bar.x, 32u); else xcd_barrier(bar); } PT_STAMP(k); } while (0)
#endif
#if defined(PT_MASK)
    unsigned long long pt_acc = 0, pt_last = __builtin_amdgcn_s_memrealtime();
#define PT_CLASS(k) ((k) == 0 ? 1 : (k) == N_PHASES - 1 ? 128 : (k) == 7 * DEPTH ? 256 : (((k) - 1) % 7 == 0 || ((k) - 1) % 7 == 5) ? 2 : (((k) - 1) % 7 == 1 || ((k) - 1) % 7 == 6) ? 4 : ((k) - 1) % 7 == 2 ? 8 : ((k) - 1) % 7 == 3 ? ((((k) - 1) / 7) & 1 ? 32 : 16) : 64)
#define PT_STAMP(k) do { const unsigned long long t_ = __builtin_amdgcn_s_memrealtime(); if (PT_CLASS(k) & (PT_MASK)) pt_acc += t_ - pt_last; pt_last = t_; } while (0)
#else
#define PT_STAMP(k) do {} while (0)
#endif

    bf16* XB = (bf16*)(ws + WS_XB); float* SS = (float*)(ws + WS_SS); float* KMP = (float*)(ws + WS_KMP);
    bf16* QKV = (bf16*)(ws + WS_QKV); bf16* HB = (bf16*)(ws + WS_QKV); bf16* OB = (bf16*)(ws + WS_O);

    bool local_mode = false;
#if defined(P0_TIME_PROBE)
    const unsigned long long p0_t0 = __builtin_amdgcn_s_memrealtime();
#endif
    if ((DBG_MASK & 1) && IN(0)) { for (int rep = 0; rep < NREP(1); ++rep) { p0_prologue(args, ws, lds, vcu, G, wave, lane); __syncthreads(); } }
    SEAM(0);
#if defined(P0_TIME_PROBE)
    const unsigned long long p0_dt = __builtin_amdgcn_s_memrealtime() - p0_t0;
#endif
#if LOCAL_BARRIERS
    if (MK_N_LAUNCHES == 1 && G == 256 && IN(0) && IN(1)) {
        if (tid == 0) { unsigned ok = 1u;
#pragma unroll
            for (unsigned j = 0; j < 16; ++j) { const unsigned c = xb_ld(bar.bar + XB_XCNT(j)); ok &= (j < 8u) ? (c == 32u ? 1u : 0u) : (c == 0u ? 1u : 0u); }
            MISC[13] = (ok && MISC[12] < 32u && bar.x < 8u) ? 1u : 0u; }
        __syncthreads();
        local_mode = __builtin_amdgcn_readfirstlane(MISC[13]) != 0u;
        if (local_mode) { const int rank = __builtin_amdgcn_readfirstlane(MISC[12]); bx = rank * 8 + (int)bar.x; vcu = (int)bar.x * 32 + rank; }
    }
#endif

    for (int layer = 0; layer < DEPTH; ++layer) {
        const int pb = 1 + 7 * layer;
        for (int half = 0; half < 2; ++half) {
            const int f = layer * 2 + half, pg = pb + (half ? 5 : 0);
            if ((DBG_MASK & 2) && IN(pg)) for (int rep = 0; rep < NREP(2); ++rep) {
                pg8::Gemm g{XB, (const bf16*)(ws + WS_WGU + (size_t)f * WGU_BYTES), M, 2 * FF, D}; pg8::StaticOrder S; S.init(M, 2 * FF, G, bx);
#if defined(GU_PROBE_VARIANT)
#if defined(GU_KPROBE)
                if (rep == 1) { pg8::EpiGUProbe<GU_KPROBE> E{}; E.H = HB; E.SS = SS; pg8::gemm_phase<pg8::EpiGUProbe<GU_KPROBE>, pg8::StaticOrder, true, true, GEMM_XDMA>(lds + RING_OFF, g, S, E); } else
#else
                if (rep == 1) { pg8::EpiGU_<GU_PROBE_VARIANT> E{HB, SS}; pg8::gemm_phase<pg8::EpiGU_<GU_PROBE_VARIANT>, pg8::StaticOrder, true, true, GEMM_XDMA>(lds + RING_OFF, g, S, E); } else
#endif
#endif
                { pg8::EpiGU E{HB, SS};
                const int fullr = S.nwg / G, rem = S.nwg - fullr * G; const bool hm = (2 * rem == G) && (G % 16 == 0);
                if (hm) S.maxr = fullr;
                pg8::gemm_phase<pg8::EpiGU, pg8::StaticOrder, GU_ALIGN, true, GEMM_XDMA>(lds + RING_OFF, g, S, E);
                if (hm) { const int j = bx >> 3; pg8::Unit uu; S.unit_of((long)fullr * G + (bx & 7) + 8 * (j >> 1), uu); const pg8::HUnit hu{uu.pm * 2 + (j & 1), uu.pn};
                    pg8::gemm_half_unit<pg8::EpiGU>(lds + RING_OFF, g, hu, E);
#if defined(HM_DUP)
                    __syncthreads(); pg8::gemm_half_unit<pg8::EpiGU>(lds + RING_OFF, g, hu, E);
#endif
                    } }
            }
            SEAM(pg);
            if ((DBG_MASK & 4) && IN(pg + 1)) for (int rep = 0; rep < NREP(4); ++rep) {
                pg8::Gemm g{HB, (const bf16*)(ws + WS_WD + (size_t)f * WD_BYTES), M, D, FF}; pg8::StaticOrder S; S.init(M, D, G, bx);
#if defined(DOWN_NOOP_PROBE)
                if (rep == 1) { pg8::EpiResNoop E; pg8::gemm_phase<pg8::EpiResNoop, pg8::StaticOrder, true, true, GEMM_XDMA>(lds + RING_OFF, g, S, E); } else {
#endif
                pg8::EpiRes E{XB, SS, rep ? 0.0f : 0.5f};
                pg8::gemm_phase<pg8::EpiRes, pg8::StaticOrder, true, true, GEMM_XDMA>(lds + RING_OFF, g, S, E);
#if defined(DOWN_NOOP_PROBE)
                }
#endif
            }
            SEAM(pg + 1);
            if (half == 0) {
                const int i2 = layer >> 1; const bool odd = layer & 1;
                if ((DBG_MASK & 8) && IN(pb + 2)) for (int rep = 0; rep < NREP(8); ++rep) {
                    const int N = odd ? 3072 : 2048;
                    pg8::Gemm g{XB, (const bf16*)(ws + (odd ? WS_WQKV_O + (size_t)i2 * 3072 * D * 2 : WS_WIN_E + (size_t)i2 * 2048 * D * 2)), M, N, D}; pg8::StaticOrder S; S.init(M, N, G, bx);
                    pg8::EpiQKV E{QKV, N, SS, odd ? 4 : 2, QSCALE, odd ? KMP : nullptr, 4, 8};
                    pg8::gemm_phase<pg8::EpiQKV, pg8::StaticOrder, true, true, GEMM_XDMA>(lds + RING_OFF, g, S, E);
                }
                SEAM(pb + 2);
                if (IN(pb + 3)) {
                    if ((DBG_MASK & 16) && !odd) for (int rep = 0; rep < NREP(16); ++rep) {
                        for (int ui = vcu; ui < 512; ui += G) {
                            const int bh = (ui & 255) >> 2, s = ui & 3, qb = (ui >> 8) ? 7 - s : s;
                            att::attn_unit<false>(bh >> 3, bh & 7, qb, QKV, 2048, 512, 1024, OB, lds + RING_OFF, nullptr, 0.f);
                        }
                        pool_rows(QKV, OB, vcu, G, tid);
                    } else if (DBG_MASK & 32) for (int rep = 0; rep < NREP(32); ++rep) {
                        for (int ui = vcu; ui < 1024; ui += G) {
                            const int bh = (ui & 255) >> 1, j = ui & 1, k = ui >> 8;
                            const int qb = (k == 0) ? (j ? 6 : 7) : (k == 1) ? (j ? 5 : 4) : (k == 2) ? (j ? 2 : 3) : (j ? 1 : 0);
                            const int h = bh & 15;
                            const float sl2 = exp2f(-0.5f * (float)(h + 1)) * 1.4426950408889634f;
#if defined(CMP_PROBE)
                            att::attn_unit<true>(bh >> 4, h, qb, QKV, 3072, 1024, 2048, OB, lds + RING_OFF, KMP, sl2);
                            if ((bh >> 4) < 4) {
                                att::attn_unit<true>(bh >> 4, h, qb, QKV, 3072, 1024, 2048, (bf16*)(ws + WS_END), lds + RING_OFF, KMP, CMP_SL2, CMP_FORCE);
#if defined(CMP_EXA)
                                exa::attn_unit<8>(bh >> 4, h, qb, QKV, (bf16*)(ws + WS_END + 16 * MiB), lds + RING_OFF, KMP, CMP_SL2, CMP_FORCE);
#else
                                exa::attn_unit<8>(bh >> 4, h, qb, QKV, (bf16*)(ws + WS_END + 16 * MiB), lds + RING_OFF, KMP, CMP_SL2, CMP_FORCE);
#endif
                                cmp_unit((const bf16*)(ws + WS_END), (const bf16*)(ws + WS_END + 16 * MiB), bh >> 4, h, qb, CMP_PROBE, ctl + 2048, tid); }
#elif defined(MOBA_OLD)
                            att::attn_unit<true>(bh >> 4, h, qb, QKV, 3072, 1024, 2048, OB, lds + RING_OFF, KMP, sl2);
#else
#if defined(UNIT_OVH_PROBE)
                            if (rep == 1) exa::attn_unit<8>(bh >> 4, h, 0, QKV, (bf16*)(ws + WS_END), lds + RING_OFF, KMP, sl2, 0u); else
#endif
                            exa::attn_unit<8>(bh >> 4, h, qb, QKV, OB, lds + RING_OFF, KMP, sl2, 0u);
#endif
                        }
                    }
                }
                SEAM(pb + 3);
                if ((DBG_MASK & 64) && IN(pb + 4)) for (int rep = 0; rep < NREP(64); ++rep) {
                    pg8::Gemm g{OB, (const bf16*)(ws + (odd ? WS_WO_O : WS_WOUT_E) + (size_t)i2 * D * D * 2), M, D, D}; pg8::StaticOrder S; S.init(M, D, G, bx);
                    pg8::EpiRes E{XB, SS, rep ? 0.0f : 1.0f};
                    pg8::gemm_phase<pg8::EpiRes, pg8::StaticOrder, true, true, GEMM_XDMA>(lds + RING_OFF, g, S, E);
                }
                SEAM(pb + 4);
            }
        }
    }
    if ((DBG_MASK & 128) && IN(N_PHASES - 1)) final_norm(XB, args.out, SS, args.in[16], vcu, G, wave, lane);
#if defined(PT_MASK)
    __syncthreads(); PT_STAMP(N_PHASES - 1);
    if (blockIdx.x == 0 && tid == 0) { const unsigned long long t0 = __builtin_amdgcn_s_memrealtime(), dt = pt_acc * (unsigned long long)(PT_MUL);
        while (__builtin_amdgcn_s_memrealtime() - t0 < dt) __builtin_amdgcn_s_sleep(8); }
#endif
#if defined(P0_TIME_PROBE)
    if (blockIdx.x == 0 && tid == 0) { const unsigned long long t0 = __builtin_amdgcn_s_memrealtime(), dt = p0_dt * (unsigned long long)(P0_TIME_PROBE);
        while (__builtin_amdgcn_s_memrealtime() - t0 < dt) __builtin_amdgcn_s_sleep(8); }
#endif
#if defined(CMP_PROBE)
    xcd_barrier(bar);
    if (blockIdx.x == 0 && tid == 0) { const unsigned w = __hip_atomic_load(ctl + 2048, RLX_AGENT); const unsigned long long t0 = __builtin_amdgcn_s_memrealtime(), dt = (unsigned long long)w * 10000ull;
        while (__builtin_amdgcn_s_memrealtime() - t0 < dt) __builtin_amdgcn_s_sleep(8); }
#endif
#undef IN
#undef SEAM
}

extern "C" void kernel_launch(void* const* d_in, const int* in_sizes, int n_in, void* d_out, int out_size, void* d_ws, size_t ws_size, hipStream_t stream) {
    static int grid = 0;
    if (grid == 0) {
        if (n_in != 17 || in_sizes[0] != M * D || out_size != M * D || ws_size < WS_END) { fprintf(stderr, "kernel_launch: unexpected shapes (n_in %d, in0 %d, out %d, ws %zu); nothing launched\n", n_in, n_in > 0 ? in_sizes[0] : -1, out_size, ws_size); grid = -1; return; }
        int dev = 0, cus = 0, per_cu = 0;
        if (hipGetDevice(&dev) != hipSuccess || hipDeviceGetAttribute(&cus, hipDeviceAttributeMultiprocessorCount, dev) != hipSuccess) { grid = -1; return; }
        if (hipFuncSetAttribute((const void*)mk_fwd, hipFuncAttributeMaxDynamicSharedMemorySize, LDS_BYTES) != hipSuccess) { fprintf(stderr, "kernel_launch: hipFuncSetAttribute failed\n"); grid = -1; return; }
        if (hipOccupancyMaxActiveBlocksPerMultiprocessor(&per_cu, (const void*)mk_fwd, NWAVES * 64, LDS_BYTES) != hipSuccess || per_cu < 1)
            fprintf(stderr, "kernel_launch: note: occupancy query reports %d workgroups per CU\n", per_cu);
        (void)hipGetLastError();
        grid = cus;
    }
    if (grid < 0) return;
    if (hipMemsetAsync((char*)d_ws + WS_CTL, 0, CTL_ZERO_BYTES, stream) != hipSuccess) return;
    Args a{};
    for (int i = 0; i < 17; ++i) a.in[i] = (const float*)d_in[i];
    a.out = (float*)d_out; a.ws = (unsigned char*)d_ws;
#if MK_N_LAUNCHES == 1
    a.ph_lo = 0; a.ph_hi = N_PHASES;
    hipLaunchKernelGGL(mk_fwd, dim3(grid), dim3(NWAVES * 64), LDS_BYTES, stream, a);
#else
    for (int p = 0; p < N_PHASES; ++p) { a.ph_lo = p; a.ph_hi = p + 1; hipLaunchKernelGGL(mk_fwd, dim3(grid), dim3(NWAVES * 64), LDS_BYTES, stream, a); }
#endif
}
```

```cpp
#include <hip/hip_runtime.h>
#include <cstdio>
#include <cstdint>
#define LAS __attribute__((address_space(3)))
#define GAS __attribute__((address_space(1)))
#ifndef MK_N_LAUNCHES
#define MK_N_LAUNCHES 1
#endif
#define P0_NT 1
#define EXA_G1 1
#define EXA_G2 1
#define EXA_G3 1
namespace pg8 {
#define PG8_LAS __attribute__((address_space(3)))
typedef unsigned short bf16_t;
typedef short bf16x8 __attribute__((ext_vector_type(8)));
typedef float f32x4 __attribute__((ext_vector_type(4)));
typedef unsigned u32x4 __attribute__((ext_vector_type(4)));
constexpr int BM = 256, BK = 64, HALF = 128, HTB = HALF * BK * 2  , STAGE_BYTES = 8 * HTB, NXCD = 8, WGM = 8;

__host__ __device__ __forceinline__ int lds_byte(int r, int c) { const int st = (r >> 4) * 2 + (c >> 5), rr = r & 15, cc = c & 31, ob = rr * 64 + cc * 2; return st * 1024 + (ob ^ (((ob >> 9) & 1) << 5)); }
__host__ __device__ __forceinline__ void stage_rc(int b, int& R, int& C) { const int st = b / 1024, sb = b % 1024, swz = sb ^ (((sb >> 9) & 1) << 5); R = (st >> 1) * 16 + swz / 64; C = (st & 1) * 32 + (swz % 64) / 2; }
__host__ __device__ __forceinline__ int perm32(int rho) { const int n = rho >> 4, i = rho & 15; return 8 * (i >> 2) + 4 * n + (i & 3); }

struct Unit { int pm, pn; };
struct HUnit { int pm2, pn; };
struct Gemm { const bf16_t* A; const bf16_t* Bt; int M, N, K; int lda = 0; };

struct StaticOrder {
    int nM, nN, nwg, G, c, maxr;
    __host__ __device__ void init(int M, int N, int G_, int c_) { nM = M / BM; nN = N / BM; nwg = nM * nN; G = G_; c = c_; maxr = 1 << 30; }
    __host__ __device__ bool next(int i, Unit& u) const {
        const long L = (long)i * G + c; if (L >= nwg || i >= maxr) return false;
        unit_of(L, u); return true;
    }
    __host__ __device__ void unit_of(long L, Unit& u) const {
        int wgid = (int)L; { const int q = nwg / NXCD, r = nwg % NXCD, xcd = wgid % NXCD, off = wgid / NXCD; wgid = (xcd < r ? xcd * (q + 1) : r * (q + 1) + (xcd - r) * q) + off; }
        const int nig = WGM * nN, gid = wgid / nig, fm = gid * WGM, gsz = (nM - fm) < WGM ? (nM - fm) : WGM;
        u.pm = fm + ((wgid % nig) % gsz); u.pn = (wgid % nig) / gsz;
    }
    __device__ __forceinline__ void a_ready(const Unit&) const {}
    __device__ __forceinline__ void done(const Unit&) const {}
};

__device__ __forceinline__ unsigned cvt_pk_bf16(float lo, float hi) { unsigned r; asm volatile("v_cvt_pk_bf16_f32 %0, %1, %2" : "=v"(r) : "v"(lo), "v"(hi)); return r; }
typedef float f32x2 __attribute__((ext_vector_type(2)));
__device__ __forceinline__ float row_rstd(const float* SS, int row, int fq) {
    const f32x4 v = *(const f32x4*)(SS + (size_t)row * 16 + 4 * fq);
    float s = (v[0] + v[1]) + (v[2] + v[3]);
    s += __shfl_xor(s, 16); s += __shfl_xor(s, 32);
    return __builtin_amdgcn_rsqf(s * (1.0f / 1024.0f) + 1e-6f);
}
__device__ __forceinline__ void row_rstd8(const float* SS, int row0, int fq, float (&r8)[8]) {
    f32x4 sv[8];
#pragma unroll
    for (int k = 0; k < 8; ++k) sv[k] = *(const f32x4*)(SS + (size_t)(row0 + (k >> 2) * HALF + (k & 3) * 16) * 16 + 4 * fq);
#pragma unroll
    for (int k = 0; k < 8; ++k) { float s = (sv[k][0] + sv[k][1]) + (sv[k][2] + sv[k][3]); s += __shfl_xor(s, 16); s += __shfl_xor(s, 32); r8[k] = __builtin_amdgcn_rsqf(s * (1.0f / 1024.0f) + 1e-6f); }
}
__device__ __forceinline__ void row_rstd8v(const float* SS, int row0, int fq, float (&r8)[8], float (&v8)[8]) {
    f32x4 sv[8];
#pragma unroll
    for (int k = 0; k < 8; ++k) sv[k] = *(const f32x4*)(SS + (size_t)(row0 + (k >> 2) * HALF + (k & 3) * 16) * 16 + 4 * fq);
#pragma unroll
    for (int k = 0; k < 8; ++k) { float s = (sv[k][0] + sv[k][1]) + (sv[k][2] + sv[k][3]); s += __shfl_xor(s, 16); s += __shfl_xor(s, 32); v8[k] = s * (1.0f / 1024.0f) + 1e-6f; r8[k] = __builtin_amdgcn_rsqf(v8[k]); }
}
constexpr int HPITCH = 3072;
template <int VARIANT = 0> struct EpiGU_ {
    static constexpr bool PERM = true, AFTER_DRAIN = false;
    bf16_t* H; const float* SS;
    __device__ __forceinline__ void gu_row(const f32x4 (&ga)[2], const f32x4 (&ua)[2], float r, float v, bf16_t* dst) const {
        const float rn = r * -1.4426950408889634f;
        const f32x2 rn2 = {rn, rn}, v2 = {v, v};
        f32x2 t[4], p[4];
#pragma unroll
        for (int k = 0; k < 4; ++k) { const f32x2 g = {ga[k >> 1][2 * (k & 1)], ga[k >> 1][2 * (k & 1) + 1]}, uu = {ua[k >> 1][2 * (k & 1)], ua[k >> 1][2 * (k & 1) + 1]};
            t[k] = g * rn2; p[k] = g * uu; }
#pragma unroll
        for (int k = 0; k < 4; ++k) { t[k].x = __builtin_amdgcn_exp2f(t[k].x); t[k].y = __builtin_amdgcn_exp2f(t[k].y); }
#pragma unroll
        for (int k = 0; k < 4; ++k) t[k] = __builtin_elementwise_fma(t[k], v2, v2);
#pragma unroll
        for (int k = 0; k < 4; ++k) { t[k].x = __builtin_amdgcn_rcpf(t[k].x); t[k].y = __builtin_amdgcn_rcpf(t[k].y); }
#pragma unroll
        for (int k = 0; k < 4; ++k) p[k] = p[k] * t[k];
        u32x4 w; w.x = cvt_pk_bf16(p[0].x, p[0].y); w.y = cvt_pk_bf16(p[1].x, p[1].y); w.z = cvt_pk_bf16(p[2].x, p[2].y); w.w = cvt_pk_bf16(p[3].x, p[3].y);
        if (VARIANT == 2) { asm volatile("" :: "v"(w)); } else *(u32x4*)dst = w;
    }
    __device__ __forceinline__ void half(const f32x4 (&acc)[2][4][2], const HUnit& u, int wr, int wc, int fr, int fq) const {
        const int row0 = u.pm2 * HALF + wr * 64 + fr, col0 = u.pn * 128 + wc * 32 + 8 * fq;
        f32x4 sv[4];
#pragma unroll
        for (int k = 0; k < 4; ++k) sv[k] = *(const f32x4*)(SS + (size_t)(row0 + k * 16) * 16 + 4 * fq);
#pragma unroll
        for (int m = 0; m < 4; ++m) { float s = (sv[m][0] + sv[m][1]) + (sv[m][2] + sv[m][3]); s += __shfl_xor(s, 16); s += __shfl_xor(s, 32); const float v = s * (1.0f / 1024.0f) + 1e-6f;
            gu_row(acc[0][m], acc[1][m], __builtin_amdgcn_rsqf(v), v, H + (size_t)(row0 + m * 16) * HPITCH + col0); }
    }
    __device__ __forceinline__ void operator()(const f32x4 (&acc)[2][2][4][2], const Unit& u, int wr, int wc, int fr, int fq) const {
        if (VARIANT == 1) {
#pragma unroll
            for (int ai = 0; ai < 2; ++ai)
#pragma unroll
                for (int bj = 0; bj < 2; ++bj)
                    asm volatile("" :: "v"(acc[ai][bj][0][0]), "v"(acc[ai][bj][0][1]), "v"(acc[ai][bj][1][0]), "v"(acc[ai][bj][1][1]), "v"(acc[ai][bj][2][0]), "v"(acc[ai][bj][2][1]), "v"(acc[ai][bj][3][0]), "v"(acc[ai][bj][3][1]));
            return; }
        const int row0 = u.pm * BM + wr * 64 + fr, col0 = u.pn * 128 + wc * 32 + 8 * fq;
        float r8[8], v8[8]; row_rstd8v(SS, row0, fq, r8, v8);
#pragma unroll
        for (int ai = 0; ai < 2; ++ai)
#pragma unroll
            for (int m = 0; m < 4; ++m) {
                gu_row(acc[ai][0][m], acc[ai][1][m], r8[ai * 4 + m], v8[ai * 4 + m], H + (size_t)(row0 + ai * HALF + m * 16) * HPITCH + col0);
            }
    }
};
typedef EpiGU_<0> EpiGU;
template <int KP> struct EpiGUProbe : EpiGU_<1> { static constexpr int KPROBE = KP; };
struct EpiRes {
    static constexpr bool PERM = true, AFTER_DRAIN = false;
    bf16_t* XB; float* SS; float alpha;
    __device__ __forceinline__ void operator()(const f32x4 (&acc)[2][2][4][2], const Unit& u, int wr, int wc, int fr, int fq) const {
        const int row0 = u.pm * BM + wr * 64 + fr, col0 = u.pn * BM + wc * 32 + 8 * fq;
#pragma unroll
        for (int ai = 0; ai < 2; ++ai) {
            u32x4 bv[4][2];
#pragma unroll
            for (int m = 0; m < 4; ++m)
#pragma unroll
                for (int bj = 0; bj < 2; ++bj) bv[m][bj] = *(const u32x4*)(XB + (size_t)(row0 + ai * HALF + m * 16) * 1024 + col0 + bj * HALF);
#pragma unroll
            for (int m = 0; m < 4; ++m) {
                const int row = row0 + ai * HALF + m * 16; const size_t off = (size_t)row * 1024 + col0;
                float s = 0.f;
#pragma unroll
                for (int bj = 0; bj < 2; ++bj) {
                    const u32x4 b = bv[m][bj];
                    const f32x4 b0 = {__builtin_bit_cast(float, b.x << 16), __builtin_bit_cast(float, b.x & 0xffff0000u), __builtin_bit_cast(float, b.y << 16), __builtin_bit_cast(float, b.y & 0xffff0000u)};
                    const f32x4 b1 = {__builtin_bit_cast(float, b.z << 16), __builtin_bit_cast(float, b.z & 0xffff0000u), __builtin_bit_cast(float, b.w << 16), __builtin_bit_cast(float, b.w & 0xffff0000u)};
                    const f32x4 v0 = b0 + acc[ai][bj][m][0] * alpha, v1 = b1 + acc[ai][bj][m][1] * alpha;
                    u32x4 w; w.x = cvt_pk_bf16(v0[0], v0[1]); w.y = cvt_pk_bf16(v0[2], v0[3]); w.z = cvt_pk_bf16(v1[0], v1[1]); w.w = cvt_pk_bf16(v1[2], v1[3]);
                    *(u32x4*)(XB + off + bj * HALF) = w;
                    const float r0 = __builtin_bit_cast(float, w.x << 16), r1 = __builtin_bit_cast(float, w.x & 0xffff0000u), r2 = __builtin_bit_cast(float, w.y << 16), r3 = __builtin_bit_cast(float, w.y & 0xffff0000u);
                    const float r4 = __builtin_bit_cast(float, w.z << 16), r5 = __builtin_bit_cast(float, w.z & 0xffff0000u), r6 = __builtin_bit_cast(float, w.w << 16), r7 = __builtin_bit_cast(float, w.w & 0xffff0000u);
                    s += (r0 * r0 + r1 * r1) + (r2 * r2 + r3 * r3) + (r4 * r4 + r5 * r5) + (r6 * r6 + r7 * r7);
                }
                s += __shfl_xor(s, 16); s += __shfl_xor(s, 32);
                if (fq == 0) SS[(size_t)row * 16 + u.pn * 4 + wc] = s;
            }
        }
    }
};
struct EpiResNoop {
    static constexpr bool PERM = true, AFTER_DRAIN = false;
    __device__ __forceinline__ void operator()(const f32x4 (&acc)[2][2][4][2], const Unit&, int, int, int, int) const {
#pragma unroll
        for (int ai = 0; ai < 2; ++ai)
#pragma unroll
            for (int bj = 0; bj < 2; ++bj)
                asm volatile("" :: "v"(acc[ai][bj][0][0]), "v"(acc[ai][bj][0][1]), "v"(acc[ai][bj][1][0]), "v"(acc[ai][bj][1][1]), "v"(acc[ai][bj][2][0]), "v"(acc[ai][bj][2][1]), "v"(acc[ai][bj][3][0]), "v"(acc[ai][bj][3][1]));
    }
};
struct EpiQKV {
    static constexpr bool PERM = true, AFTER_DRAIN = false;
    bf16_t* O; int ldc; const float* SS; int nq_tiles; float qscale; float* KMP; int k_lo, k_hi;
    __device__ __forceinline__ void operator()(const f32x4 (&acc)[2][2][4][2], const Unit& u, int wr, int wc, int fr, int fq) const {
        const int row0 = u.pm * BM + wr * 64 + fr, col0 = u.pn * BM + wc * 32 + 8 * fq;
        const float sc = (u.pn < nq_tiles) ? qscale : 1.0f;
        float r8[8]; row_rstd8(SS, row0, fq, r8);
#pragma unroll
        for (int ai = 0; ai < 2; ++ai)
#pragma unroll
            for (int m = 0; m < 4; ++m) {
                const int row = row0 + ai * HALF + m * 16;
                const float r = r8[ai * 4 + m] * sc;
                bf16_t* rowp = O + (size_t)row * ldc + col0;
#pragma unroll
                for (int bj = 0; bj < 2; ++bj) {
                    const f32x4 v0 = acc[ai][bj][m][0] * r, v1 = acc[ai][bj][m][1] * r;
                    u32x4 w; w.x = cvt_pk_bf16(v0[0], v0[1]); w.y = cvt_pk_bf16(v0[2], v0[3]); w.z = cvt_pk_bf16(v1[0], v1[1]); w.w = cvt_pk_bf16(v1[2], v1[3]);
                    *(u32x4*)(rowp + bj * HALF) = w;
                }
            }
        if (KMP != nullptr && u.pn >= k_lo && u.pn < k_hi) {
            float* dst = KMP + ((size_t)u.pm * 2 + wr) * 1024 + (u.pn - k_lo) * BM + wc * 32 + 8 * fq;
#pragma unroll
            for (int bj = 0; bj < 2; ++bj)
#pragma unroll
                for (int n = 0; n < 2; ++n) {
                    f32x4 cs = {0.f, 0.f, 0.f, 0.f};
#pragma unroll
                    for (int ai = 0; ai < 2; ++ai)
#pragma unroll
                        for (int m = 0; m < 4; ++m) cs += acc[ai][bj][m][n] * r8[ai * 4 + m];
#pragma unroll
                    for (int i = 0; i < 4; ++i) { float c = cs[i]; c += __shfl_xor(c, 1); c += __shfl_xor(c, 2); c += __shfl_xor(c, 4); c += __shfl_xor(c, 8); cs[i] = c; }
                    if (fr == 0) *(f32x4*)(dst + bj * HALF + 4 * n) = cs;
                }
        }
    }
};
#ifndef PG8_PRIO_MMA
#define PG8_PRIO_MMA 1
#define PG8_PRIO_LOAD 0
#endif
template <class E, class = void> struct kprobe_of { static constexpr int value = 0; };
template <class E> struct kprobe_of<E, decltype((void)E::KPROBE)> { static constexpr int value = E::KPROBE; };
template <class Epi, class Sched, bool ALIGN_EPI = false, bool SP2 = false, bool XDMA = false>
__device__ __forceinline__ void gemm_phase(PG8_LAS unsigned char* lds, const Gemm g, const Sched& S, const Epi& E) {
    int tid = threadIdx.x; asm volatile("" : "+v"(tid));
    const int wid = __builtin_amdgcn_readfirstlane(tid >> 6), lane = tid & 63, wr = wid >> 2, wc = wid & 3, fr = lane & 15, fq = lane >> 4;
    const int K = g.K, nt = K / BK, lda = g.lda ? g.lda : g.K;
    unsigned voffA[2], voffB[2];
#pragma unroll
    for (int i = 0; i < 2; ++i) { int R, C; stage_rc(tid * 16 + i * 8192, R, C); const int Rb = Epi::PERM ? ((R & ~31) + perm32(R & 31)) : R;
        voffA[i] = (unsigned)(R * lda + C) * 2u; voffB[i] = (unsigned)(Rb * K + C) * 2u; }
    const size_t kstep = (size_t)(BK * 2);
    const size_t hstepA = (size_t)HALF * lda * 2, hstepB = (size_t)HALF * K * 2;
    const size_t tstepA = 2 * hstepA, tstepB = 2 * hstepB;
    const unsigned ldsw = (unsigned)wid * 1024u;
    const int aoff = lds_byte(wr * 64 + fr, fq * 8), boff = lds_byte(wc * 32 + fr, fq * 8);
#define PG8_SA(b, h) (((b) * 2 + (h)) * HTB)
#define PG8_SB(b, h) ((4 + (b) * 2 + (h)) * HTB)
#define PG8_STAGE(bufoff, gbase, voff) do { if constexpr (kprobe_of<Epi>::value != 1) _Pragma("unroll") for (int _i = 0; _i < 2; ++_i) \
        __builtin_amdgcn_global_load_lds((const unsigned*)((const char*)(gbase) + (voff)[_i]), (PG8_LAS unsigned*)(lds + (bufoff) + ldsw + _i * 8192), 16, 0, 0); } while (0)
#define PG8_LDA(dst, b, h) do { if constexpr (kprobe_of<Epi>::value != 2) _Pragma("unroll") for (int m = 0; m < 4; ++m) _Pragma("unroll") for (int k = 0; k < 2; ++k) dst[m][k] = *(const PG8_LAS bf16x8*)(lds + PG8_SA(b, h) + aoff + m * 2048 + k * 1024); } while (0)
#define PG8_LDB(dst, b, h) do { if constexpr (kprobe_of<Epi>::value != 2) _Pragma("unroll") for (int n = 0; n < 2; ++n) _Pragma("unroll") for (int k = 0; k < 2; ++k) dst[n][k] = *(const PG8_LAS bf16x8*)(lds + PG8_SB(b, h) + boff + n * 2048 + k * 1024); } while (0)
#define PG8_MMA(ai, bj, At, Bt) do { __builtin_amdgcn_s_setprio(PG8_PRIO_MMA); _Pragma("unroll") for (int m = 0; m < 4; ++m) _Pragma("unroll") for (int n = 0; n < 2; ++n) _Pragma("unroll") for (int k = 0; k < 2; ++k) \
        acc[ai][bj][m][n] = __builtin_amdgcn_mfma_f32_16x16x32_bf16(Bt[n][k], At[m][k], acc[ai][bj][m][n], 0, 0, 0); __builtin_amdgcn_s_setprio(PG8_PRIO_LOAD); } while (0)
#define PG8_WAIT_V(n) asm volatile("s_waitcnt vmcnt(" #n ")" ::: "memory")
#define PG8_WAIT_L(n) asm volatile("s_waitcnt lgkmcnt(" #n ")" ::: "memory")
#define PG8_BAR __builtin_amdgcn_s_barrier()
#define PG8_SCHED __builtin_amdgcn_sched_barrier(0)
    Unit cur, nxt; int ui = 0;
    if (!S.next(0, cur)) return;
    f32x4 acc[2][2][4][2];
#pragma unroll
    for (int a = 0; a < 2; ++a)
#pragma unroll
        for (int b = 0; b < 2; ++b)
#pragma unroll
            for (int m = 0; m < 4; ++m)
#pragma unroll
                for (int n = 0; n < 2; ++n) acc[a][b][m][n] = (f32x4){0.f, 0.f, 0.f, 0.f};
    bf16x8 At[4][2], B0[2][2], B1[2][2];
    const char* cA = (const char*)g.A + (size_t)cur.pm * tstepA; const char* cB = (const char*)g.Bt + (size_t)cur.pn * tstepB;
    S.a_ready(cur);
    if constexpr (SP2) {
        PG8_STAGE(PG8_SB(0, 0), cB, voffB); PG8_STAGE(PG8_SB(0, 1), cB + hstepB, voffB); PG8_STAGE(PG8_SA(0, 0), cA, voffA); PG8_STAGE(PG8_SA(0, 1), cA + hstepA, voffA);
        if (wr == 1) PG8_BAR;
        PG8_WAIT_V(2); PG8_BAR;
        PG8_STAGE(PG8_SB(1, 0), cB + kstep, voffB); PG8_STAGE(PG8_SA(1, 0), cA + kstep, voffA); PG8_STAGE(PG8_SB(1, 1), cB + hstepB + kstep, voffB);
        PG8_WAIT_V(6); PG8_BAR;
    } else {
        PG8_STAGE(PG8_SB(0, 0), cB, voffB); PG8_STAGE(PG8_SA(0, 0), cA, voffA); PG8_STAGE(PG8_SB(0, 1), cB + hstepB, voffB); PG8_STAGE(PG8_SA(0, 1), cA + hstepA, voffA);
        if (wr == 1) PG8_BAR;
        PG8_WAIT_V(4); PG8_BAR;
        PG8_STAGE(PG8_SB(1, 0), cB + kstep, voffB); PG8_STAGE(PG8_SA(1, 0), cA + kstep, voffA); PG8_STAGE(PG8_SB(1, 1), cB + hstepB + kstep, voffB);
        PG8_WAIT_V(6); PG8_BAR;
    }
    for (;;) {
        const bool has_next = S.next(ui + 1, nxt);
        const char* nA = has_next ? (const char*)g.A + (size_t)nxt.pm * tstepA : cA; const char* nB = has_next ? (const char*)g.Bt + (size_t)nxt.pn * tstepB : cB;
        for (int t = 0; t < nt; t += 2) {
            const bool last = (t == nt - 2);
            const char* a1 = cA + (size_t)(t + 1) * kstep;
            const char* a2 = last ? nA : cA + (size_t)(t + 2) * kstep; const char* b2 = last ? nB : cB + (size_t)(t + 2) * kstep;
            const char* a3 = a2 + kstep; const char* b3 = b2 + kstep;
            if (last && has_next) S.a_ready(nxt);
            if constexpr (SP2) {
            if constexpr (XDMA) {
            PG8_LDB(B0, 0, 0); PG8_LDB(B1, 0, 1); PG8_SCHED; PG8_LDA(At, 0, 0);
            PG8_WAIT_V(6); PG8_WAIT_L(0); PG8_BAR; PG8_MMA(0, 0, At, B0); PG8_STAGE(PG8_SA(1, 1), a1 + hstepA, voffA); PG8_MMA(0, 1, At, B1); PG8_BAR; PG8_SCHED;
            PG8_LDA(At, 0, 1);
            PG8_WAIT_V(2); PG8_WAIT_L(0); PG8_BAR; PG8_MMA(1, 0, At, B0); PG8_STAGE(PG8_SB(0, 0), b2, voffB); PG8_STAGE(PG8_SB(0, 1), b2 + hstepB, voffB); PG8_STAGE(PG8_SA(0, 0), a2, voffA); PG8_MMA(1, 1, At, B1); PG8_BAR; PG8_SCHED;
            PG8_LDB(B0, 1, 0); PG8_LDB(B1, 1, 1); PG8_SCHED; PG8_LDA(At, 1, 0);
            PG8_WAIT_V(6); PG8_WAIT_L(0); PG8_BAR; PG8_MMA(0, 0, At, B0); PG8_STAGE(PG8_SA(0, 1), a2 + hstepA, voffA); PG8_MMA(0, 1, At, B1); PG8_BAR; PG8_SCHED;
            PG8_LDA(At, 1, 1);
            PG8_WAIT_V(2); PG8_WAIT_L(0); PG8_BAR; PG8_MMA(1, 0, At, B0); PG8_STAGE(PG8_SB(1, 0), b3, voffB); PG8_STAGE(PG8_SB(1, 1), b3 + hstepB, voffB); PG8_STAGE(PG8_SA(1, 0), a3, voffA); PG8_MMA(1, 1, At, B1); PG8_BAR; PG8_SCHED;
            } else {
            PG8_LDB(B0, 0, 0); PG8_LDB(B1, 0, 1); PG8_SCHED; PG8_LDA(At, 0, 0); PG8_STAGE(PG8_SA(1, 1), a1 + hstepA, voffA);
            PG8_WAIT_V(8); PG8_WAIT_L(0); PG8_BAR; PG8_MMA(0, 0, At, B0); PG8_MMA(0, 1, At, B1); PG8_BAR; PG8_SCHED;
            PG8_LDA(At, 0, 1); PG8_STAGE(PG8_SB(0, 0), b2, voffB); PG8_STAGE(PG8_SB(0, 1), b2 + hstepB, voffB); PG8_STAGE(PG8_SA(0, 0), a2, voffA);
            PG8_WAIT_V(8); PG8_WAIT_L(0); PG8_BAR; PG8_MMA(1, 0, At, B0); PG8_MMA(1, 1, At, B1); PG8_BAR; PG8_SCHED;
            PG8_LDB(B0, 1, 0); PG8_LDB(B1, 1, 1); PG8_SCHED; PG8_LDA(At, 1, 0); PG8_STAGE(PG8_SA(0, 1), a2 + hstepA, voffA);
            PG8_WAIT_V(8); PG8_WAIT_L(0); PG8_BAR; PG8_MMA(0, 0, At, B0); PG8_MMA(0, 1, At, B1); PG8_BAR; PG8_SCHED;
            PG8_LDA(At, 1, 1); PG8_STAGE(PG8_SB(1, 0), b3, voffB); PG8_STAGE(PG8_SB(1, 1), b3 + hstepB, voffB); PG8_STAGE(PG8_SA(1, 0), a3, voffA);
            PG8_WAIT_V(8); PG8_WAIT_L(0); PG8_BAR; PG8_MMA(1, 0, At, B0); PG8_MMA(1, 1, At, B1); PG8_BAR; PG8_SCHED;
            }
            } else {
            PG8_LDB(B0, 0, 0); PG8_SCHED; PG8_LDA(At, 0, 0); PG8_STAGE(PG8_SA(1, 1), a1 + hstepA, voffA);
            PG8_WAIT_L(8); PG8_BAR; PG8_WAIT_L(0); PG8_MMA(0, 0, At, B0); PG8_BAR; PG8_SCHED;
            PG8_LDB(B1, 0, 1); PG8_STAGE(PG8_SB(0, 0), b2, voffB);
            PG8_BAR; PG8_WAIT_L(0); PG8_MMA(0, 1, At, B1); PG8_BAR;
            PG8_LDA(At, 0, 1); PG8_STAGE(PG8_SA(0, 0), a2, voffA);
            PG8_BAR; PG8_WAIT_L(0); PG8_MMA(1, 0, At, B0); PG8_BAR; PG8_SCHED;
            PG8_STAGE(PG8_SB(0, 1), b2 + hstepB, voffB);
            PG8_WAIT_V(6); PG8_BAR; PG8_MMA(1, 1, At, B1); PG8_BAR;
            PG8_LDB(B0, 1, 0); PG8_SCHED; PG8_LDA(At, 1, 0); PG8_STAGE(PG8_SA(0, 1), a2 + hstepA, voffA);
            PG8_WAIT_L(8); PG8_BAR; PG8_WAIT_L(0); PG8_MMA(0, 0, At, B0); PG8_BAR; PG8_SCHED;
            PG8_LDB(B1, 1, 1); PG8_STAGE(PG8_SB(1, 0), b3, voffB);
            PG8_BAR; PG8_WAIT_L(0); PG8_MMA(0, 1, At, B1); PG8_BAR;
            PG8_LDA(At, 1, 1); PG8_STAGE(PG8_SA(1, 0), a3, voffA);
            PG8_BAR; PG8_WAIT_L(0); PG8_MMA(1, 0, At, B0); PG8_BAR; PG8_SCHED;
            PG8_STAGE(PG8_SB(1, 1), b3 + hstepB, voffB);
            PG8_WAIT_V(6); PG8_BAR; PG8_MMA(1, 1, At, B1); PG8_BAR;
            }
        }
        if constexpr (ALIGN_EPI) { if (wr == 0) PG8_BAR; }
        if constexpr (!Epi::AFTER_DRAIN) { E(acc, cur, wr, wc, fr, fq); S.done(cur); }
        if (!has_next) break;
#pragma unroll
        for (int a = 0; a < 2; ++a)
#pragma unroll
            for (int b = 0; b < 2; ++b)
#pragma unroll
                for (int m = 0; m < 4; ++m)
#pragma unroll
                    for (int n = 0; n < 2; ++n) acc[a][b][m][n] = (f32x4){0.f, 0.f, 0.f, 0.f};
        cur = nxt; cA = nA; cB = nB; ++ui;
        if constexpr (ALIGN_EPI) { if (wr == 1) PG8_BAR; }
    }
    PG8_WAIT_V(0);
    if constexpr (!ALIGN_EPI) { if (wr == 0) PG8_BAR; }
    PG8_BAR;
    if constexpr (Epi::AFTER_DRAIN) { E.fused(acc, cur, wr, wc, fr, fq, lds, wid, lane); S.done(cur); }
#undef PG8_SA
#undef PG8_SB
#undef PG8_STAGE
#undef PG8_LDA
#undef PG8_LDB
#undef PG8_MMA
#undef PG8_WAIT_V
#undef PG8_WAIT_L
#undef PG8_BAR
#undef PG8_SCHED
}
}
namespace pg8 {
constexpr int HM_STAGE_BYTES = 9 * HTB;
template <class Epi>
__device__ __forceinline__ void gemm_half_unit(PG8_LAS unsigned char* lds, const Gemm g, const HUnit hu, const Epi& E) {
    int tid = threadIdx.x; asm volatile("" : "+v"(tid));
    const int wid = __builtin_amdgcn_readfirstlane(tid >> 6), lane = tid & 63, wr = wid >> 2, wc = wid & 3, fr = lane & 15, fq = lane >> 4;
    const int K = g.K, nt = K / BK, lda = g.lda ? g.lda : g.K;
    unsigned voffA[2], voffB[2];
#pragma unroll
    for (int i = 0; i < 2; ++i) { int R, C; stage_rc(tid * 16 + i * 8192, R, C); const int Rb = Epi::PERM ? ((R & ~31) + perm32(R & 31)) : R;
        voffA[i] = (unsigned)(R * lda + C) * 2u; voffB[i] = (unsigned)(Rb * K + C) * 2u; }
    const size_t kstep = (size_t)(BK * 2);
    const size_t hstepA = (size_t)HALF * lda * 2, hstepB = (size_t)HALF * K * 2;
    const unsigned ldsw = (unsigned)wid * 1024u;
    const int aoff = lds_byte(wr * 64 + fr, fq * 8), boff = lds_byte(wc * 32 + fr, fq * 8);
#define HM_SA(b) ((b) * 3 * HTB)
#define HM_SB(b, h) (((b) * 3 + 1 + (h)) * HTB)
#define HM_STAGE(bufoff, gbase, voff) do { _Pragma("unroll") for (int _i = 0; _i < 2; ++_i) \
        __builtin_amdgcn_global_load_lds((const unsigned*)((const char*)(gbase) + (voff)[_i]), (PG8_LAS unsigned*)(lds + (bufoff) + ldsw + _i * 8192), 16, 0, 0); } while (0)
#define HM_LDA(dst, b) do { _Pragma("unroll") for (int m = 0; m < 4; ++m) _Pragma("unroll") for (int k = 0; k < 2; ++k) dst[m][k] = *(const PG8_LAS bf16x8*)(lds + HM_SA(b) + aoff + m * 2048 + k * 1024); } while (0)
#define HM_LDB(dst, b, h) do { _Pragma("unroll") for (int n = 0; n < 2; ++n) _Pragma("unroll") for (int k = 0; k < 2; ++k) dst[n][k] = *(const PG8_LAS bf16x8*)(lds + HM_SB(b, h) + boff + n * 2048 + k * 1024); } while (0)
#define HM_MMA(bj, At, Bt) do { __builtin_amdgcn_s_setprio(PG8_PRIO_MMA); _Pragma("unroll") for (int m = 0; m < 4; ++m) _Pragma("unroll") for (int n = 0; n < 2; ++n) _Pragma("unroll") for (int k = 0; k < 2; ++k) \
        acc[bj][m][n] = __builtin_amdgcn_mfma_f32_16x16x32_bf16(Bt[n][k], At[m][k], acc[bj][m][n], 0, 0, 0); __builtin_amdgcn_s_setprio(PG8_PRIO_LOAD); } while (0)
#define HM_WAIT_V(n) asm volatile("s_waitcnt vmcnt(" #n ")" ::: "memory")
#define HM_WAIT_L(n) asm volatile("s_waitcnt lgkmcnt(" #n ")" ::: "memory")
#define HM_BAR __builtin_amdgcn_s_barrier()
#define HM_SCHED __builtin_amdgcn_sched_barrier(0)
    f32x4 acc[2][4][2];
#pragma unroll
    for (int b = 0; b < 2; ++b)
#pragma unroll
        for (int m = 0; m < 4; ++m)
#pragma unroll
            for (int n = 0; n < 2; ++n) acc[b][m][n] = (f32x4){0.f, 0.f, 0.f, 0.f};
    bf16x8 At[4][2], B0[2][2], B1[2][2];
    const char* cA = (const char*)g.A + (size_t)hu.pm2 * hstepA; const char* cB = (const char*)g.Bt + (size_t)hu.pn * 2 * hstepB;
    HM_STAGE(HM_SB(0, 0), cB, voffB); HM_STAGE(HM_SB(0, 1), cB + hstepB, voffB); HM_STAGE(HM_SA(0), cA, voffA);
    HM_STAGE(HM_SB(1, 0), cB + kstep, voffB); HM_STAGE(HM_SB(1, 1), cB + hstepB + kstep, voffB); HM_STAGE(HM_SA(1), cA + kstep, voffA);
    if (wr == 1) HM_BAR;
    HM_WAIT_V(6); HM_BAR; HM_BAR;
#define HM_SP(b, bn2, s) do { \
        HM_LDB(B0, b, 0); HM_LDB(B1, b, 1); HM_SCHED; HM_LDA(At, b); \
        if ((s) + 2 < nt) { const char* a2 = cA + (size_t)((s) + 2) * kstep; const char* b2 = cB + (size_t)((s) + 2) * kstep; \
            HM_STAGE(HM_SB(bn2, 0), b2, voffB); HM_STAGE(HM_SB(bn2, 1), b2 + hstepB, voffB); HM_STAGE(HM_SA(bn2), a2, voffA); HM_WAIT_V(6); } \
        else { HM_WAIT_V(0); } \
        HM_WAIT_L(0); HM_BAR; HM_MMA(0, At, B0); HM_MMA(1, At, B1); HM_BAR; HM_SCHED; } while (0)
    for (int s = 0; s < nt; s += 3) {
        HM_SP(0, 2, s);
        if (s + 1 < nt) HM_SP(1, 0, s + 1);
        if (s + 2 < nt) HM_SP(2, 1, s + 2);
    }
    if (wr == 0) HM_BAR;
    E.half(acc, hu, wr, wc, fr, fq);
#undef HM_SA
#undef HM_SB
#undef HM_STAGE
#undef HM_LDA
#undef HM_LDB
#undef HM_MMA
#undef HM_WAIT_V
#undef HM_WAIT_L
#undef HM_BAR
#undef HM_SCHED
#undef HM_SP
}
}
namespace att {
typedef short bf16x8 __attribute__((ext_vector_type(8)));
typedef short s16x4 __attribute__((ext_vector_type(4)));
typedef float f32x16 __attribute__((ext_vector_type(16)));
typedef float f32x4 __attribute__((ext_vector_type(4)));
typedef unsigned u32x4 __attribute__((ext_vector_type(4)));
typedef int int4v __attribute__((ext_vector_type(4)));
typedef unsigned short bf16_t;
constexpr int SEQ = 2048, OPITCH = 1024;
constexpr int SLOTB = 8192, NSLOT = 4;
constexpr int LDS_K = 0, LDS_V = NSLOT * SLOTB, LDS_WS = 2 * NSLOT * SLOTB, LDS_OST = LDS_WS + 8 * 256, LDS_KMT = LDS_OST + 8 * 4096, LDS_END = LDS_KMT + 8 * 64 * 4;
typedef LAS const char* lds_cptr;
#define ATT_SBAR() __builtin_amdgcn_sched_barrier(0)
#define ATT_WAIT_BAR(N) asm volatile("s_waitcnt vmcnt(" #N ") lgkmcnt(0)\n\ts_barrier" ::: "memory")
__device__ __forceinline__ int crow(int r, int hi) { return (r & 3) + 8 * (r >> 2) + 4 * hi; }
__device__ __forceinline__ void glds16(const void* gsrc, unsigned lds_dst) { unsigned keep;
    asm volatile("s_mov_b32 %0, m0\n\ts_mov_b32 m0, %2\n\ts_nop 0\n\tglobal_load_lds_dwordx4 %1, off\n\ts_mov_b32 m0, %0" : "=&s"(keep) : "v"(gsrc), "s"(lds_dst) : "memory"); }
typedef float f32x2_t __attribute__((ext_vector_type(2))); typedef __bf16 bf16x2_t __attribute__((ext_vector_type(2)));
__device__ __forceinline__ unsigned cvtpk(float lo, float hi) { f32x2_t v = {lo, hi}; bf16x2_t b = __builtin_convertvector(v, bf16x2_t); return __builtin_bit_cast(unsigned, b); }
__device__ __forceinline__ float bf2f(short s) { return __builtin_bit_cast(float, (unsigned)(unsigned short)s << 16); }
__device__ __forceinline__ float partner(float x, int hi) {
    auto rr = __builtin_amdgcn_permlane32_swap(__builtin_bit_cast(unsigned, x), __builtin_bit_cast(unsigned, x), false, false);
    return __builtin_bit_cast(float, hi ? rr[0] : rr[1]);
}
typedef short v4i16_t __attribute__((ext_vector_type(4)));
__device__ __forceinline__ s16x4 vtr(lds_cptr p) { return __builtin_bit_cast(s16x4, __builtin_amdgcn_ds_read_tr16_b64_v4i16((LAS v4i16_t*)p)); }
__device__ __forceinline__ void vload16(s16x4* vlo, s16x4* vhi, lds_cptr vp) {
#pragma unroll
    for (int i = 0; i < 8; ++i) { vlo[i] = vtr(vp + ((i >> 2) * 4096 + (i & 3) * 1024)); vhi[i] = vtr(vp + ((i >> 2) * 4096 + (i & 3) * 1024 + 512)); }
}
__device__ __forceinline__ void pv_r(f32x16* o, const s16x4* vlo, const s16x4* vhi, bf16x8 pa0, bf16x8 pa1, bf16x8 pa2, bf16x8 pa3) {
#define ATT_VF(i) (bf16x8){vlo[i][0], vlo[i][1], vlo[i][2], vlo[i][3], vhi[i][0], vhi[i][1], vhi[i][2], vhi[i][3]}
    o[0] = __builtin_amdgcn_mfma_f32_32x32x16_bf16(pa0, ATT_VF(0), o[0], 0, 0, 0); o[1] = __builtin_amdgcn_mfma_f32_32x32x16_bf16(pa0, ATT_VF(4), o[1], 0, 0, 0);
    o[0] = __builtin_amdgcn_mfma_f32_32x32x16_bf16(pa1, ATT_VF(1), o[0], 0, 0, 0); o[1] = __builtin_amdgcn_mfma_f32_32x32x16_bf16(pa1, ATT_VF(5), o[1], 0, 0, 0);
    o[0] = __builtin_amdgcn_mfma_f32_32x32x16_bf16(pa2, ATT_VF(2), o[0], 0, 0, 0); o[1] = __builtin_amdgcn_mfma_f32_32x32x16_bf16(pa2, ATT_VF(6), o[1], 0, 0, 0);
    o[0] = __builtin_amdgcn_mfma_f32_32x32x16_bf16(pa3, ATT_VF(3), o[0], 0, 0, 0); o[1] = __builtin_amdgcn_mfma_f32_32x32x16_bf16(pa3, ATT_VF(7), o[1], 0, 0, 0);
#undef ATT_VF
}
__device__ __forceinline__ void qkt(f32x16& p0, f32x16& p1, lds_cptr kb, const bf16x8* qr) {
    const f32x16 z = {};
#pragma unroll
    for (int d0 = 0; d0 < 4; ++d0) {
        const bf16x8 b0 = *(const LAS bf16x8*)(kb + d0 * 2048);
        const bf16x8 b1 = *(const LAS bf16x8*)(kb + d0 * 2048 + 512);
        if (d0 == 0) { p0 = __builtin_amdgcn_mfma_f32_32x32x16_bf16(b0, qr[0], z, 0, 0, 0); p1 = __builtin_amdgcn_mfma_f32_32x32x16_bf16(b1, qr[0], z, 0, 0, 0); }
        else { p0 = __builtin_amdgcn_mfma_f32_32x32x16_bf16(b0, qr[d0], p0, 0, 0, 0); p1 = __builtin_amdgcn_mfma_f32_32x32x16_bf16(b1, qr[d0], p1, 0, 0, 0); }
    }
}
__device__ __forceinline__ void qkt_aug(f32x16& p0, f32x16& p1, lds_cptr kb, const bf16x8* qr, const f32x16& c, bf16x8 kaug0, bf16x8 kaug1, bf16x8 qaug) {
    p0 = __builtin_amdgcn_mfma_f32_32x32x16_bf16(kaug0, qaug, c, 0, 0, 0); p1 = __builtin_amdgcn_mfma_f32_32x32x16_bf16(kaug1, qaug, c, 0, 0, 0);
#pragma unroll
    for (int d0 = 0; d0 < 4; ++d0) {
        const bf16x8 b0 = *(const LAS bf16x8*)(kb + d0 * 2048);
        const bf16x8 b1 = *(const LAS bf16x8*)(kb + d0 * 2048 + 512);
        p0 = __builtin_amdgcn_mfma_f32_32x32x16_bf16(b0, qr[d0], p0, 0, 0, 0); p1 = __builtin_amdgcn_mfma_f32_32x32x16_bf16(b1, qr[d0], p1, 0, 0, 0);
    }
}
__device__ __forceinline__ void pv(f32x16* o, int vb, bf16x8 pa0, bf16x8 pa1, bf16x8 pa2, bf16x8 pa3) {
#pragma unroll
    for (int d0 = 0; d0 < 2; ++d0) { s16x4 lo[4], hi[4];
#pragma unroll
        for (int ks = 0; ks < 4; ++ks) {
            asm volatile("ds_read_b64_tr_b16 %0,%1 offset:%c2" : "=&v"(lo[ks]) : "v"(vb), "i"(d0 * 4096 + ks * 1024) : "memory");
            asm volatile("ds_read_b64_tr_b16 %0,%1 offset:%c2" : "=&v"(hi[ks]) : "v"(vb), "i"(d0 * 4096 + ks * 1024 + 512) : "memory"); }
        asm volatile("s_waitcnt lgkmcnt(0)" ::: "memory"); ATT_SBAR();
#define ATT_PK(k) (bf16x8){lo[k][0], lo[k][1], lo[k][2], lo[k][3], hi[k][0], hi[k][1], hi[k][2], hi[k][3]}
        o[d0] = __builtin_amdgcn_mfma_f32_32x32x16_bf16(pa0, ATT_PK(0), o[d0], 0, 0, 0);
        o[d0] = __builtin_amdgcn_mfma_f32_32x32x16_bf16(pa1, ATT_PK(1), o[d0], 0, 0, 0);
        o[d0] = __builtin_amdgcn_mfma_f32_32x32x16_bf16(pa2, ATT_PK(2), o[d0], 0, 0, 0);
        o[d0] = __builtin_amdgcn_mfma_f32_32x32x16_bf16(pa3, ATT_PK(3), o[d0], 0, 0, 0);
#undef ATT_PK
    }
}
template <bool MOBA>
__device__ __forceinline__ void attn_unit(const int b, const int h, const int qb, const bf16_t* __restrict__ QKV, const int pitch, const int koff, const int voff,
                                          bf16_t* __restrict__ O, LAS unsigned char* lds, const float* __restrict__ KMP, const float sl2, const unsigned force_sel = 0u) {
    int tid = threadIdx.x; asm volatile("" : "+v"(tid));
    const int lane = tid & 63, r32 = lane & 31, hi = lane >> 5;
    const int wid = __builtin_amdgcn_readfirstlane(tid >> 6);
    const long rowbase = (long)b * SEQ; const int q0 = qb * 256;
    const bf16_t* Qw = QKV + (rowbase + q0 + wid * 32) * pitch + h * 64;
    const bf16_t* Kh = QKV + rowbase * pitch + koff + h * 64;
    const bf16_t* Vh = QKV + rowbase * pitch + voff + h * 64;
    const unsigned lds0 = (unsigned)(uintptr_t)lds;
    const bf16_t* ksrc = Kh + (long)lane * pitch + wid * 8;
    const bf16_t* vsrc = Vh + (long)(16 * (wid & 3) + (lane >> 2)) * pitch + (wid >> 2) * 32 + (lane & 3) * 8;
    const unsigned kdst = lds0 + LDS_K + wid * 1024, vdst = lds0 + LDS_V + wid * 1024;
#define ATT_DMA_KV(t, slot) do { glds16(ksrc + (long)(t) * 64 * pitch, (unsigned)__builtin_amdgcn_readfirstlane(kdst + (slot))); \
                                 glds16(vsrc + (long)(t) * 64 * pitch, (unsigned)__builtin_amdgcn_readfirstlane(vdst + (slot))); } while (0)
    const int NT = 4 * qb + 4;
    const int tdiag = 4 * qb + (wid >> 1);
    LAS float* wsf = (LAS float*)(lds + LDS_WS) + wid * 64;
    const lds_cptr kp0 = (lds_cptr)lds + LDS_K + hi * 1024 + r32 * 16;
    const int vb0 = (int)(lds0 + LDS_V) + ((lane >> 4) & 1) * 32 + (lane & 3) * 8 + (4 * hi + ((lane & 15) >> 2)) * 64;
    ATT_DMA_KV(NT - 1, 0); ATT_DMA_KV(NT - 2, SLOTB);
    bf16x8 qr[4];
#pragma unroll
    for (int d0 = 0; d0 < 4; ++d0) qr[d0] = *(const bf16x8*)(Qw + (long)r32 * pitch + d0 * 16 + hi * 8);
    f32x16 o[2]; o[0] = f32x16{}; o[1] = f32x16{};
    const int qrel = wid * 32 + r32;
    float carry = 1.0f;
    float mhat = 0.f, lrow = 0.f; unsigned selmask = 0u;
    bf16x8 kaug0 = {0, 0, 0, 0, 0, 0, 0, 0}, kaug1 = {0, 0, 0, 0, 0, 0, 0, 0}, qaug = {0, 0, 0, 0, 0, 0, 0, 0};
    if constexpr (MOBA) {
        LAS float* kmt = (LAS float*)(lds + LDS_KMT);
        { const int n = tid >> 6, d = tid & 63;
          if (n < qb) { const float* kp = KMP + ((size_t)(b * 8 + n) * 2) * 1024 + h * 64 + d; kmt[n * 64 + d] = (kp[0] + kp[1024]) * (1.0f / 256.0f); } }
        asm volatile("s_waitcnt lgkmcnt(0)\n\ts_barrier" ::: "memory");
        float gate[7];
#pragma unroll
        for (int n = 0; n < 7; ++n) {
            float g = -INFINITY;
            if (n < qb) {
                float s = 0.f;
#pragma unroll
                for (int d0 = 0; d0 < 4; ++d0) {
                    const f32x4 k0 = *(const LAS f32x4*)(kmt + n * 64 + d0 * 16 + hi * 8), k1 = *(const LAS f32x4*)(kmt + n * 64 + d0 * 16 + hi * 8 + 4);
                    s += bf2f(qr[d0][0]) * k0[0] + bf2f(qr[d0][1]) * k0[1] + bf2f(qr[d0][2]) * k0[2] + bf2f(qr[d0][3]) * k0[3]
                       + bf2f(qr[d0][4]) * k1[0] + bf2f(qr[d0][5]) * k1[1] + bf2f(qr[d0][6]) * k1[2] + bf2f(qr[d0][7]) * k1[3];
                }
                g = s + partner(s, hi);
            }
            gate[n] = g;
        }
#pragma unroll
        for (int r = 0; r < 3; ++r) {
            int best = -1; float bv = -INFINITY;
#pragma unroll
            for (int n = 0; n < 7; ++n) { const bool taken = (selmask >> n) & 1u; if (!taken && gate[n] > bv) { best = n; bv = gate[n]; } }
            if (best >= 0) selmask |= 1u << best;
        }
        selmask |= (1u << qb) | force_sel;
        mhat = sl2 * (float)qrel;
        if (hi == 0) {
            const unsigned sh = __builtin_bit_cast(unsigned, sl2) + 0x7fffu + ((__builtin_bit_cast(unsigned, sl2) >> 16) & 1u), shb = sh >> 16;
            const float rem = sl2 - __builtin_bit_cast(float, shb << 16); const unsigned sl = (__builtin_bit_cast(unsigned, rem) + 0x7fffu + ((__builtin_bit_cast(unsigned, rem) >> 16) & 1u)) >> 16;
            qaug[0] = (short)shb; qaug[1] = (short)sl;
            const short k0s = (short)(__builtin_bit_cast(unsigned, (float)r32) >> 16), k1s = (short)(__builtin_bit_cast(unsigned, (float)(32 + r32)) >> 16);
            kaug0[0] = k0s; kaug0[1] = k0s; kaug1[0] = k1s; kaug1[1] = k1s;
        }
    }
    LAS int* done = (LAS int*)(lds + LDS_KMT);
    bool wdone = false;
    if constexpr (!MOBA) { if (lane == 0) done[wid] = 0x7fffffff; }
    const lds_cptr vp0 = (lds_cptr)lds + LDS_V + ((lane >> 4) & 1) * 32 + (lane & 3) * 8 + (4 * hi + ((lane & 15) >> 2)) * 64;
    int slot = 0;
    for (int i = 0; i < NT; ++i) {
        const int t = NT - 1 - i;
        const int nslot = (slot == (NSLOT - 1) * SLOTB) ? 0 : slot + SLOTB;
        const int n2slot = (nslot == (NSLOT - 1) * SLOTB) ? 0 : nslot + SLOTB;
        if (i + 2 < NT) { ATT_DMA_KV(t - 2, n2slot); ATT_WAIT_BAR(4); } else if (i + 1 < NT) { ATT_WAIT_BAR(2); } else { ATT_WAIT_BAR(0); }
        if constexpr (!MOBA) {
            const int4v d0v = *(const LAS int4v*)(done), d1v = *(const LAS int4v*)(done + 4);
            int dm = max(max(max(d0v[0], d0v[1]), max(d0v[2], d0v[3])), max(max(d1v[0], d1v[1]), max(d1v[2], d1v[3])));
            dm = __builtin_amdgcn_readfirstlane(dm);
            if (dm < i) break;
        }
        if (t <= tdiag && !wdone) {
            f32x16 p0, p1;
            u32x4 pw0 = {0u, 0u, 0u, 0u}, pw1 = pw0, pw2 = pw0, pw3 = pw0; bool dead = false;
            if constexpr (!MOBA) {
                qkt(p0, p1, kp0 + slot, qr);
                s16x4 vlo[8], vhi[8]; vload16(vlo, vhi, vp0 + slot);
                float om[32];
#pragma unroll
                for (int r = 0; r < 16; r += 2) {
                    f32x2_t e0 = {__builtin_amdgcn_exp2f(p0[r]), __builtin_amdgcn_exp2f(p0[r + 1])}, e1 = {__builtin_amdgcn_exp2f(p1[r]), __builtin_amdgcn_exp2f(p1[r + 1])};
                    const f32x2_t one2 = {1.0f, 1.0f}; e0 = e0 + one2; e1 = e1 + one2;
                    om[r] = __builtin_amdgcn_rcpf(e0.x); om[r + 1] = __builtin_amdgcn_rcpf(e0.y); om[16 + r] = __builtin_amdgcn_rcpf(e1.x); om[16 + r + 1] = __builtin_amdgcn_rcpf(e1.y);
                }
                if (t == tdiag) {
                    const int kb = 64 * (t - 4 * qb) + 4 * hi;
#pragma unroll
                    for (int r = 0; r < 16; ++r) { const int kv = kb + (r & 3) + 8 * (r >> 2);
                        if (kv >= qrel) om[r] = 1.0f; if (kv + 32 >= qrel) om[16 + r] = 1.0f; }
                }
                float xin0[8], xin1[8], xin2[8], gp[8], OS[9];
#pragma unroll
                for (int j = 0; j < 8; ++j) { xin2[j] = om[4 * j + 3]; xin1[j] = xin2[j] * om[4 * j + 2]; xin0[j] = xin1[j] * om[4 * j + 1]; gp[j] = xin0[j] * om[4 * j]; }
                OS[8] = 1.0f;
#pragma unroll
                for (int j = 7; j >= 0; --j) OS[j] = gp[j] * OS[j + 1];
                float oth[8];
#pragma unroll
                for (int j = 0; j < 8; ++j) {
                    auto rr = __builtin_amdgcn_permlane32_swap(__builtin_bit_cast(unsigned, OS[j]), __builtin_bit_cast(unsigned, OS[j + 1]), false, false);
                    oth[j] = __builtin_bit_cast(float, hi ? rr[0] : rr[1]);
                }
                float tot = OS[0] * oth[0];
                { auto rr = __builtin_amdgcn_permlane32_swap(__builtin_bit_cast(unsigned, tot), __builtin_bit_cast(unsigned, tot), false, false); tot = hi ? __builtin_bit_cast(float, rr[0]) : tot; }
                float av[32];
#pragma unroll
                for (int j = 0; j < 8; ++j) { const float xc = carry * (OS[j + 1] * oth[j]); const f32x2_t xc2 = {xc, xc};
                    const f32x2_t dlo = {xin0[j] - gp[j], xin1[j] - xin0[j]}, dhi = {xin2[j] - xin1[j], 1.0f - xin2[j]};
                    const f32x2_t alo = dlo * xc2, ahi = dhi * xc2;
                    av[4 * j] = alo.x; av[4 * j + 1] = alo.y; av[4 * j + 2] = ahi.x; av[4 * j + 3] = ahi.y; }
                carry *= tot;
                if (__all(carry == 0.0f)) { wdone = true; if (lane == 0) done[wid] = i; }
                pw0 = (u32x4){cvtpk(av[0], av[1]), cvtpk(av[2], av[3]), cvtpk(av[4], av[5]), cvtpk(av[6], av[7])};
                pw1 = (u32x4){cvtpk(av[8], av[9]), cvtpk(av[10], av[11]), cvtpk(av[12], av[13]), cvtpk(av[14], av[15])};
                pw2 = (u32x4){cvtpk(av[16], av[17]), cvtpk(av[18], av[19]), cvtpk(av[20], av[21]), cvtpk(av[22], av[23])};
                pw3 = (u32x4){cvtpk(av[24], av[25]), cvtpk(av[26], av[27]), cvtpk(av[28], av[29]), cvtpk(av[30], av[31])};
                pv_r(o, vlo, vhi, __builtin_bit_cast(bf16x8, pw0), __builtin_bit_cast(bf16x8, pw1), __builtin_bit_cast(bf16x8, pw2), __builtin_bit_cast(bf16x8, pw3));
            } else {
                const int blk = t >> 2;
                const bool sel = (selmask >> blk) & 1u;
                const float nv = sel ? (sl2 * (float)(64 * t - q0) - mhat) : -INFINITY;
                f32x16 c;
#pragma unroll
                for (int r = 0; r < 16; ++r) c[r] = nv;
                qkt_aug(p0, p1, kp0 + slot, qr, c, kaug0, kaug1, qaug);
                s16x4 vlo[8], vhi[8]; vload16(vlo, vhi, vp0 + slot);
                if (t == tdiag) {
                    const int kb = 64 * (t - 4 * qb) + 4 * hi;
#pragma unroll
                    for (int r = 0; r < 16; ++r) { const int kv = kb + (r & 3) + 8 * (r >> 2);
                        if (kv > qrel) p0[r] = -INFINITY; if (kv + 32 > qrel) p1[r] = -INFINITY; }
                }
                float a0 = __builtin_fmaxf(__builtin_fmaxf(p0[0], p0[1]), p0[2]), a1 = __builtin_fmaxf(__builtin_fmaxf(p1[0], p1[1]), p1[2]);
#pragma unroll
                for (int r = 3; r < 15; r += 2) { a0 = __builtin_fmaxf(__builtin_fmaxf(a0, p0[r]), p0[r + 1]); a1 = __builtin_fmaxf(__builtin_fmaxf(a1, p1[r]), p1[r + 1]); }
                float rm = __builtin_fmaxf(__builtin_fmaxf(a0, p0[15]), __builtin_fmaxf(a1, p1[15]));
                rm = __builtin_fmaxf(rm, partner(rm, hi));
                dead = __all(rm < -160.0f);
                if (!dead && __any(rm > 8.0f)) {
                    const float dl = __builtin_fmaxf(rm, 0.f);
                    mhat += dl;
#pragma unroll
                    for (int r = 0; r < 16; ++r) { p0[r] -= dl; p1[r] -= dl; }
                    const float f = __builtin_amdgcn_exp2f(-dl);
                    lrow *= f;
                    if (hi == 0) wsf[r32] = f;
                    asm volatile("s_waitcnt lgkmcnt(0)" ::: "memory");
#pragma unroll
                    for (int g4 = 0; g4 < 4; ++g4) { const f32x4 fv = *(const LAS f32x4*)(wsf + 8 * g4 + 4 * hi);
#pragma unroll
                        for (int i2 = 0; i2 < 4; ++i2) { o[0][4 * g4 + i2] *= fv[i2]; o[1][4 * g4 + i2] *= fv[i2]; } }
                    asm volatile("s_waitcnt lgkmcnt(0)" ::: "memory");
                }
                if (!dead) {
                float rs = 0.f;
#pragma unroll
                for (int r = 0; r < 16; ++r) { p0[r] = __builtin_amdgcn_exp2f(p0[r]); p1[r] = __builtin_amdgcn_exp2f(p1[r]); rs += p0[r] + p1[r]; }
                lrow += rs;
                pw0 = (u32x4){cvtpk(p0[0], p0[1]), cvtpk(p0[2], p0[3]), cvtpk(p0[4], p0[5]), cvtpk(p0[6], p0[7])};
                pw1 = (u32x4){cvtpk(p0[8], p0[9]), cvtpk(p0[10], p0[11]), cvtpk(p0[12], p0[13]), cvtpk(p0[14], p0[15])};
                pw2 = (u32x4){cvtpk(p1[0], p1[1]), cvtpk(p1[2], p1[3]), cvtpk(p1[4], p1[5]), cvtpk(p1[6], p1[7])};
                pw3 = (u32x4){cvtpk(p1[8], p1[9]), cvtpk(p1[10], p1[11]), cvtpk(p1[12], p1[13]), cvtpk(p1[14], p1[15])};
                pv_r(o, vlo, vhi, __builtin_bit_cast(bf16x8, pw0), __builtin_bit_cast(bf16x8, pw1), __builtin_bit_cast(bf16x8, pw2), __builtin_bit_cast(bf16x8, pw3));
                }
            }
        }
        slot = nslot;
    }
    if constexpr (!MOBA) asm volatile("s_waitcnt vmcnt(0)" ::: "memory");
    float rli[16];
    if constexpr (MOBA) {
        const float lt = lrow + partner(lrow, hi);
        if (hi == 0) wsf[32 + r32] = lt;
        asm volatile("s_waitcnt lgkmcnt(0)" ::: "memory");
#pragma unroll
        for (int g4 = 0; g4 < 4; ++g4) { const f32x4 lv = *(const LAS f32x4*)(wsf + 32 + 8 * g4 + 4 * hi);
#pragma unroll
            for (int i2 = 0; i2 < 4; ++i2) rli[4 * g4 + i2] = __builtin_amdgcn_rcpf(lv[i2]); }
    } else {
#pragma unroll
        for (int r = 0; r < 16; ++r) rli[r] = 1.0f;
    }
    {
        LAS bf16_t* stg = (LAS bf16_t*)(lds + LDS_OST) + wid * 2048;
#pragma unroll
        for (int r = 0; r < 16; ++r) { const int orow = crow(r, hi);
#pragma unroll
            for (int d0 = 0; d0 < 2; ++d0) stg[orow * 64 + d0 * 32 + r32] = (bf16_t)(cvtpk(o[d0][r] * rli[r], 0.f) & 0xffffu); }
        asm volatile("s_waitcnt lgkmcnt(0)" ::: "memory");
        bf16_t* Ow = O + (rowbase + q0 + wid * 32) * OPITCH + h * 64;
#pragma unroll
        for (int i = 0; i < 4; ++i) { const int row = i * 8 + (lane >> 3), ch = lane & 7; const u32x4 v = *(const LAS u32x4*)(stg + row * 64 + ch * 8); *(u32x4*)(Ow + (long)row * OPITCH + ch * 8) = v; }
    }
    asm volatile("s_waitcnt lgkmcnt(0)\n\ts_barrier" ::: "memory");
#undef ATT_DMA_KV
}
#undef ATT_SBAR
#undef ATT_WAIT_BAR
}
namespace exa {
using bf16=unsigned short;
using bf16x8=__attribute__((ext_vector_type(8)))short;
using s16x4=__attribute__((ext_vector_type(4)))short;
using f32x16=__attribute__((ext_vector_type(16)))float;
using u32x4=__attribute__((ext_vector_type(4)))unsigned;
constexpr int SEQ=2048,D=64,DM=3072;
constexpr int NW=8,QBLK=32,QB=QBLK*NW,KVBLK=64;
__device__ __forceinline__ int crow(int r,int hi){return (r&3)+8*(r>>2)+4*hi;}
#define SBAR() __builtin_amdgcn_sched_barrier(0)
__device__ __forceinline__ void cmask(f32x16&p0,f32x16&p1,int jb,int qrel,int hi){
  const float NEG=-INFINITY; int kb=64*jb+4*hi;
  #pragma unroll
  for(int r=0;r<16;++r){int kv=kb+(r&3)+8*(r>>2); if(kv>qrel)p0[r]=NEG; if(kv+32>qrel)p1[r]=NEG;}
}
constexpr int NSLOT=3, SLOTB=8192;
constexpr int LDS_K=0, LDS_V=NSLOT*SLOTB, LDS_WS=2*NSLOT*SLOTB, LDS_OST=LDS_WS+NW*64*4, LDS_BYTES=LDS_OST+NW*4096;
__device__ __forceinline__ void glds16(const void*gsrc,unsigned lds_dst){unsigned keep;
  asm volatile("s_mov_b32 %0, m0\n\ts_mov_b32 m0, %2\n\ts_nop 0\n\tglobal_load_lds_dwordx4 %1, off\n\ts_mov_b32 m0, %0":"=&s"(keep):"v"(gsrc),"s"(lds_dst):"memory");}
__device__ __forceinline__ float max3f(float a,float b,float c){float r;asm("v_max3_f32 %0, %1, %2, %3":"=v"(r):"v"(a),"v"(b),"v"(c));return r;}
__device__ __forceinline__ float max2f(float a,float b){float r;asm("v_max_f32_e32 %0, %1, %2":"=v"(r):"v"(a),"v"(b));return r;}
__device__ __forceinline__ float fadd_s(float a,float b){float r;asm("v_add_f32_e32 %0, %1, %2":"=v"(r):"v"(a),"v"(b));return r;}
__device__ __forceinline__ float fsub_s(float a,float b){float r;asm("v_sub_f32_e32 %0, %1, %2":"=v"(r):"v"(a),"v"(b));return r;}
typedef float f32x2_t __attribute__((ext_vector_type(2))); typedef __bf16 bf16x2_t __attribute__((ext_vector_type(2)));
__device__ __forceinline__ unsigned cvtpk_s(float lo,float hi){f32x2_t v={lo,hi};bf16x2_t b=__builtin_convertvector(v,bf16x2_t);return __builtin_bit_cast(unsigned,b);}
#define WAIT_BAR(N) asm volatile("s_waitcnt vmcnt(" #N ") lgkmcnt(0)\n\ts_barrier":::"memory")
typedef LAS const char* lds_cptr;
__device__ __forceinline__ void qkt(f32x16&p0,f32x16&p1,lds_cptr Kslot,const bf16x8*qr,const f32x16&negm,int r32,int hi){
  const lds_cptr kb=Kslot+hi*1024+r32*16;
  #pragma unroll
  for(int d0=0;d0<4;++d0){
    const bf16x8 b0=*(const LAS bf16x8*)(kb+d0*2048);
    const bf16x8 b1=*(const LAS bf16x8*)(kb+d0*2048+512);
    if(d0==0){p0=__builtin_amdgcn_mfma_f32_32x32x16_bf16(b0,qr[0],negm,0,0,0);p1=__builtin_amdgcn_mfma_f32_32x32x16_bf16(b1,qr[0],negm,0,0,0);}
    else{p0=__builtin_amdgcn_mfma_f32_32x32x16_bf16(b0,qr[d0],p0,0,0,0);p1=__builtin_amdgcn_mfma_f32_32x32x16_bf16(b1,qr[d0],p1,0,0,0);}}
}
typedef short v4i16_t __attribute__((ext_vector_type(4)));
__device__ __forceinline__ void kload8(bf16x8*kf,lds_cptr kp){
  kf[0]=*(const LAS bf16x8*)(kp);      kf[1]=*(const LAS bf16x8*)(kp+512);
  kf[2]=*(const LAS bf16x8*)(kp+2048); kf[3]=*(const LAS bf16x8*)(kp+2560);
  kf[4]=*(const LAS bf16x8*)(kp+4096); kf[5]=*(const LAS bf16x8*)(kp+4608);
  kf[6]=*(const LAS bf16x8*)(kp+6144); kf[7]=*(const LAS bf16x8*)(kp+6656);
}
__device__ __forceinline__ void kload2(bf16x8*kf,lds_cptr kp,int j){ kf[2*j]=*(const LAS bf16x8*)(kp+j*2048); kf[2*j+1]=*(const LAS bf16x8*)(kp+j*2048+512); }
__device__ __forceinline__ s16x4 vtr(lds_cptr p){ return __builtin_bit_cast(s16x4,__builtin_amdgcn_ds_read_tr16_b64_v4i16((LAS v4i16_t*)p)); }
__device__ __forceinline__ float rowmax(const f32x16&p0,const f32x16&p1){
  float a=max3f(p0[0],p0[1],p1[0]),b=max3f(p0[2],p0[3],p1[1]);a=max3f(a,p1[2],p1[3]);
  #pragma unroll
  for(int r=4;r<16;r+=4){a=max3f(a,p0[r],p0[r+1]);b=max3f(b,p0[r+2],p0[r+3]);a=max3f(a,p1[r],p1[r+1]);b=max3f(b,p1[r+2],p1[r+3]);}
  const float m=max2f(a,b);
  auto rr=__builtin_amdgcn_permlane32_swap(__float_as_uint(m),__float_as_uint(m),false,false);
  return max2f(__uint_as_float(rr[0]),__uint_as_float(rr[1]));
}
__device__ __forceinline__ void pv(f32x16*o,int vb,bf16x8 pa0,bf16x8 pa1,bf16x8 pa2,bf16x8 pa3){
  #pragma unroll
  for(int d0=0;d0<2;++d0){s16x4 lo[4],hi[4];
    #pragma unroll
    for(int ks=0;ks<4;++ks){
      asm volatile("ds_read_b64_tr_b16 %0,%1 offset:%c2":"=&v"(lo[ks]):"v"(vb),"i"(d0*4096+ks*1024):"memory");
      asm volatile("ds_read_b64_tr_b16 %0,%1 offset:%c2":"=&v"(hi[ks]):"v"(vb),"i"(d0*4096+ks*1024+512):"memory");}
    asm volatile("s_waitcnt lgkmcnt(0)":::"memory");SBAR();
    #define PK(k) (bf16x8){lo[k][0],lo[k][1],lo[k][2],lo[k][3],hi[k][0],hi[k][1],hi[k][2],hi[k][3]}
    o[d0]=__builtin_amdgcn_mfma_f32_32x32x16_bf16(pa0,PK(0),o[d0],0,0,0);
    o[d0]=__builtin_amdgcn_mfma_f32_32x32x16_bf16(pa1,PK(1),o[d0],0,0,0);
    o[d0]=__builtin_amdgcn_mfma_f32_32x32x16_bf16(pa2,PK(2),o[d0],0,0,0);
    o[d0]=__builtin_amdgcn_mfma_f32_32x32x16_bf16(pa3,PK(3),o[d0],0,0,0);
    #undef PK
  }
}
template<int THRL> __device__ __forceinline__ void attn_unit(int b,int h,int qb,const bf16*QKV,bf16*O,LAS unsigned char*shm,const float*KMP=nullptr,const float sl2=0.f,const unsigned force_sel=0u){
  int tid=threadIdx.x; asm volatile("":"+v"(tid)); const int lane=tid&63,r32=lane&31,hi=lane>>5; const int wid=__builtin_amdgcn_readfirstlane(tid>>6);
  const long rowbase=(long)b*SEQ; const int q0=qb*QB;
  const bf16*Qw=QKV+(rowbase+q0+wid*QBLK)*DM+h*D;
  const bf16*Kh=QKV+rowbase*DM+1024+h*D,*Vh=QKV+rowbase*DM+2048+h*D;
  const unsigned lds0=(unsigned)(uintptr_t)shm;
  LAS float*wsf=(LAS float*)(shm+LDS_WS)+wid*64;
  const bf16*ksrc=Kh+(long)lane*DM+wid*8;
  const bf16*vsrc=Vh+(long)(16*(wid&3)+(lane>>2))*DM+(wid>>2)*32+(lane&3)*8;
  const unsigned kdst=lds0+LDS_K+wid*1024, vdst=lds0+LDS_V+wid*1024;
  #define DMA_K(t,slot) glds16(ksrc+(long)(t)*KVBLK*DM,(unsigned)__builtin_amdgcn_readfirstlane(kdst+(slot)))
  #define DMA_V(t,slot) glds16(vsrc+(long)(t)*KVBLK*DM,(unsigned)__builtin_amdgcn_readfirstlane(vdst+(slot)))
  const int vb0=(int)(lds0+LDS_V)+((lane>>4)&1)*32+(lane&3)*8+(4*hi+((lane&15)>>2))*64;
  bf16x8 kf[8];
  const lds_cptr shm3=(lds_cptr)shm; const lds_cptr kp0=shm3+LDS_K+hi*1024+r32*16; const lds_cptr vp0=shm3+LDS_V+((lane>>4)&1)*32+(lane&3)*8+(4*hi+((lane&15)>>2))*64;
  const int NT=(q0+QB)/KVBLK;
  DMA_K(0,0);DMA_V(0,0);DMA_K(1,SLOTB);DMA_K(2,2*SLOTB);
  bf16x8 qr[4];
  #pragma unroll
  for(int d0=0;d0<4;++d0)qr[d0]=*reinterpret_cast<const bf16x8*>(&Qw[(long)r32*DM+d0*16+hi*8]);
#if defined(EXA_G1)
  unsigned selmask=0u; bf16x8 kaug0={0,0,0,0,0,0,0,0},kaug1={0,0,0,0,0,0,0,0},qaug={0,0,0,0,0,0,0,0};
  { LAS float*kmt=(LAS float*)(shm+LDS_BYTES);
    { const int n=tid>>6,d=tid&63; if(n<qb){ const float*kp=KMP+((size_t)(b*8+n)*2)*1024+h*64+d; kmt[n*64+d]=(kp[0]+kp[1024])*(1.0f/256.0f);} }
    asm volatile("s_waitcnt lgkmcnt(0)\n\ts_barrier":::"memory");
    float gate[7];
    #pragma unroll
    for(int n=0;n<7;++n){ float g=-INFINITY; if(n<qb){ float s=0.f;
        #pragma unroll
        for(int d0=0;d0<4;++d0){ const att::f32x4 k0=*(const LAS att::f32x4*)(kmt+n*64+d0*16+hi*8),k1=*(const LAS att::f32x4*)(kmt+n*64+d0*16+hi*8+4);
          s+=att::bf2f(qr[d0][0])*k0[0]+att::bf2f(qr[d0][1])*k0[1]+att::bf2f(qr[d0][2])*k0[2]+att::bf2f(qr[d0][3])*k0[3]+att::bf2f(qr[d0][4])*k1[0]+att::bf2f(qr[d0][5])*k1[1]+att::bf2f(qr[d0][6])*k1[2]+att::bf2f(qr[d0][7])*k1[3]; }
        g=s+att::partner(s,hi);} gate[n]=g; }
    #pragma unroll
    for(int r=0;r<3;++r){ int best=-1; float bv=-INFINITY;
      #pragma unroll
      for(int n=0;n<7;++n){ const bool taken=(selmask>>n)&1u; if(!taken&&gate[n]>bv){best=n;bv=gate[n];} }
      if(best>=0)selmask|=1u<<best; }
    selmask|=(1u<<qb)|force_sel;
    if(hi==0){ const unsigned sh=__float_as_uint(sl2)+0x7fffu+((__float_as_uint(sl2)>>16)&1u),shb=sh>>16; const float rem=sl2-__uint_as_float(shb<<16); const unsigned sl=(__float_as_uint(rem)+0x7fffu+((__float_as_uint(rem)>>16)&1u))>>16;
      qaug[0]=(short)shb; qaug[1]=(short)sl; const short k0s=(short)(__float_as_uint((float)r32)>>16),k1s=(short)(__float_as_uint((float)(32+r32))>>16); kaug0[0]=k0s;kaug0[1]=k0s;kaug1[0]=k1s;kaug1[1]=k1s; } }
  asm volatile(""::"v"(selmask),"v"(kaug0),"v"(kaug1),"v"(qaug));
#endif
  float mhat=0.f,l_reg=0.f;f32x16 o[2];o[0]=f32x16{};o[1]=f32x16{};f32x16 negm=f32x16{};asm volatile("":"+v"(negm));
  const int qrel=wid*QBLK+r32;
  #define CMASK(P0,P1,t) do{int jb_=(t)-(NT-4); if(jb_>=0)cmask(P0,P1,jb_,qrel,hi);}while(0)
  bool resc=false;
  #define START(P0,P1) do{ const float rm=rowmax(P0,P1); resc=false; \
    { const float dl=rm; mhat=fadd_s(mhat,dl); \
      _Pragma("unroll") for(int r=0;r<16;++r){P0[r]=fsub_s(P0[r],dl);P1[r]=fsub_s(P1[r],dl);} \
      _Pragma("unroll") for(int r=0;r<16;++r)negm[r]=-mhat; asm volatile("":"+v"(negm)); } \
    _Pragma("unroll") for(int r=0;r<16;++r)P0[r]=__builtin_amdgcn_exp2f(P0[r]); }while(0)
  #define RESC() do{ if(resc){ asm volatile("s_waitcnt lgkmcnt(0)":::"memory"); \
      _Pragma("unroll") for(int d_=0;d_<2;++d_) _Pragma("unroll") for(int r=0;r<16;++r)o[d_][r]*=wsf[crow(r,hi)]; } }while(0)
#if defined(EXA_G3)
  const float boff=-sl2*(float)(q0+qrel);
  #define SETNEGM(t) do{ const float nv_=((selmask>>((t)>>2))&1u)?(sl2*(float)(64*(t))+boff-mhat):-INFINITY; _Pragma("unroll") for(int r=0;r<16;++r)negm[r]=nv_; asm volatile("":"+v"(negm)); }while(0)
  #define NEGMUPD() do{}while(0)
#else
  #define SETNEGM(t) do{}while(0)
  #define NEGMUPD() do{ _Pragma("unroll") for(int r=0;r<16;++r)negm[r]=-mhat; asm volatile("":"+v"(negm)); }while(0)
#endif
  f32x16 pA0,pA1,pB0,pB1;
  int sl_prev=0,sl_cur=0,sl_next=SLOTB;
  #define ROT() do{sl_prev=sl_cur;sl_cur=sl_next;sl_next=(sl_next==(NSLOT-1)*SLOTB)?0:sl_next+SLOTB;}while(0)
  WAIT_BAR(3);
  SETNEGM(0);
#if defined(EXA_G2)
  { f32x16 a0_=__builtin_amdgcn_mfma_f32_32x32x16_bf16(kaug0,qaug,negm,0,0,0), a1_=__builtin_amdgcn_mfma_f32_32x32x16_bf16(kaug1,qaug,negm,0,0,0); qkt(pA0,pA1,(lds_cptr)shm+LDS_K,qr,negm,r32,hi);
    (void)a0_; (void)a1_; }
  {
    const lds_cptr kb=(lds_cptr)shm+LDS_K+hi*1024+r32*16;
    pA0=__builtin_amdgcn_mfma_f32_32x32x16_bf16(kaug0,qaug,negm,0,0,0); pA1=__builtin_amdgcn_mfma_f32_32x32x16_bf16(kaug1,qaug,negm,0,0,0);
    #pragma unroll
    for(int d0=0;d0<4;++d0){ const bf16x8 b0=*(const LAS bf16x8*)(kb+d0*2048); const bf16x8 b1=*(const LAS bf16x8*)(kb+d0*2048+512);
      pA0=__builtin_amdgcn_mfma_f32_32x32x16_bf16(b0,qr[d0],pA0,0,0,0); pA1=__builtin_amdgcn_mfma_f32_32x32x16_bf16(b1,qr[d0],pA1,0,0,0); }
  }
#else
  qkt(pA0,pA1,(lds_cptr)shm+LDS_K,qr,negm,r32,hi);
#endif
  asm volatile("s_nop 15\n\ts_nop 7":"+v"(pA0),"+v"(pA1));CMASK(pA0,pA1,0);
#if defined(EXA_G3)
  { const float rm=rowmax(pA0,pA1); if(__builtin_expect(__any(rm>(float)THRL),0)){ const float dl=__builtin_fmaxf(rm,0.f); mhat+=dl;
      #pragma unroll
      for(int r=0;r<16;++r){pA0[r]-=dl;pA1[r]-=dl;} } }
  #pragma unroll
  for(int r=0;r<16;++r)pA0[r]=__builtin_amdgcn_exp2f(pA0[r]);
#else
  START(pA0,pA1);
#endif
  _Pragma("unroll") for(int r=0;r<16;++r)pA1[r]=__builtin_amdgcn_exp2f(pA1[r]);
  WAIT_BAR(0);
  DMA_K(3,0);DMA_V(1,SLOTB);
  ROT();
  kload8(kf,kp0+sl_cur);
  WAIT_BAR(2);
  s16x4 vlo[8],vhi[8]; u32x4 pw0,pw1,pw2,pw3;
  #define PKW(P,B) cvtpk_s(P[B],P[B+1])
  #define PAF(k) __builtin_bit_cast(bf16x8,pw##k)
  #define VFR(i) (bf16x8){vlo[i][0],vlo[i][1],vlo[i][2],vlo[i][3],vhi[i][0],vhi[i][1],vhi[i][2],vhi[i][3]}
  #define PIN(x) asm volatile("":"+v"(x))
  #define MX3(a,b,c) __builtin_fmaxf(__builtin_fmaxf((a),(b)),(c))
  #define GAPA(MF,A0,A1,A2,A3,W0,W1,PW) do{ MF; sacc+=A0; sacc+=A1; sacc+=A2; sacc+=A3; PIN(sacc); W0; W1; PIN(PW); SBAR(); }while(0)
  #define EX(v) __builtin_amdgcn_exp2f(v)
  #define GAPB(MF,X,B) do{ MF; X[B]=EX(X[B]); X[B+1]=EX(X[B+1]); X[B+2]=EX(X[B+2]); X[B+3]=EX(X[B+3]); PIN(X); SBAR(); }while(0)
  #define VRD(i) do{ vlo[i]=vtr(vp_+(((i)>>2)*4096+((i)&3)*1024)); vhi[i]=vtr(vp_+(((i)>>2)*4096+((i)&3)*1024+512)); }while(0)
  #define KRD(G,j) do{ if(G){ kload2(kf,kp0+sl_next,j); SBAR(); } }while(0)
#if defined(EXA_G2)
  #define EXA_AUG(C0,C1) do{ C0=__builtin_amdgcn_mfma_f32_32x32x16_bf16(kaug0,qaug,negm,0,0,0); C1=__builtin_amdgcn_mfma_f32_32x32x16_bf16(kaug1,qaug,negm,0,0,0); SBAR(); }while(0)
  #define EXA_C0IN(C) C
#else
  #define EXA_AUG(C0,C1) do{}while(0)
  #define EXA_C0IN(C) negm
#endif
  #define STEP(C0,C1,P0,P1,t,GK,GV,GL) do{ SBAR(); \
    const lds_cptr vp_=vp0+sl_prev; \
    EXA_AUG(C0,C1); \
    VRD(0); SBAR(); float sacc=(P0[0]+P0[1]); \
    GAPA(C0=__builtin_amdgcn_mfma_f32_32x32x16_bf16(kf[0],qr[0],EXA_C0IN(C0),0,0,0), P0[2],P0[3],P0[4],P0[5],     pw0[0]=PKW(P0,0), pw0[1]=PKW(P0,2), pw0); \
    VRD(4); SBAR(); GAPA(C1=__builtin_amdgcn_mfma_f32_32x32x16_bf16(kf[1],qr[0],EXA_C0IN(C1),0,0,0), P0[6],P0[7],P0[8],P0[9],     pw0[2]=PKW(P0,4), pw0[3]=PKW(P0,6), pw0); \
    VRD(1); SBAR(); GAPA(C0=__builtin_amdgcn_mfma_f32_32x32x16_bf16(kf[2],qr[1],C0,0,0,0),   P0[10],P0[11],P0[12],P0[13], pw1[0]=PKW(P0,8), pw1[1]=PKW(P0,10), pw1); \
    VRD(5); SBAR(); GAPA(C1=__builtin_amdgcn_mfma_f32_32x32x16_bf16(kf[3],qr[1],C1,0,0,0),   P0[14],P0[15],P1[0],P1[1],   pw1[2]=PKW(P0,12),pw1[3]=PKW(P0,14), pw1); \
    VRD(2); SBAR(); GAPA(C0=__builtin_amdgcn_mfma_f32_32x32x16_bf16(kf[4],qr[2],C0,0,0,0),   P1[2],P1[3],P1[4],P1[5],     pw2[0]=PKW(P1,0), pw2[1]=PKW(P1,2), pw2); \
    VRD(6); SBAR(); GAPA(C1=__builtin_amdgcn_mfma_f32_32x32x16_bf16(kf[5],qr[2],C1,0,0,0),   P1[6],P1[7],P1[8],P1[9],     pw2[2]=PKW(P1,4), pw2[3]=PKW(P1,6), pw2); \
    VRD(3); SBAR(); GAPA(C0=__builtin_amdgcn_mfma_f32_32x32x16_bf16(kf[6],qr[3],C0,0,0,0),   P1[10],P1[11],P1[12],P1[13], pw3[0]=PKW(P1,8), pw3[1]=PKW(P1,10), pw3); \
    VRD(7); SBAR(); GAPA(C1=__builtin_amdgcn_mfma_f32_32x32x16_bf16(kf[7],qr[3],C1,0,0,0),   P1[14],P1[15],0.f,0.f,       pw3[2]=PKW(P1,12),pw3[3]=PKW(P1,14), pw3); \
    l_reg+=sacc; \
    if(GK){DMA_K((t)+3,sl_cur);} if(GV){DMA_V((t)+1,sl_next);} \
    CMASK(C0,C1,t); \
    { float a=MX3(C0[0],C0[1],C1[0]),b=MX3(C0[2],C0[3],C1[1]); a=MX3(a,C1[2],C1[3]); \
      _Pragma("unroll") for(int r=4;r<16;r+=4){a=MX3(a,C0[r],C0[r+1]);b=MX3(b,C0[r+2],C0[r+3]);a=MX3(a,C1[r],C1[r+1]);b=MX3(b,C1[r+2],C1[r+3]);} \
      float rm=__builtin_fmaxf(a,b); { auto rr=__builtin_amdgcn_permlane32_swap(__float_as_uint(rm),__float_as_uint(rm),false,false); rm=__builtin_fmaxf(__uint_as_float(rr[0]),__uint_as_float(rr[1])); } \
      resc=false; \
      if(__builtin_expect(__any(rm>(float)THRL),0)){ const float dl=__builtin_fmaxf(rm,0.f); mhat+=dl; \
        _Pragma("unroll") for(int r=0;r<16;++r){C0[r]-=dl;C1[r]-=dl;} \
        NEGMUPD(); \
        const float f=__builtin_amdgcn_exp2f(-dl); l_reg*=f; if(hi==0)wsf[r32]=f; resc=true; } } \
    SBAR(); \
    GAPB(o[0]=__builtin_amdgcn_mfma_f32_32x32x16_bf16(PAF(0),VFR(0),o[0],0,0,0), C0,0); \
    GAPB(o[1]=__builtin_amdgcn_mfma_f32_32x32x16_bf16(PAF(0),VFR(4),o[1],0,0,0), C0,4); \
    KRD(GL,0); GAPB(o[0]=__builtin_amdgcn_mfma_f32_32x32x16_bf16(PAF(1),VFR(1),o[0],0,0,0), C0,8); \
    KRD(GL,1); GAPB(o[1]=__builtin_amdgcn_mfma_f32_32x32x16_bf16(PAF(1),VFR(5),o[1],0,0,0), C0,12); \
    KRD(GL,2); GAPB(o[0]=__builtin_amdgcn_mfma_f32_32x32x16_bf16(PAF(2),VFR(2),o[0],0,0,0), C1,0); \
    KRD(GL,3); GAPB(o[1]=__builtin_amdgcn_mfma_f32_32x32x16_bf16(PAF(2),VFR(6),o[1],0,0,0), C1,4); \
    GAPB(o[0]=__builtin_amdgcn_mfma_f32_32x32x16_bf16(PAF(3),VFR(3),o[0],0,0,0), C1,8); \
    GAPB(o[1]=__builtin_amdgcn_mfma_f32_32x32x16_bf16(PAF(3),VFR(7),o[1],0,0,0), C1,12); \
    }while(0)
  int t=1;
  #undef CMASK
  #define CMASK(P0,P1,t) do{}while(0)
  for(;t+5<NT;t+=2){
    SETNEGM(t); STEP(pB0,pB1,pA0,pA1,t,true,true,true);     WAIT_BAR(2); RESC(); ROT();
    SETNEGM(t+1); STEP(pA0,pA1,pB0,pB1,t+1,true,true,true);   WAIT_BAR(2); RESC(); ROT();
  }
  #undef CMASK
  #define CMASK(P0,P1,t) do{int jb_=(t)-(NT-4); if(jb_>=0)cmask(P0,P1,jb_,qrel,hi);}while(0)
  #define ENDW(tt) do{ if((tt)+3<NT){WAIT_BAR(2);} else if((tt)+2<NT){WAIT_BAR(1);} else {WAIT_BAR(0);} }while(0)
  for(;t+1<NT;t+=2){
    SETNEGM(t); STEP(pB0,pB1,pA0,pA1,t,(t+3<NT),(t+1<NT),(t+1<NT));       ENDW(t);   RESC(); ROT();
    SETNEGM(t+1); STEP(pA0,pA1,pB0,pB1,t+1,(t+4<NT),(t+2<NT),(t+2<NT));     ENDW(t+1); RESC(); ROT();
  }
  SETNEGM(NT-1); STEP(pB0,pB1,pA0,pA1,NT-1,false,false,false); RESC();
  { float sacc=pB0[0]+pB0[1]; _Pragma("unroll") for(int r=2;r<16;++r)sacc+=pB0[r]; _Pragma("unroll") for(int r=0;r<16;++r)sacc+=pB1[r]; l_reg+=sacc;
    pw0=(u32x4){PKW(pB0,0),PKW(pB0,2),PKW(pB0,4),PKW(pB0,6)};pw1=(u32x4){PKW(pB0,8),PKW(pB0,10),PKW(pB0,12),PKW(pB0,14)};pw2=(u32x4){PKW(pB1,0),PKW(pB1,2),PKW(pB1,4),PKW(pB1,6)};pw3=(u32x4){PKW(pB1,8),PKW(pB1,10),PKW(pB1,12),PKW(pB1,14)};
    SBAR(); pv(o,vb0+sl_cur,PAF(0),PAF(1),PAF(2),PAF(3)); }
  #undef PKW
  #undef PAF
  #undef VFR
  #undef PIN
  #undef MX3
  #undef GAPA
  #undef GAPB
  #undef EX
  #undef VRD
  #undef KRD
  #undef STEP
  #undef ENDW
  {auto rr=__builtin_amdgcn_permlane32_swap(__float_as_uint(l_reg),__float_as_uint(l_reg),false,false);l_reg=__uint_as_float(rr[0])+__uint_as_float(rr[1]);}
  if(hi==0)wsf[32+r32]=l_reg;asm volatile("s_waitcnt lgkmcnt(0)":::"memory");
  float rli[16];
  #pragma unroll
  for(int r=0;r<16;++r)rli[r]=__builtin_amdgcn_rcpf(wsf[32+crow(r,hi)]);
  bf16*Ow=O+(rowbase+q0+wid*QBLK)*1024+h*D;
  { LAS bf16*stg=(LAS bf16*)(shm+LDS_OST)+wid*2048;
    #pragma unroll
    for(int r=0;r<16;++r){const int orow=crow(r,hi);
      #pragma unroll
      for(int d0=0;d0<2;++d0)stg[orow*64+d0*32+r32]=(bf16)(cvtpk_s(o[d0][r]*rli[r],0.f)&0xffffu);}
    asm volatile("s_waitcnt lgkmcnt(0)":::"memory");
    #pragma unroll
    for(int i=0;i<4;++i){const int row=i*8+(lane>>3),ch=lane&7; const u32x4 v=*(const LAS u32x4*)(stg+row*64+ch*8); *(u32x4*)(Ow+(long)row*1024+ch*8)=v;} }
  asm volatile("s_waitcnt lgkmcnt(0)\n\ts_barrier":::"memory");
  #undef DMA_K
  #undef DMA_V
  #undef CMASK
  #undef START
  #undef RESC
  #undef ROT
}

#undef SBAR
#undef WAIT_BAR
}
#define XB_TMO      128
#define XB_XCNT(j)  (256  + 64 * (j))
#define XB_XSUB(j)  (1280 + 64 * (j))
#define XB_XGEN(j)  (2304 + 64 * (j))
#define XB_TOP      3328
#define XB_TOPGEN   3392
#define XCD_BAR_WORDS 3456
#define XB_SPIN_CAP (1u << 18)

__device__ __forceinline__ unsigned xb_ld(unsigned* p)              { return __hip_atomic_load(p, __ATOMIC_RELAXED, __HIP_MEMORY_SCOPE_AGENT); }
__device__ __forceinline__ unsigned xb_add(unsigned* p, unsigned v) { return __hip_atomic_fetch_add(p, v, __ATOMIC_RELAXED, __HIP_MEMORY_SCOPE_AGENT); }
__device__ __forceinline__ unsigned xb_xcc_id() { return (unsigned)__builtin_amdgcn_s_getreg((3 << 11) | 20) & 0xFu; }
#define XB_SPIN(cond, bar) do { unsigned _sp = 0; while (cond) { __builtin_amdgcn_s_sleep(1); \
    if ((++_sp & 255u) == 0u) { if (xb_ld(&(bar)[XB_TMO])) break; if (_sp > XB_SPIN_CAP) { atomicAdd(&(bar)[XB_TMO], 1u); break; } } } } while (0)

struct XcdBarrier {
    unsigned* bar; unsigned x;
    volatile LAS unsigned* st;
};

__device__ __forceinline__ XcdBarrier xcd_barrier_post(unsigned* bar, volatile LAS unsigned* st) {
    XcdBarrier b; b.bar = bar; b.x = xb_xcc_id(); b.st = st;
    if (threadIdx.x == 0) (void)xb_add(&bar[XB_XCNT(b.x)], 1u);
    return b;
}
__device__ __forceinline__ void xcd_barrier_complete(unsigned* bar, unsigned x, unsigned& nloc, unsigned& nx) {
    const unsigned G = gridDim.x * gridDim.y * gridDim.z;
    unsigned sum, cnt, mine, sp = 0u;
    for (;;) {
        sum = 0u; cnt = 0u; mine = 0u;
#pragma unroll
        for (unsigned j = 0; j < 16; ++j) { const unsigned c = xb_ld(&bar[XB_XCNT(j)]); sum += c; cnt += (c > 0u) ? 1u : 0u; mine = (j == x) ? c : mine; }
        if (sum == G) break;
        __builtin_amdgcn_s_sleep(1);
        if ((++sp & 255u) == 0u) { if (xb_ld(&bar[XB_TMO])) break; if (sp > XB_SPIN_CAP) { atomicAdd(&bar[XB_TMO], 1u); break; } }
    }
    nloc = mine > 0u ? mine : 1u; nx = cnt > 0u ? cnt : 1u;
}

__device__ __forceinline__ void xcd_barrier(const XcdBarrier& b) {
    asm volatile("s_waitcnt vmcnt(0)" ::: "memory");
    __syncthreads();
    if (threadIdx.x == 0) {
        unsigned* bar = b.bar;
        __builtin_amdgcn_s_waitcnt(0);
        unsigned nloc = b.st[0], nx = b.st[1];
        if (nloc == 0u) { xcd_barrier_complete(bar, b.x, nloc, nx); b.st[0] = nloc; b.st[1] = nx; }
        const unsigned old = xb_add(&bar[XB_XSUB(b.x)], 1u);
        const unsigned gen = old / nloc;
        if (old + 1u == (gen + 1u) * nloc) {
            __builtin_amdgcn_fence(__ATOMIC_RELEASE, "agent");
            asm volatile("s_waitcnt vmcnt(0)" ::: "memory");
            const unsigned og = xb_add(&bar[XB_TOP], 1u);
            const unsigned tg = og / nx;
            if (og + 1u == (tg + 1u) * nx) xb_add(&bar[XB_TOPGEN], 1u);
            else XB_SPIN(xb_ld(&bar[XB_TOPGEN]) == tg, bar);
            __builtin_amdgcn_fence(__ATOMIC_ACQUIRE, "agent");
            xb_add(&bar[XB_XGEN(b.x)], 1u);
            asm volatile("s_waitcnt vmcnt(0)" ::: "memory");
        } else {
            XB_SPIN(xb_ld(&bar[XB_XGEN(b.x)]) == gen, bar);
            __builtin_amdgcn_fence(__ATOMIC_ACQUIRE, "agent");
            asm volatile("s_waitcnt vmcnt(0)" ::: "memory");
        }
    }
    __syncthreads();
}

__device__ __forceinline__ void xcd_local_barrier(unsigned* lb, unsigned* gbar, unsigned x, unsigned nloc) {
    asm volatile("s_waitcnt vmcnt(0)" ::: "memory");
    __syncthreads();
    if (threadIdx.x == 0) {
        __builtin_amdgcn_s_waitcnt(0);
        const unsigned old = xb_add(&lb[64 * x], 1u);
        const unsigned gen = old / nloc;
        if (old + 1u == (gen + 1u) * nloc) xb_add(&lb[1024 + 64 * x], 1u);
        else XB_SPIN(xb_ld(&lb[1024 + 64 * x]) == gen, gbar);
        __builtin_amdgcn_fence(__ATOMIC_ACQUIRE, "agent");
        asm volatile("s_waitcnt vmcnt(0)" ::: "memory");
    }
    __syncthreads();
}
#ifndef DBG_MASK
#define DBG_MASK 255
#endif
#ifndef GEMM_XDMA
#define GEMM_XDMA false
#endif
#ifndef GU_ALIGN
#define GU_ALIGN true
#endif
#ifndef DUP_MASK
#define DUP_MASK 0
#endif
#define NREP(bit) ((DUP_MASK & (bit)) ? 2 : 1)
constexpr int NWAVES = 8;
constexpr int NBATCH = 8, SEQ = 2048, D = 1024, FF = 2816, M = NBATCH * SEQ, DEPTH = 4;
constexpr int N_PHASES = 2 + 7 * DEPTH;
constexpr float QSCALE = 0.125f * 1.4426950408889634f;
typedef unsigned short bf16;
typedef float f32x4 __attribute__((ext_vector_type(4)));
typedef unsigned v4u __attribute__((ext_vector_type(4)));
typedef GAS unsigned gu32;
#define RLX_AGENT __ATOMIC_RELAXED, __HIP_MEMORY_SCOPE_AGENT
constexpr size_t MiB = 1u << 20;
constexpr size_t WS_CTL = 0, CTL_ZERO_BYTES = 1 * MiB;
constexpr size_t WS_WGU = 1 * MiB;
constexpr size_t WS_WD = 89 * MiB;
constexpr size_t WS_WIN_E = 133 * MiB;
constexpr size_t WS_WOUT_E = 141 * MiB;
constexpr size_t WS_WQKV_O = 145 * MiB;
constexpr size_t WS_WO_O = 157 * MiB;
constexpr size_t WS_XB = 161 * MiB;
constexpr size_t WS_SS = 193 * MiB;
constexpr size_t WS_KMP = 194 * MiB;
constexpr size_t WS_QKV = 195 * MiB;
constexpr size_t WS_O = 291 * MiB;
constexpr size_t WS_END = 323 * MiB;
constexpr size_t WGU_BYTES = (size_t)2 * FF * D * 2, WD_BYTES = (size_t)D * FF * 2;
static_assert(WS_WGU + 8 * WGU_BYTES <= WS_WD && WS_WD + 8 * WD_BYTES <= WS_WIN_E && WS_QKV + (size_t)M * 3072 * 2 <= WS_O && WS_O + (size_t)M * D * 2 <= WS_END, "d_ws map");
constexpr int CW_BAR = 4096;
constexpr int CW_LBAR = 16384, CW_TICKET = 20480;
#ifndef LOCAL_BARRIERS
#define LOCAL_BARRIERS 1
#endif
constexpr int RING_OFF = 0, RING_BYTES = 131072;
constexpr int P0_TS = 65, P0_SCR_BYTES = 64 * P0_TS * 4;
constexpr int LDSCTL_OFF = pg8::HM_STAGE_BYTES, MISC_OFF = LDSCTL_OFF + 320;
constexpr int LDS_BYTES = LDSCTL_OFF + 1024;
static_assert(att::LDS_END <= RING_BYTES && exa::LDS_BYTES + 2048 <= RING_BYTES && MISC_OFF + 128 <= LDS_BYTES && 8 * P0_SCR_BYTES <= LDSCTL_OFF && LDS_BYTES <= 160 * 1024, "LDS map");

__device__ __forceinline__ unsigned f2bf(float f) { unsigned u = __builtin_bit_cast(unsigned, f); return (u + 0x7fffu + ((u >> 16) & 1u)) >> 16; }
__device__ __forceinline__ unsigned pk2(float lo, float hi) { return att::cvtpk(lo, hi); }
__device__ __forceinline__ float wave_sum(float v) {
#pragma unroll
    for (int o = 1; o < 64; o <<= 1) v += __shfl_xor(v, o);
    return v;
}
#define LDS_WAIT() asm volatile("s_waitcnt lgkmcnt(0)" ::: "memory")
#define VM_WAIT() asm volatile("s_waitcnt vmcnt(0)" ::: "memory")

__device__ __forceinline__ void p0_write_tile(bf16* WT, int K, int dst_row0, int k0, LAS float* scr, int lane) {
    LDS_WAIT(); asm volatile("" ::: "memory");
    const int c = lane & 7, nn = lane >> 3;
#pragma unroll
    for (int j = 0; j < 8; ++j) { const int n = nn + 8 * j; const LAS float* s = scr + (8 * c) * P0_TS + n;
        v4u o; o.x = pk2(s[0 * P0_TS], s[1 * P0_TS]); o.y = pk2(s[2 * P0_TS], s[3 * P0_TS]); o.z = pk2(s[4 * P0_TS], s[5 * P0_TS]); o.w = pk2(s[6 * P0_TS], s[7 * P0_TS]);
        *(GAS v4u*)(WT + (size_t)(dst_row0 + n) * K + k0 + 8 * c) = o; }
    LDS_WAIT(); asm volatile("" ::: "memory");
}
#if defined(P0_NT)
#define P0_LOADW(p) __builtin_nontemporal_load(p)
#else
#define P0_LOADW(p) (*(p))
#endif
struct P0Item { const float* W; const float* gain; bf16* WT; int ldw, K, dst_row0, k0, n0; };
__device__ __forceinline__ void p0_item_load(const P0Item& d, f32x4 (&v)[16], float (&g)[16], int lane) {
    const int q = lane >> 4, p = lane & 15;
#pragma unroll
    for (int i = 0; i < 16; ++i) { v[i] = P0_LOADW((const GAS f32x4*)(d.W + (size_t)(d.k0 + 4 * i + q) * d.ldw + d.n0 + 4 * p)); g[i] = d.gain ? d.gain[d.k0 + 4 * i + q] : 1.0f; }
}
__device__ __forceinline__ void p0_item_finish(const P0Item& d, const f32x4 (&v)[16], const float (&g)[16], LAS float* scr, int lane) {
    const int q = lane >> 4, p = lane & 15;
#pragma unroll
    for (int i = 0; i < 16; ++i) { LAS float* dd = scr + (4 * i + q) * P0_TS + 4 * p; dd[0] = v[i][0] * g[i]; dd[1] = v[i][1] * g[i]; dd[2] = v[i][2] * g[i]; dd[3] = v[i][3] * g[i]; }
    p0_write_tile(d.WT, d.K, d.dst_row0, d.k0, scr, lane);
}
typedef const float __attribute__((address_space(4))) cfloat_t;
__device__ __forceinline__ void p0_fold_sub(const float* Win  , const float* Wp  , const float* pscale  , const float* gain, bf16* WT, int k0, int n0, int lane) {
    const int g = n0 >> 7, d = (n0 & 127) + lane;
    const float* wpb = Wp + (size_t)g * 128 * 128 + d;
    cfloat_t* wrow = (cfloat_t*)(Win + (size_t)k0 * 2048 + 1536 + g * 128);
    cfloat_t* gk = (cfloat_t*)(gain + k0);
    float acc[8];
#pragma unroll
    for (int k = 0; k < 8; ++k) acc[k] = 0.f;
#pragma unroll 1
    for (int c0 = 0; c0 < 128; c0 += 32) {
        float wp[32];
#pragma unroll
        for (int c = 0; c < 32; ++c) wp[c] = wpb[(size_t)(c0 + c) * 128];
#pragma unroll
        for (int k = 0; k < 8; ++k)
#pragma unroll
            for (int c = 0; c < 32; ++c) acc[k] = __builtin_fmaf(wrow[(size_t)k * 2048 + c0 + c], wp[c], acc[k]);
    }
    const float ps = pscale[g * 128 + d];
    v4u o; o.x = pk2(acc[0] * ps * gk[0], acc[1] * ps * gk[1]); o.y = pk2(acc[2] * ps * gk[2], acc[3] * ps * gk[3]); o.z = pk2(acc[4] * ps * gk[4], acc[5] * ps * gk[5]); o.w = pk2(acc[6] * ps * gk[6], acc[7] * ps * gk[7]);
    *(GAS v4u*)(WT + (size_t)(1536 + n0 + lane) * 1024 + k0) = o;
}

struct Args { const float* in[17]; float* out; unsigned char* ws; int ph_lo, ph_hi; };

__device__ __forceinline__ void p0_prologue(const Args& a, unsigned char* ws, LAS unsigned char* lds, int vcu, int G, int wave, int lane) {
    LAS float* scr = (LAS float*)(lds + wave * P0_SCR_BYTES);
    const int gw = vcu * NWAVES + wave, NGW = G * NWAVES;
    constexpr int I_GU = 16 * 44, I_DN = 44 * 16, I_EIN = 16 * 24, I_EFO = 16 * 8, I_SQ = 16 * 16, I_OQKV = 16 * 48;
    constexpr int S_G = 0, S_U = S_G + 8 * I_GU, S_D = S_U + 8 * I_GU, S_EIN = S_D + 8 * I_DN, S_EOUT = S_EIN + 2 * I_EIN, S_OQKV = S_EOUT + 2 * I_SQ, S_OO = S_OQKV + 2 * I_OQKV, NITEMS = S_OO + 2 * I_SQ;
    auto decode = [&](int it) -> P0Item {
        P0Item d;
        if (it < S_D) {
            const bool up = it >= S_U; const int r0 = it - (up ? S_U : S_G), f = r0 / I_GU, r = r0 % I_GU, layer = f >> 1, half = f & 1, kb = r / 44, nb = r % 44, n0 = 64 * nb;
            d.W = a.in[half ? (up ? 8 : 7) : (up ? 3 : 2)] + (size_t)layer * D * FF; d.gain = a.in[half ? 6 : 1] + layer * D; d.WT = (bf16*)(ws + WS_WGU + (size_t)f * WGU_BYTES);
            d.ldw = FF; d.K = D; d.dst_row0 = (n0 >> 7) * 256 + (up ? 128 : 0) + (n0 & 127); d.k0 = 64 * kb; d.n0 = n0;
        } else if (it < S_EIN) {
            const int r0 = it - S_D, f = r0 / I_DN, r = r0 % I_DN, layer = f >> 1, half = f & 1, kb = r / 16, nb = r % 16;
            d.W = a.in[half ? 9 : 4] + (size_t)layer * FF * D; d.gain = nullptr; d.WT = (bf16*)(ws + WS_WD + (size_t)f * WD_BYTES); d.ldw = D; d.K = FF; d.dst_row0 = 64 * nb; d.k0 = 64 * kb; d.n0 = 64 * nb;
        } else if (it < S_EOUT) {
            const int r0 = it - S_EIN, i = r0 / I_EIN, r = r0 % I_EIN, kb = r / 24, nb = r % 24;
            d.W = a.in[10] + (size_t)i * D * 2048; d.gain = a.in[5] + (2 * i) * D; d.WT = (bf16*)(ws + WS_WIN_E + (size_t)i * 2048 * D * 2); d.ldw = 2048; d.K = D; d.dst_row0 = 64 * nb; d.k0 = 64 * kb; d.n0 = 64 * nb;
        } else if (it < S_OQKV) {
            const int r0 = it - S_EOUT, i = r0 / I_SQ, r = r0 % I_SQ, kb = r / 16, nb = r % 16;
            d.W = a.in[13] + (size_t)i * D * D; d.gain = nullptr; d.WT = (bf16*)(ws + WS_WOUT_E + (size_t)i * D * D * 2); d.ldw = D; d.K = D; d.dst_row0 = 64 * nb; d.k0 = 64 * kb; d.n0 = 64 * nb;
        } else if (it < S_OO) {
            const int r0 = it - S_OQKV, i = r0 / I_OQKV, r = r0 % I_OQKV, kb = r / 48, nb = r % 48;
            d.W = a.in[14] + (size_t)i * D * 3072; d.gain = a.in[5] + (2 * i + 1) * D; d.WT = (bf16*)(ws + WS_WQKV_O + (size_t)i * 3072 * D * 2); d.ldw = 3072; d.K = D; d.dst_row0 = 64 * nb; d.k0 = 64 * kb; d.n0 = 64 * nb;
        } else {
            const int r0 = it - S_OO, i = r0 / I_SQ, r = r0 % I_SQ, kb = r / 16, nb = r % 16;
            d.W = a.in[15] + (size_t)i * D * D; d.gain = nullptr; d.WT = (bf16*)(ws + WS_WO_O + (size_t)i * D * D * 2); d.ldw = D; d.K = D; d.dst_row0 = 64 * nb; d.k0 = 64 * kb; d.n0 = 64 * nb;
        }
        return d;
    };
    if (gw < NITEMS) {
        P0Item cur = decode(gw); f32x4 v[16]; float g[16];
        p0_item_load(cur, v, g, lane);
        for (int it = gw; it < NITEMS; it += NGW) {
            const bool more = it + NGW < NITEMS;
            P0Item nxt = cur; f32x4 v2[16]; float g2[16];
            if (more) { nxt = decode(it + NGW); p0_item_load(nxt, v2, g2, lane); }
            p0_item_finish(cur, v, g, scr, lane);
            if (more) { cur = nxt;
#pragma unroll
                for (int i = 0; i < 16; ++i) { v[i] = v2[i]; g[i] = g2[i]; } }
        }
    }
#if defined(P0_FOLD_DUP)
    for (int rep_ = 0; rep_ < P0_FOLD_DUP; ++rep_)
#endif
    for (int s0 = gw; s0 < 2 * 128 * 8; s0 += NGW) {
        const int i = s0 >> 10, r = s0 & 1023, kb = r >> 3, nb = r & 7;
        p0_fold_sub(a.in[10] + (size_t)i * D * 2048, a.in[11] + (size_t)i * 4 * 128 * 128, a.in[12] + i * 512, a.in[5] + (2 * i) * D, (bf16*)(ws + WS_WIN_E + (size_t)i * 2048 * D * 2), 8 * kb, 64 * nb, lane);
    }
    const float* x = a.in[0]; bf16* XB = (bf16*)(ws + WS_XB); float* SS = (float*)(ws + WS_SS);
#if defined(P0_XB_DUP)
    for (int rep_ = 0; rep_ < P0_XB_DUP; ++rep_)
#endif
    {
        f32x4 v[4];
        if (gw < M) { const GAS f32x4* xr = (const GAS f32x4*)(x + (size_t)gw * D) + lane;
#pragma unroll
            for (int j = 0; j < 4; ++j) v[j] = xr[64 * j]; }
        for (int m = gw; m < M; m += NGW) {
            f32x4 vn[4];
            if (m + NGW < M) { const GAS f32x4* xr = (const GAS f32x4*)(x + (size_t)(m + NGW) * D) + lane;
#pragma unroll
                for (int j = 0; j < 4; ++j) vn[j] = xr[64 * j]; }
            float s = 0.f;
#pragma unroll
            for (int j = 0; j < 4; ++j) s += (v[j].x * v[j].x + v[j].y * v[j].y) + (v[j].z * v[j].z + v[j].w * v[j].w);
            s = wave_sum(s);
            GAS unsigned long long* o8 = (GAS unsigned long long*)(XB + (size_t)m * D) + lane;
#pragma unroll
            for (int j = 0; j < 4; ++j) o8[64 * j] = (unsigned long long)pk2(v[j].x, v[j].y) | ((unsigned long long)pk2(v[j].z, v[j].w) << 32);
            if (lane < 16) SS[(size_t)m * 16 + lane] = (lane == 0) ? s : 0.f;
            if (m + NGW < M) {
#pragma unroll
                for (int j = 0; j < 4; ++j) v[j] = vn[j]; }
        }
    }
}
__device__ __forceinline__ void pool_rows(const bf16* QKV, bf16* O, int vcu, int G, int tid) {
    asm volatile("" : "+v"(tid));
    const int cc = tid & 63, rg = tid >> 6, g = cc >> 4, w = 2 << g;
    for (int R0 = vcu * 64; R0 < M; R0 += G * 64) {
#pragma unroll 1
        for (int rr = 0; rr < 8; ++rr) {
            const int row = R0 + rg * 8 + rr, t = row & (SEQ - 1);
            const int cnt = (t + 1) < w ? (t + 1) : w;
            float s[8];
#pragma unroll
            for (int e = 0; e < 8; ++e) s[e] = 0.f;
            v4u cur = {0u, 0u, 0u, 0u};
            for (int i = 0; i < cnt; ++i) {
                const v4u v = *(const v4u*)(QKV + (size_t)(row - i) * pg8::HPITCH + 1536 + cc * 8);
                if (i == 0) cur = v;
                s[0] += __builtin_bit_cast(float, v.x << 16); s[1] += __builtin_bit_cast(float, v.x & 0xffff0000u);
                s[2] += __builtin_bit_cast(float, v.y << 16); s[3] += __builtin_bit_cast(float, v.y & 0xffff0000u);
                s[4] += __builtin_bit_cast(float, v.z << 16); s[5] += __builtin_bit_cast(float, v.z & 0xffff0000u);
                s[6] += __builtin_bit_cast(float, v.w << 16); s[7] += __builtin_bit_cast(float, v.w & 0xffff0000u);
            }
            const float rc = 1.0f / (float)cnt;
            v4u o;
            o.x = pk2(s[0] * rc - __builtin_bit_cast(float, cur.x << 16), s[1] * rc - __builtin_bit_cast(float, cur.x & 0xffff0000u));
            o.y = pk2(s[2] * rc - __builtin_bit_cast(float, cur.y << 16), s[3] * rc - __builtin_bit_cast(float, cur.y & 0xffff0000u));
            o.z = pk2(s[4] * rc - __builtin_bit_cast(float, cur.z << 16), s[5] * rc - __builtin_bit_cast(float, cur.z & 0xffff0000u));
            o.w = pk2(s[6] * rc - __builtin_bit_cast(float, cur.w << 16), s[7] * rc - __builtin_bit_cast(float, cur.w & 0xffff0000u));
            *(v4u*)(O + (size_t)row * 1024 + 512 + cc * 8) = o;
        }
    }
}
__device__ __forceinline__ void final_norm(const bf16* XBs, float* out, const float* SS, const float* gfin, int vcu, int G, int wave, int lane) {
    const int gw = vcu * NWAVES + wave, NGW = G * NWAVES;
    f32x4 gv[2][2];
#pragma unroll
    for (int j = 0; j < 2; ++j) { gv[j][0] = *(const f32x4*)(gfin + 512 * j + 8 * lane); gv[j][1] = *(const f32x4*)(gfin + 512 * j + 8 * lane + 4); }
    for (int m0 = gw * 8; m0 < M; m0 += NGW * 8) for (int m = m0; m < m0 + 8; ++m) {
        float s = (lane < 16) ? SS[(size_t)m * 16 + lane] : 0.f;
        s = wave_sum(s);
        const float r = 1.0f / sqrtf(s * (1.0f / D) + 1e-6f);
#pragma unroll
        for (int j = 0; j < 2; ++j) {
            const v4u b = *(const GAS v4u*)(XBs + (size_t)m * D + 512 * j + 8 * lane);
            const f32x4 x0 = {__builtin_bit_cast(float, b.x << 16), __builtin_bit_cast(float, b.x & 0xffff0000u), __builtin_bit_cast(float, b.y << 16), __builtin_bit_cast(float, b.y & 0xffff0000u)};
            const f32x4 x1 = {__builtin_bit_cast(float, b.z << 16), __builtin_bit_cast(float, b.z & 0xffff0000u), __builtin_bit_cast(float, b.w << 16), __builtin_bit_cast(float, b.w & 0xffff0000u)};
            GAS f32x4* o = (GAS f32x4*)(out + (size_t)m * D + 512 * j + 8 * lane);
            o[0] = x0 * r * gv[j][0]; o[1] = x1 * r * gv[j][1];
        }
    }
}

#if defined(CMP_PROBE)
__device__ __forceinline__ void cmp_unit(const bf16* A, const bf16* B, int b, int h, int qb, int cls, gu32* word, int tid) {
    asm volatile("" : "+v"(tid));
    __threadfence(); __syncthreads();
    unsigned bucket = 0u;
    if (tid < 256) {
        float se = 0.f, sx = 0.f;
        for (int c = 0; c < 64; ++c) { const size_t idx = ((size_t)b * SEQ + qb * 256 + tid) * 1024 + h * 64 + c;
            const float x = __builtin_bit_cast(float, (unsigned)A[idx] << 16), y = __builtin_bit_cast(float, (unsigned)B[idx] << 16);
            se += (x - y) * (x - y); sx += x * x; }
        const float rel = sqrtf(se / (sx + 1e-12f));
#if defined(CMP_BUCKETS)
        if (rel > 0.02f) bucket |= 4u; if (rel > 0.05f) bucket |= 8u; if (rel > 0.15f) bucket |= 16u; if (rel > 0.5f) bucket |= 32u; if (rel > 1.5f) bucket |= 64u; if (!(rel == rel)) bucket |= 128u;
#else
        if (!(rel <= CMP_RTOL)) bucket |= 1u << cls;
#endif
    }
    if (bucket) __hip_atomic_fetch_or(word, bucket, __ATOMIC_RELAXED, __HIP_MEMORY_SCOPE_AGENT);
    __syncthreads();
}
#endif
__global__ void __launch_bounds__(NWAVES * 64, 2) mk_fwd(Args args) {
    extern __shared__ __attribute__((aligned(16))) unsigned char lds_raw[];
    LAS unsigned char* lds = (LAS unsigned char*)lds_raw;
    volatile LAS unsigned* MISC = (volatile LAS unsigned*)(lds + MISC_OFF);
    const int tid = threadIdx.x, lane = tid & 63, wave = __builtin_amdgcn_readfirstlane(tid >> 6);
    const int G = gridDim.x; int bx = blockIdx.x; int vcu = (G % 8 == 0) ? (bx % 8) * (G / 8) + bx / 8 : bx;
    unsigned char* ws = args.ws;
    gu32* ctl = (gu32*)(ws + WS_CTL);
    for (int u = tid; u < (LDS_BYTES - LDSCTL_OFF) / 4; u += NWAVES * 64) ((LAS unsigned*)(lds + LDSCTL_OFF))[u] = 0u;
    __syncthreads();
    XcdBarrier bar; bar.bar = (unsigned*)(ctl + CW_BAR); bar.x = 0; bar.st = nullptr;
    if (MK_N_LAUNCHES == 1) bar = xcd_barrier_post((unsigned*)(ctl + CW_BAR), MISC + 8);
    if (LOCAL_BARRIERS && MK_N_LAUNCHES == 1 && tid == 0) MISC[12] = xb_add((unsigned*)(ctl + CW_TICKET) + 64 * bar.x, 1u);
    const int lo = args.ph_lo, hi = args.ph_hi;
#define IN(k) (lo <= (k) && (k) < hi)
#if defined(BAR_DUP)
#define SEAM(k) do { if (IN(k) && IN((k) + 1)) { xcd_barrier(bar); xcd_barrier(bar); } } while (0)
#else
#define SEAM(k) do { if (IN(k) && IN((k) + 1)) { if (local_mode) xcd_local_barrier((unsigned*)(ctl + CW_LBAR), bar.bar, bar.x, 32u); else xcd_barrier(bar); } PT_STAMP(k); } while (0)
#endif
#if defined(PT_MASK)
    unsigned long long pt_acc = 0, pt_last = __builtin_amdgcn_s_memrealtime();
#define PT_CLASS(k) ((k) == 0 ? 1 : (k) == N_PHASES - 1 ? 128 : (k) == 7 * DEPTH ? 256 : (((k) - 1) % 7 == 0 || ((k) - 1) % 7 == 5) ? 2 : (((k) - 1) % 7 == 1 || ((k) - 1) % 7 == 6) ? 4 : ((k) - 1) % 7 == 2 ? 8 : ((k) - 1) % 7 == 3 ? ((((k) - 1) / 7) & 1 ? 32 : 16) : 64)
#define PT_STAMP(k) do { const unsigned long long t_ = __builtin_amdgcn_s_memrealtime(); if (PT_CLASS(k) & (PT_MASK)) pt_acc += t_ - pt_last; pt_last = t_; } while (0)
#else
#define PT_STAMP(k) do {} while (0)
#endif

    bf16* XB = (bf16*)(ws + WS_XB); float* SS = (float*)(ws + WS_SS); float* KMP = (float*)(ws + WS_KMP);
    bf16* QKV = (bf16*)(ws + WS_QKV); bf16* HB = (bf16*)(ws + WS_QKV); bf16* OB = (bf16*)(ws + WS_O);

    bool local_mode = false;
#if defined(P0_TIME_PROBE)
    const unsigned long long p0_t0 = __builtin_amdgcn_s_memrealtime();
#endif
    if ((DBG_MASK & 1) && IN(0)) { for (int rep = 0; rep < NREP(1); ++rep) { p0_prologue(args, ws, lds, vcu, G, wave, lane); __syncthreads(); } }
    SEAM(0);
#if defined(P0_TIME_PROBE)
    const unsigned long long p0_dt = __builtin_amdgcn_s_memrealtime() - p0_t0;
#endif
#if LOCAL_BARRIERS
    if (MK_N_LAUNCHES == 1 && G == 256 && IN(0) && IN(1)) {
        if (tid == 0) { unsigned ok = 1u;
#pragma unroll
            for (unsigned j = 0; j < 16; ++j) { const unsigned c = xb_ld(bar.bar + XB_XCNT(j)); ok &= (j < 8u) ? (c == 32u ? 1u : 0u) : (c == 0u ? 1u : 0u); }
#if defined(FORCE_FALLBACK)
            ok = 0u;
#endif
            MISC[13] = (ok && MISC[12] < 32u && bar.x < 8u) ? 1u : 0u; }
        __syncthreads();
        local_mode = __builtin_amdgcn_readfirstlane(MISC[13]) != 0u;
        if (local_mode) { const int rank = __builtin_amdgcn_readfirstlane(MISC[12]); bx = rank * 8 + (int)bar.x; vcu = (int)bar.x * 32 + rank; }
    }
#endif

    for (int layer = 0; layer < DEPTH; ++layer) {
        const int pb = 1 + 7 * layer;
        for (int half = 0; half < 2; ++half) {
            const int f = layer * 2 + half, pg = pb + (half ? 5 : 0);
            if ((DBG_MASK & 2) && IN(pg)) for (int rep = 0; rep < NREP(2); ++rep) {
                pg8::Gemm g{XB, (const bf16*)(ws + WS_WGU + (size_t)f * WGU_BYTES), M, 2 * FF, D}; pg8::StaticOrder S; S.init(M, 2 * FF, G, bx);
#if defined(GU_PROBE_VARIANT)
#if defined(GU_KPROBE)
                if (rep == 1) { pg8::EpiGUProbe<GU_KPROBE> E{}; E.H = HB; E.SS = SS; pg8::gemm_phase<pg8::EpiGUProbe<GU_KPROBE>, pg8::StaticOrder, true, true, GEMM_XDMA>(lds + RING_OFF, g, S, E); } else
#else
                if (rep == 1) { pg8::EpiGU_<GU_PROBE_VARIANT> E{HB, SS}; pg8::gemm_phase<pg8::EpiGU_<GU_PROBE_VARIANT>, pg8::StaticOrder, true, true, GEMM_XDMA>(lds + RING_OFF, g, S, E); } else
#endif
#endif
                { pg8::EpiGU E{HB, SS};
                const int fullr = S.nwg / G, rem = S.nwg - fullr * G; const bool hm = (2 * rem == G) && (G % 16 == 0);
                if (hm) S.maxr = fullr;
                pg8::gemm_phase<pg8::EpiGU, pg8::StaticOrder, GU_ALIGN, true, GEMM_XDMA>(lds + RING_OFF, g, S, E);
                if (hm) { const int j = bx >> 3; pg8::Unit uu; S.unit_of((long)fullr * G + (bx & 7) + 8 * (j >> 1), uu); const pg8::HUnit hu{uu.pm * 2 + (j & 1), uu.pn};
                    pg8::gemm_half_unit<pg8::EpiGU>(lds + RING_OFF, g, hu, E);
#if defined(HM_DUP)
                    __syncthreads(); pg8::gemm_half_unit<pg8::EpiGU>(lds + RING_OFF, g, hu, E);
#endif
                    } }
            }
            SEAM(pg);
            if ((DBG_MASK & 4) && IN(pg + 1)) for (int rep = 0; rep < NREP(4); ++rep) {
                pg8::Gemm g{HB, (const bf16*)(ws + WS_WD + (size_t)f * WD_BYTES), M, D, FF, pg8::HPITCH}; pg8::StaticOrder S; S.init(M, D, G, bx);
#if defined(DOWN_NOOP_PROBE)
                if (rep == 1) { pg8::EpiResNoop E; pg8::gemm_phase<pg8::EpiResNoop, pg8::StaticOrder, true, true, GEMM_XDMA>(lds + RING_OFF, g, S, E); } else {
#endif
                pg8::EpiRes E{XB, SS, rep ? 0.0f : 0.5f};
                pg8::gemm_phase<pg8::EpiRes, pg8::StaticOrder, true, true, GEMM_XDMA>(lds + RING_OFF, g, S, E);
#if defined(DOWN_NOOP_PROBE)
                }
#endif
            }
            SEAM(pg + 1);
            if (half == 0) {
                const int i2 = layer >> 1; const bool odd = layer & 1;
                if ((DBG_MASK & 8) && IN(pb + 2)) for (int rep = 0; rep < NREP(8); ++rep) {
                    const int N = odd ? 3072 : 2048;
                    pg8::Gemm g{XB, (const bf16*)(ws + (odd ? WS_WQKV_O + (size_t)i2 * 3072 * D * 2 : WS_WIN_E + (size_t)i2 * 2048 * D * 2)), M, N, D}; pg8::StaticOrder S; S.init(M, N, G, bx);
                    pg8::EpiQKV E{QKV, pg8::HPITCH, SS, odd ? 4 : 2, QSCALE, odd ? KMP : nullptr, 4, 8};
                    pg8::gemm_phase<pg8::EpiQKV, pg8::StaticOrder, true, true, GEMM_XDMA>(lds + RING_OFF, g, S, E);
                }
                SEAM(pb + 2);
                if (IN(pb + 3)) {
                    if ((DBG_MASK & 16) && !odd) for (int rep = 0; rep < NREP(16); ++rep) {
                        for (int ui = vcu; ui < 512; ui += G) {
                            const int bh = (ui & 255) >> 2, s = ui & 3, qb = (ui >> 8) ? 7 - s : s;
                            att::attn_unit<false>(bh >> 3, bh & 7, qb, QKV, pg8::HPITCH, 512, 1024, OB, lds + RING_OFF, nullptr, 0.f);
                        }
                        pool_rows(QKV, OB, vcu, G, tid);
                    } else if (DBG_MASK & 32) for (int rep = 0; rep < NREP(32); ++rep) {
                        for (int ui = vcu; ui < 1024; ui += G) {
                            const int bh = (ui & 255) >> 1, j = ui & 1, k = ui >> 8;
                            const int qb = (k == 0) ? (j ? 6 : 7) : (k == 1) ? (j ? 5 : 4) : (k == 2) ? (j ? 2 : 3) : (j ? 1 : 0);
                            const int h = bh & 15;
                            const float sl2 = exp2f(-0.5f * (float)(h + 1)) * 1.4426950408889634f;
#if defined(CMP_PROBE)
                            att::attn_unit<true>(bh >> 4, h, qb, QKV, 3072, 1024, 2048, OB, lds + RING_OFF, KMP, sl2);
                            if ((bh >> 4) < 4) {
                                att::attn_unit<true>(bh >> 4, h, qb, QKV, 3072, 1024, 2048, (bf16*)(ws + WS_END), lds + RING_OFF, KMP, CMP_SL2, CMP_FORCE);
#if defined(CMP_EXA)
                                exa::attn_unit<8>(bh >> 4, h, qb, QKV, (bf16*)(ws + WS_END + 16 * MiB), lds + RING_OFF, KMP, CMP_SL2, CMP_FORCE);
#else
                                exa::attn_unit<8>(bh >> 4, h, qb, QKV, (bf16*)(ws + WS_END + 16 * MiB), lds + RING_OFF, KMP, CMP_SL2, CMP_FORCE);
#endif
                                cmp_unit((const bf16*)(ws + WS_END), (const bf16*)(ws + WS_END + 16 * MiB), bh >> 4, h, qb, CMP_PROBE, ctl + 2048, tid); }
#elif defined(MOBA_OLD)
                            att::attn_unit<true>(bh >> 4, h, qb, QKV, 3072, 1024, 2048, OB, lds + RING_OFF, KMP, sl2);
#else
#if defined(UNIT_OVH_PROBE)
                            if (rep == 1) exa::attn_unit<8>(bh >> 4, h, 0, QKV, (bf16*)(ws + WS_END), lds + RING_OFF, KMP, sl2, 0u); else
#endif
                            exa::attn_unit<8>(bh >> 4, h, qb, QKV, OB, lds + RING_OFF, KMP, sl2, 0u);
#endif
                        }
                    }
                }
                SEAM(pb + 3);
                if ((DBG_MASK & 64) && IN(pb + 4)) for (int rep = 0; rep < NREP(64); ++rep) {
                    pg8::Gemm g{OB, (const bf16*)(ws + (odd ? WS_WO_O : WS_WOUT_E) + (size_t)i2 * D * D * 2), M, D, D}; pg8::StaticOrder S; S.init(M, D, G, bx);
                    pg8::EpiRes E{XB, SS, rep ? 0.0f : 1.0f};
                    pg8::gemm_phase<pg8::EpiRes, pg8::StaticOrder, true, true, GEMM_XDMA>(lds + RING_OFF, g, S, E);
                }
                SEAM(pb + 4);
            }
        }
    }
    if ((DBG_MASK & 128) && IN(N_PHASES - 1)) final_norm(XB, args.out, SS, args.in[16], vcu, G, wave, lane);
#if defined(PT_MASK)
    __syncthreads(); PT_STAMP(N_PHASES - 1);
    if (blockIdx.x == 0 && tid == 0) { const unsigned long long t0 = __builtin_amdgcn_s_memrealtime(), dt = pt_acc * (unsigned long long)(PT_MUL);
        while (__builtin_amdgcn_s_memrealtime() - t0 < dt) __builtin_amdgcn_s_sleep(8); }
#endif
#if defined(P0_TIME_PROBE)
    if (blockIdx.x == 0 && tid == 0) { const unsigned long long t0 = __builtin_amdgcn_s_memrealtime(), dt = p0_dt * (unsigned long long)(P0_TIME_PROBE);
        while (__builtin_amdgcn_s_memrealtime() - t0 < dt) __builtin_amdgcn_s_sleep(8); }
#endif
#if defined(CMP_PROBE)
    xcd_barrier(bar);
    if (blockIdx.x == 0 && tid == 0) { const unsigned w = __hip_atomic_load(ctl + 2048, RLX_AGENT); const unsigned long long t0 = __builtin_amdgcn_s_memrealtime(), dt = (unsigned long long)w * 10000ull;
        while (__builtin_amdgcn_s_memrealtime() - t0 < dt) __builtin_amdgcn_s_sleep(8); }
#endif
#undef IN
#undef SEAM
}

extern "C" void kernel_launch(void* const* d_in, const int* in_sizes, int n_in, void* d_out, int out_size, void* d_ws, size_t ws_size, hipStream_t stream) {
    static int grid = 0;
    if (grid == 0) {
        if (n_in != 17 || in_sizes[0] != M * D || out_size != M * D || ws_size < WS_END) { fprintf(stderr, "kernel_launch: unexpected shapes (n_in %d, in0 %d, out %d, ws %zu); nothing launched\n", n_in, n_in > 0 ? in_sizes[0] : -1, out_size, ws_size); grid = -1; return; }
        int dev = 0, cus = 0, per_cu = 0;
        if (hipGetDevice(&dev) != hipSuccess || hipDeviceGetAttribute(&cus, hipDeviceAttributeMultiprocessorCount, dev) != hipSuccess) { grid = -1; return; }
        if (hipFuncSetAttribute((const void*)mk_fwd, hipFuncAttributeMaxDynamicSharedMemorySize, LDS_BYTES) != hipSuccess) { fprintf(stderr, "kernel_launch: hipFuncSetAttribute failed\n"); grid = -1; return; }
        if (hipOccupancyMaxActiveBlocksPerMultiprocessor(&per_cu, (const void*)mk_fwd, NWAVES * 64, LDS_BYTES) != hipSuccess || per_cu < 1)
            fprintf(stderr, "kernel_launch: note: occupancy query reports %d workgroups per CU\n", per_cu);
        (void)hipGetLastError();
        grid = cus;
    }
    if (grid < 0) return;
    if (hipMemsetAsync((char*)d_ws + WS_CTL, 0, CTL_ZERO_BYTES, stream) != hipSuccess) return;
    Args a{};
    for (int i = 0; i < 17; ++i) a.in[i] = (const float*)d_in[i];
    a.out = (float*)d_out; a.ws = (unsigned char*)d_ws;
#if MK_N_LAUNCHES == 1
    a.ph_lo = 0; a.ph_hi = N_PHASES;
    hipLaunchKernelGGL(mk_fwd, dim3(grid), dim3(NWAVES * 64), LDS_BYTES, stream, a);
#else
    for (int p = 0; p < N_PHASES; ++p) { a.ph_lo = p; a.ph_hi = p + 1; hipLaunchKernelGGL(mk_fwd, dim3(grid), dim3(NWAVES * 64), LDS_BYTES, stream, a); }
#endif
}
```
